# Optimizing an MI355X kernel written in HIP

```python
import math
import jax, jax.numpy as jnp
from jax import lax
import numpy as np


D_MODEL = 2048
BATCH = 4
SEQ = 2048
DEPTH = 2
DEC_BATCH = 128
DEC_SEQ = 4
PAST_LEN = 16384
PAGE_SIZE = 128

LRU_WIDTH = D_MODEL // 2
LRU_BLOCKS = 8
LRU_BS = LRU_WIDTH // LRU_BLOCKS
LRU_C = 8.0
CONV_W = 4
GLA_HEADS = 4
GLA_DK = D_MODEL // 4 // GLA_HEADS
GLA_DV = D_MODEL // 2 // GLA_HEADS
GLA_RANK = 16
GLA_TAU = 16.0
GLA_CHUNK = 64
MLSTM_HEADS = 4
MLSTM_WIDTH = D_MODEL // 2
MLSTM_DH = MLSTM_WIDTH // MLSTM_HEADS
MLSTM_QKV_BS = 4
MLSTM_NB = MLSTM_WIDTH // MLSTM_QKV_BS
MLSTM_CHUNK = 64
D_FF = 4 * D_MODEL
N_BRANCH = 3
EPS = 1e-6
SPLIT_SIZES = (LRU_WIDTH, GLA_HEADS * GLA_DK, GLA_HEADS * GLA_DK, GLA_HEADS * GLA_DV, GLA_RANK,
               GLA_HEADS * GLA_DV, MLSTM_WIDTH, MLSTM_WIDTH, 2 * MLSTM_HEADS, N_BRANCH * D_MODEL)
D_IN = (LRU_WIDTH + 2 * GLA_HEADS * GLA_DK + 2 * GLA_HEADS * GLA_DV + GLA_RANK
        + 2 * MLSTM_WIDTH + 2 * MLSTM_HEADS + N_BRANCH * D_MODEL)

kernel_name = 'hybrid_rglru_gla_mlstm_decoder_step'


def _split_points():
    return [int(v) for v in np.cumsum(SPLIT_SIZES)[:-1]]


def rmsnorm(x, g):
    xf = x.astype(jnp.float32)
    y = xf * lax.rsqrt(jnp.mean(xf * xf, axis=-1, keepdims=True) + EPS)
    return (y * g.astype(jnp.float32)).astype(x.dtype)


def blockdiag(x, w):
    nb, bi, bo = w.shape
    y = jnp.einsum('btnc,ncd->btnd', x.reshape(*x.shape[:-1], nb, bi), w)
    return y.reshape(*x.shape[:-1], nb * bo)


def causal_conv(x, buf, w, b):
    T = x.shape[1]
    xp = jnp.concatenate([buf.astype(x.dtype), x], axis=1)
    y = b + xp[:, 0:T] * w[0]
    for j in range(1, CONV_W):
        y = y + xp[:, j:j + T] * w[j]
    return y, xp[:, -(CONV_W - 1):]


def rglru(x, h0, w_a, b_a, w_x, b_x, lam):
    f32 = jnp.float32
    r = jax.nn.sigmoid((blockdiag(x, w_a) + b_a).astype(f32))
    i = jax.nn.sigmoid((blockdiag(x, w_x) + b_x).astype(f32))
    log_a = LRU_C * r * jax.nn.log_sigmoid(lam.astype(f32))
    a = jnp.exp(log_a)
    u = jnp.sqrt(-jnp.expm1(2.0 * log_a)) * (i * x.astype(f32))

    def step(h, au):
        a_t, u_t = au
        h = a_t * h + u_t
        return h, h

    hT, hs = lax.scan(step, h0.astype(f32), (a.swapaxes(0, 1), u.swapaxes(0, 1)))
    return hs.swapaxes(0, 1), hT


def gla_chunked(q, k, v, g, S0):
    f32 = jnp.float32
    B, T, H, DK = q.shape
    DV = v.shape[-1]
    L = math.gcd(T, GLA_CHUNK)
    nc = T // L

    def chunks(a):
        return a.astype(f32).reshape(B, nc, L, H, a.shape[-1]).transpose(1, 0, 3, 2, 4)

    qc, kc, vc, gc = chunks(q * (DK ** -0.5)), chunks(k), chunks(v), chunks(g)
    mask = jnp.tril(jnp.ones((L, L), dtype=bool))

    def step(S, inp):
        q_, k_, v_, g_ = inp
        b = jnp.cumsum(g_, axis=-2)
        qe = q_ * jnp.exp(b)
        ke = k_ * jnp.exp(-b)
        A = jnp.where(mask, jnp.einsum('bhid,bhjd->bhij', qe, ke), 0.0)
        o = jnp.einsum('bhid,bhde->bhie', qe, S) + jnp.einsum('bhij,bhje->bhie', A, v_)
        bL = b[..., -1:, :]
        S = jnp.exp(bL[..., 0, :])[..., None] * S + jnp.einsum('bhjd,bhje->bhde', k_ * jnp.exp(bL - b), v_)
        return S, o

    ST, o = lax.scan(step, S0.astype(f32), (qc, kc, vc, gc))
    return o.transpose(1, 0, 3, 2, 4).reshape(B, T, H, DV), ST


def mlstm_chunked(q, k, v, ig, fg, C0, n0, m0):
    f32 = jnp.float32
    B, T, H, DH = q.shape
    L = math.gcd(T, MLSTM_CHUNK)
    nc = T // L

    def chunks(a):
        return a.astype(f32).reshape(B, nc, L, H, a.shape[-1]).transpose(1, 0, 3, 2, 4)

    def gchunks(a):
        return a.astype(f32).reshape(B, nc, L, H).transpose(1, 0, 3, 2)

    qc, kc, vc = chunks(q), chunks(k), chunks(v)
    ic, lfc = gchunks(ig), gchunks(jax.nn.log_sigmoid(fg.astype(f32)))
    mask = jnp.tril(jnp.ones((L, L), dtype=bool))

    def step(carry, inp):
        C, n, m = carry
        q_, k_, v_, i_, lf_ = inp
        F = jnp.cumsum(lf_, axis=-1)
        Dm = jnp.where(mask, F[..., :, None] - F[..., None, :] + i_[..., None, :], -jnp.inf)
        inter = F + m[..., None]
        mt = jnp.maximum(inter, jnp.max(Dm, axis=-1))
        W = jnp.exp(Dm - mt[..., None])
        ci = jnp.exp(inter - mt)
        S = jnp.einsum('bhid,bhjd->bhij', q_, k_) * W
        num = ci[..., None] * jnp.einsum('bhid,bhde->bhie', q_, C) + jnp.einsum('bhij,bhje->bhie', S, v_)
        den = ci * jnp.einsum('bhid,bhd->bhi', q_, n) + jnp.sum(S, axis=-1)
        h = num / jnp.maximum(jnp.abs(den), jnp.exp(-mt))[..., None]
        FL = F[..., -1]
        dj = FL[..., None] - F + i_
        m_new = jnp.maximum(FL + m, jnp.max(dj, axis=-1))
        cs = jnp.exp(FL + m - m_new)
        wj = jnp.exp(dj - m_new[..., None])
        C = cs[..., None, None] * C + jnp.einsum('bhj,bhjd,bhje->bhde', wj, k_, v_)
        n = cs[..., None] * n + jnp.einsum('bhj,bhjd->bhd', wj, k_)
        return (C, n, m_new), h

    (CT, nT, mT), h = lax.scan(step, (C0.astype(f32), n0.astype(f32), m0.astype(f32)), (qc, kc, vc, ic, lfc))
    return h.transpose(1, 0, 3, 2, 4).reshape(B, T, H, DH), CT, nT, mT


def mixer(xn, st, P):
    lru_h, lru_conv, gla_S, ml_C, ml_n, ml_m, ml_conv = st
    B, T, _ = xn.shape
    dt = xn.dtype
    proj = xn @ P['w_in']
    (lru_x, g_q, g_k, g_v, g_lr, g_gate, m_x, m_o, m_if, mg) = jnp.split(proj, _split_points(), axis=-1)
    u, lru_conv_new = causal_conv(lru_x, lru_conv, P['lru_conv_w'], P['lru_conv_b'])
    y_lru, lru_h_new = rglru(u, lru_h, P['lru_w_a'], P['lru_b_a'], P['lru_w_x'], P['lru_b_x'], P['lru_lam'])
    y_lru = y_lru.astype(dt)
    q = g_q.reshape(B, T, GLA_HEADS, GLA_DK)
    k = g_k.reshape(B, T, GLA_HEADS, GLA_DK)
    v = g_v.reshape(B, T, GLA_HEADS, GLA_DV)
    logdec = jax.nn.log_sigmoid((g_lr @ P['gla_w_g2'] + P['gla_b_g']).astype(jnp.float32)) / GLA_TAU
    o, gla_S_new = gla_chunked(q, k, v, logdec.reshape(B, T, GLA_HEADS, GLA_DK), gla_S)
    y_gla = rmsnorm(o.astype(dt), P['gla_g_norm']).reshape(B, T, GLA_HEADS * GLA_DV) * jax.nn.silu(g_gate)
    mc, ml_conv_new = causal_conv(m_x, ml_conv, P['ml_conv_w'], P['ml_conv_b'])
    mc = jax.nn.silu(mc)
    mq = blockdiag(mc, P['ml_w_q']).reshape(B, T, MLSTM_HEADS, MLSTM_DH)
    mk = blockdiag(mc, P['ml_w_k']).reshape(B, T, MLSTM_HEADS, MLSTM_DH) * (MLSTM_DH ** -0.5)
    mv = blockdiag(m_x, P['ml_w_v']).reshape(B, T, MLSTM_HEADS, MLSTM_DH)
    gates = (m_if + P['ml_b_if']).astype(jnp.float32)
    h, C_new, n_new, m_new = mlstm_chunked(mq, mk, mv, gates[..., :MLSTM_HEADS], gates[..., MLSTM_HEADS:],
                                           ml_C, ml_n, ml_m)
    y_ml = jax.nn.sigmoid(m_o) * rmsnorm(h.astype(dt), P['ml_g_norm']).reshape(B, T, MLSTM_WIDTH)
    gate = jax.nn.sigmoid(mg).reshape(B, T, N_BRANCH, D_MODEL)
    merged = (gate[:, :, 0] * (y_lru @ P['w_br_lru'])
              + gate[:, :, 1] * (y_gla @ P['w_br_gla'])
              + gate[:, :, 2] * (y_ml @ P['w_br_ml']))
    new_st = (lru_h_new.astype(dt), lru_conv_new.astype(dt), gla_S_new.astype(dt), C_new.astype(dt),
              n_new.astype(dt), m_new.astype(dt), ml_conv_new.astype(dt))
    return merged @ P['w_out'], new_st


def run_trunk(x, c, states, layer_params, g_final):
    new_states = []
    for l in range(DEPTH):
        P = layer_params[l]
        mod = jax.nn.silu(c) @ P['w_ada'] + P['b_ada']
        sh1, sc1, gt1, sh2, sc2, gt2 = [m[:, None, :] for m in jnp.split(mod, 6, axis=-1)]
        xn = rmsnorm(x, P['g_norm1']) * (1.0 + sc1) + sh1
        mix, st = mixer(xn, states[l], P)
        x = x + gt1 * mix
        xn = rmsnorm(x, P['g_norm2']) * (1.0 + sc2) + sh2
        x = x + gt2 * (jnp.square(jax.nn.relu(xn @ P['w_ff1'])) @ P['w_ff2'])
        new_states.append(st)
    y = rmsnorm(x, g_final)
    stacked = [jnp.stack([s[i] for s in new_states]) for i in range(7)]
    return y, stacked


def setup_inputs(seed: int = 0) -> dict:
    key = jax.random.key(seed)
    ks = jax.random.split(key, 48)
    f32 = jnp.float32

    def nrm(i, shape, s):
        return jax.random.normal(ks[i], shape, f32) * s

    a0 = jax.random.uniform(ks[47], (DEPTH, LRU_WIDTH), f32, minval=0.9, maxval=0.999)
    a1 = a0 ** (1.0 / LRU_C)
    b_if = jnp.concatenate([nrm(44, (DEPTH, MLSTM_HEADS), 0.1) - 1.0,
                            3.0 + nrm(45, (DEPTH, MLSTM_HEADS), 0.5)], axis=-1)
    return {
        'x_prompt': nrm(0, (BATCH, SEQ, D_MODEL), 1.0),
        'x_sample': nrm(1, (DEC_BATCH, DEC_SEQ, D_MODEL), 1.0),
        'c_prompt': nrm(2, (BATCH, D_MODEL), 1.0),
        'c_sample': nrm(3, (DEC_BATCH, D_MODEL), 1.0),
        'state_lru_h': nrm(4, (DEPTH, DEC_BATCH, LRU_WIDTH), 0.5),
        'state_lru_conv': nrm(5, (DEPTH, DEC_BATCH, CONV_W - 1, LRU_WIDTH), 1.0),
        'state_gla': nrm(6, (DEPTH, DEC_BATCH, GLA_HEADS, GLA_DK, GLA_DV), 1.0),
        'state_mlstm_C': nrm(7, (DEPTH, DEC_BATCH, MLSTM_HEADS, MLSTM_DH, MLSTM_DH), 0.5),
        'state_mlstm_n': nrm(8, (DEPTH, DEC_BATCH, MLSTM_HEADS, MLSTM_DH), 0.5),
        'state_mlstm_m': nrm(9, (DEPTH, DEC_BATCH, MLSTM_HEADS), 0.5),
        'state_mlstm_conv': nrm(10, (DEPTH, DEC_BATCH, CONV_W - 1, MLSTM_WIDTH), 1.0),
        'w_ada': nrm(11, (DEPTH, D_MODEL, 6 * D_MODEL), 0.2 * D_MODEL ** -0.5),
        'b_ada': nrm(12, (DEPTH, 6 * D_MODEL), 0.02),
        'g_norm1': 1.0 + nrm(13, (DEPTH, D_MODEL), 0.02),
        'g_norm2': 1.0 + nrm(14, (DEPTH, D_MODEL), 0.02),
        'w_in': nrm(15, (DEPTH, D_MODEL, D_IN), D_MODEL ** -0.5),
        'lru_conv_w': nrm(16, (DEPTH, CONV_W, LRU_WIDTH), CONV_W ** -0.5),
        'lru_conv_b': nrm(17, (DEPTH, LRU_WIDTH), 0.02),
        'lru_w_a': nrm(18, (DEPTH, LRU_BLOCKS, LRU_BS, LRU_BS), LRU_BS ** -0.5),
        'lru_b_a': nrm(19, (DEPTH, LRU_WIDTH), 0.02),
        'lru_w_x': nrm(20, (DEPTH, LRU_BLOCKS, LRU_BS, LRU_BS), LRU_BS ** -0.5),
        'lru_b_x': nrm(21, (DEPTH, LRU_WIDTH), 0.02),
        'lru_lam': jnp.log(a1) - jnp.log1p(-a1),
        'gla_w_g2': nrm(22, (DEPTH, GLA_RANK, GLA_HEADS * GLA_DK), GLA_RANK ** -0.5),
        'gla_b_g': nrm(23, (DEPTH, GLA_HEADS * GLA_DK), 0.5),
        'gla_g_norm': 1.0 + nrm(24, (DEPTH, GLA_DV), 0.02),
        'ml_conv_w': nrm(25, (DEPTH, CONV_W, MLSTM_WIDTH), CONV_W ** -0.5),
        'ml_conv_b': nrm(26, (DEPTH, MLSTM_WIDTH), 0.02),
        'ml_w_q': nrm(27, (DEPTH, MLSTM_NB, MLSTM_QKV_BS, MLSTM_QKV_BS), MLSTM_QKV_BS ** -0.5),
        'ml_w_k': nrm(28, (DEPTH, MLSTM_NB, MLSTM_QKV_BS, MLSTM_QKV_BS), MLSTM_QKV_BS ** -0.5),
        'ml_w_v': nrm(29, (DEPTH, MLSTM_NB, MLSTM_QKV_BS, MLSTM_QKV_BS), MLSTM_QKV_BS ** -0.5),
        'ml_b_if': b_if,
        'ml_g_norm': 1.0 + nrm(30, (DEPTH, MLSTM_DH), 0.02),
        'w_br_lru': nrm(31, (DEPTH, LRU_WIDTH, D_MODEL), LRU_WIDTH ** -0.5),
        'w_br_gla': nrm(32, (DEPTH, GLA_HEADS * GLA_DV, D_MODEL), (GLA_HEADS * GLA_DV) ** -0.5),
        'w_br_ml': nrm(33, (DEPTH, MLSTM_WIDTH, D_MODEL), MLSTM_WIDTH ** -0.5),
        'w_out': nrm(34, (DEPTH, D_MODEL, D_MODEL), D_MODEL ** -0.5),
        'w_ff1': nrm(35, (DEPTH, D_MODEL, D_FF), D_MODEL ** -0.5),
        'w_ff2': nrm(36, (DEPTH, D_FF, D_MODEL), D_FF ** -0.5),
        'g_final': 1.0 + nrm(37, (D_MODEL,), 0.02),
    }


def reference(x_prompt, x_sample, c_prompt, c_sample, state_lru_h, state_lru_conv, state_gla,
              state_mlstm_C, state_mlstm_n, state_mlstm_m, state_mlstm_conv,
              w_ada, b_ada, g_norm1, g_norm2, w_in, lru_conv_w, lru_conv_b, lru_w_a, lru_b_a,
              lru_w_x, lru_b_x, lru_lam, gla_w_g2, gla_b_g, gla_g_norm, ml_conv_w, ml_conv_b,
              ml_w_q, ml_w_k, ml_w_v, ml_b_if, ml_g_norm, w_br_lru, w_br_gla, w_br_ml, w_out,
              w_ff1, w_ff2, g_final):
    layer_params = [dict(w_ada=w_ada[l], b_ada=b_ada[l], g_norm1=g_norm1[l], g_norm2=g_norm2[l],
                         w_in=w_in[l], lru_conv_w=lru_conv_w[l], lru_conv_b=lru_conv_b[l],
                         lru_w_a=lru_w_a[l], lru_b_a=lru_b_a[l], lru_w_x=lru_w_x[l], lru_b_x=lru_b_x[l],
                         lru_lam=lru_lam[l], gla_w_g2=gla_w_g2[l], gla_b_g=gla_b_g[l],
                         gla_g_norm=gla_g_norm[l], ml_conv_w=ml_conv_w[l], ml_conv_b=ml_conv_b[l],
                         ml_w_q=ml_w_q[l], ml_w_k=ml_w_k[l], ml_w_v=ml_w_v[l], ml_b_if=ml_b_if[l],
                         ml_g_norm=ml_g_norm[l], w_br_lru=w_br_lru[l], w_br_gla=w_br_gla[l],
                         w_br_ml=w_br_ml[l], w_out=w_out[l], w_ff1=w_ff1[l], w_ff2=w_ff2[l])
                    for l in range(DEPTH)]
    dt = x_prompt.dtype
    zero = (jnp.zeros((BATCH, LRU_WIDTH), dt), jnp.zeros((BATCH, CONV_W - 1, LRU_WIDTH), dt),
            jnp.zeros((BATCH, GLA_HEADS, GLA_DK, GLA_DV), dt),
            jnp.zeros((BATCH, MLSTM_HEADS, MLSTM_DH, MLSTM_DH), dt),
            jnp.zeros((BATCH, MLSTM_HEADS, MLSTM_DH), dt), jnp.zeros((BATCH, MLSTM_HEADS), dt),
            jnp.zeros((BATCH, CONV_W - 1, MLSTM_WIDTH), dt))
    prompt_states = [zero for _ in range(DEPTH)]
    sample_states = [(state_lru_h[l], state_lru_conv[l], state_gla[l], state_mlstm_C[l], state_mlstm_n[l],
                      state_mlstm_m[l], state_mlstm_conv[l]) for l in range(DEPTH)]
    y_prompt, ps = run_trunk(x_prompt, c_prompt, prompt_states, layer_params, g_final)
    y_sample, ss = run_trunk(x_sample, c_sample, sample_states, layer_params, g_final)
    p_lru_h, p_lru_conv, p_gla, p_C, p_n, p_m, p_ml_conv = ps
    s_lru_h, s_lru_conv, s_gla, s_C, s_n, s_m, s_ml_conv = ss
    return (y_prompt, y_sample, p_lru_h, p_lru_conv, p_gla, p_C, p_n, p_m, p_ml_conv,
            s_lru_h, s_lru_conv, s_gla, s_C, s_n, s_m, s_ml_conv)
```

```cpp
#include <hip/hip_runtime.h>
#include <cstdio>
#include <cstdint>

constexpr int D = 2048, DEPTH = 2;
constexpr int NP = 4, TP = 2048, NS = 128, TS = 4;
constexpr int MP = NP * TP, MS = NS * TS, MTOT = MP + MS;
constexpr int NB = NP + NS;
constexpr int DIN = 12312, NPROJ = 12288, NPROJ_PAD = 12544, NSMALL = 24;
constexpr int C_LRUX = 0, C_GQ = 1024, C_GK = 1536, C_GV = 2048, C_GGATE = 3072, C_MX = 4096, C_MO = 5120, C_MG = 6144;
constexpr int DFF = 8192, NADA = 12288, KBR = 3072;
constexpr float EPS = 1e-6f;
#define MK_N_LAUNCHES 19
namespace pg8 {
#define PG8_LAS __attribute__((address_space(3)))
typedef unsigned short bf16_t;
typedef short bf16x8 __attribute__((ext_vector_type(8)));
typedef float f32x4 __attribute__((ext_vector_type(4)));
typedef unsigned u32x4 __attribute__((ext_vector_type(4)));
constexpr int BM = 256, BK = 64, HALF = 128, HTB = HALF * BK * 2  , STAGE_BYTES = 8 * HTB, NXCD = 8, WGM = 8;

__host__ __device__ __forceinline__ int lds_byte(int r, int c) { const int st = (r >> 4) * 2 + (c >> 5), rr = r & 15, cc = c & 31, ob = rr * 64 + cc * 2; return st * 1024 + (ob ^ (((ob >> 9) & 1) << 5)); }
__host__ __device__ __forceinline__ void stage_rc(int b, int& R, int& C) { const int st = b / 1024, sb = b % 1024, swz = sb ^ (((sb >> 9) & 1) << 5); R = (st >> 1) * 16 + swz / 64; C = (st & 1) * 32 + (swz % 64) / 2; }
__host__ __device__ __forceinline__ int perm32(int rho) { const int n = rho >> 4, i = rho & 15; return 8 * (i >> 2) + 4 * n + (i & 3); }

struct Unit { int pm, pn; };
struct Gemm { const bf16_t* A; const bf16_t* Bt; int M, N, K, lda, ldb; };

struct StaticOrder {
    int nM, nN, nwg, G, c;
    __host__ __device__ void init(int M, int N, int G_, int c_) { nM = M / BM; nN = N / BM; nwg = nM * nN; G = G_; c = c_; }
    __host__ __device__ bool next(int i, Unit& u) const {
        const long L = (long)i * G + c; if (L >= nwg) return false;
        int wgid = (int)L; { const int q = nwg / NXCD, r = nwg % NXCD, xcd = wgid % NXCD, off = wgid / NXCD; wgid = (xcd < r ? xcd * (q + 1) : r * (q + 1) + (xcd - r) * q) + off; }
        const int nig = WGM * nN, gid = wgid / nig, fm = gid * WGM, gsz = (nM - fm) < WGM ? (nM - fm) : WGM;
        u.pm = fm + ((wgid % nig) % gsz); u.pn = (wgid % nig) / gsz; return true;
    }
    __device__ __forceinline__ void a_ready(const Unit&) const {}
    __device__ __forceinline__ void done(const Unit&) const {}
};

__device__ __forceinline__ unsigned cvt_pk_bf16(float lo, float hi) { unsigned r; asm volatile("v_cvt_pk_bf16_f32 %0, %1, %2" : "=v"(r) : "v"(lo), "v"(hi)); return r; }
__device__ __forceinline__ float bflo(unsigned w) { return __uint_as_float(w << 16); }
__device__ __forceinline__ float bfhi(unsigned w) { return __uint_as_float(w & 0xffff0000u); }

#define PG8_COORDS() int tz_ = threadIdx.x; asm volatile("" : "+v"(tz_)); const int wid_ = __builtin_amdgcn_readfirstlane(tz_ >> 6); \
    const int wr = wid_ >> 2, wc = wid_ & 3, fr = tz_ & 15, fq = (tz_ & 63) >> 4

struct EpiF32 {
    static constexpr bool PERM = false, AFTER_DRAIN = false; static constexpr int NMID = 0, MID1 = -1, MID2 = -1;
    float* C; int ldc; const float* bias;
    __device__ __forceinline__ void operator()(const f32x4 (&acc)[2][2][4][2], const Unit& u, int, int, int, int) const {
        PG8_COORDS();
        const int row0 = u.pm * BM + wr * 64 + fr, col0 = u.pn * BM + wc * 32 + 4 * fq;
        f32x4 bv[2][2];
#pragma unroll
        for (int bj = 0; bj < 2; ++bj)
#pragma unroll
            for (int n = 0; n < 2; ++n) bv[bj][n] = bias ? *(const f32x4*)(bias + col0 + bj * HALF + n * 16) : (f32x4){0.f, 0.f, 0.f, 0.f};
#pragma unroll
        for (int ai = 0; ai < 2; ++ai)
#pragma unroll
            for (int m = 0; m < 4; ++m) { float* rowp = C + (size_t)(row0 + ai * HALF + m * 16) * ldc + col0;
#pragma unroll
                for (int bj = 0; bj < 2; ++bj)
#pragma unroll
                    for (int n = 0; n < 2; ++n) *(f32x4*)(rowp + bj * HALF + n * 16) = acc[ai][bj][m][n] + bv[bj][n]; }
    }
    __device__ __forceinline__ void mid(f32x4 (&)[2][2][4][2], const Unit&, int, int, int, int, int) const {}
};

struct EpiProj {
    static constexpr bool PERM = true, AFTER_DRAIN = false; static constexpr int NMID = 0, MID1 = -1, MID2 = -1;
    bf16_t* O; float* sm;
    __device__ __forceinline__ void operator()(const f32x4 (&acc)[2][2][4][2], const Unit& u, int, int, int, int) const {
        PG8_COORDS();
        const int row0 = u.pm * BM + wr * 64 + fr;
        if (u.pn < 48) {
            const int col0 = u.pn * BM + wc * 32 + 8 * fq;
#pragma unroll
            for (int ai = 0; ai < 2; ++ai)
#pragma unroll
                for (int m = 0; m < 4; ++m) { bf16_t* rowp = O + (size_t)(row0 + ai * HALF + m * 16) * 12288 + col0;
#pragma unroll
                    for (int bj = 0; bj < 2; ++bj) { const f32x4 v0 = acc[ai][bj][m][0], v1 = acc[ai][bj][m][1];
                        u32x4 w; w.x = cvt_pk_bf16(v0[0], v0[1]); w.y = cvt_pk_bf16(v0[2], v0[3]); w.z = cvt_pk_bf16(v1[0], v1[1]); w.w = cvt_pk_bf16(v1[2], v1[3]);
                        *(u32x4*)(rowp + bj * HALF) = w; } }
        } else {
#pragma unroll
            for (int ai = 0; ai < 2; ++ai)
#pragma unroll
                for (int m = 0; m < 4; ++m) { float* rowp = sm + (size_t)(row0 + ai * HALF + m * 16) * 24;
#pragma unroll
                    for (int n = 0; n < 2; ++n) { const int c = wc * 32 + 8 * fq + 4 * n;
                        if (c < 24) *(f32x4*)(rowp + c) = acc[ai][0][m][n]; } }
        }
    }
    __device__ __forceinline__ void mid(f32x4 (&)[2][2][4][2], const Unit&, int, int, int, int, int) const {}
};

struct EpiMerge {
    static constexpr bool PERM = true, AFTER_DRAIN = false; static constexpr int NMID = 2, MID1 = 16, MID2 = 32;
    const bf16_t* proj; bf16_t* O;
    static __device__ __forceinline__ void ld8(const bf16_t* p, float (&z)[8]) { const u32x4 w = *(const u32x4*)p;
        z[0] = bflo(w.x); z[1] = bfhi(w.x); z[2] = bflo(w.y); z[3] = bfhi(w.y); z[4] = bflo(w.z); z[5] = bfhi(w.z); z[6] = bflo(w.w); z[7] = bfhi(w.w); }
    static __device__ __forceinline__ float en(float z) { z = fminf(fmaxf(z, -30.f), 30.f); return __expf(-z); }
    __device__ __forceinline__ void mid(f32x4 (&acc)[2][2][4][2], const Unit& u, int t, int, int, int, int) const {
        PG8_COORDS();
        const int b = (t == MID1) ? 0 : 1;
        int row0 = u.pm * BM + wr * 64 + fr, col0 = u.pn * BM + wc * 32 + 8 * fq;
        asm volatile("" : "+v"(row0), "+v"(col0));
#pragma unroll
        for (int ai = 0; ai < 2; ++ai)
#pragma unroll
            for (int m = 0; m < 4; ++m) { const bf16_t* rowp = proj + (size_t)(row0 + ai * HALF + m * 16) * 12288 + 6144 + 2048 * b + col0;
#pragma unroll
                for (int bj = 0; bj < 2; ++bj) { float za[8], zb[8]; ld8(rowp + bj * HALF, za); ld8(rowp + 2048 + bj * HALF, zb);
#pragma unroll
                    for (int j = 0; j < 8; ++j) { const float r = (1.f + en(zb[j])) / (1.f + en(za[j]));
                        acc[ai][bj][m][j >> 2][j & 3] *= r; } }
                asm volatile("" ::: "memory"); }
    }
    __device__ __forceinline__ void operator()(const f32x4 (&acc)[2][2][4][2], const Unit& u, int, int, int, int) const {
        PG8_COORDS();
        const int row0 = u.pm * BM + wr * 64 + fr, col0 = u.pn * BM + wc * 32 + 8 * fq;
#pragma unroll
        for (int ai = 0; ai < 2; ++ai)
#pragma unroll
            for (int m = 0; m < 4; ++m) { const size_t r = (size_t)(row0 + ai * HALF + m * 16); const bf16_t* gp = proj + r * 12288 + 6144 + 4096 + col0; bf16_t* op = O + r * 2048 + col0;
#pragma unroll
                for (int bj = 0; bj < 2; ++bj) { float z[8], v[8]; ld8(gp + bj * HALF, z);
#pragma unroll
                    for (int j = 0; j < 8; ++j) v[j] = acc[ai][bj][m][j >> 2][j & 3] / (1.f + en(z[j]));
                    u32x4 w; w.x = cvt_pk_bf16(v[0], v[1]); w.y = cvt_pk_bf16(v[2], v[3]); w.z = cvt_pk_bf16(v[4], v[5]); w.w = cvt_pk_bf16(v[6], v[7]);
                    *(u32x4*)(op + bj * HALF) = w; }
                asm volatile("" ::: "memory"); }
    }
};

struct EpiResid {
    static constexpr bool PERM = false, AFTER_DRAIN = false; static constexpr int NMID = 0, MID1 = -1, MID2 = -1;
    const float* base_p; const float* base_s; float* out; const float* gate;
    __device__ __forceinline__ void operator()(const f32x4 (&acc)[2][2][4][2], const Unit& u, int, int, int, int) const {
        PG8_COORDS();
        const int row0 = u.pm * BM + wr * 64 + fr, col0 = u.pn * BM + wc * 32 + 4 * fq;
#pragma unroll
        for (int ai = 0; ai < 2; ++ai)
#pragma unroll
            for (int m = 0; m < 4; ++m) { const int row = row0 + ai * HALF + m * 16;
                const int cond = row < 8192 ? (row >> 11) : 4 + ((row - 8192) >> 2);
                const float* bp = (row < 8192 ? base_p + (size_t)row * 2048 : base_s + (size_t)(row - 8192) * 2048) + col0;
                const float* gp = gate + (size_t)cond * 24576 + col0; float* op = out + (size_t)row * 2048 + col0;
#pragma unroll
                for (int bj = 0; bj < 2; ++bj)
#pragma unroll
                    for (int n = 0; n < 2; ++n) { const f32x4 bs = *(const f32x4*)(bp + bj * HALF + n * 16), gt = *(const f32x4*)(gp + bj * HALF + n * 16);
                        *(f32x4*)(op + bj * HALF + n * 16) = bs + gt * acc[ai][bj][m][n]; }
                asm volatile("" ::: "memory"); }
    }
    __device__ __forceinline__ void mid(f32x4 (&)[2][2][4][2], const Unit&, int, int, int, int, int) const {}
};

struct EpiRelu2 {
    static constexpr bool PERM = true, AFTER_DRAIN = false; static constexpr int NMID = 0, MID1 = -1, MID2 = -1;
    bf16_t* O; int ldc;
    __device__ __forceinline__ void operator()(const f32x4 (&acc)[2][2][4][2], const Unit& u, int, int, int, int) const {
        PG8_COORDS();
        const int row0 = u.pm * BM + wr * 64 + fr, col0 = u.pn * BM + wc * 32 + 8 * fq;
#pragma unroll
        for (int ai = 0; ai < 2; ++ai)
#pragma unroll
            for (int m = 0; m < 4; ++m) { bf16_t* rowp = O + (size_t)(row0 + ai * HALF + m * 16) * ldc + col0;
#pragma unroll
                for (int bj = 0; bj < 2; ++bj) { f32x4 v0 = acc[ai][bj][m][0], v1 = acc[ai][bj][m][1];
#pragma unroll
                    for (int j = 0; j < 4; ++j) { const float a = fmaxf(v0[j], 0.f), b = fmaxf(v1[j], 0.f); v0[j] = a * a; v1[j] = b * b; }
                    u32x4 w; w.x = cvt_pk_bf16(v0[0], v0[1]); w.y = cvt_pk_bf16(v0[2], v0[3]); w.z = cvt_pk_bf16(v1[0], v1[1]); w.w = cvt_pk_bf16(v1[2], v1[3]);
                    *(u32x4*)(rowp + bj * HALF) = w; } }
    }
    __device__ __forceinline__ void mid(f32x4 (&)[2][2][4][2], const Unit&, int, int, int, int, int) const {}
};

template <class Epi, class Sched, bool STAMP = false>
__device__ __forceinline__ void gemm_phase(PG8_LAS unsigned char* lds, const Gemm g, const Sched& S, const Epi& E, unsigned long long* stamps) {
    int tid_ = threadIdx.x; asm volatile("" : "+v"(tid_));
    const int tid = tid_, wid = __builtin_amdgcn_readfirstlane(tid >> 6), lane = tid & 63, wr = wid >> 2, wc = wid & 3, fr = lane & 15, fq = lane >> 4;
    const int K = g.K, nt = K / BK;
    int ts_lo = 0, ts_hi = 0, nts = 0; const unsigned long long rt_entry = STAMP ? (unsigned long long)wall_clock64() : 0ull;
#define PG8_STAMP() do { if (STAMP && wid == 0 && nts < 64) { const unsigned long long _c = (unsigned long long)clock64(); \
        ts_lo = (lane == nts) ? (int)(unsigned)_c : ts_lo; ts_hi = (lane == nts) ? (int)(unsigned)(_c >> 32) : ts_hi; ++nts; } } while (0)
    PG8_STAMP();
    unsigned voffA[2], voffB[2];
#pragma unroll
    for (int i = 0; i < 2; ++i) { int R, C; stage_rc(tid * 16 + i * 8192, R, C); const int Rb = Epi::PERM ? ((R & ~31) + perm32(R & 31)) : R;
        voffA[i] = (unsigned)(R * g.lda + C) * 2u; voffB[i] = (unsigned)(Rb * g.ldb + C) * 2u; }
    const size_t kstep = (size_t)(BK * 2);
    const size_t hstepA = (size_t)HALF * g.lda * 2, hstepB = (size_t)HALF * g.ldb * 2;
    const size_t tstepA = 2 * hstepA, tstepB = 2 * hstepB;
    const unsigned ldsw = (unsigned)wid * 1024u;
    const int aoff = lds_byte(wr * 64 + fr, fq * 8), boff = lds_byte(wc * 32 + fr, fq * 8);
#define PG8_SA(b, h) (((b) * 2 + (h)) * HTB)
#define PG8_SB(b, h) ((4 + (b) * 2 + (h)) * HTB)
#define PG8_STAGE(bufoff, gbase, voff) do { _Pragma("unroll") for (int _i = 0; _i < 2; ++_i) \
        __builtin_amdgcn_global_load_lds((const unsigned*)((const char*)(gbase) + (voff)[_i]), (PG8_LAS unsigned*)(lds + (bufoff) + ldsw + _i * 8192), 16, 0, 0); } while (0)
#define PG8_LDA(dst, b, h) do { _Pragma("unroll") for (int m = 0; m < 4; ++m) _Pragma("unroll") for (int k = 0; k < 2; ++k) dst[m][k] = *(const PG8_LAS bf16x8*)(lds + PG8_SA(b, h) + aoff + m * 2048 + k * 1024); } while (0)
#define PG8_LDB(dst, b, h) do { _Pragma("unroll") for (int n = 0; n < 2; ++n) _Pragma("unroll") for (int k = 0; k < 2; ++k) dst[n][k] = *(const PG8_LAS bf16x8*)(lds + PG8_SB(b, h) + boff + n * 2048 + k * 1024); } while (0)
#define PG8_MMA(ai, bj, At, Bt) do { __builtin_amdgcn_s_setprio(1); _Pragma("unroll") for (int m = 0; m < 4; ++m) _Pragma("unroll") for (int n = 0; n < 2; ++n) _Pragma("unroll") for (int k = 0; k < 2; ++k) \
        acc[ai][bj][m][n] = __builtin_amdgcn_mfma_f32_16x16x32_bf16(Bt[n][k], At[m][k], acc[ai][bj][m][n], 0, 0, 0); __builtin_amdgcn_s_setprio(0); } while (0)
#define PG8_WAIT_V(n) asm volatile("s_waitcnt vmcnt(" #n ")" ::: "memory")
#define PG8_WAIT_L(n) asm volatile("s_waitcnt lgkmcnt(" #n ")" ::: "memory")
#define PG8_BAR __builtin_amdgcn_s_barrier()
#define PG8_SCHED __builtin_amdgcn_sched_barrier(0)
    Unit cur, nxt; int ui = 0;
    if (!S.next(0, cur)) return;
    f32x4 acc[2][2][4][2];
#pragma unroll
    for (int a = 0; a < 2; ++a)
#pragma unroll
        for (int b = 0; b < 2; ++b)
#pragma unroll
            for (int m = 0; m < 4; ++m)
#pragma unroll
                for (int n = 0; n < 2; ++n) acc[a][b][m][n] = (f32x4){0.f, 0.f, 0.f, 0.f};
    bf16x8 At[4][2], B0[2][2], B1[2][2];
    const char* cA = (const char*)g.A + (size_t)cur.pm * tstepA; const char* cB = (const char*)g.Bt + (size_t)cur.pn * tstepB;
    S.a_ready(cur);
    PG8_STAGE(PG8_SB(0, 0), cB, voffB); PG8_STAGE(PG8_SA(0, 0), cA, voffA); PG8_STAGE(PG8_SB(0, 1), cB + hstepB, voffB); PG8_STAGE(PG8_SA(0, 1), cA + hstepA, voffA);
    if (wr == 1) PG8_BAR;
    PG8_WAIT_V(4); PG8_BAR;
    PG8_STAGE(PG8_SB(1, 0), cB + kstep, voffB); PG8_STAGE(PG8_SA(1, 0), cA + kstep, voffA); PG8_STAGE(PG8_SB(1, 1), cB + hstepB + kstep, voffB);
    PG8_WAIT_V(6); PG8_BAR;
    PG8_STAMP();
    for (;;) {
        const bool has_next = S.next(ui + 1, nxt);
        const char* nA = has_next ? (const char*)g.A + (size_t)nxt.pm * tstepA : cA; const char* nB = has_next ? (const char*)g.Bt + (size_t)nxt.pn * tstepB : cB;
        for (int t = 0; t < nt; t += 2) {
            const bool last = (t == nt - 2);
            const char* a1 = cA + (size_t)(t + 1) * kstep;
            const char* a2 = last ? nA : cA + (size_t)(t + 2) * kstep; const char* b2 = last ? nB : cB + (size_t)(t + 2) * kstep;
            const char* a3 = a2 + kstep; const char* b3 = b2 + kstep;
            if (last && has_next) S.a_ready(nxt);
            if constexpr (Epi::NMID > 0) { if (t == Epi::MID1 || t == Epi::MID2) E.mid(acc, cur, t, wr, wc, fr, fq); }
            PG8_LDB(B0, 0, 0); PG8_SCHED; PG8_LDA(At, 0, 0); PG8_STAGE(PG8_SA(1, 1), a1 + hstepA, voffA);
            PG8_WAIT_L(8); PG8_BAR; PG8_WAIT_L(0); PG8_MMA(0, 0, At, B0); PG8_BAR; PG8_SCHED;
            PG8_LDB(B1, 0, 1); PG8_STAGE(PG8_SB(0, 0), b2, voffB);
            PG8_BAR; PG8_WAIT_L(0); PG8_MMA(0, 1, At, B1); PG8_BAR;
            PG8_LDA(At, 0, 1); PG8_STAGE(PG8_SA(0, 0), a2, voffA);
            PG8_BAR; PG8_WAIT_L(0); PG8_MMA(1, 0, At, B0); PG8_BAR; PG8_SCHED;
            PG8_STAGE(PG8_SB(0, 1), b2 + hstepB, voffB);
            PG8_WAIT_V(6); PG8_BAR; PG8_MMA(1, 1, At, B1); PG8_BAR;
            PG8_LDB(B0, 1, 0); PG8_SCHED; PG8_LDA(At, 1, 0); PG8_STAGE(PG8_SA(0, 1), a2 + hstepA, voffA);
            PG8_WAIT_L(8); PG8_BAR; PG8_WAIT_L(0); PG8_MMA(0, 0, At, B0); PG8_BAR; PG8_SCHED;
            PG8_LDB(B1, 1, 1); PG8_STAGE(PG8_SB(1, 0), b3, voffB);
            PG8_BAR; PG8_WAIT_L(0); PG8_MMA(0, 1, At, B1); PG8_BAR;
            PG8_LDA(At, 1, 1); PG8_STAGE(PG8_SA(1, 0), a3, voffA);
            PG8_BAR; PG8_WAIT_L(0); PG8_MMA(1, 0, At, B0); PG8_BAR; PG8_SCHED;
            PG8_STAGE(PG8_SB(1, 1), b3 + hstepB, voffB);
            PG8_WAIT_V(6); PG8_BAR; PG8_MMA(1, 1, At, B1); PG8_BAR;
        }
        PG8_STAMP();
        if constexpr (!Epi::AFTER_DRAIN) { E(acc, cur, wr, wc, fr, fq); S.done(cur); }
        PG8_STAMP();
        if (!has_next) break;
#pragma unroll
        for (int a = 0; a < 2; ++a)
#pragma unroll
            for (int b = 0; b < 2; ++b)
#pragma unroll
                for (int m = 0; m < 4; ++m)
#pragma unroll
                    for (int n = 0; n < 2; ++n) acc[a][b][m][n] = (f32x4){0.f, 0.f, 0.f, 0.f};
        cur = nxt; cA = nA; cB = nB; ++ui;
    }
    PG8_WAIT_V(0);
    if (wr == 0) PG8_BAR;
    PG8_BAR;
    if constexpr (Epi::AFTER_DRAIN) { E.fused(acc, cur, wr, wc, fr, fq, lds, wid, lane); S.done(cur); }
    PG8_STAMP();
    if (STAMP && wid == 0) { stamps[lane] = lane < nts ? (((unsigned long long)(unsigned)ts_hi << 32) | (unsigned)ts_lo) : 0ull;
        if (lane == 62) stamps[62] = rt_entry; if (lane == 63) stamps[63] = (unsigned long long)wall_clock64(); }
#undef PG8_STAMP
#undef PG8_SA
#undef PG8_SB
#undef PG8_STAGE
#undef PG8_LDA
#undef PG8_LDB
#undef PG8_MMA
#undef PG8_WAIT_V
#undef PG8_WAIT_L
#undef PG8_BAR
#undef PG8_SCHED
}
}

#define GAS __attribute__((address_space(1)))
#define LAS __attribute__((address_space(3)))
#define DI __device__ __forceinline__
typedef unsigned short bf16;
typedef unsigned v4u __attribute__((ext_vector_type(4)));
typedef unsigned v2u __attribute__((ext_vector_type(2)));
typedef float f32x4 __attribute__((ext_vector_type(4)));
#define RLX_AGENT __ATOMIC_RELAXED, __HIP_MEMORY_SCOPE_AGENT
#define LDS_WAIT() asm volatile("s_waitcnt lgkmcnt(0)" ::: "memory")

constexpr int NWAVES = 8, NTHREADS = 512, GRID = 256;
#ifndef MK_N_LAUNCHES
#define MK_N_LAUNCHES 1
#endif
constexpr int PH_TOTAL = 19;
constexpr int N_LAUNCHES = MK_N_LAUNCHES;

constexpr size_t O_YP = 0, O_YS = O_YP + (size_t)MP * D, O_P_LRUH = O_YS + (size_t)MS * D, O_P_LRUC = O_P_LRUH + (size_t)DEPTH * NP * 1024,
    O_P_GLA = O_P_LRUC + (size_t)DEPTH * NP * 3 * 1024, O_P_C = O_P_GLA + (size_t)DEPTH * NP * 4 * 128 * 256, O_P_N = O_P_C + (size_t)DEPTH * NP * 4 * 256 * 256,
    O_P_M = O_P_N + (size_t)DEPTH * NP * 4 * 256, O_P_MLC = O_P_M + (size_t)DEPTH * NP * 4, O_S_LRUH = O_P_MLC + (size_t)DEPTH * NP * 3 * 1024,
    O_S_LRUC = O_S_LRUH + (size_t)DEPTH * NS * 1024, O_S_GLA = O_S_LRUC + (size_t)DEPTH * NS * 3 * 1024, O_S_C = O_S_GLA + (size_t)DEPTH * NS * 4 * 128 * 256,
    O_S_N = O_S_C + (size_t)DEPTH * NS * 4 * 256 * 256, O_S_M = O_S_N + (size_t)DEPTH * NS * 4 * 256, O_S_MLC = O_S_M + (size_t)DEPTH * NS * 4,
    O_END = O_S_MLC + (size_t)DEPTH * NS * 3 * 1024;
static_assert(O_END == 123798560, "output size");

constexpr size_t MiB = 1u << 20;
constexpr size_t WS_CTL = 0, CTL_ZERO_BYTES = 1 * MiB;
constexpr size_t WS_WADA = 2 * MiB, WS_WIN = 98 * MiB, WS_WBR = 196 * MiB, WS_WOUT = 220 * MiB, WS_WFF1 = 236 * MiB, WS_WFF2 = 300 * MiB;
constexpr size_t WS_CSILU = 364 * MiB, WS_MOD = 365 * MiB, WS_XA = 389 * MiB, WS_XB = 457 * MiB, WS_XN = 525 * MiB, WS_MERGED = 559 * MiB, WS_YCAT = 593 * MiB,
    WS_SMALL = 644 * MiB, WS_PROJ = 645 * MiB, WS_HFF = 849 * MiB, WS_END = 985 * MiB;
static_assert(WS_WADA + (size_t)2 * NADA * D * 2 <= WS_WIN && WS_WIN + (size_t)2 * NPROJ_PAD * D * 2 <= WS_WBR && WS_WBR + (size_t)2 * D * KBR * 2 <= WS_WOUT &&
              WS_WOUT + (size_t)2 * D * D * 2 <= WS_WFF1 && WS_WFF1 + (size_t)2 * DFF * D * 2 <= WS_WFF2 && WS_WFF2 + (size_t)2 * DFF * D * 2 <= WS_CSILU &&
              WS_CSILU + (size_t)256 * D * 2 <= WS_MOD && WS_MOD + (size_t)256 * 2 * NADA * 4 <= WS_XA && WS_XA + (size_t)MTOT * D * 4 <= WS_XB && WS_XB + (size_t)MTOT * D * 4 <= WS_XN &&
              WS_XN + (size_t)MTOT * D * 2 <= WS_MERGED && WS_MERGED + (size_t)MTOT * D * 2 <= WS_YCAT && WS_YCAT + (size_t)MTOT * KBR * 2 <= WS_SMALL &&
              WS_SMALL + (size_t)MTOT * NSMALL * 4 <= WS_PROJ && WS_PROJ + (size_t)MTOT * NPROJ * 2 <= WS_HFF && WS_HFF + (size_t)MTOT * DFF * 2 <= WS_END, "d_ws map");
constexpr int CW_BAR = 4096;

constexpr int RING_OFF = 0, RING_BYTES = 131072;
constexpr int LDSCTL_OFF = RING_BYTES, MISC_OFF = LDSCTL_OFF + 320;
constexpr int LDS_BYTES = 147456;

DI float bf2f(bf16 b) { return __uint_as_float(((unsigned)b) << 16); }
DI unsigned f2bf(float f) { unsigned u = __float_as_uint(f); return (u + 0x7fffu + ((u >> 16) & 1u)) >> 16; }
DI unsigned pk2(float lo, float hi) { return f2bf(lo) | (f2bf(hi) << 16); }
DI float sigm(float x) { return 1.f / (1.f + expf(-x)); }
DI float logsig(float x) { return fminf(x, 0.f) - log1pf(expf(-fabsf(x))); }
DI float wave_sum(float v) {
#pragma unroll
    for (int o = 1; o < 64; o <<= 1) v += __shfl_xor(v, o);
    return v;
}

#define XB_TMO      128
#define XB_XCNT(j)  (256  + 64 * (j))
#define XB_XSUB(j)  (1280 + 64 * (j))
#define XB_XGEN(j)  (2304 + 64 * (j))
#define XB_TOP      3328
#define XB_TOPGEN   3392
#define XCD_BAR_WORDS 3456
#define XB_SPIN_CAP (1u << 18)

__device__ __forceinline__ unsigned xb_ld(unsigned* p)              { return __hip_atomic_load(p, __ATOMIC_RELAXED, __HIP_MEMORY_SCOPE_AGENT); }
__device__ __forceinline__ unsigned xb_add(unsigned* p, unsigned v) { return __hip_atomic_fetch_add(p, v, __ATOMIC_RELAXED, __HIP_MEMORY_SCOPE_AGENT); }
__device__ __forceinline__ unsigned xb_xcc_id() { return (unsigned)__builtin_amdgcn_s_getreg((3 << 11) | 20) & 0xFu; }
#define XB_SPIN(cond, bar) do { unsigned _sp = 0; while (cond) { __builtin_amdgcn_s_sleep(1); \
    if ((++_sp & 255u) == 0u) { if (xb_ld(&(bar)[XB_TMO])) break; if (_sp > XB_SPIN_CAP) { atomicAdd(&(bar)[XB_TMO], 1u); break; } } } } while (0)

struct XcdBarrier {
    unsigned* bar; unsigned x;
    volatile LAS unsigned* st;
};
__device__ __forceinline__ XcdBarrier xcd_barrier_post(unsigned* bar, volatile LAS unsigned* st) {
    XcdBarrier b; b.bar = bar; b.x = xb_xcc_id(); b.st = st;
    if (threadIdx.x == 0) (void)xb_add(&bar[XB_XCNT(b.x)], 1u);
    return b;
}
__device__ __forceinline__ void xcd_barrier_complete(unsigned* bar, unsigned x, unsigned& nloc, unsigned& nx) {
    const unsigned G = gridDim.x * gridDim.y * gridDim.z;
    unsigned sum, cnt, mine, sp = 0u;
    for (;;) {
        sum = 0u; cnt = 0u; mine = 0u;
#pragma unroll
        for (unsigned j = 0; j < 16; ++j) { const unsigned c = xb_ld(&bar[XB_XCNT(j)]); sum += c; cnt += (c > 0u) ? 1u : 0u; mine = (j == x) ? c : mine; }
        if (sum == G) break;
        __builtin_amdgcn_s_sleep(1);
        if ((++sp & 255u) == 0u) { if (xb_ld(&bar[XB_TMO])) break; if (sp > XB_SPIN_CAP) { atomicAdd(&bar[XB_TMO], 1u); break; } }
    }
    nloc = mine > 0u ? mine : 1u; nx = cnt > 0u ? cnt : 1u;
}
__device__ __forceinline__ void xcd_barrier(const XcdBarrier& b) {
    asm volatile("s_waitcnt vmcnt(0)" ::: "memory");
    __syncthreads();
    if (threadIdx.x == 0) {
        unsigned* bar = b.bar;
        __builtin_amdgcn_s_waitcnt(0);
        unsigned nloc = b.st[0], nx = b.st[1];
        if (nloc == 0u) { xcd_barrier_complete(bar, b.x, nloc, nx); b.st[0] = nloc; b.st[1] = nx; }
        const unsigned old = xb_add(&bar[XB_XSUB(b.x)], 1u);
        const unsigned gen = old / nloc;
        if (old + 1u == (gen + 1u) * nloc) {
            __builtin_amdgcn_fence(__ATOMIC_RELEASE, "agent");
            asm volatile("s_waitcnt vmcnt(0)" ::: "memory");
            const unsigned og = xb_add(&bar[XB_TOP], 1u);
            const unsigned tg = og / nx;
            if (og + 1u == (tg + 1u) * nx) xb_add(&bar[XB_TOPGEN], 1u);
            else XB_SPIN(xb_ld(&bar[XB_TOPGEN]) == tg, bar);
            __builtin_amdgcn_fence(__ATOMIC_ACQUIRE, "agent");
            xb_add(&bar[XB_XGEN(b.x)], 1u);
            asm volatile("s_waitcnt vmcnt(0)" ::: "memory");
        } else {
            XB_SPIN(xb_ld(&bar[XB_XGEN(b.x)]) == gen, bar);
            __builtin_amdgcn_fence(__ATOMIC_ACQUIRE, "agent");
            asm volatile("s_waitcnt vmcnt(0)" ::: "memory");
        }
    }
    __syncthreads();
}

struct Args { const float* in[40]; float* out; unsigned char* ws; int ph_lo, ph_hi, li, pad; };
typedef __attribute__((address_space(4))) const Args CArgs;
__device__ __forceinline__ CArgs* kargs() { CArgs* p = (CArgs*)__builtin_amdgcn_kernarg_segment_ptr(); asm volatile("" : "+s"(p)); return p; }

DI void transpose_item(const float* src, int src_ld, int ncols, bf16* dst, int dst_ld, LAS float* scr, int item, int lane) {
    const int nblk = ncols / 32, kb = item / nblk, nb = item % nblk, k0 = 64 * kb, n0 = 32 * nb;
#pragma unroll 8
    for (int i = 0; i < 32; ++i) { const int kk = 2 * i + (lane >> 5); scr[kk * 33 + (lane & 31)] = src[(size_t)(k0 + kk) * src_ld + n0 + (lane & 31)]; }
    LDS_WAIT(); asm volatile("" ::: "memory");
    const int c = lane & 7;
#pragma unroll
    for (int j = 0; j < 4; ++j) { const int n = (lane >> 3) + 8 * j; const LAS float* s = scr + (8 * c) * 33 + n;
        v4u o; o.x = pk2(s[0 * 33], s[1 * 33]); o.y = pk2(s[2 * 33], s[3 * 33]); o.z = pk2(s[4 * 33], s[5 * 33]); o.w = pk2(s[6 * 33], s[7 * 33]);
        *(v4u*)(dst + (size_t)(n0 + n) * dst_ld + k0 + 8 * c) = o; }
    LDS_WAIT(); asm volatile("" ::: "memory");
}
DI void transpose_job(const float* src, int src_ld, int K, int ncols, bf16* dst, int dst_ld, LAS float* scr, int gw, int ngw, int lane) {
    const int nitems = (K / 64) * (ncols / 32);
    for (int it = gw; it < nitems; it += ngw) transpose_item(src, src_ld, ncols, dst, dst_ld, scr, it, lane);
}

DI void norm_rows(const float* xp, const float* xs, const float* g, const float* modp  ,
                  bf16* out_bf, float* outp, float* outs, int gw, int ngw, int lane) {
    for (int row = gw; row < MTOT; row += ngw) {
        const float* xr = row < MP ? xp + (size_t)row * D : xs + (size_t)(row - MP) * D;
        const f32x4* x4 = (const f32x4*)xr + lane;
        f32x4 v[8]; float ss = 0.f;
#pragma unroll
        for (int j = 0; j < 8; ++j) { v[j] = x4[64 * j]; ss += (v[j].x * v[j].x + v[j].y * v[j].y) + (v[j].z * v[j].z + v[j].w * v[j].w); }
        ss = wave_sum(ss);
        const float r = 1.f / sqrtf(ss * (1.f / D) + EPS);
        const int cond = row < MP ? (row >> 11) : NP + ((row - MP) >> 2);
        const f32x4* g4 = (const f32x4*)g + lane;
#pragma unroll
        for (int j = 0; j < 8; ++j) {
            f32x4 y = v[j] * r * g4[64 * j];
            if (modp) { const f32x4* m4 = (const f32x4*)(modp + (size_t)cond * 24576) + lane; const f32x4 sh = m4[64 * j], sc = m4[512 + 64 * j]; y = y * (1.f + sc) + sh; }
            if (out_bf) { v2u w; w.x = pk2(y.x, y.y); w.y = pk2(y.z, y.w); *((v2u*)(out_bf + (size_t)row * D) + lane + 64 * j) = w; }
            else { float* o = row < MP ? outp + (size_t)row * D : outs + (size_t)(row - MP) * D; *((f32x4*)o + lane + 64 * j) = y; }
        }
    }
}

DI float* out_state(float* out, int s, int l, size_t off_p, size_t off_s, size_t per) {
    return s < NP ? out + off_p + ((size_t)l * NP + s) * per : out + off_s + ((size_t)l * NS + (s - NP)) * per;
}

DI void lru_unit(int l, bool prompt, int grp, int n, LAS float* lds, int tid) {
    CArgs* A = kargs();
    LAS float* u_s = lds; LAS float* a_s = lds + 2048; LAS float* v_s = lds + 4096;
    const bf16* proj = (const bf16*)(A->ws + WS_PROJ); bf16* ycat = (bf16*)(A->ws + WS_YCAT);
    const float* cw = A->in[16] + (size_t)l * 4 * 1024; const float* cb = A->in[17] + (size_t)l * 1024;
    const float* wa = A->in[18] + ((size_t)l * 8 + n) * 128 * 128; const float* ba = A->in[19] + (size_t)l * 1024 + n * 128;
    const float* wx = A->in[20] + ((size_t)l * 8 + n) * 128 * 128; const float* bx = A->in[21] + (size_t)l * 1024 + n * 128;
    const float* lam = A->in[22] + (size_t)l * 1024 + n * 128;
    const float* st_h = A->in[4]; const float* st_c = A->in[5];
    const int ntiles = prompt ? TP / 16 : 1;
    const int c = tid & 127, rg = tid >> 7, ch = n * 128 + c;
    float h = 0.f;
    for (int tile = 0; tile < ntiles; ++tile) {
        {
            const float w0 = cw[ch], w1 = cw[1024 + ch], w2 = cw[2048 + ch], w3 = cw[3072 + ch], bb = cb[ch];
#pragma unroll
            for (int q = 0; q < 4; ++q) {
                const int r = 4 * rg + q;
                int s, t, T, row0;
                if (prompt) { s = grp; t = tile * 16 + r; T = TP; row0 = grp * TP; } else { s = NP + 4 * grp + (r >> 2); t = r & 3; T = TS; row0 = MP + (4 * grp + (r >> 2)) * TS; }
                float x[4];
#pragma unroll
                for (int jj = 0; jj < 4; ++jj) { const int tp = t - 3 + jj;
                    if (tp >= 0) x[jj] = bf2f(proj[(size_t)(row0 + tp) * NPROJ + C_LRUX + ch]);
                    else x[jj] = prompt ? 0.f : st_c[(((size_t)l * NS + (s - NP)) * 3 + (3 + tp)) * 1024 + ch]; }
                u_s[r * 128 + c] = bb + w0 * x[0] + w1 * x[1] + w2 * x[2] + w3 * x[3];
                if (t >= T - 3) out_state(A->out, s, l, O_P_LRUC, O_S_LRUC, 3 * 1024)[(size_t)(t - (T - 3)) * 1024 + ch] = x[3];
            }
        }
        __syncthreads();
        {
            float aa[4], ax[4];
#pragma unroll
            for (int q = 0; q < 4; ++q) { aa[q] = ba[c]; ax[q] = bx[c]; }
            for (int cc = 0; cc < 128; ++cc) { const float wa_ = wa[cc * 128 + c], wx_ = wx[cc * 128 + c];
#pragma unroll
                for (int q = 0; q < 4; ++q) { const float uq = u_s[(4 * rg + q) * 128 + cc]; aa[q] += uq * wa_; ax[q] += uq * wx_; } }
            const float ls = logsig(lam[c]);
#pragma unroll
            for (int q = 0; q < 4; ++q) { const int r = 4 * rg + q; const float rr = sigm(aa[q]), ii = sigm(ax[q]), la = 8.f * rr * ls;
                a_s[r * 128 + c] = expf(la); v_s[r * 128 + c] = sqrtf(-expm1f(2.f * la)) * (ii * u_s[r * 128 + c]); }
        }
        __syncthreads();
        if (prompt) {
            if (tid < 128) {
#pragma unroll 4
                for (int r = 0; r < 16; ++r) { h = a_s[r * 128 + c] * h + v_s[r * 128 + c];
                    ycat[(size_t)(grp * TP + tile * 16 + r) * KBR + ch] = (bf16)f2bf(h); }
            }
        } else {
            const int b = 4 * grp + rg; float hh = st_h[((size_t)l * NS + b) * 1024 + ch];
#pragma unroll
            for (int t = 0; t < 4; ++t) { const int r = rg * 4 + t; hh = a_s[r * 128 + c] * hh + v_s[r * 128 + c];
                ycat[(size_t)(MP + b * TS + t) * KBR + ch] = (bf16)f2bf(hh); }
            A->out[O_S_LRUH + ((size_t)l * NS + b) * 1024 + ch] = hh;
        }
    }
    if (prompt && tid < 128) A->out[O_P_LRUH + ((size_t)l * NP + grp) * 1024 + ch] = h;
    __syncthreads();
}

DI void gla_unit(int l, int s, int hh, LAS float* lds, int tid, int lane, int wave) {
    CArgs* A = kargs();
    const bool prompt = s < NP; const int T = prompt ? TP : TS, row0 = prompt ? s * TP : MP + (s - NP) * TS;
    const bf16* proj = (const bf16*)(A->ws + WS_PROJ); bf16* ycat = (bf16*)(A->ws + WS_YCAT); const float* sm = (const float*)(A->ws + WS_SMALL);
    const float* wg2 = A->in[23] + (size_t)l * 16 * 512; const float* bg = A->in[24] + (size_t)l * 512; const float* gn = A->in[25] + (size_t)l * 256;
    LAS float* eg_s = lds; LAS float* q_s = lds + 1024; LAS float* k_s = lds + 2048; LAS float* v_s = lds + 3072; LAS float* o_s = lds + 5120;
    const int e = 32 * wave + (lane & 31), dh = lane >> 5;
    float S[64];
    if (prompt) {
#pragma unroll
        for (int dd = 0; dd < 64; ++dd) S[dd] = 0.f;
    } else { const float* sp = A->in[6] + ((((size_t)l * NS + (s - NP)) * 4 + hh) * 128 + 64 * dh) * 256 + e;
#pragma unroll
        for (int dd = 0; dd < 64; ++dd) S[dd] = sp[(size_t)dd * 256]; }
    for (int t0 = 0; t0 < T; t0 += 8) {
        const int nb = (T - t0) < 8 ? (T - t0) : 8;
        for (int i = tid; i < nb * 128; i += NTHREADS) { const int tb = i >> 7, d = i & 127, col = hh * 128 + d; const size_t row = (size_t)(row0 + t0 + tb);
            float z = bg[col];
#pragma unroll
            for (int r = 0; r < 16; ++r) z += sm[row * NSMALL + r] * wg2[r * 512 + col];
            eg_s[i] = expf(logsig(z) * (1.f / 16.f));
            q_s[i] = bf2f(proj[row * NPROJ + C_GQ + col]) * 0.08838834764831845f;
            k_s[i] = bf2f(proj[row * NPROJ + C_GK + col]); }
        for (int i = tid; i < nb * 256; i += NTHREADS) { const int tb = i >> 8, ee = i & 255; v_s[i] = bf2f(proj[(size_t)(row0 + t0 + tb) * NPROJ + C_GV + hh * 256 + ee]); }
        __syncthreads();
        for (int tb = 0; tb < nb; ++tb) {
            const float ve = v_s[tb * 256 + e]; float po = 0.f;
            const LAS float* egp = eg_s + tb * 128 + 64 * dh; const LAS float* kp = k_s + tb * 128 + 64 * dh; const LAS float* qp = q_s + tb * 128 + 64 * dh;
#pragma unroll
            for (int d4 = 0; d4 < 16; ++d4) { const f32x4 eg4 = *(const LAS f32x4*)(egp + 4 * d4), k4 = *(const LAS f32x4*)(kp + 4 * d4), q4 = *(const LAS f32x4*)(qp + 4 * d4);
                S[4 * d4 + 0] = eg4.x * S[4 * d4 + 0] + k4.x * ve; po += q4.x * S[4 * d4 + 0];
                S[4 * d4 + 1] = eg4.y * S[4 * d4 + 1] + k4.y * ve; po += q4.y * S[4 * d4 + 1];
                S[4 * d4 + 2] = eg4.z * S[4 * d4 + 2] + k4.z * ve; po += q4.z * S[4 * d4 + 2];
                S[4 * d4 + 3] = eg4.w * S[4 * d4 + 3] + k4.w * ve; po += q4.w * S[4 * d4 + 3];
                if ((d4 & 3) == 3) asm volatile("" ::: "memory"); }
            po += __shfl_xor(po, 32);
            if (dh == 0) o_s[tb * 256 + e] = po;
        }
        __syncthreads();
        if (wave < nb) { const int tb = wave; const size_t row = (size_t)(row0 + t0 + tb);
            const f32x4 ov = *(const LAS f32x4*)(o_s + tb * 256 + 4 * lane);
            float ss = (ov.x * ov.x + ov.y * ov.y) + (ov.z * ov.z + ov.w * ov.w); ss = wave_sum(ss);
            const float rs = 1.f / sqrtf(ss * (1.f / 256.f) + EPS);
            const f32x4 g4 = *(const f32x4*)(gn + 4 * lane);
            const v2u gw = *(const v2u*)(proj + row * NPROJ + C_GGATE + hh * 256 + 4 * lane);
            const float z0 = __uint_as_float(gw.x << 16), z1 = __uint_as_float(gw.x & 0xffff0000u), z2 = __uint_as_float(gw.y << 16), z3 = __uint_as_float(gw.y & 0xffff0000u);
            v2u w; w.x = pk2(ov.x * rs * g4.x * (z0 * sigm(z0)), ov.y * rs * g4.y * (z1 * sigm(z1))); w.y = pk2(ov.z * rs * g4.z * (z2 * sigm(z2)), ov.w * rs * g4.w * (z3 * sigm(z3)));
            *(v2u*)(ycat + row * KBR + 1024 + hh * 256 + 4 * lane) = w; }
    }
    { float* op = out_state(A->out, s, l, O_P_GLA, O_S_GLA, 4 * 128 * 256) + ((size_t)hh * 128 + 64 * dh) * 256 + e;
#pragma unroll
      for (int dd = 0; dd < 64; ++dd) op[(size_t)dd * 256] = S[dd]; }
    __syncthreads();
}

DI void ml_unit(int l, int s, int hh, LAS float* lds, int tid, int lane, int wave) {
    CArgs* A = kargs();
    const bool prompt = s < NP; const int T = prompt ? TP : TS, row0 = prompt ? s * TP : MP + (s - NP) * TS;
    const bf16* proj = (const bf16*)(A->ws + WS_PROJ); bf16* ycat = (bf16*)(A->ws + WS_YCAT); const float* sm = (const float*)(A->ws + WS_SMALL);
    const float* mcw = A->in[26] + (size_t)l * 4 * 1024; const float* mcb = A->in[27] + (size_t)l * 1024;
    const float* wq = A->in[28] + (size_t)l * 256 * 16; const float* wk = A->in[29] + (size_t)l * 256 * 16; const float* wv = A->in[30] + (size_t)l * 256 * 16;
    const float* bif = A->in[31] + (size_t)l * 8; const float* gn = A->in[32] + (size_t)l * 256;
    LAS float* mx_s = lds; LAS float* mc_s = lds + 2816; LAS float* q_s = lds + 4864; LAS float* k_s = lds + 6912; LAS float* v_s = lds + 8960; LAS float* h_s = lds + 11008;
    LAS float* ig_s = lds + 13056; LAS float* lf_s = lds + 13064;
    const int e = 32 * wave + (lane & 31), dh = lane >> 5;
    float C[128]; float nn[4]; float m;
    if (prompt) {
#pragma unroll
        for (int dd = 0; dd < 128; ++dd) C[dd] = 0.f;
        nn[0] = nn[1] = nn[2] = nn[3] = 0.f; m = 0.f;
    } else { const size_t bh = ((size_t)l * NS + (s - NP)) * 4 + hh; const float* cp = A->in[7] + (bh * 256 + 128 * dh) * 256 + e;
#pragma unroll
        for (int dd = 0; dd < 128; ++dd) C[dd] = cp[(size_t)dd * 256];
        const f32x4 n4 = *(const f32x4*)(A->in[8] + bh * 256 + 4 * lane); nn[0] = n4.x; nn[1] = n4.y; nn[2] = n4.z; nn[3] = n4.w; m = A->in[9][bh]; }
    float* out_mlc = out_state(A->out, s, l, O_P_MLC, O_S_MLC, 3 * 1024);
    for (int t0 = 0; t0 < T; t0 += 8) {
        const int nb = (T - t0) < 8 ? (T - t0) : 8;
        for (int i = tid; i < (nb + 3) * 256; i += NTHREADS) { const int tr = i >> 8, c = i & 255, tp = t0 - 3 + tr, ch = hh * 256 + c;
            float x;
            if (tp >= 0) x = bf2f(proj[(size_t)(row0 + tp) * NPROJ + C_MX + ch]);
            else x = prompt ? 0.f : A->in[10][(((size_t)l * NS + (s - NP)) * 3 + (3 + tp)) * 1024 + ch];
            mx_s[i] = x;
            if (tp >= T - 3) out_mlc[(size_t)(tp - (T - 3)) * 1024 + ch] = x; }
        __syncthreads();
        for (int i = tid; i < nb * 256; i += NTHREADS) { const int tb = i >> 8, c = i & 255, ch = hh * 256 + c;
            float acc = mcb[ch];
#pragma unroll
            for (int j = 0; j < 4; ++j) acc += mcw[j * 1024 + ch] * mx_s[(tb + j) * 256 + c];
            mc_s[i] = acc * sigm(acc); }
        __syncthreads();
        for (int i = tid; i < nb * 256; i += NTHREADS) { const int tb = i >> 8, c = i & 255, nq = c >> 2, dq = c & 3, wb = (64 * hh + nq) * 16 + dq;
            float q = 0.f, k = 0.f, v = 0.f;
#pragma unroll
            for (int cc = 0; cc < 4; ++cc) { const float mcv = mc_s[tb * 256 + 4 * nq + cc], mxv = mx_s[(tb + 3) * 256 + 4 * nq + cc];
                q += mcv * wq[wb + 4 * cc]; k += mcv * wk[wb + 4 * cc]; v += mxv * wv[wb + 4 * cc]; }
            q_s[i] = q; k_s[i] = k * 0.0625f; v_s[i] = v; }
        if (tid < nb) { const size_t row = (size_t)(row0 + t0 + tid);
            ig_s[tid] = sm[row * NSMALL + 16 + hh] + bif[hh]; lf_s[tid] = logsig(sm[row * NSMALL + 20 + hh] + bif[4 + hh]); }
        __syncthreads();
        for (int tb = 0; tb < nb; ++tb) {
            const float lf = lf_s[tb], ig = ig_s[tb];
            const float mnew = fmaxf(lf + m, ig), fdec = expf(lf + m - mnew), iw = expf(ig - mnew); m = mnew;
            const f32x4 k4 = *(const LAS f32x4*)(k_s + tb * 256 + 4 * lane), q4 = *(const LAS f32x4*)(q_s + tb * 256 + 4 * lane);
            nn[0] = fdec * nn[0] + iw * k4.x; nn[1] = fdec * nn[1] + iw * k4.y; nn[2] = fdec * nn[2] + iw * k4.z; nn[3] = fdec * nn[3] + iw * k4.w;
            const float den = wave_sum((q4.x * nn[0] + q4.y * nn[1]) + (q4.z * nn[2] + q4.w * nn[3]));
            const float ve = v_s[tb * 256 + e] * iw; float pn = 0.f;
            const LAS float* kp = k_s + tb * 256 + 128 * dh; const LAS float* qp = q_s + tb * 256 + 128 * dh;
#pragma unroll
            for (int d4 = 0; d4 < 32; ++d4) { const f32x4 k4v = *(const LAS f32x4*)(kp + 4 * d4), q4v = *(const LAS f32x4*)(qp + 4 * d4);
                C[4 * d4 + 0] = fdec * C[4 * d4 + 0] + k4v.x * ve; pn += q4v.x * C[4 * d4 + 0];
                C[4 * d4 + 1] = fdec * C[4 * d4 + 1] + k4v.y * ve; pn += q4v.y * C[4 * d4 + 1];
                C[4 * d4 + 2] = fdec * C[4 * d4 + 2] + k4v.z * ve; pn += q4v.z * C[4 * d4 + 2];
                C[4 * d4 + 3] = fdec * C[4 * d4 + 3] + k4v.w * ve; pn += q4v.w * C[4 * d4 + 3];
                if ((d4 & 3) == 3) asm volatile("" ::: "memory"); }
            pn += __shfl_xor(pn, 32);
            if (dh == 0) h_s[tb * 256 + e] = pn / fmaxf(fabsf(den), expf(-m));
        }
        __syncthreads();
        if (wave < nb) { const int tb = wave; const size_t row = (size_t)(row0 + t0 + tb);
            const f32x4 hv = *(const LAS f32x4*)(h_s + tb * 256 + 4 * lane);
            float ss = (hv.x * hv.x + hv.y * hv.y) + (hv.z * hv.z + hv.w * hv.w); ss = wave_sum(ss);
            const float rs = 1.f / sqrtf(ss * (1.f / 256.f) + EPS);
            const f32x4 g4 = *(const f32x4*)(gn + 4 * lane);
            const v2u ow = *(const v2u*)(proj + row * NPROJ + C_MO + hh * 256 + 4 * lane);
            const float z0 = __uint_as_float(ow.x << 16), z1 = __uint_as_float(ow.x & 0xffff0000u), z2 = __uint_as_float(ow.y << 16), z3 = __uint_as_float(ow.y & 0xffff0000u);
            v2u w; w.x = pk2(sigm(z0) * (hv.x * rs * g4.x), sigm(z1) * (hv.y * rs * g4.y)); w.y = pk2(sigm(z2) * (hv.z * rs * g4.z), sigm(z3) * (hv.w * rs * g4.w));
            *(v2u*)(ycat + row * KBR + 2048 + hh * 256 + 4 * lane) = w; }
    }
    { float* cp = out_state(A->out, s, l, O_P_C, O_S_C, 4 * 256 * 256) + ((size_t)hh * 256 + 128 * dh) * 256 + e;
#pragma unroll
      for (int dd = 0; dd < 128; ++dd) cp[(size_t)dd * 256] = C[dd];
      if (wave == 0) { f32x4 n4; n4.x = nn[0]; n4.y = nn[1]; n4.z = nn[2]; n4.w = nn[3]; *(f32x4*)(out_state(A->out, s, l, O_P_N, O_S_N, 4 * 256) + hh * 256 + 4 * lane) = n4; }
      if (tid == 0) out_state(A->out, s, l, O_P_M, O_S_M, 4)[hh] = m; }
    __syncthreads();
}

#ifndef EN_PRO
#define EN_PRO 1
#endif
#ifndef EN_MOD
#define EN_MOD 1
#endif
#ifndef EN_NORM
#define EN_NORM 1
#endif
#ifndef EN_PROJ
#define EN_PROJ 1
#endif
#ifndef EN_MIX
#define EN_MIX 1
#endif
#ifndef EN_MERGE
#define EN_MERGE 1
#endif
#ifndef EN_OUT
#define EN_OUT 1
#endif
#ifndef EN_FF1
#define EN_FF1 1
#endif
#ifndef EN_FF2
#define EN_FF2 1
#endif
#ifndef EN_ML
#define EN_ML 1
#endif
#ifndef EN_GLA
#define EN_GLA 1
#endif
#ifndef EN_LRU
#define EN_LRU 1
#endif
#define WSP(T, off) ((T*)(ws + (off)))
__global__ void __launch_bounds__(NTHREADS, 2) mk_fwd(Args a_unused) {
    extern __shared__ __attribute__((aligned(16))) unsigned char lds_raw[];
    LAS unsigned char* lds = (LAS unsigned char*)lds_raw;
    const int bid = blockIdx.x;
    constexpr int G = GRID, ngw = GRID * NWAVES;
#define TIDS() int tid_ = threadIdx.x; asm volatile("" : "+v"(tid_)); const int tid = tid_, lane = tid & 63, wave = __builtin_amdgcn_readfirstlane(tid >> 6), gw = bid * NWAVES + wave; (void)lane; (void)gw
    for (int u = threadIdx.x; u < (LDS_BYTES - LDSCTL_OFF) / 4; u += NTHREADS) ((LAS unsigned*)(lds + LDSCTL_OFF))[u] = 0u;
    __syncthreads();
    int lo, hi;
    { CArgs* A = kargs(); lo = A->ph_lo; hi = A->ph_hi;
      if (hi - lo > 1) (void)xcd_barrier_post((unsigned*)(A->ws + WS_CTL) + CW_BAR + A->li * XCD_BAR_WORDS, (volatile LAS unsigned*)(lds + MISC_OFF) + 8); }
#define IN(k) (lo <= (k) && (k) < hi)
#define SEAM(k) do { if (IN(k) && IN((k) + 1)) { CArgs* Ab = kargs(); XcdBarrier bar; bar.bar = (unsigned*)(Ab->ws + WS_CTL) + CW_BAR + Ab->li * XCD_BAR_WORDS; bar.x = xb_xcc_id(); \
        bar.st = (volatile LAS unsigned*)(lds + MISC_OFF) + 8; xcd_barrier(bar); } } while (0)

    if (EN_PRO && IN(0)) {
        TIDS(); CArgs* A = kargs(); unsigned char* const ws = A->ws;
        LAS float* scr = (LAS float*)(lds + RING_OFF + wave * 16384);
        for (int l = 0; l < DEPTH; ++l) {
            const float* w_in = A->in[15] + (size_t)l * D * DIN; bf16* wt_in = WSP(bf16, WS_WIN) + (size_t)l * NPROJ_PAD * D;
            transpose_job(w_in, DIN, D, 3072, wt_in, D, scr, gw, ngw, lane);
            transpose_job(w_in + 3088, DIN, D, 3072, wt_in + (size_t)3072 * D, D, scr, gw, ngw, lane);
            transpose_job(w_in + 6168, DIN, D, 6144, wt_in + (size_t)6144 * D, D, scr, gw, ngw, lane);
            transpose_job(A->in[11] + (size_t)l * D * NADA, NADA, D, NADA, WSP(bf16, WS_WADA) + (size_t)l * NADA * D, D, scr, gw, ngw, lane);
            bf16* wt_br = WSP(bf16, WS_WBR) + (size_t)l * D * KBR;
            transpose_job(A->in[33] + (size_t)l * 1024 * D, D, 1024, D, wt_br, KBR, scr, gw, ngw, lane);
            transpose_job(A->in[34] + (size_t)l * 1024 * D, D, 1024, D, wt_br + 1024, KBR, scr, gw, ngw, lane);
            transpose_job(A->in[35] + (size_t)l * 1024 * D, D, 1024, D, wt_br + 2048, KBR, scr, gw, ngw, lane);
            transpose_job(A->in[36] + (size_t)l * D * D, D, D, D, WSP(bf16, WS_WOUT) + (size_t)l * D * D, D, scr, gw, ngw, lane);
            transpose_job(A->in[37] + (size_t)l * D * DFF, DFF, D, DFF, WSP(bf16, WS_WFF1) + (size_t)l * DFF * D, D, scr, gw, ngw, lane);
            transpose_job(A->in[38] + (size_t)l * DFF * D, D, DFF, D, WSP(bf16, WS_WFF2) + (size_t)l * D * DFF, DFF, scr, gw, ngw, lane);
            for (int i = bid * NTHREADS + tid; i < 256 * D; i += G * NTHREADS) { const int j = i >> 11, k = i & 2047;
                const float v = j < 24 ? w_in[(size_t)k * DIN + (j < 16 ? 3072 + j : 6160 + (j - 16))] : 0.f;
                wt_in[(size_t)(NPROJ + j) * D + k] = (bf16)f2bf(v); }
        }
        bf16* csilu = WSP(bf16, WS_CSILU);
        for (int i = bid * NTHREADS + tid; i < 256 * D; i += G * NTHREADS) { const int r = i >> 11, c = i & 2047;
            float v = 0.f;
            if (r < NP) v = A->in[2][r * D + c]; else if (r < NB) v = A->in[3][(r - NP) * D + c];
            csilu[i] = (bf16)f2bf(r < NB ? v * sigm(v) : 0.f); }
    }
    SEAM(0);

    if (EN_MOD && IN(1)) {
        CArgs* A = kargs(); unsigned char* const ws = A->ws;
        pg8::Gemm g{WSP(bf16, WS_CSILU), WSP(bf16, WS_WADA), 256, 2 * NADA, D, D, D}; pg8::StaticOrder S; S.init(256, 2 * NADA, G, bid);
        pg8::EpiF32 E{WSP(float, WS_MOD), 2 * NADA, A->in[12]};
        pg8::gemm_phase<pg8::EpiF32, pg8::StaticOrder>(lds + RING_OFF, g, S, E, nullptr);
    }
    SEAM(1);

    for (int l = 0; l < DEPTH; ++l) {
        const int pb = 2 + 8 * l;
        if (EN_NORM && IN(pb + 0)) { TIDS(); CArgs* A = kargs(); unsigned char* const ws = A->ws;
            const float* xin_p = l == 0 ? A->in[0] : WSP(float, WS_XB); const float* xin_s = l == 0 ? A->in[1] : WSP(float, WS_XB) + (size_t)MP * D;
            norm_rows(xin_p, xin_s, A->in[13] + (size_t)l * D, WSP(float, WS_MOD) + (size_t)l * NADA, WSP(bf16, WS_XN), nullptr, nullptr, gw, ngw, lane); }
        SEAM(pb + 0);
        if (EN_PROJ && IN(pb + 1)) { CArgs* A = kargs(); unsigned char* const ws = A->ws;
            pg8::Gemm g{WSP(bf16, WS_XN), WSP(bf16, WS_WIN) + (size_t)l * NPROJ_PAD * D, MTOT, NPROJ_PAD, D, D, D}; pg8::StaticOrder S; S.init(MTOT, NPROJ_PAD, G, bid);
            pg8::EpiProj E{WSP(bf16, WS_PROJ), WSP(float, WS_SMALL)};
            pg8::gemm_phase<pg8::EpiProj, pg8::StaticOrder>(lds + RING_OFF, g, S, E, nullptr); }
        SEAM(pb + 1);
        if (EN_MIX && IN(pb + 2)) {
            TIDS();
            LAS float* fl = (LAS float*)(lds + RING_OFF);
            const int first = bid, step = bid < 64 ? (1 << 20) : (G - 64);
            for (int u = first; u < 64 + 1280; u += step) {
                int type, p0, p1; bool prm = true;
                if (u < 16) { type = 0; p0 = u >> 2; p1 = u & 3; }
                else if (u < 32) { type = 1; p0 = (u - 16) >> 2; p1 = u & 3; }
                else if (u < 64) { type = 2; p0 = (u - 32) >> 3; p1 = u & 7; }
                else { const int v = u - 64; prm = false;
                    if (v < 512) { type = 0; p0 = NP + (v >> 2); p1 = v & 3; }
                    else if (v < 1024) { type = 1; p0 = NP + ((v - 512) >> 2); p1 = v & 3; }
                    else { type = 2; p0 = (v - 1024) >> 3; p1 = v & 7; } }
                if (type == 0) { if (EN_ML) ml_unit(l, p0, p1, fl, tid, lane, wave); }
                else if (type == 1) { if (EN_GLA) gla_unit(l, p0, p1, fl, tid, lane, wave); }
                else { if (EN_LRU) lru_unit(l, prm, p0, p1, fl, tid); }
            }
        }
        SEAM(pb + 2);
        if (EN_MERGE && IN(pb + 3)) { CArgs* A = kargs(); unsigned char* const ws = A->ws;
            pg8::Gemm g{WSP(bf16, WS_YCAT), WSP(bf16, WS_WBR) + (size_t)l * D * KBR, MTOT, D, KBR, KBR, KBR}; pg8::StaticOrder S; S.init(MTOT, D, G, bid);
            pg8::EpiMerge E{WSP(bf16, WS_PROJ), WSP(bf16, WS_MERGED)};
            pg8::gemm_phase<pg8::EpiMerge, pg8::StaticOrder>(lds + RING_OFF, g, S, E, nullptr); }
        SEAM(pb + 3);
        if (EN_OUT && IN(pb + 4)) { CArgs* A = kargs(); unsigned char* const ws = A->ws;
            const float* xin_p = l == 0 ? A->in[0] : WSP(float, WS_XB); const float* xin_s = l == 0 ? A->in[1] : WSP(float, WS_XB) + (size_t)MP * D;
            pg8::Gemm g{WSP(bf16, WS_MERGED), WSP(bf16, WS_WOUT) + (size_t)l * D * D, MTOT, D, D, D, D}; pg8::StaticOrder S; S.init(MTOT, D, G, bid);
            pg8::EpiResid E{xin_p, xin_s, WSP(float, WS_XA), WSP(float, WS_MOD) + (size_t)l * NADA + 4096};
            pg8::gemm_phase<pg8::EpiResid, pg8::StaticOrder>(lds + RING_OFF, g, S, E, nullptr); }
        SEAM(pb + 4);
        if (EN_NORM && IN(pb + 5)) { TIDS(); CArgs* A = kargs(); unsigned char* const ws = A->ws;
            norm_rows(WSP(float, WS_XA), WSP(float, WS_XA) + (size_t)MP * D, A->in[14] + (size_t)l * D, WSP(float, WS_MOD) + (size_t)l * NADA + 6144, WSP(bf16, WS_XN), nullptr, nullptr, gw, ngw, lane); }
        SEAM(pb + 5);
        if (EN_FF1 && IN(pb + 6)) { CArgs* A = kargs(); unsigned char* const ws = A->ws;
            pg8::Gemm g{WSP(bf16, WS_XN), WSP(bf16, WS_WFF1) + (size_t)l * DFF * D, MTOT, DFF, D, D, D}; pg8::StaticOrder S; S.init(MTOT, DFF, G, bid);
            pg8::EpiRelu2 E{WSP(bf16, WS_HFF), DFF};
            pg8::gemm_phase<pg8::EpiRelu2, pg8::StaticOrder>(lds + RING_OFF, g, S, E, nullptr); }
        SEAM(pb + 6);
        if (EN_FF2 && IN(pb + 7)) { CArgs* A = kargs(); unsigned char* const ws = A->ws;
            pg8::Gemm g{WSP(bf16, WS_HFF), WSP(bf16, WS_WFF2) + (size_t)l * D * DFF, MTOT, D, DFF, DFF, DFF}; pg8::StaticOrder S; S.init(MTOT, D, G, bid);
            pg8::EpiResid E{WSP(float, WS_XA), WSP(float, WS_XA) + (size_t)MP * D, WSP(float, WS_XB), WSP(float, WS_MOD) + (size_t)l * NADA + 10240};
            pg8::gemm_phase<pg8::EpiResid, pg8::StaticOrder>(lds + RING_OFF, g, S, E, nullptr); }
        SEAM(pb + 7);
    }
    if (EN_NORM && IN(18)) { TIDS(); CArgs* A = kargs(); unsigned char* const ws = A->ws;
        norm_rows(WSP(float, WS_XB), WSP(float, WS_XB) + (size_t)MP * D, A->in[39], nullptr, nullptr, A->out + O_YP, A->out + O_YS, gw, ngw, lane); }
#undef IN
#undef SEAM
}

extern "C" void kernel_launch(void* const* d_in, const int* in_sizes, int n_in, void* d_out, int out_size, void* d_ws, size_t ws_size, hipStream_t stream) {
    static int grid = 0;
    if (grid == 0) {
        if (n_in != 40 || (size_t)out_size != O_END || ws_size < WS_END) { fprintf(stderr, "kernel_launch: unexpected shapes (n_in %d, out %d, ws %zu); nothing launched\n", n_in, out_size, ws_size); grid = -1; return; }
        if (hipFuncSetAttribute((const void*)mk_fwd, hipFuncAttributeMaxDynamicSharedMemorySize, LDS_BYTES) != hipSuccess) { fprintf(stderr, "kernel_launch: hipFuncSetAttribute failed\n"); grid = -1; return; }
        int per_cu = 0;
        if (hipOccupancyMaxActiveBlocksPerMultiprocessor(&per_cu, (const void*)mk_fwd, NTHREADS, LDS_BYTES) != hipSuccess || per_cu < 1)
            fprintf(stderr, "kernel_launch: note: occupancy query reports %d workgroups per CU\n", per_cu);
        (void)hipGetLastError();
        grid = GRID;
    }
    if (grid < 0) return;
    if (hipMemsetAsync((char*)d_ws + WS_CTL, 0, CTL_ZERO_BYTES, stream) != hipSuccess) { fprintf(stderr, "kernel_launch: hipMemsetAsync failed\n"); return; }
    Args a{};
    for (int i = 0; i < 40; ++i) a.in[i] = (const float*)d_in[i];
    a.out = (float*)d_out; a.ws = (unsigned char*)d_ws; a.pad = 0;
    for (int li = 0; li < N_LAUNCHES; ++li) {
        if (N_LAUNCHES == 1) { a.ph_lo = 0; a.ph_hi = PH_TOTAL; } else { a.ph_lo = li; a.ph_hi = li + 1; }
        a.li = (N_LAUNCHES == 1) ? 0 : 0;
        hipLaunchKernelGGL(mk_fwd, dim3(grid), dim3(NTHREADS), LDS_BYTES, stream, a);
        const hipError_t le = hipPeekAtLastError();
        if (le != hipSuccess) { fprintf(stderr, "kernel_launch: launch %d failed: %s\n", li, hipGetErrorName(le)); break; }
    }
}
```

```cpp
#include <hip/hip_runtime.h>
#include <cstdio>
#include <cstdint>

constexpr int D = 2048, DEPTH = 2;
constexpr int NP = 4, TP = 2048, NS = 128, TS = 4;
constexpr int MP = NP * TP, MS = NS * TS, MTOT = MP + MS;
constexpr int NB = NP + NS;
constexpr int DIN = 12312, NPROJ = 12288, NPROJ_PAD = 12544, NSMALL = 24;
constexpr int PPITCH = 6144;
constexpr int C_LRUX = 0, C_GQ = 1024, C_GK = 1536, C_GV = 2048, C_GGATE = 3072, C_MX = 4096, C_MO = 5120, C_MG = 6144;
constexpr int DFF = 8192, NADA = 12288, KBR = 3072;
constexpr float EPS = 1e-6f;
#define MK_N_LAUNCHES 1
namespace pg8 {
#define PG8_LAS __attribute__((address_space(3)))
typedef unsigned short bf16_t;
typedef short bf16x8 __attribute__((ext_vector_type(8)));
typedef float f32x4 __attribute__((ext_vector_type(4)));
typedef unsigned u32x4 __attribute__((ext_vector_type(4)));
constexpr int BM = 256, BK = 64, HALF = 128, HTB = HALF * BK * 2  , STAGE_BYTES = 8 * HTB, NXCD = 8, WGM = 8;

__host__ __device__ __forceinline__ int lds_byte(int r, int c) { const int st = (r >> 4) * 2 + (c >> 5), rr = r & 15, cc = c & 31, ob = rr * 64 + cc * 2; return st * 1024 + (ob ^ (((ob >> 9) & 1) << 5)); }
__host__ __device__ __forceinline__ void stage_rc(int b, int& R, int& C) { const int st = b / 1024, sb = b % 1024, swz = sb ^ (((sb >> 9) & 1) << 5); R = (st >> 1) * 16 + swz / 64; C = (st & 1) * 32 + (swz % 64) / 2; }
__host__ __device__ __forceinline__ int perm32(int rho) { const int n = rho >> 4, i = rho & 15; return 8 * (i >> 2) + 4 * n + (i & 3); }

struct Unit { int pm, pn, koff; };
struct Gemm { const bf16_t* A; const bf16_t* Bt; int M, N, K, lda, ldb; };

struct StaticOrder {
    int nM, nN, nwg, G, c;
    __host__ __device__ void init(int M, int N, int G_, int c_) { nM = M / BM; nN = N / BM; nwg = nM * nN; G = G_; c = c_; }
    __host__ __device__ bool next(int i, Unit& u) const { return at((long)i * G + c, u); }
    __host__ __device__ bool at(long L, Unit& u) const {
        if (L >= nwg) return false;
        int wgid = (int)L; { const int q = nwg / NXCD, r = nwg % NXCD, xcd = wgid % NXCD, off = wgid / NXCD; wgid = (xcd < r ? xcd * (q + 1) : r * (q + 1) + (xcd - r) * q) + off; }
        const int nig = WGM * nN, gid = wgid / nig, fm = gid * WGM, gsz = (nM - fm) < WGM ? (nM - fm) : WGM;
        u.pm = fm + ((wgid % nig) % gsz); u.pn = (wgid % nig) / gsz; u.koff = 0; return true;
    }
    __device__ __forceinline__ void a_ready(const Unit&) const {}
    __device__ __forceinline__ void done(const Unit&) const {}
};
struct SplitOrder {
    int pm0, npm, nN, split, ksub, G, c;
    __device__ __forceinline__ bool next(int i, Unit& u) const {
        const int L = i * G + c, nt = npm * nN; if (L >= nt * split) return false;
        const int tile = L % nt, ks = L / nt; u.pm = pm0 + tile / nN; u.pn = tile % nN; u.koff = ks * ksub; return true;
    }
    __device__ __forceinline__ void a_ready(const Unit&) const {}
    __device__ __forceinline__ void done(const Unit&) const {}
};
struct TileMapOrder {
    StaticOrder so; int t1, t2, s0, s1, s2; int nh = 0, sk = 0;
    __device__ __forceinline__ bool next(int i, Unit& u) const {
        const int gl = so.G - nh, lt = (int)(so.c >= nh), early = lt * (int)(i < sk);
        const long L = early ? (long)i * gl + (so.c - nh) : (long)sk * gl + (long)(i - lt * sk) * so.G + so.c;
        if (!so.at(L, u)) return false; u.pn += s0 + (int)(u.pn >= t1) * (s1 - s0) + (int)(u.pn >= t2) * (s2 - s1); return true; }
    __device__ __forceinline__ void a_ready(const Unit&) const {}
    __device__ __forceinline__ void done(const Unit&) const {}
};


__device__ __forceinline__ unsigned cvt_pk_bf16(float lo, float hi) { unsigned r; asm volatile("v_cvt_pk_bf16_f32 %0, %1, %2" : "=v"(r) : "v"(lo), "v"(hi)); return r; }
typedef float f32x2 __attribute__((ext_vector_type(2)));
typedef int i32x4 __attribute__((ext_vector_type(4)));
typedef int i32x8 __attribute__((ext_vector_type(8)));
__device__ __forceinline__ unsigned pk4_fp8(float a, float b, float c, float d) { int w = __builtin_amdgcn_cvt_pk_fp8_f32(a, b, 0, false); w = __builtin_amdgcn_cvt_pk_fp8_f32(c, d, w, true); return (unsigned)w; }
__device__ __forceinline__ float bflo(unsigned w) { return __uint_as_float(w << 16); }
__device__ __forceinline__ float bfhi(unsigned w) { return __uint_as_float(w & 0xffff0000u); }

#define PG8_COORDS() int tz_ = threadIdx.x; asm volatile("" : "+v"(tz_)); const int wid_ = __builtin_amdgcn_readfirstlane(tz_ >> 6); \
    const int wr = wid_ >> 2, wc = wid_ & 3, fr = tz_ & 15, fq = (tz_ & 63) >> 4

struct EpiF32 {
    static constexpr bool PERM = false, AFTER_DRAIN = false; static constexpr int NMID = 0, MID1 = -1, MID2 = -1;
    float* C; int ldc; const float* bias;
    __device__ __forceinline__ void operator()(const f32x4 (&acc)[2][2][4][2], const Unit& u, int, int, int, int) const {
        PG8_COORDS();
        const int row0 = u.pm * BM + wr * 64 + fr, col0 = u.pn * BM + wc * 32 + 4 * fq;
        f32x4 bv[2][2];
#pragma unroll
        for (int bj = 0; bj < 2; ++bj)
#pragma unroll
            for (int n = 0; n < 2; ++n) bv[bj][n] = bias ? *(const f32x4*)(bias + col0 + bj * HALF + n * 16) : (f32x4){0.f, 0.f, 0.f, 0.f};
#pragma unroll
        for (int ai = 0; ai < 2; ++ai)
#pragma unroll
            for (int m = 0; m < 4; ++m) { float* rowp = C + (size_t)(row0 + ai * HALF + m * 16) * ldc + col0;
#pragma unroll
                for (int bj = 0; bj < 2; ++bj)
#pragma unroll
                    for (int n = 0; n < 2; ++n) *(f32x4*)(rowp + bj * HALF + n * 16) = acc[ai][bj][m][n] + bv[bj][n]; }
    }
    __device__ __forceinline__ void mid(f32x4 (&)[2][2][4][2], const Unit&, int, int, int, int, int) const {}
};

struct EpiProj {
    static constexpr bool PERM = true, AFTER_DRAIN = false; static constexpr int NMID = 0, MID1 = -1, MID2 = -1;
    bf16_t* O; float* sm; float ascale; unsigned char* mg8;
    __device__ __forceinline__ void operator()(const f32x4 (&acc)[2][2][4][2], const Unit& u, int, int, int, int) const {
        PG8_COORDS();
        const int row0 = u.pm * BM + wr * 64 + fr;
        if (u.pn < 24) {
            const int col0 = u.pn * BM + wc * 32 + 8 * fq;
#pragma unroll
            for (int ai = 0; ai < 2; ++ai)
#pragma unroll
                for (int m = 0; m < 4; ++m) { bf16_t* rowp = O + (size_t)(row0 + ai * HALF + m * 16) * 6144 + col0;
#pragma unroll
                    for (int bj = 0; bj < 2; ++bj) { const f32x4 v0 = acc[ai][bj][m][0] * ascale, v1 = acc[ai][bj][m][1] * ascale;
                        u32x4 w; w.x = cvt_pk_bf16(v0[0], v0[1]); w.y = cvt_pk_bf16(v0[2], v0[3]); w.z = cvt_pk_bf16(v1[0], v1[1]); w.w = cvt_pk_bf16(v1[2], v1[3]);
                        *(u32x4*)(rowp + bj * HALF) = w; } }
        } else if (u.pn < 48) {
            const int col0 = (u.pn - 24) * BM + wc * 32 + 8 * fq;
#pragma unroll
            for (int ai = 0; ai < 2; ++ai)
#pragma unroll
                for (int m = 0; m < 4; ++m) { unsigned char* rowp = mg8 + (size_t)(row0 + ai * HALF + m * 16) * 6144 + col0;
#pragma unroll
                    for (int bj = 0; bj < 2; ++bj) { const f32x4 v0 = acc[ai][bj][m][0] * ascale, v1 = acc[ai][bj][m][1] * ascale;
                        *(unsigned long long*)(rowp + bj * HALF) = (unsigned long long)pk4_fp8(v0[0], v0[1], v0[2], v0[3]) | ((unsigned long long)pk4_fp8(v1[0], v1[1], v1[2], v1[3]) << 32); } }
        } else {
#pragma unroll
            for (int ai = 0; ai < 2; ++ai)
#pragma unroll
                for (int m = 0; m < 4; ++m) { float* rowp = sm + (size_t)(row0 + ai * HALF + m * 16) * 24;
#pragma unroll
                    for (int n = 0; n < 2; ++n) { const int c = wc * 32 + 8 * fq + 4 * n;
                        if (c < 24) *(f32x4*)(rowp + c) = acc[ai][0][m][n]; } }
        }
    }
    __device__ __forceinline__ void mid(f32x4 (&)[2][2][4][2], const Unit&, int, int, int, int, int) const {}
};

template <int M1, int M2> struct EpiMergeT {
    static constexpr bool PERM = true, AFTER_DRAIN = false; static constexpr int NMID = 2, MID1 = M1, MID2 = M2;
    const unsigned char* proj; unsigned char* O; float ascale;
    static __device__ __forceinline__ void ld8(const unsigned char* p, float (&z)[8]) { const unsigned long long w = *(const unsigned long long*)p; const int lo = (int)(unsigned)w, hi = (int)(unsigned)(w >> 32);
        const f32x2 a = __builtin_amdgcn_cvt_pk_f32_fp8(lo, false), b = __builtin_amdgcn_cvt_pk_f32_fp8(lo, true), c = __builtin_amdgcn_cvt_pk_f32_fp8(hi, false), d = __builtin_amdgcn_cvt_pk_f32_fp8(hi, true);
        z[0] = a[0]; z[1] = a[1]; z[2] = b[0]; z[3] = b[1]; z[4] = c[0]; z[5] = c[1]; z[6] = d[0]; z[7] = d[1]; }
    static __device__ __forceinline__ float en(float z) { z = fminf(fmaxf(z, -30.f), 30.f); return __expf(-z); }
    __device__ __forceinline__ void mid(f32x4 (&acc)[2][2][4][2], const Unit& u, int t, int, int, int, int) const {
        PG8_COORDS();
        const int b = (t == MID1) ? 0 : 1;
        int row0 = u.pm * BM + wr * 64 + fr, col0 = u.pn * BM + wc * 32 + 8 * fq;
        asm volatile("" : "+v"(row0), "+v"(col0));
#pragma unroll
        for (int ai = 0; ai < 2; ++ai)
#pragma unroll
            for (int m = 0; m < 4; ++m) { const unsigned char* rowp = proj + (size_t)(row0 + ai * HALF + m * 16) * 6144 + 2048 * b + col0;
#pragma unroll
                for (int bj = 0; bj < 2; ++bj) { float za[8], zb[8]; ld8(rowp + bj * HALF, za); ld8(rowp + 2048 + bj * HALF, zb);
#pragma unroll
                    for (int j = 0; j < 8; ++j) { const float r = (1.f + en(zb[j])) / (1.f + en(za[j]));
                        acc[ai][bj][m][j >> 2][j & 3] *= r; } }
                asm volatile("" ::: "memory"); }
    }
    __device__ __forceinline__ void operator()(const f32x4 (&acc)[2][2][4][2], const Unit& u, int, int, int, int) const {
        PG8_COORDS();
        const int row0 = u.pm * BM + wr * 64 + fr, col0 = u.pn * BM + wc * 32 + 8 * fq;
#pragma unroll
        for (int ai = 0; ai < 2; ++ai)
#pragma unroll
            for (int m = 0; m < 4; ++m) { const size_t r = (size_t)(row0 + ai * HALF + m * 16); const unsigned char* gp = proj + r * 6144 + 4096 + col0; unsigned char* op = O + r * 2048 + col0;
#pragma unroll
                for (int bj = 0; bj < 2; ++bj) { float z[8], v[8]; ld8(gp + bj * HALF, z);
#pragma unroll
                    for (int j = 0; j < 8; ++j) v[j] = acc[ai][bj][m][j >> 2][j & 3] * ascale / (1.f + en(z[j]));
                    *(unsigned long long*)(op + bj * HALF) = (unsigned long long)pk4_fp8(v[0], v[1], v[2], v[3]) | ((unsigned long long)pk4_fp8(v[4], v[5], v[6], v[7]) << 32); }
                asm volatile("" ::: "memory"); }
    }
};

typedef EpiMergeT<16, 32> EpiMerge;
typedef EpiMergeT<8, 16> EpiMergeF8;

struct EpiResid {
    static constexpr bool PERM = false, AFTER_DRAIN = false; static constexpr int NMID = 0, MID1 = -1, MID2 = -1;
    const bf16_t* base; bf16_t* out; const float* gate; float ascale;
    __device__ __forceinline__ void operator()(const f32x4 (&acc)[2][2][4][2], const Unit& u, int, int, int, int) const {
        PG8_COORDS();
        const int row0 = u.pm * BM + wr * 64 + fr, col0 = u.pn * BM + wc * 32 + 4 * fq;
#pragma unroll
        for (int ai = 0; ai < 2; ++ai)
#pragma unroll
            for (int m = 0; m < 4; ++m) { const int row = row0 + ai * HALF + m * 16;
                const int cond = row < 8192 ? (row >> 11) : 4 + ((row - 8192) >> 2);
                const bf16_t* bp = base + (size_t)row * 2048 + col0; const float* gp = gate + (size_t)cond * 24576 + col0; bf16_t* op = out + (size_t)row * 2048 + col0;
#pragma unroll
                for (int bj = 0; bj < 2; ++bj)
#pragma unroll
                    for (int n = 0; n < 2; ++n) { const unsigned long long bw = *(const unsigned long long*)(bp + bj * HALF + n * 16); const unsigned b0 = (unsigned)bw, b1 = (unsigned)(bw >> 32);
                        const f32x4 bs = {bflo(b0), bfhi(b0), bflo(b1), bfhi(b1)}, gt = *(const f32x4*)(gp + bj * HALF + n * 16);
                        const f32x4 v = bs + gt * (acc[ai][bj][m][n] * ascale);
                        *(unsigned long long*)(op + bj * HALF + n * 16) = (unsigned long long)cvt_pk_bf16(v[0], v[1]) | ((unsigned long long)cvt_pk_bf16(v[2], v[3]) << 32); }
                asm volatile("" ::: "memory"); }
    }
    __device__ __forceinline__ void mid(f32x4 (&)[2][2][4][2], const Unit&, int, int, int, int, int) const {}
};

struct EpiSlab {
    static constexpr bool PERM = false, AFTER_DRAIN = false; static constexpr int NMID = 0, MID1 = -1, MID2 = -1;
    bf16_t* slab; int ksub; float ascale;
    __device__ __forceinline__ void operator()(const f32x4 (&acc)[2][2][4][2], const Unit& u, int, int, int, int) const {
        PG8_COORDS();
        const int row0 = u.pm * BM + wr * 64 + fr - 8192, col0 = u.pn * BM + wc * 32 + 4 * fq; bf16_t* sl = slab + (size_t)(u.koff / ksub) * 512 * 2048;
#pragma unroll
        for (int ai = 0; ai < 2; ++ai)
#pragma unroll
            for (int m = 0; m < 4; ++m) { bf16_t* op = sl + (size_t)(row0 + ai * HALF + m * 16) * 2048 + col0;
#pragma unroll
                for (int bj = 0; bj < 2; ++bj)
#pragma unroll
                    for (int n = 0; n < 2; ++n) { const f32x4 v = acc[ai][bj][m][n] * ascale; *(unsigned long long*)(op + bj * HALF + n * 16) = (unsigned long long)cvt_pk_bf16(v[0], v[1]) | ((unsigned long long)cvt_pk_bf16(v[2], v[3]) << 32); } }
    }
    __device__ __forceinline__ void mid(f32x4 (&)[2][2][4][2], const Unit&, int, int, int, int, int) const {}
};

struct EpiGateSlab {
    static constexpr bool PERM = false, AFTER_DRAIN = false; static constexpr int NMID = 0, MID1 = -1, MID2 = -1;
    const unsigned char* proj; bf16_t* slab; int kshift; float ascale;
    __device__ __forceinline__ void operator()(const f32x4 (&acc)[2][2][4][2], const Unit& u, int, int, int, int) const {
        PG8_COORDS();
        const int b = u.koff >> kshift, row0 = u.pm * BM + wr * 64 + fr, col0 = u.pn * BM + wc * 32 + 4 * fq; bf16_t* sl = slab + (size_t)b * 512 * 2048;
#pragma unroll
        for (int ai = 0; ai < 2; ++ai)
#pragma unroll
            for (int m = 0; m < 4; ++m) { const int row = row0 + ai * HALF + m * 16; const unsigned char* gp = proj + (size_t)row * 6144 + 2048 * b + col0; bf16_t* op = sl + (size_t)(row - 8192) * 2048 + col0;
#pragma unroll
                for (int bj = 0; bj < 2; ++bj)
#pragma unroll
                    for (int n = 0; n < 2; ++n) { const int gw = (int)*(const unsigned*)(gp + bj * HALF + n * 16); const f32x2 ga = __builtin_amdgcn_cvt_pk_f32_fp8(gw, false), gb = __builtin_amdgcn_cvt_pk_f32_fp8(gw, true);
                        f32x4 v = acc[ai][bj][m][n] * ascale;
                        v[0] /= 1.f + EpiMerge::en(ga[0]); v[1] /= 1.f + EpiMerge::en(ga[1]); v[2] /= 1.f + EpiMerge::en(gb[0]); v[3] /= 1.f + EpiMerge::en(gb[1]);
                        *(unsigned long long*)(op + bj * HALF + n * 16) = (unsigned long long)cvt_pk_bf16(v[0], v[1]) | ((unsigned long long)cvt_pk_bf16(v[2], v[3]) << 32); }
                asm volatile("" ::: "memory"); }
    }
    __device__ __forceinline__ void mid(f32x4 (&)[2][2][4][2], const Unit&, int, int, int, int, int) const {}
};

struct EpiRelu2 {
    static constexpr bool PERM = true, AFTER_DRAIN = false; static constexpr int NMID = 0, MID1 = -1, MID2 = -1;
    bf16_t* O; int ldc;
    __device__ __forceinline__ void operator()(const f32x4 (&acc)[2][2][4][2], const Unit& u, int, int, int, int) const {
        PG8_COORDS();
        const int row0 = u.pm * BM + wr * 64 + fr, col0 = u.pn * BM + wc * 32 + 8 * fq;
#pragma unroll
        for (int ai = 0; ai < 2; ++ai)
#pragma unroll
            for (int m = 0; m < 4; ++m) { bf16_t* rowp = O + (size_t)(row0 + ai * HALF + m * 16) * ldc + col0;
#pragma unroll
                for (int bj = 0; bj < 2; ++bj) { f32x4 v0 = acc[ai][bj][m][0], v1 = acc[ai][bj][m][1];
#pragma unroll
                    for (int j = 0; j < 4; ++j) { const float a = fmaxf(v0[j], 0.f), b = fmaxf(v1[j], 0.f); v0[j] = a * a; v1[j] = b * b; }
                    u32x4 w; w.x = cvt_pk_bf16(v0[0], v0[1]); w.y = cvt_pk_bf16(v0[2], v0[3]); w.z = cvt_pk_bf16(v1[0], v1[1]); w.w = cvt_pk_bf16(v1[2], v1[3]);
                    *(u32x4*)(rowp + bj * HALF) = w; } }
    }
    __device__ __forceinline__ void mid(f32x4 (&)[2][2][4][2], const Unit&, int, int, int, int, int) const {}
};


struct EpiRelu2F8 {
    static constexpr bool PERM = true, AFTER_DRAIN = false; static constexpr int NMID = 0, MID1 = -1, MID2 = -1;
    unsigned char* O; int ldc; float ascale;
    __device__ __forceinline__ void operator()(const f32x4 (&acc)[2][2][4][2], const Unit& u, int, int, int, int) const {
        PG8_COORDS();
        const int row0 = u.pm * BM + wr * 64 + fr, col0 = u.pn * BM + wc * 32 + 8 * fq;
#pragma unroll
        for (int ai = 0; ai < 2; ++ai)
#pragma unroll
            for (int m = 0; m < 4; ++m) { unsigned char* rowp = O + (size_t)(row0 + ai * HALF + m * 16) * ldc + col0;
#pragma unroll
                for (int bj = 0; bj < 2; ++bj) { f32x4 v0 = acc[ai][bj][m][0], v1 = acc[ai][bj][m][1];
#pragma unroll
                    for (int j = 0; j < 4; ++j) { const float a = fmaxf(v0[j] * ascale, 0.f), b = fmaxf(v1[j] * ascale, 0.f); v0[j] = a * a; v1[j] = b * b; }
                    unsigned long long w = (unsigned long long)pk4_fp8(v0[0], v0[1], v0[2], v0[3]) | ((unsigned long long)pk4_fp8(v1[0], v1[1], v1[2], v1[3]) << 32);
                    *(unsigned long long*)(rowp + bj * HALF) = w; } }
    }
    __device__ __forceinline__ void mid(f32x4 (&)[2][2][4][2], const Unit&, int, int, int, int, int) const {}
};
template <class Epi, class Sched, bool FP8 = false, bool STAMP = false>
__device__ __forceinline__ void gemm_phase(PG8_LAS unsigned char* lds, const Gemm g, const Sched& S, const Epi& E, unsigned long long* stamps) {
    int tid_ = threadIdx.x; asm volatile("" : "+v"(tid_));
    const int tid = tid_, wid = __builtin_amdgcn_readfirstlane(tid >> 6), lane = tid & 63, wr = wid >> 2, wc = wid & 3, fr = lane & 15, fq = lane >> 4;
    const int K = g.K, nt = K / BK;
    int ts_lo = 0, ts_hi = 0, nts = 0; const unsigned long long rt_entry = STAMP ? (unsigned long long)wall_clock64() : 0ull;
#define PG8_STAMP() do { if (STAMP && wid == 0 && nts < 64) { const unsigned long long _c = (unsigned long long)clock64(); \
        ts_lo = (lane == nts) ? (int)(unsigned)_c : ts_lo; ts_hi = (lane == nts) ? (int)(unsigned)(_c >> 32) : ts_hi; ++nts; } } while (0)
    PG8_STAMP();
    unsigned voffA[2], voffB[2];
#pragma unroll
    for (int i = 0; i < 2; ++i) { int R, C; stage_rc(tid * 16 + i * 8192, R, C); const int Rb = Epi::PERM ? ((R & ~31) + perm32(R & 31)) : R;
        voffA[i] = (unsigned)(R * g.lda + C) * 2u; voffB[i] = (unsigned)(Rb * g.ldb + C) * 2u; }
    const size_t kstep = (size_t)(BK * 2);
    const size_t hstepA = (size_t)HALF * g.lda * 2, hstepB = (size_t)HALF * g.ldb * 2;
    const size_t tstepA = 2 * hstepA, tstepB = 2 * hstepB;
    const unsigned ldsw = (unsigned)wid * 1024u;
    const int aoff = lds_byte(wr * 64 + fr, fq * 8), boff = lds_byte(wc * 32 + fr, fq * 8);
#define PG8_SA(b, h) (((b) * 2 + (h)) * HTB)
#define PG8_SB(b, h) ((4 + (b) * 2 + (h)) * HTB)
#define PG8_STAGE(bufoff, gbase, voff) do { _Pragma("unroll") for (int _i = 0; _i < 2; ++_i) \
        __builtin_amdgcn_global_load_lds((const unsigned*)((const char*)(gbase) + (voff)[_i]), (PG8_LAS unsigned*)(lds + (bufoff) + ldsw + _i * 8192), 16, 0, 0); } while (0)
#define PG8_LDA(dst, b, h) do { _Pragma("unroll") for (int m = 0; m < 4; ++m) { \
        if constexpr (FP8) { const i32x4 lo_ = *(const PG8_LAS i32x4*)(lds + PG8_SA(b, h) + aoff + m * 2048), hi_ = *(const PG8_LAS i32x4*)(lds + PG8_SA(b, h) + aoff + m * 2048 + 1024); dst##8[m] = __builtin_shufflevector(lo_, hi_, 0, 1, 2, 3, 4, 5, 6, 7); } \
        else { _Pragma("unroll") for (int k = 0; k < 2; ++k) dst[m][k] = *(const PG8_LAS bf16x8*)(lds + PG8_SA(b, h) + aoff + m * 2048 + k * 1024); } } } while (0)
#define PG8_LDB(dst, b, h) do { _Pragma("unroll") for (int n = 0; n < 2; ++n) { \
        if constexpr (FP8) { const i32x4 lo_ = *(const PG8_LAS i32x4*)(lds + PG8_SB(b, h) + boff + n * 2048), hi_ = *(const PG8_LAS i32x4*)(lds + PG8_SB(b, h) + boff + n * 2048 + 1024); dst##8[n] = __builtin_shufflevector(lo_, hi_, 0, 1, 2, 3, 4, 5, 6, 7); } \
        else { _Pragma("unroll") for (int k = 0; k < 2; ++k) dst[n][k] = *(const PG8_LAS bf16x8*)(lds + PG8_SB(b, h) + boff + n * 2048 + k * 1024); } } } while (0)
#define PG8_MMA(ai, bj, At, Bt) do { __builtin_amdgcn_s_setprio(1); _Pragma("unroll") for (int m = 0; m < 4; ++m) _Pragma("unroll") for (int n = 0; n < 2; ++n) { \
        if constexpr (FP8) asm volatile("v_mfma_scale_f32_16x16x128_f8f6f4 %0, %1, %2, %0, %3, %3 op_sel_hi:[0,0,0]" : "+v"(acc[ai][bj][m][n]) : "v"(Bt##8[n]), "v"(At##8[m]), "v"(one_scale)); \
        else { _Pragma("unroll") for (int k = 0; k < 2; ++k) acc[ai][bj][m][n] = __builtin_amdgcn_mfma_f32_16x16x32_bf16(Bt[n][k], At[m][k], acc[ai][bj][m][n], 0, 0, 0); } } \
        __builtin_amdgcn_s_setprio(0); } while (0)
#define PG8_WAIT_V(n) asm volatile("s_waitcnt vmcnt(" #n ")" ::: "memory")
#define PG8_WAIT_L(n) asm volatile("s_waitcnt lgkmcnt(" #n ")" ::: "memory")
#define PG8_BAR __builtin_amdgcn_s_barrier()
#define PG8_SCHED __builtin_amdgcn_sched_barrier(0)
    Unit cur, nxt; int ui = 0;
    if (!S.next(0, cur)) return;
    f32x4 acc[2][2][4][2];
#pragma unroll
    for (int a = 0; a < 2; ++a)
#pragma unroll
        for (int b = 0; b < 2; ++b)
#pragma unroll
            for (int m = 0; m < 4; ++m)
#pragma unroll
                for (int n = 0; n < 2; ++n) acc[a][b][m][n] = (f32x4){0.f, 0.f, 0.f, 0.f};
    bf16x8 At[4][2], B0[2][2], B1[2][2]; i32x8 At8[4], B08[2], B18[2]; const int one_scale = 0x7f7f7f7f;
    const char* cA = (const char*)g.A + (size_t)cur.pm * tstepA + (size_t)cur.koff * 2; const char* cB = (const char*)g.Bt + (size_t)cur.pn * tstepB + (size_t)cur.koff * 2;
    S.a_ready(cur);
    PG8_STAGE(PG8_SB(0, 0), cB, voffB); PG8_STAGE(PG8_SA(0, 0), cA, voffA); PG8_STAGE(PG8_SB(0, 1), cB + hstepB, voffB); PG8_STAGE(PG8_SA(0, 1), cA + hstepA, voffA);
    if (wr == 1) PG8_BAR;
    PG8_WAIT_V(4); PG8_BAR;
    PG8_STAGE(PG8_SB(1, 0), cB + kstep, voffB); PG8_STAGE(PG8_SA(1, 0), cA + kstep, voffA); PG8_STAGE(PG8_SB(1, 1), cB + hstepB + kstep, voffB);
    PG8_WAIT_V(6); PG8_BAR;
    PG8_STAMP();
    for (;;) {
        const bool has_next = S.next(ui + 1, nxt);
        const char* nA = has_next ? (const char*)g.A + (size_t)nxt.pm * tstepA + (size_t)nxt.koff * 2 : cA; const char* nB = has_next ? (const char*)g.Bt + (size_t)nxt.pn * tstepB + (size_t)nxt.koff * 2 : cB;
        for (int t = 0; t < nt; t += 2) {
            const bool last = (t == nt - 2);
            const char* a1 = cA + (size_t)(t + 1) * kstep;
            const char* a2 = last ? nA : cA + (size_t)(t + 2) * kstep; const char* b2 = last ? nB : cB + (size_t)(t + 2) * kstep;
            const char* a3 = a2 + kstep; const char* b3 = b2 + kstep;
            if (last && has_next) S.a_ready(nxt);
            if constexpr (Epi::NMID > 0) { if (t == Epi::MID1 || t == Epi::MID2) E.mid(acc, cur, t, wr, wc, fr, fq); }
            PG8_LDB(B0, 0, 0); PG8_SCHED; PG8_LDA(At, 0, 0); PG8_STAGE(PG8_SA(1, 1), a1 + hstepA, voffA);
            PG8_WAIT_L(8); PG8_BAR; PG8_WAIT_L(0); PG8_MMA(0, 0, At, B0); PG8_BAR; PG8_SCHED;
            PG8_LDB(B1, 0, 1); PG8_STAGE(PG8_SB(0, 0), b2, voffB);
            PG8_BAR; PG8_WAIT_L(0); PG8_MMA(0, 1, At, B1); PG8_BAR;
            PG8_LDA(At, 0, 1); PG8_STAGE(PG8_SA(0, 0), a2, voffA);
            PG8_BAR; PG8_WAIT_L(0); PG8_MMA(1, 0, At, B0); PG8_BAR; PG8_SCHED;
            PG8_STAGE(PG8_SB(0, 1), b2 + hstepB, voffB);
            PG8_WAIT_V(6); PG8_BAR; PG8_MMA(1, 1, At, B1); PG8_BAR;
            PG8_LDB(B0, 1, 0); PG8_SCHED; PG8_LDA(At, 1, 0); PG8_STAGE(PG8_SA(0, 1), a2 + hstepA, voffA);
            PG8_WAIT_L(8); PG8_BAR; PG8_WAIT_L(0); PG8_MMA(0, 0, At, B0); PG8_BAR; PG8_SCHED;
            PG8_LDB(B1, 1, 1); PG8_STAGE(PG8_SB(1, 0), b3, voffB);
            PG8_BAR; PG8_WAIT_L(0); PG8_MMA(0, 1, At, B1); PG8_BAR;
            PG8_LDA(At, 1, 1); PG8_STAGE(PG8_SA(1, 0), a3, voffA);
            PG8_BAR; PG8_WAIT_L(0); PG8_MMA(1, 0, At, B0); PG8_BAR; PG8_SCHED;
            PG8_STAGE(PG8_SB(1, 1), b3 + hstepB, voffB);
            PG8_WAIT_V(6); PG8_BAR; PG8_MMA(1, 1, At, B1); PG8_BAR;
        }
        PG8_STAMP();
        if constexpr (FP8) asm volatile("s_nop 15\n\ts_nop 15" ::: "memory");
        if constexpr (!Epi::AFTER_DRAIN) { E(acc, cur, wr, wc, fr, fq); S.done(cur); }
        PG8_STAMP();
        if (!has_next) break;
#pragma unroll
        for (int a = 0; a < 2; ++a)
#pragma unroll
            for (int b = 0; b < 2; ++b)
#pragma unroll
                for (int m = 0; m < 4; ++m)
#pragma unroll
                    for (int n = 0; n < 2; ++n) acc[a][b][m][n] = (f32x4){0.f, 0.f, 0.f, 0.f};
        cur = nxt; cA = nA; cB = nB; ++ui;
    }
    PG8_WAIT_V(0);
    if (wr == 0) PG8_BAR;
    PG8_BAR;
    if constexpr (Epi::AFTER_DRAIN) { E.fused(acc, cur, wr, wc, fr, fq, lds, wid, lane); S.done(cur); }
    PG8_STAMP();
    if (STAMP && wid == 0) { stamps[lane] = lane < nts ? (((unsigned long long)(unsigned)ts_hi << 32) | (unsigned)ts_lo) : 0ull;
        if (lane == 62) stamps[62] = rt_entry; if (lane == 63) stamps[63] = (unsigned long long)wall_clock64(); }
#undef PG8_STAMP
#undef PG8_SA
#undef PG8_SB
#undef PG8_STAGE
#undef PG8_LDA
#undef PG8_LDB
#undef PG8_MMA
#undef PG8_WAIT_V
#undef PG8_WAIT_L
#undef PG8_BAR
#undef PG8_SCHED
}
}

#define GAS __attribute__((address_space(1)))
#define LAS __attribute__((address_space(3)))
#define DI __device__ __forceinline__
typedef unsigned short bf16;
typedef unsigned v4u __attribute__((ext_vector_type(4)));
typedef unsigned v2u __attribute__((ext_vector_type(2)));
typedef float f32x4 __attribute__((ext_vector_type(4)));
#define RLX_AGENT __ATOMIC_RELAXED, __HIP_MEMORY_SCOPE_AGENT
#define LDS_WAIT() asm volatile("s_waitcnt lgkmcnt(0)" ::: "memory")

constexpr int NWAVES = 8, NTHREADS = 512, GRID = 256;
#ifndef MK_N_LAUNCHES
#define MK_N_LAUNCHES 1
#endif
constexpr int PH_TOTAL = 21;
constexpr int N_LAUNCHES = MK_N_LAUNCHES;

constexpr size_t O_YP = 0, O_YS = O_YP + (size_t)MP * D, O_P_LRUH = O_YS + (size_t)MS * D, O_P_LRUC = O_P_LRUH + (size_t)DEPTH * NP * 1024,
    O_P_GLA = O_P_LRUC + (size_t)DEPTH * NP * 3 * 1024, O_P_C = O_P_GLA + (size_t)DEPTH * NP * 4 * 128 * 256, O_P_N = O_P_C + (size_t)DEPTH * NP * 4 * 256 * 256,
    O_P_M = O_P_N + (size_t)DEPTH * NP * 4 * 256, O_P_MLC = O_P_M + (size_t)DEPTH * NP * 4, O_S_LRUH = O_P_MLC + (size_t)DEPTH * NP * 3 * 1024,
    O_S_LRUC = O_S_LRUH + (size_t)DEPTH * NS * 1024, O_S_GLA = O_S_LRUC + (size_t)DEPTH * NS * 3 * 1024, O_S_C = O_S_GLA + (size_t)DEPTH * NS * 4 * 128 * 256,
    O_S_N = O_S_C + (size_t)DEPTH * NS * 4 * 256 * 256, O_S_M = O_S_N + (size_t)DEPTH * NS * 4 * 256, O_S_MLC = O_S_M + (size_t)DEPTH * NS * 4,
    O_END = O_S_MLC + (size_t)DEPTH * NS * 3 * 1024;
static_assert(O_END == 123798560, "output size");

constexpr size_t MiB = 1u << 20;
constexpr size_t WS_CTL = 0, CTL_ZERO_BYTES = 1 * MiB;
constexpr size_t WS_WADA = 2 * MiB, WS_WIN = 98 * MiB, WS_WBR = 196 * MiB, WS_WOUT = 220 * MiB, WS_WFF1 = 236 * MiB, WS_WFF2 = 300 * MiB;
constexpr size_t WS_CSILU = 364 * MiB, WS_MOD = 365 * MiB, WS_XA = 389 * MiB, WS_XB = 457 * MiB, WS_XN = 525 * MiB, WS_MERGED = 559 * MiB, WS_YCAT = 593 * MiB,
    WS_SMALL = 644 * MiB, WS_PROJ = 645 * MiB, WS_HFF = 849 * MiB, WS_GIMG = 985 * MiB, WS_MIMG = 1008 * MiB, WS_END = 1100 * MiB;
static_assert(WS_WADA + (size_t)2 * NADA * D * 2 <= WS_WIN && WS_WIN + (size_t)2 * NPROJ_PAD * D * 2 <= WS_WBR && WS_WBR + (size_t)2 * D * KBR * 2 <= WS_WOUT &&
              WS_WOUT + (size_t)2 * D * D * 2 <= WS_WFF1 && WS_WFF1 + (size_t)2 * DFF * D * 2 <= WS_WFF2 && WS_WFF2 + (size_t)2 * DFF * D * 2 <= WS_CSILU &&
              WS_CSILU + (size_t)256 * D * 2 <= WS_MOD && WS_MOD + (size_t)256 * 2 * NADA * 4 <= WS_XA && WS_XA + (size_t)MTOT * D * 4 <= WS_XB && WS_XB + (size_t)MTOT * D * 4 <= WS_XN &&
              WS_XN + (size_t)MTOT * D * 2 <= WS_MERGED && WS_MERGED + (size_t)MTOT * D * 2 <= WS_YCAT && WS_YCAT + (size_t)MTOT * KBR * 2 <= WS_SMALL &&
              WS_SMALL + (size_t)MTOT * NSMALL * 4 <= WS_PROJ && WS_PROJ + (size_t)MTOT * NPROJ * 2 <= WS_HFF && WS_HFF + (size_t)MTOT * DFF * 2 <= WS_GIMG && WS_GIMG + (size_t)512 * 46080 <= WS_MIMG && WS_MIMG + (size_t)512 * 115712 <= WS_END, "d_ws map");
constexpr size_t WS_WIN8_0 = WS_WFF1 + 32 * MiB, WS_WIN8_1 = WS_WFF2 + 32 * MiB, WS_XN8 = WS_HFF + 72 * MiB;
static_assert((size_t)2 * DFF * D <= 32 * MiB && (size_t)NPROJ_PAD * D <= 32 * MiB && (size_t)MTOT * DFF <= 72 * MiB && WS_XN8 + (size_t)MTOT * D <= WS_GIMG, "fp8 copies fit in the free halves");
constexpr size_t WS_MG8 = WS_PROJ + 104 * MiB;
static_assert((size_t)MTOT * PPITCH * 2 <= 104 * MiB && WS_MG8 + (size_t)MTOT * 6144 <= WS_HFF, "proj / gate buffers");
constexpr int CW_BAR = 4096;

constexpr int RING_OFF = 0, RING_BYTES = 131072;
constexpr int LDS_BYTES = 163840;
constexpr int LDSCTL_OFF = LDS_BYTES - 1024, MISC_OFF = LDSCTL_OFF + 320;

DI float bf2f(bf16 b) { return __uint_as_float(((unsigned)b) << 16); }
DI unsigned f2bf(float f) { unsigned u = __float_as_uint(f); return (u + 0x7fffu + ((u >> 16) & 1u)) >> 16; }
typedef float f32x2v __attribute__((ext_vector_type(2)));
typedef __bf16 bf16x2v __attribute__((ext_vector_type(2)));
DI unsigned pkbf(float a, float b) { const f32x2v v = {a, b}; const bf16x2v r = __builtin_convertvector(v, bf16x2v); return __builtin_bit_cast(unsigned, r); }
DI unsigned pk2(float lo, float hi) { return f2bf(lo) | (f2bf(hi) << 16); }
DI float bflo_(unsigned w) { return __uint_as_float(w << 16); }
DI float bfhi_(unsigned w) { return __uint_as_float(w & 0xffff0000u); }
DI float sigm(float x) { return __builtin_amdgcn_rcpf(1.f + __expf(-x)); }
DI float lru_in_scale(float la) { const float t = 2.f * la;
    const float em = (t > -0.125f) ? -t * (1.f + t * (0.5f + t * (0.16666667f + t * (0.041666668f + t * 0.0083333338f)))) : 1.f - __expf(t);
    return __builtin_amdgcn_sqrtf(em); }
DI float logsig(float x) { return fminf(x, 0.f) - __logf(1.f + __expf(-fabsf(x))); }
template <int CTRL, int ROWMASK> DI float dpp_f(float v) { return __int_as_float(__builtin_amdgcn_update_dpp(0, __float_as_int(v), CTRL, ROWMASK, 0xf, false)); }
DI float wave_sum(float v) {
    v += dpp_f<0xB1, 0xf>(v);
    v += dpp_f<0x4E, 0xf>(v);
    v += dpp_f<0x141, 0xf>(v);
    v += dpp_f<0x140, 0xf>(v);
    v += dpp_f<0x142, 0xa>(v);
    v += dpp_f<0x143, 0xc>(v);
    return __int_as_float(__builtin_amdgcn_readlane(__float_as_int(v), 63));
}

#define XB_TMO      128
#define XB_XCNT(j)  (256  + 64 * (j))
#define XB_XSUB(j)  (1280 + 64 * (j))
#define XB_XGEN(j)  (2304 + 64 * (j))
#define XB_TOP      3328
#define XB_TOPGEN   3392
#define XCD_BAR_WORDS 3456
#define XB_SPIN_CAP (1u << 18)

__device__ __forceinline__ unsigned xb_ld(unsigned* p)              { return __hip_atomic_load(p, __ATOMIC_RELAXED, __HIP_MEMORY_SCOPE_AGENT); }
__device__ __forceinline__ unsigned xb_add(unsigned* p, unsigned v) { return __hip_atomic_fetch_add(p, v, __ATOMIC_RELAXED, __HIP_MEMORY_SCOPE_AGENT); }
__device__ __forceinline__ unsigned xb_xcc_id() { return (unsigned)__builtin_amdgcn_s_getreg((3 << 11) | 20) & 0xFu; }
#define XB_SPIN(cond, bar) do { unsigned _sp = 0; while (cond) { __builtin_amdgcn_s_sleep(1); \
    if ((++_sp & 255u) == 0u) { if (xb_ld(&(bar)[XB_TMO])) break; if (_sp > XB_SPIN_CAP) { atomicAdd(&(bar)[XB_TMO], 1u); break; } } } } while (0)

struct XcdBarrier {
    unsigned* bar; unsigned x;
    volatile LAS unsigned* st;
};
__device__ __forceinline__ XcdBarrier xcd_barrier_post(unsigned* bar, volatile LAS unsigned* st) {
    XcdBarrier b; b.bar = bar; b.x = xb_xcc_id(); b.st = st;
    if (threadIdx.x == 0) (void)xb_add(&bar[XB_XCNT(b.x)], 1u);
    return b;
}
__device__ __forceinline__ void xcd_barrier_complete(unsigned* bar, unsigned x, unsigned& nloc, unsigned& nx) {
    const unsigned G = gridDim.x * gridDim.y * gridDim.z;
    unsigned sum, cnt, mine, sp = 0u;
    for (;;) {
        sum = 0u; cnt = 0u; mine = 0u;
#pragma unroll
        for (unsigned j = 0; j < 16; ++j) { const unsigned c = xb_ld(&bar[XB_XCNT(j)]); sum += c; cnt += (c > 0u) ? 1u : 0u; mine = (j == x) ? c : mine; }
        if (sum == G) break;
        __builtin_amdgcn_s_sleep(1);
        if ((++sp & 255u) == 0u) { if (xb_ld(&bar[XB_TMO])) break; if (sp > XB_SPIN_CAP) { atomicAdd(&bar[XB_TMO], 1u); break; } }
    }
    nloc = mine > 0u ? mine : 1u; nx = cnt > 0u ? cnt : 1u;
}
__device__ __forceinline__ void xcd_barrier(const XcdBarrier& b) {
    asm volatile("s_waitcnt vmcnt(0)" ::: "memory");
    __syncthreads();
    if (threadIdx.x == 0) {
        unsigned* bar = b.bar;
        __builtin_amdgcn_s_waitcnt(0);
        unsigned nloc = b.st[0], nx = b.st[1];
        if (nloc == 0u) { xcd_barrier_complete(bar, b.x, nloc, nx); b.st[0] = nloc; b.st[1] = nx; }
        const unsigned old = xb_add(&bar[XB_XSUB(b.x)], 1u);
        const unsigned gen = old / nloc;
        if (old + 1u == (gen + 1u) * nloc) {
            __builtin_amdgcn_fence(__ATOMIC_RELEASE, "agent");
            asm volatile("s_waitcnt vmcnt(0)" ::: "memory");
            const unsigned og = xb_add(&bar[XB_TOP], 1u);
            const unsigned tg = og / nx;
            if (og + 1u == (tg + 1u) * nx) xb_add(&bar[XB_TOPGEN], 1u);
            else XB_SPIN(xb_ld(&bar[XB_TOPGEN]) == tg, bar);
            __builtin_amdgcn_fence(__ATOMIC_ACQUIRE, "agent");
            xb_add(&bar[XB_XGEN(b.x)], 1u);
            asm volatile("s_waitcnt vmcnt(0)" ::: "memory");
        } else {
            XB_SPIN(xb_ld(&bar[XB_XGEN(b.x)]) == gen, bar);
            __builtin_amdgcn_fence(__ATOMIC_ACQUIRE, "agent");
            asm volatile("s_waitcnt vmcnt(0)" ::: "memory");
        }
    }
    __syncthreads();
}

struct Args { const float* in[40]; float* out; unsigned char* ws; int ph_lo, ph_hi, li, pad; };
typedef __attribute__((address_space(4))) const Args CArgs;
__device__ __forceinline__ CArgs* kargs() { CArgs* p = (CArgs*)__builtin_amdgcn_kernarg_segment_ptr(); asm volatile("" : "+s"(p)); return p; }

DI void transpose_item(const float* src, int src_ld, int ncols, bf16* dst, int dst_ld, LAS float* scr, int item, int lane) {
    const int nblk = ncols / 32, kb = item / nblk, nb = item % nblk, k0 = 64 * kb, n0 = 32 * nb;
#pragma unroll 8
    for (int i = 0; i < 32; ++i) { const int kk = 2 * i + (lane >> 5); scr[kk * 33 + (lane & 31)] = __builtin_nontemporal_load(src + (size_t)(k0 + kk) * src_ld + n0 + (lane & 31)); }
    LDS_WAIT(); asm volatile("" ::: "memory");
    const int c = lane & 7;
#pragma unroll
    for (int j = 0; j < 4; ++j) { const int n = (lane >> 3) + 8 * j; const LAS float* s = scr + (8 * c) * 33 + n;
        v4u o; o.x = pk2(s[0 * 33], s[1 * 33]); o.y = pk2(s[2 * 33], s[3 * 33]); o.z = pk2(s[4 * 33], s[5 * 33]); o.w = pk2(s[6 * 33], s[7 * 33]);
        *(v4u*)(dst + (size_t)(n0 + n) * dst_ld + k0 + 8 * c) = o; }
    LDS_WAIT(); asm volatile("" ::: "memory");
}
DI void transpose_item_f8(const float* src, int src_ld, int ncols, unsigned char* dst, int dst_ld, float scale, LAS float* scr, int item, int lane) {
    const int nblk = ncols / 32, kb = item / nblk, nb = item % nblk, k0 = 64 * kb, n0 = 32 * nb;
#pragma unroll 8
    for (int i = 0; i < 32; ++i) { const int kk = 2 * i + (lane >> 5); scr[kk * 33 + (lane & 31)] = __builtin_nontemporal_load(src + (size_t)(k0 + kk) * src_ld + n0 + (lane & 31)); }
    LDS_WAIT(); asm volatile("" ::: "memory");
    const int c = lane & 7;
#pragma unroll
    for (int j = 0; j < 4; ++j) { const int n = (lane >> 3) + 8 * j; const LAS float* s = scr + (8 * c) * 33 + n;
        v2u o; o.x = pg8::pk4_fp8(s[0 * 33] * scale, s[1 * 33] * scale, s[2 * 33] * scale, s[3 * 33] * scale); o.y = pg8::pk4_fp8(s[4 * 33] * scale, s[5 * 33] * scale, s[6 * 33] * scale, s[7 * 33] * scale);
        *(v2u*)(dst + (size_t)(n0 + n) * dst_ld + k0 + 8 * c) = o; }
    LDS_WAIT(); asm volatile("" ::: "memory");
}
DI void transpose_job_f8(const float* src, int src_ld, int K, int ncols, unsigned char* dst, int dst_ld, float scale, LAS float* scr, int gw, int ngw, int lane) {
    const int nitems = (K / 64) * (ncols / 32);
    for (int it = gw; it < nitems; it += ngw) transpose_item_f8(src, src_ld, ncols, dst, dst_ld, scale, scr, it, lane);
}
DI void transpose_job(const float* src, int src_ld, int K, int ncols, bf16* dst, int dst_ld, LAS float* scr, int gw, int ngw, int lane) {
    const int nitems = (K / 64) * (ncols / 32);
    for (int it = gw; it < nitems; it += ngw) transpose_item(src, src_ld, ncols, dst, dst_ld, scr, it, lane);
}

DI void norm_rows(const void* xp, const void* xs, bool in_f32, const float* g, const float* modp  ,
                  bf16* out_bf, float* outp, float* outs, int gw, int ngw, int lane, bf16* copy_out = nullptr,
                  int nslab = 0, const bf16* slab = nullptr, const float* sgate = nullptr, bf16* xs_out = nullptr, unsigned char* out_f8 = nullptr, unsigned char* out_f8_also = nullptr) {
    for (int row = gw; row < MTOT; row += ngw) {
        f32x4 v[8]; float ss = 0.f;
        if (in_f32) { const float* xr = row < MP ? (const float*)xp + (size_t)row * D : (const float*)xs + (size_t)(row - MP) * D; const f32x4* x4 = (const f32x4*)xr + lane;
#pragma unroll
            for (int j = 0; j < 8; ++j) v[j] = x4[64 * j];
            if (copy_out) {
#pragma unroll
                for (int j = 0; j < 8; ++j) { v2u w; w.x = pkbf(v[j].x, v[j].y); w.y = pkbf(v[j].z, v[j].w); *((v2u*)(copy_out + (size_t)row * D) + lane + 64 * j) = w; } }
        } else { const bf16* xr = row < MP ? (const bf16*)xp + (size_t)row * D : (const bf16*)xs + (size_t)(row - MP) * D; const v2u* x2 = (const v2u*)xr + lane;
#pragma unroll
            for (int j = 0; j < 8; ++j) { const v2u w = x2[64 * j]; v[j] = (f32x4){bflo_(w.x), bfhi_(w.x), bflo_(w.y), bfhi_(w.y)}; } }
        const int cond = row < MP ? (row >> 11) : NP + ((row - MP) >> 2);
        if (nslab > 0 && row >= MP) {
            const v2u* s4 = (const v2u*)(slab + (size_t)(row - MP) * D) + lane; const f32x4* gt4 = (const f32x4*)(sgate + (size_t)cond * 24576) + lane;
            v2u* xo = (v2u*)(xs_out + (size_t)(row - MP) * D) + lane;
#pragma unroll
            for (int j = 0; j < 8; ++j) { f32x4 a = {0.f, 0.f, 0.f, 0.f};
                for (int k = 0; k < nslab; ++k) { const v2u w = s4[(size_t)k * (MS * D / 4) + 64 * j]; a += (f32x4){bflo_(w.x), bfhi_(w.x), bflo_(w.y), bfhi_(w.y)}; }
                v[j] = v[j] + gt4[64 * j] * a; v2u w; w.x = pkbf(v[j].x, v[j].y); w.y = pkbf(v[j].z, v[j].w); xo[64 * j] = w; }
        }
#pragma unroll
        for (int j = 0; j < 8; ++j) ss += (v[j].x * v[j].x + v[j].y * v[j].y) + (v[j].z * v[j].z + v[j].w * v[j].w);
        ss = wave_sum(ss);
        const float r = __builtin_amdgcn_rsqf(ss * (1.f / D) + EPS);
        const f32x4* g4 = (const f32x4*)g + lane;
#pragma unroll
        for (int j = 0; j < 8; ++j) {
            f32x4 y = v[j] * r * g4[64 * j];
            if (modp) { const f32x4* m4 = (const f32x4*)(modp + (size_t)cond * 24576) + lane; const f32x4 sh = m4[64 * j], sc = m4[512 + 64 * j]; y = y * (1.f + sc) + sh; }
            if (out_f8_also) *((unsigned*)(out_f8_also + (size_t)row * D) + lane + 64 * j) = pg8::pk4_fp8(y.x, y.y, y.z, y.w);
            if (out_f8) *((unsigned*)(out_f8 + (size_t)row * D) + lane + 64 * j) = pg8::pk4_fp8(y.x, y.y, y.z, y.w);
            else if (out_bf) { v2u w; w.x = pk2(y.x, y.y); w.y = pk2(y.z, y.w); *((v2u*)(out_bf + (size_t)row * D) + lane + 64 * j) = w; }
            else { float* o = row < MP ? outp + (size_t)row * D : outs + (size_t)(row - MP) * D; *((f32x4*)o + lane + 64 * j) = y; }
        }
    }
}

DI float* out_state(float* out, int s, int l, size_t off_p, size_t off_s, size_t per) {
    return s < NP ? out + off_p + ((size_t)l * NP + s) * per : out + off_s + ((size_t)l * NS + (s - NP)) * per;
}

DI void lru_unit(int l, bool prompt, int grp, int n, LAS float* lds, int tid) {
    CArgs* A = kargs();
    LAS float* u_s = lds; LAS float* a_s = lds + 2048; LAS float* v_s = lds + 4096;
    const bf16* proj = (const bf16*)(A->ws + WS_PROJ); bf16* ycat = (bf16*)(A->ws + WS_YCAT); unsigned char* ycat8 = A->ws + WS_YCAT; (void)ycat; (void)ycat8;
    const float* cw = A->in[16] + (size_t)l * 4 * 1024; const float* cb = A->in[17] + (size_t)l * 1024;
    const float* wa = A->in[18] + ((size_t)l * 8 + n) * 128 * 128; const float* ba = A->in[19] + (size_t)l * 1024 + n * 128;
    const float* wx = A->in[20] + ((size_t)l * 8 + n) * 128 * 128; const float* bx = A->in[21] + (size_t)l * 1024 + n * 128;
    const float* lam = A->in[22] + (size_t)l * 1024 + n * 128;
    const float* st_h = A->in[4]; const float* st_c = A->in[5];
    const int ntiles = prompt ? TP / 16 : 1;
    const int c = tid & 127, rg = tid >> 7, ch = n * 128 + c;
    float h = 0.f;
    for (int tile = 0; tile < ntiles; ++tile) {
        {
            const float w0 = cw[ch], w1 = cw[1024 + ch], w2 = cw[2048 + ch], w3 = cw[3072 + ch], bb = cb[ch];
#pragma unroll
            for (int q = 0; q < 4; ++q) {
                const int r = 4 * rg + q;
                int s, t, T, row0;
                if (prompt) { s = grp; t = tile * 16 + r; T = TP; row0 = grp * TP; } else { s = NP + 4 * grp + (r >> 2); t = r & 3; T = TS; row0 = MP + (4 * grp + (r >> 2)) * TS; }
                float x[4];
#pragma unroll
                for (int jj = 0; jj < 4; ++jj) { const int tp = t - 3 + jj;
                    if (tp >= 0) x[jj] = bf2f(proj[(size_t)(row0 + tp) * PPITCH + C_LRUX + ch]);
                    else x[jj] = prompt ? 0.f : st_c[(((size_t)l * NS + (s - NP)) * 3 + (3 + tp)) * 1024 + ch]; }
                u_s[r * 128 + c] = bb + w0 * x[0] + w1 * x[1] + w2 * x[2] + w3 * x[3];
                if (t >= T - 3) out_state(A->out, s, l, O_P_LRUC, O_S_LRUC, 3 * 1024)[(size_t)(t - (T - 3)) * 1024 + ch] = x[3];
            }
        }
        __syncthreads();
        {
            float aa[4], ax[4];
#pragma unroll
            for (int q = 0; q < 4; ++q) { aa[q] = ba[c]; ax[q] = bx[c]; }
#pragma unroll 16
            for (int cc = 0; cc < 128; ++cc) { const float wa_ = wa[cc * 128 + c], wx_ = wx[cc * 128 + c];
#pragma unroll
                for (int q = 0; q < 4; ++q) { const float uq = u_s[(4 * rg + q) * 128 + cc]; aa[q] += uq * wa_; ax[q] += uq * wx_; } }
            const float ls = logsig(lam[c]);
#pragma unroll
            for (int q = 0; q < 4; ++q) { const int r = 4 * rg + q; const float rr = sigm(aa[q]), ii = sigm(ax[q]), la = 8.f * rr * ls;
                a_s[r * 128 + c] = __expf(la); v_s[r * 128 + c] = lru_in_scale(la) * (ii * u_s[r * 128 + c]); }
        }
        __syncthreads();
        if (prompt) {
            if (tid < 128) {
#pragma unroll 4
                for (int r = 0; r < 16; ++r) { h = a_s[r * 128 + c] * h + v_s[r * 128 + c];
                    ycat[(size_t)(grp * TP + tile * 16 + r) * KBR + ch] = (bf16)f2bf(h); }
            }
        } else {
            const int b = 4 * grp + rg; float hh = st_h[((size_t)l * NS + b) * 1024 + ch];
#pragma unroll
            for (int t = 0; t < 4; ++t) { const int r = rg * 4 + t; hh = a_s[r * 128 + c] * hh + v_s[r * 128 + c];
                ycat[(size_t)(MP + b * TS + t) * KBR + ch] = (bf16)f2bf(hh); }
            A->out[O_S_LRUH + ((size_t)l * NS + b) * 1024 + ch] = hh;
        }
    }
    if (prompt && tid < 128) A->out[O_P_LRUH + ((size_t)l * NP + grp) * 1024 + ch] = h;
    __syncthreads();
}

DI void gla_unit(int l, int s, int hh, LAS float* lds, int tid, int lane, int wave) {
    CArgs* A = kargs();
    const int b = s - NP, row0 = MP + b * TS;
    const bf16* proj = (const bf16*)(A->ws + WS_PROJ); bf16* ycat = (bf16*)(A->ws + WS_YCAT); unsigned char* ycat8 = A->ws + WS_YCAT; (void)ycat; (void)ycat8;     const float* sm = (const float*)(A->ws + WS_SMALL);
    const float* wg2 = A->in[23] + (size_t)l * 16 * 512; const float* bg = A->in[24] + (size_t)l * 512; const float* gn = A->in[25] + (size_t)l * 256;
    LAS float* eg_s = lds; LAS float* q_s = lds + 512; LAS float* k_s = lds + 1024; LAS float* v_s = lds + 1536; LAS float* part = lds + 2560;
    f32x4 S[16];
    { const f32x4* sp = (const f32x4*)(A->in[6] + ((((size_t)l * NS + b) * 4 + hh) * 128 + 16 * wave) * 256) + lane;
#pragma unroll
      for (int dd = 0; dd < 16; ++dd) S[dd] = __builtin_nontemporal_load(sp + dd * 64); }
    for (int i = tid; i < 4 * 128; i += NTHREADS) { const int tb = i >> 7, d = i & 127, col = hh * 128 + d; const size_t row = (size_t)(row0 + tb);
        float z = bg[col];
#pragma unroll
        for (int r = 0; r < 16; ++r) z += sm[row * NSMALL + r] * wg2[r * 512 + col];
        eg_s[i] = __expf(logsig(z) * (1.f / 16.f));
        q_s[i] = bf2f(proj[row * PPITCH + C_GQ + col]) * 0.08838834764831845f;
        k_s[i] = bf2f(proj[row * PPITCH + C_GK + col]); }
    for (int i = tid; i < 4 * 256; i += NTHREADS) { const int tb = i >> 8, ee = i & 255; v_s[i] = bf2f(proj[(size_t)(row0 + tb) * PPITCH + C_GV + hh * 256 + ee]); }
    __syncthreads();
#pragma unroll
    for (int tb = 0; tb < 4; ++tb) {
        const f32x4 v4 = *(const LAS f32x4*)(v_s + tb * 256 + 4 * lane); f32x4 po = {0.f, 0.f, 0.f, 0.f};
        const LAS float* egp = eg_s + tb * 128 + 16 * wave; const LAS float* kp = k_s + tb * 128 + 16 * wave; const LAS float* qp = q_s + tb * 128 + 16 * wave;
#pragma unroll
        for (int d4 = 0; d4 < 4; ++d4) { const f32x4 eg4 = *(const LAS f32x4*)(egp + 4 * d4), k4 = *(const LAS f32x4*)(kp + 4 * d4), q4 = *(const LAS f32x4*)(qp + 4 * d4);
            S[4 * d4 + 0] = S[4 * d4 + 0] * eg4.x + v4 * k4.x; po += S[4 * d4 + 0] * q4.x;
            S[4 * d4 + 1] = S[4 * d4 + 1] * eg4.y + v4 * k4.y; po += S[4 * d4 + 1] * q4.y;
            S[4 * d4 + 2] = S[4 * d4 + 2] * eg4.z + v4 * k4.z; po += S[4 * d4 + 2] * q4.z;
            S[4 * d4 + 3] = S[4 * d4 + 3] * eg4.w + v4 * k4.w; po += S[4 * d4 + 3] * q4.w; }
        *(LAS f32x4*)(part + (tb * 8 + wave) * 256 + 4 * lane) = po;
    }
    { f32x4* op = (f32x4*)(A->out + O_S_GLA + ((((size_t)l * NS + b) * 4 + hh) * 128 + 16 * wave) * 256) + lane;
#pragma unroll
      for (int dd = 0; dd < 16; ++dd) __builtin_nontemporal_store(S[dd], op + dd * 64); }
    __syncthreads();
    if (wave < 4) { const int tb = wave; const size_t row = (size_t)(row0 + tb);
        f32x4 ov = {0.f, 0.f, 0.f, 0.f};
#pragma unroll
        for (int w8 = 0; w8 < 8; ++w8) ov += *(const LAS f32x4*)(part + (tb * 8 + w8) * 256 + 4 * lane);
        float ss = (ov.x * ov.x + ov.y * ov.y) + (ov.z * ov.z + ov.w * ov.w); ss = wave_sum(ss);
        const float rs = __builtin_amdgcn_rsqf(ss * (1.f / 256.f) + EPS);
        const f32x4 g4 = *(const f32x4*)(gn + 4 * lane);
        const v2u gw = *(const v2u*)(proj + row * PPITCH + C_GGATE + hh * 256 + 4 * lane);
        const float z0 = __uint_as_float(gw.x << 16), z1 = __uint_as_float(gw.x & 0xffff0000u), z2 = __uint_as_float(gw.y << 16), z3 = __uint_as_float(gw.y & 0xffff0000u);
                *(unsigned*)(ycat8 + row * KBR + 1024 + hh * 256 + 4 * lane) = pg8::pk4_fp8(ov.x * rs * g4.x * (z0 * sigm(z0)), ov.y * rs * g4.y * (z1 * sigm(z1)), ov.z * rs * g4.z * (z2 * sigm(z2)), ov.w * rs * g4.w * (z3 * sigm(z3))); }
    __syncthreads();
}

DI void ml_unit(int l, int s, int hh, LAS float* lds, int tid, int lane, int wave) {
    CArgs* A = kargs();
    const int b = s - NP, row0 = MP + b * TS;
    const bf16* proj = (const bf16*)(A->ws + WS_PROJ); bf16* ycat = (bf16*)(A->ws + WS_YCAT); unsigned char* ycat8 = A->ws + WS_YCAT; (void)ycat; (void)ycat8;     const float* sm = (const float*)(A->ws + WS_SMALL);
    const float* mcw = A->in[26] + (size_t)l * 4 * 1024; const float* mcb = A->in[27] + (size_t)l * 1024;
    const float* wq = A->in[28] + (size_t)l * 256 * 16; const float* wk = A->in[29] + (size_t)l * 256 * 16; const float* wv = A->in[30] + (size_t)l * 256 * 16;
    const float* bif = A->in[31] + (size_t)l * 8; const float* gn = A->in[32] + (size_t)l * 256;
    LAS float* mx_s = lds; LAS float* mc_s = lds + 1792; LAS float* q_s = lds + 2816; LAS float* k_s = lds + 3840; LAS float* v_s = lds + 4864;
    LAS float* ig_s = lds + 5888; LAS float* lf_s = lds + 5896; LAS float* part = lds + 5904;
    const size_t bh = ((size_t)l * NS + b) * 4 + hh;
    f32x4 C[32];
    { const f32x4* cp = (const f32x4*)(A->in[7] + (bh * 256 + 32 * wave) * 256) + lane;
#pragma unroll
      for (int dd = 0; dd < 32; ++dd) C[dd] = __builtin_nontemporal_load(cp + dd * 64); }
    float nn[4]; { const f32x4 n4 = *(const f32x4*)(A->in[8] + bh * 256 + 4 * lane); nn[0] = n4.x; nn[1] = n4.y; nn[2] = n4.z; nn[3] = n4.w; }
    float m = A->in[9][bh];
    const int c0 = tid & 255, ch0 = hh * 256 + c0, wb0 = (64 * hh + (c0 >> 2)) * 16 + (c0 & 3);
    const float cw0 = mcw[ch0], cw1 = mcw[1024 + ch0], cw2 = mcw[2048 + ch0], cw3 = mcw[3072 + ch0], cbv = mcb[ch0];
    float wq4[4], wk4[4], wv4[4];
#pragma unroll
    for (int cc = 0; cc < 4; ++cc) { wq4[cc] = wq[wb0 + 4 * cc]; wk4[cc] = wk[wb0 + 4 * cc] * 0.0625f; wv4[cc] = wv[wb0 + 4 * cc]; }
    float gi = 0.f, gf = 0.f; if (tid < 4) { gi = sm[(size_t)(row0 + tid) * NSMALL + 16 + hh] + bif[hh]; gf = sm[(size_t)(row0 + tid) * NSMALL + 20 + hh] + bif[4 + hh]; }
    for (int i = tid; i < 7 * 256; i += NTHREADS) { const int tr = i >> 8, c = i & 255, tp = tr - 3, ch = hh * 256 + c;
        const float x = tp >= 0 ? bf2f(proj[(size_t)(row0 + tp) * PPITCH + C_MX + ch]) : A->in[10][(((size_t)l * NS + b) * 3 + (3 + tp)) * 1024 + ch];
        mx_s[i] = x;
        if (tp >= 1) A->out[O_S_MLC + (((size_t)l * NS + b) * 3 + (tp - 1)) * 1024 + ch] = x; }
    __syncthreads();
    for (int i = tid; i < 4 * 256; i += NTHREADS) { const int tb = i >> 8, c = i & 255;
        const float acc = cbv + cw0 * mx_s[tb * 256 + c] + cw1 * mx_s[(tb + 1) * 256 + c] + cw2 * mx_s[(tb + 2) * 256 + c] + cw3 * mx_s[(tb + 3) * 256 + c];
        mc_s[i] = acc * sigm(acc); }
    __syncthreads();
    for (int i = tid; i < 4 * 256; i += NTHREADS) { const int tb = i >> 8, c = i & 255, nq = c >> 2;
        float q = 0.f, k = 0.f, v = 0.f;
#pragma unroll
        for (int cc = 0; cc < 4; ++cc) { const float mcv = mc_s[tb * 256 + 4 * nq + cc], mxv = mx_s[(tb + 3) * 256 + 4 * nq + cc];
            q += mcv * wq4[cc]; k += mcv * wk4[cc]; v += mxv * wv4[cc]; }
        q_s[i] = q; k_s[i] = k; v_s[i] = v; }
    if (tid < 4) { ig_s[tid] = gi; lf_s[tid] = logsig(gf); }
    __syncthreads();
    for (int tb = 0; tb < 4; ++tb) {
        const float lf = lf_s[tb], ig = ig_s[tb];
        const float mnew = fmaxf(lf + m, ig), fdec = __expf(lf + m - mnew), iw = __expf(ig - mnew); m = mnew;
        const f32x4 k4n = *(const LAS f32x4*)(k_s + tb * 256 + 4 * lane), q4n = *(const LAS f32x4*)(q_s + tb * 256 + 4 * lane);
        nn[0] = fdec * nn[0] + iw * k4n.x; nn[1] = fdec * nn[1] + iw * k4n.y; nn[2] = fdec * nn[2] + iw * k4n.z; nn[3] = fdec * nn[3] + iw * k4n.w;
        const float den = wave_sum((q4n.x * nn[0] + q4n.y * nn[1]) + (q4n.z * nn[2] + q4n.w * nn[3]));
        if (tid == 0) ig_s[4 + tb] = 1.f / fmaxf(fabsf(den), __expf(-m));
        const f32x4 v4 = *(const LAS f32x4*)(v_s + tb * 256 + 4 * lane) * iw; f32x4 pn = {0.f, 0.f, 0.f, 0.f};
        const LAS float* kp = k_s + tb * 256 + 32 * wave; const LAS float* qp = q_s + tb * 256 + 32 * wave;
#pragma unroll
        for (int d4 = 0; d4 < 8; ++d4) { const f32x4 k4 = *(const LAS f32x4*)(kp + 4 * d4), q4 = *(const LAS f32x4*)(qp + 4 * d4);
            C[4 * d4 + 0] = C[4 * d4 + 0] * fdec + v4 * k4.x; pn += C[4 * d4 + 0] * q4.x;
            C[4 * d4 + 1] = C[4 * d4 + 1] * fdec + v4 * k4.y; pn += C[4 * d4 + 1] * q4.y;
            C[4 * d4 + 2] = C[4 * d4 + 2] * fdec + v4 * k4.z; pn += C[4 * d4 + 2] * q4.z;
            C[4 * d4 + 3] = C[4 * d4 + 3] * fdec + v4 * k4.w; pn += C[4 * d4 + 3] * q4.w; }
        *(LAS f32x4*)(part + (tb * 8 + wave) * 256 + 4 * lane) = pn;
    }
    { f32x4* cp = (f32x4*)(A->out + O_S_C + (bh * 256 + 32 * wave) * 256) + lane;
#pragma unroll
      for (int dd = 0; dd < 32; ++dd) __builtin_nontemporal_store(C[dd], cp + dd * 64);
      if (wave == 0) { f32x4 n4; n4.x = nn[0]; n4.y = nn[1]; n4.z = nn[2]; n4.w = nn[3]; *(f32x4*)(A->out + O_S_N + bh * 256 + 4 * lane) = n4; }
      if (tid == 0) A->out[O_S_M + bh] = m; }
    __syncthreads();
    if (wave < 4) { const int tb = wave; const size_t row = (size_t)(row0 + tb);
        f32x4 hv = {0.f, 0.f, 0.f, 0.f};
#pragma unroll
        for (int w8 = 0; w8 < 8; ++w8) hv += *(const LAS f32x4*)(part + (tb * 8 + w8) * 256 + 4 * lane);
        const float rd = ig_s[4 + tb];
        hv = hv * rd;
        float ss = (hv.x * hv.x + hv.y * hv.y) + (hv.z * hv.z + hv.w * hv.w); ss = wave_sum(ss);
        const float rs = __builtin_amdgcn_rsqf(ss * (1.f / 256.f) + EPS);
        const f32x4 g4 = *(const f32x4*)(gn + 4 * lane);
        const v2u ow = *(const v2u*)(proj + row * PPITCH + C_MO + hh * 256 + 4 * lane);
        const float z0 = __uint_as_float(ow.x << 16), z1 = __uint_as_float(ow.x & 0xffff0000u), z2 = __uint_as_float(ow.y << 16), z3 = __uint_as_float(ow.y & 0xffff0000u);
                *(unsigned*)(ycat8 + row * KBR + 2048 + hh * 256 + 4 * lane) = pg8::pk4_fp8(sigm(z0) * (hv.x * rs * g4.x), sigm(z1) * (hv.y * rs * g4.y), sigm(z2) * (hv.z * rs * g4.z), sigm(z3) * (hv.w * rs * g4.w)); }
    __syncthreads();
}

typedef short bf16x8 __attribute__((ext_vector_type(8)));
typedef float f32x16 __attribute__((ext_vector_type(16)));
#define GL_DSR128(dst, addr, off) asm volatile("ds_read_b128 %0, %1 offset:" #off : "=v"(dst) : "v"(addr))
#define GL_DSR2X64(dst, addr, o0, o1) asm volatile("ds_read2_b64 %0, %1 offset0:" #o0 " offset1:" #o1 : "=v"(dst) : "v"(addr))
#define GL_LWAIT(n, x) asm volatile("s_waitcnt lgkmcnt(" #n ")" : "+v"(x))
#define WG_RAW_BARRIER() asm volatile("s_waitcnt lgkmcnt(0)\n\ts_barrier" ::: "memory")
#define MFMA32(a, b, c) __builtin_amdgcn_mfma_f32_32x32x16_bf16((a), (b), (c), 0, 0, 0)
DI bf16x8 frag16(const LAS unsigned char* p) { return *(const LAS bf16x8*)p; }
DI bf16x8 frag8x2(const LAS unsigned char* p) { const v2u lo = *(const LAS v2u*)p, hi = *(const LAS v2u*)(p + 16);
    const v4u w = {lo.x, lo.y, hi.x, hi.y}; return __builtin_bit_cast(bf16x8, w); }
DI bf16x8 pack_acc(const f32x16& x, int s) {
    const v4u w = {pkbf(x[8 * s + 0], x[8 * s + 1]), pkbf(x[8 * s + 2], x[8 * s + 3]), pkbf(x[8 * s + 4], x[8 * s + 5]), pkbf(x[8 * s + 6], x[8 * s + 7])};
    return __builtin_bit_cast(bf16x8, w); }
DI unsigned short lds_u16(const LAS unsigned char* p) { return *(const LAS unsigned short*)p; }

constexpr int GL_QE = 0, GL_KE = 17408, GL_KDT = 34816, GL_V = 53248, GL_A = 87040, GL_SM = 96256, GL_SEG = 100352, GL_DEC = 102400, GL_OS = 0;
constexpr int GL_PQ = 272, GL_PT = 144, GL_PV = 528, GL_PO = 1040;
constexpr int GIMG_BYTES = 46080, GI_Q = 0, GI_K = 17408, GI_A = 35840, GI_D = 45056, GI_PIECES = 2848;
DI int gimg_lds_off(int idx) {
    return idx < 1088 ? GL_QE + idx * 16 : idx < 2240 ? GL_KDT + (idx - 1088) * 16 : idx < 2816 ? GL_A + (idx - 2240) * 16 : GL_DEC + (idx - 2816) * 16;
}
DI void gla_prep_unit(int l, int s, int hh, int c, LAS unsigned char* lds, int tid) {
    CArgs* A = kargs();
    const bf16* proj = (const bf16*)(A->ws + WS_PROJ); const float* sm = (const float*)(A->ws + WS_SMALL);
    const float* wg2 = A->in[23] + (size_t)l * 16 * 512; const float* bg = A->in[24] + (size_t)l * 512;
    const int lane = tid & 63, w = __builtin_amdgcn_readfirstlane(tid >> 6), r = lane & 31, h = lane >> 5;
    const int d_ = tid & 127, seg = __builtin_amdgcn_readfirstlane(tid >> 7);
    float wg[16];
#pragma unroll
    for (int q = 0; q < 16; ++q) wg[q] = wg2[q * 512 + hh * 128 + d_];
    const float bgv = bg[hh * 128 + d_];
    const int r0 = s * TP + 64 * c;
#pragma unroll
    for (int i = 0; i < 2; ++i) { const int idx = tid + 512 * i, row = idx >> 4, ch = idx & 15; const bf16* rp = proj + (size_t)(r0 + row) * PPITCH + hh * 128 + 8 * ch;
        *(LAS v4u*)(lds + GL_QE + row * GL_PQ + ch * 16) = *(const v4u*)(rp + C_GQ); *(LAS v4u*)(lds + GL_KE + row * GL_PQ + ch * 16) = *(const v4u*)(rp + C_GK); }
    if (tid < 256) { const int row = tid >> 2, qd = tid & 3; *(LAS f32x4*)(lds + GL_SM + row * 64 + qd * 16) = *(const f32x4*)(sm + (size_t)(r0 + row) * NSMALL + 4 * qd); }
    __syncthreads();
    float b[16]; float run = 0.f;
#pragma unroll
    for (int t = 0; t < 16; ++t) { const LAS f32x4* sp = (const LAS f32x4*)(lds + GL_SM + (16 * seg + t) * 64);
        const f32x4 s0 = sp[0], s1 = sp[1], s2 = sp[2], s3 = sp[3];
        float z = bgv;
        z += s0.x * wg[0] + s0.y * wg[1] + s0.z * wg[2] + s0.w * wg[3]; z += s1.x * wg[4] + s1.y * wg[5] + s1.z * wg[6] + s1.w * wg[7];
        z += s2.x * wg[8] + s2.y * wg[9] + s2.z * wg[10] + s2.w * wg[11]; z += s3.x * wg[12] + s3.y * wg[13] + s3.z * wg[14] + s3.w * wg[15];
        run += logsig(z) * (1.f / 16.f); b[t] = run; }
    *(LAS float*)(lds + GL_SEG + (seg * 128 + d_) * 4) = run;
    __syncthreads();
    { float pre = 0.f, tot = 0.f;
#pragma unroll
      for (int s2 = 0; s2 < 4; ++s2) { const float x = *(const LAS float*)(lds + GL_SEG + (s2 * 128 + d_) * 4); tot += x; pre += (s2 < seg) ? x : 0.f; }
      float kd[16];
#pragma unroll
      for (int t = 0; t < 16; ++t) { const int j = 16 * seg + t; const float bb = b[t] + pre;
          const float qraw = bf2f(*(const LAS unsigned short*)(lds + GL_QE + j * GL_PQ + d_ * 2)), kraw = bf2f(*(const LAS unsigned short*)(lds + GL_KE + j * GL_PQ + d_ * 2));
          const float qe = qraw * 0.08838834764831845f * __expf(bb), ke = kraw * __expf(-bb); kd[t] = kraw * __expf(tot - bb);
          *(LAS unsigned short*)(lds + GL_QE + j * GL_PQ + d_ * 2) = (unsigned short)(pkbf(qe, 0.f) & 0xffffu);
          *(LAS unsigned short*)(lds + GL_KE + j * GL_PQ + d_ * 2) = (unsigned short)(pkbf(ke, 0.f) & 0xffffu); }
      v4u k0, k1; k0.x = pkbf(kd[0], kd[1]); k0.y = pkbf(kd[2], kd[3]); k0.z = pkbf(kd[4], kd[5]); k0.w = pkbf(kd[6], kd[7]);
      k1.x = pkbf(kd[8], kd[9]); k1.y = pkbf(kd[10], kd[11]); k1.z = pkbf(kd[12], kd[13]); k1.w = pkbf(kd[14], kd[15]);
      *(LAS v4u*)(lds + GL_KDT + d_ * GL_PT + seg * 32) = k0; *(LAS v4u*)(lds + GL_KDT + d_ * GL_PT + seg * 32 + 16) = k1;
      if (seg == 0) *(LAS float*)(lds + GL_DEC + d_ * 4) = __expf(tot); }
    __syncthreads();
    if (w < 3) { const int it = (w >= 1) ? 1 : 0, jt = (w == 2) ? 1 : 0; f32x16 a;
#pragma unroll
        for (int i = 0; i < 16; ++i) a[i] = 0.f;
#pragma unroll
        for (int s8 = 0; s8 < 8; ++s8) a = MFMA32(frag16(lds + GL_QE + (32 * it + r) * GL_PQ + (16 * s8 + 8 * h) * 2), frag16(lds + GL_KE + (32 * jt + r) * GL_PQ + (16 * s8 + 8 * h) * 2), a);
#pragma unroll
        for (int reg = 0; reg < 16; ++reg) { const int i = 32 * it + (reg & 3) + 8 * (reg >> 2) + 4 * h, j = 32 * jt + r;
            *(LAS unsigned short*)(lds + GL_A + i * GL_PT + j * 2) = (unsigned short)(pkbf(j <= i ? a[reg] : 0.f, 0.f) & 0xffffu); } }
    __syncthreads();
    { unsigned char* img = A->ws + WS_GIMG + (size_t)((s * 4 + hh) * (TP / 64) + c) * GIMG_BYTES;
      for (int idx = tid; idx < GI_PIECES; idx += NTHREADS) *(v4u*)(img + idx * 16) = *(const LAS v4u*)(lds + gimg_lds_off(idx)); }
    __syncthreads();
}

DI void gla_seq_unit(int l, int s, int hh, LAS unsigned char* lds, int tid) {
    CArgs* A = kargs();
    const bf16* proj = (const bf16*)(A->ws + WS_PROJ); bf16* ycat = (bf16*)(A->ws + WS_YCAT); unsigned char* ycat8 = A->ws + WS_YCAT; (void)ycat; (void)ycat8;
    const float* gn = A->in[25] + (size_t)l * 256;
    const unsigned char* img0 = A->ws + WS_GIMG + (size_t)((s * 4 + hh) * (TP / 64)) * GIMG_BYTES;
    const int w = __builtin_amdgcn_readfirstlane(tid >> 6);
    f32x16 St[4];
#pragma unroll
    for (int dt = 0; dt < 4; ++dt)
#pragma unroll
        for (int i = 0; i < 16; ++i) St[dt][i] = 0.f;
    v4u pi[6], pv[4];
#define GLA_PREFETCH(cn) do { int tp_ = tid; asm volatile("" : "+v"(tp_)); const unsigned char* ib_ = img0 + (size_t)(cn) * GIMG_BYTES; \
        _Pragma("unroll") for (int i_ = 0; i_ < 6; ++i_) { const int idx_ = tp_ + 512 * i_; pi[i_] = (v4u){0u, 0u, 0u, 0u}; if (idx_ < GI_PIECES) pi[i_] = *(const v4u*)(ib_ + (unsigned)idx_ * 16u); } \
        const bf16* vb_ = proj + (size_t)(s * TP + 64 * (cn)) * PPITCH + C_GV + hh * 256; \
        _Pragma("unroll") for (int i_ = 0; i_ < 4; ++i_) { const int idx_ = tp_ + 512 * i_; pv[i_] = *(const v4u*)(vb_ + (unsigned)((idx_ >> 5) * PPITCH + 8 * (idx_ & 31))); } } while (0)
    GLA_PREFETCH(0);
    for (int c = 0; c < TP / 64; ++c) {
        const int r0 = s * TP + 64 * c;
        { int tz_ = tid; asm volatile("" : "+v"(tz_));
#pragma unroll
          for (int i = 0; i < 6; ++i) { const int idx = tz_ + 512 * i; if (idx < GI_PIECES) *(LAS v4u*)(lds + gimg_lds_off(idx)) = pi[i]; }
#pragma unroll
          for (int i = 0; i < 4; ++i) { const int idx = tz_ + 512 * i; *(LAS v4u*)(lds + GL_V + (idx >> 5) * GL_PV + (idx & 31) * 16) = pv[i]; } }
        WG_RAW_BARRIER();
        if (c + 1 < TP / 64) GLA_PREFETCH(c + 1);
        v2u gwv[8];
#pragma unroll
        for (int q = 0; q < 8; ++q) gwv[q] = *(const v2u*)(proj + (size_t)(r0 + 8 * w + q) * PPITCH + C_GGATE + hh * 256 + 4 * (tid & 63));
        f32x16 o0, o1;
        { int tz_ = tid; asm volatile("" : "+v"(tz_)); const int lane = tz_ & 63, r = lane & 31, h = lane >> 5;
#pragma unroll
        for (int i = 0; i < 16; ++i) { o0[i] = 0.f; o1[i] = 0.f; }
        { const unsigned qa = (unsigned)(__UINTPTR_TYPE__)(lds + GL_QE + r * GL_PQ + 8 * h), qb = qa + 32 * GL_PQ;
          v4u f0, f1, f2, f3;
          GL_DSR2X64(f0, qa, 0, 2);
          GL_DSR2X64(f1, qb, 0, 2);
          GL_DSR2X64(f2, qa, 4, 6);
          GL_DSR2X64(f3, qb, 4, 6);
          { const bf16x8 bfrag = pack_acc(St[0], 0);
            GL_LWAIT(3, f0); o0 = MFMA32(__builtin_bit_cast(bf16x8, f0), bfrag, o0); GL_DSR2X64(f0, qa, 8, 10);
            GL_LWAIT(3, f1); o1 = MFMA32(__builtin_bit_cast(bf16x8, f1), bfrag, o1); GL_DSR2X64(f1, qb, 8, 10);
          }
          { const bf16x8 bfrag = pack_acc(St[0], 1);
            GL_LWAIT(3, f2); o0 = MFMA32(__builtin_bit_cast(bf16x8, f2), bfrag, o0); GL_DSR2X64(f2, qa, 12, 14);
            GL_LWAIT(3, f3); o1 = MFMA32(__builtin_bit_cast(bf16x8, f3), bfrag, o1); GL_DSR2X64(f3, qb, 12, 14);
          }
          { const bf16x8 bfrag = pack_acc(St[1], 0);
            GL_LWAIT(3, f0); o0 = MFMA32(__builtin_bit_cast(bf16x8, f0), bfrag, o0); GL_DSR2X64(f0, qa, 16, 18);
            GL_LWAIT(3, f1); o1 = MFMA32(__builtin_bit_cast(bf16x8, f1), bfrag, o1); GL_DSR2X64(f1, qb, 16, 18);
          }
          { const bf16x8 bfrag = pack_acc(St[1], 1);
            GL_LWAIT(3, f2); o0 = MFMA32(__builtin_bit_cast(bf16x8, f2), bfrag, o0); GL_DSR2X64(f2, qa, 20, 22);
            GL_LWAIT(3, f3); o1 = MFMA32(__builtin_bit_cast(bf16x8, f3), bfrag, o1); GL_DSR2X64(f3, qb, 20, 22);
          }
          { const bf16x8 bfrag = pack_acc(St[2], 0);
            GL_LWAIT(3, f0); o0 = MFMA32(__builtin_bit_cast(bf16x8, f0), bfrag, o0); GL_DSR2X64(f0, qa, 24, 26);
            GL_LWAIT(3, f1); o1 = MFMA32(__builtin_bit_cast(bf16x8, f1), bfrag, o1); GL_DSR2X64(f1, qb, 24, 26);
          }
          { const bf16x8 bfrag = pack_acc(St[2], 1);
            GL_LWAIT(3, f2); o0 = MFMA32(__builtin_bit_cast(bf16x8, f2), bfrag, o0); GL_DSR2X64(f2, qa, 28, 30);
            GL_LWAIT(3, f3); o1 = MFMA32(__builtin_bit_cast(bf16x8, f3), bfrag, o1); GL_DSR2X64(f3, qb, 28, 30);
          }
          { const bf16x8 bfrag = pack_acc(St[3], 0);
            GL_LWAIT(3, f0); o0 = MFMA32(__builtin_bit_cast(bf16x8, f0), bfrag, o0);
            GL_LWAIT(2, f1); o1 = MFMA32(__builtin_bit_cast(bf16x8, f1), bfrag, o1);
          }
          { const bf16x8 bfrag = pack_acc(St[3], 1);
            GL_LWAIT(1, f2); o0 = MFMA32(__builtin_bit_cast(bf16x8, f2), bfrag, o0);
            GL_LWAIT(0, f3); o1 = MFMA32(__builtin_bit_cast(bf16x8, f3), bfrag, o1);
          }
        }
        { const unsigned aa = (unsigned)(__UINTPTR_TYPE__)(lds + GL_A + r * GL_PT + 16 * h), ka = (unsigned)(__UINTPTR_TYPE__)(lds + GL_KDT + r * GL_PT + 16 * h);
          v4u f0, f1, f2, f3;
          GL_DSR128(f0, aa, 0);
          GL_DSR128(f1, aa, 4608);
          GL_DSR128(f2, ka, 0);
          GL_DSR128(f3, ka, 4608);
#pragma unroll
          for (int dt = 0; dt < 4; ++dt)
#pragma unroll
              for (int g = 0; g < 4; ++g) { const f32x4 dc = *(const LAS f32x4*)(lds + GL_DEC + (32 * dt + 8 * g + 4 * h) * 4);
                  St[dt][4 * g + 0] *= dc.x; St[dt][4 * g + 1] *= dc.y; St[dt][4 * g + 2] *= dc.z; St[dt][4 * g + 3] *= dc.w; }
          { v4u x; const LAS unsigned char* vp = lds + GL_V + (0 + 8 * h) * GL_PV + (32 * w + r) * 2;
            x.x = (unsigned)lds_u16(vp) | ((unsigned)lds_u16(vp + GL_PV) << 16); x.y = (unsigned)lds_u16(vp + 2 * GL_PV) | ((unsigned)lds_u16(vp + 3 * GL_PV) << 16);
            x.z = (unsigned)lds_u16(vp + 4 * GL_PV) | ((unsigned)lds_u16(vp + 5 * GL_PV) << 16); x.w = (unsigned)lds_u16(vp + 6 * GL_PV) | ((unsigned)lds_u16(vp + 7 * GL_PV) << 16);
            const bf16x8 vf = __builtin_bit_cast(bf16x8, x);
            GL_LWAIT(3, f0); o0 = MFMA32(__builtin_bit_cast(bf16x8, f0), vf, o0); GL_DSR128(f0, ka, 9216);
            GL_LWAIT(3, f1); o1 = MFMA32(__builtin_bit_cast(bf16x8, f1), vf, o1); GL_DSR128(f1, ka, 13824);
            GL_LWAIT(3, f2); St[0] = MFMA32(__builtin_bit_cast(bf16x8, f2), vf, St[0]); GL_DSR128(f2, aa, 32);
            GL_LWAIT(3, f3); St[1] = MFMA32(__builtin_bit_cast(bf16x8, f3), vf, St[1]); GL_DSR128(f3, aa, 4640);
            GL_LWAIT(3, f0); St[2] = MFMA32(__builtin_bit_cast(bf16x8, f0), vf, St[2]); GL_DSR128(f0, ka, 32);
            GL_LWAIT(3, f1); St[3] = MFMA32(__builtin_bit_cast(bf16x8, f1), vf, St[3]); GL_DSR128(f1, ka, 4640);
          }
          { v4u x; const LAS unsigned char* vp = lds + GL_V + (16 + 8 * h) * GL_PV + (32 * w + r) * 2;
            x.x = (unsigned)lds_u16(vp) | ((unsigned)lds_u16(vp + GL_PV) << 16); x.y = (unsigned)lds_u16(vp + 2 * GL_PV) | ((unsigned)lds_u16(vp + 3 * GL_PV) << 16);
            x.z = (unsigned)lds_u16(vp + 4 * GL_PV) | ((unsigned)lds_u16(vp + 5 * GL_PV) << 16); x.w = (unsigned)lds_u16(vp + 6 * GL_PV) | ((unsigned)lds_u16(vp + 7 * GL_PV) << 16);
            const bf16x8 vf = __builtin_bit_cast(bf16x8, x);
            GL_LWAIT(3, f2); o0 = MFMA32(__builtin_bit_cast(bf16x8, f2), vf, o0); GL_DSR128(f2, ka, 9248);
            GL_LWAIT(3, f3); o1 = MFMA32(__builtin_bit_cast(bf16x8, f3), vf, o1); GL_DSR128(f3, ka, 13856);
            GL_LWAIT(3, f0); St[0] = MFMA32(__builtin_bit_cast(bf16x8, f0), vf, St[0]); GL_DSR128(f0, aa, 4672);
            GL_LWAIT(3, f1); St[1] = MFMA32(__builtin_bit_cast(bf16x8, f1), vf, St[1]); GL_DSR128(f1, ka, 64);
            GL_LWAIT(3, f2); St[2] = MFMA32(__builtin_bit_cast(bf16x8, f2), vf, St[2]); GL_DSR128(f2, ka, 4672);
            GL_LWAIT(3, f3); St[3] = MFMA32(__builtin_bit_cast(bf16x8, f3), vf, St[3]); GL_DSR128(f3, ka, 9280);
          }
          { v4u x; const LAS unsigned char* vp = lds + GL_V + (32 + 8 * h) * GL_PV + (32 * w + r) * 2;
            x.x = (unsigned)lds_u16(vp) | ((unsigned)lds_u16(vp + GL_PV) << 16); x.y = (unsigned)lds_u16(vp + 2 * GL_PV) | ((unsigned)lds_u16(vp + 3 * GL_PV) << 16);
            x.z = (unsigned)lds_u16(vp + 4 * GL_PV) | ((unsigned)lds_u16(vp + 5 * GL_PV) << 16); x.w = (unsigned)lds_u16(vp + 6 * GL_PV) | ((unsigned)lds_u16(vp + 7 * GL_PV) << 16);
            const bf16x8 vf = __builtin_bit_cast(bf16x8, x);
            GL_LWAIT(3, f0); o1 = MFMA32(__builtin_bit_cast(bf16x8, f0), vf, o1); GL_DSR128(f0, ka, 13888);
            GL_LWAIT(3, f1); St[0] = MFMA32(__builtin_bit_cast(bf16x8, f1), vf, St[0]); GL_DSR128(f1, aa, 4704);
            GL_LWAIT(3, f2); St[1] = MFMA32(__builtin_bit_cast(bf16x8, f2), vf, St[1]); GL_DSR128(f2, ka, 96);
            GL_LWAIT(3, f3); St[2] = MFMA32(__builtin_bit_cast(bf16x8, f3), vf, St[2]); GL_DSR128(f3, ka, 4704);
            GL_LWAIT(3, f0); St[3] = MFMA32(__builtin_bit_cast(bf16x8, f0), vf, St[3]); GL_DSR128(f0, ka, 9312);
          }
          { v4u x; const LAS unsigned char* vp = lds + GL_V + (48 + 8 * h) * GL_PV + (32 * w + r) * 2;
            x.x = (unsigned)lds_u16(vp) | ((unsigned)lds_u16(vp + GL_PV) << 16); x.y = (unsigned)lds_u16(vp + 2 * GL_PV) | ((unsigned)lds_u16(vp + 3 * GL_PV) << 16);
            x.z = (unsigned)lds_u16(vp + 4 * GL_PV) | ((unsigned)lds_u16(vp + 5 * GL_PV) << 16); x.w = (unsigned)lds_u16(vp + 6 * GL_PV) | ((unsigned)lds_u16(vp + 7 * GL_PV) << 16);
            const bf16x8 vf = __builtin_bit_cast(bf16x8, x);
            GL_LWAIT(3, f1); o1 = MFMA32(__builtin_bit_cast(bf16x8, f1), vf, o1); GL_DSR128(f1, ka, 13920);
            GL_LWAIT(3, f2); St[0] = MFMA32(__builtin_bit_cast(bf16x8, f2), vf, St[0]);
            GL_LWAIT(2, f3); St[1] = MFMA32(__builtin_bit_cast(bf16x8, f3), vf, St[1]);
            GL_LWAIT(1, f0); St[2] = MFMA32(__builtin_bit_cast(bf16x8, f0), vf, St[2]);
            GL_LWAIT(0, f1); St[3] = MFMA32(__builtin_bit_cast(bf16x8, f1), vf, St[3]);
          }
          asm volatile("" ::: "memory"); }
        }
        WG_RAW_BARRIER();
        { int tz_ = tid; asm volatile("" : "+v"(tz_)); const int lane = tz_ & 63, r = lane & 31, h = lane >> 5;
#pragma unroll
        for (int reg = 0; reg < 16; ++reg) { const int i = (reg & 3) + 8 * (reg >> 2) + 4 * h;
            *(LAS float*)(lds + GL_OS + i * GL_PO + (32 * w + r) * 4) = o0[reg]; *(LAS float*)(lds + GL_OS + (32 + i) * GL_PO + (32 * w + r) * 4) = o1[reg]; } }
        WG_RAW_BARRIER();
        { int tz_ = tid; asm volatile("" : "+v"(tz_)); const int lane = tz_ & 63;
        const f32x4 gn4 = *(const f32x4*)(gn + 4 * lane);
#pragma unroll
        for (int q = 0; q < 8; ++q) { const int i = 8 * w + q; const size_t row = (size_t)(r0 + i);
            const f32x4 ov = *(const LAS f32x4*)(lds + GL_OS + i * GL_PO + lane * 16);
            float ss = (ov.x * ov.x + ov.y * ov.y) + (ov.z * ov.z + ov.w * ov.w); ss = wave_sum(ss);
            const float rs = __builtin_amdgcn_rsqf(ss * (1.f / 256.f) + EPS);
            const v2u gw = gwv[q];
            const float z0 = __uint_as_float(gw.x << 16), z1 = __uint_as_float(gw.x & 0xffff0000u), z2 = __uint_as_float(gw.y << 16), z3 = __uint_as_float(gw.y & 0xffff0000u);
                        *(unsigned*)(ycat8 + row * KBR + 1024 + hh * 256 + 4 * lane) = pg8::pk4_fp8(ov.x * rs * gn4.x * (z0 * sigm(z0)), ov.y * rs * gn4.y * (z1 * sigm(z1)), ov.z * rs * gn4.z * (z2 * sigm(z2)), ov.w * rs * gn4.w * (z3 * sigm(z3))); } }
        WG_RAW_BARRIER();
    }
    { int tz_ = tid; asm volatile("" : "+v"(tz_)); const int lane = tz_ & 63, r = lane & 31, h = lane >> 5;
      float* op = A->out + O_P_GLA + (((size_t)l * NP + s) * 4 + hh) * 128 * 256 + 32 * w + r;
#pragma unroll
      for (int dt = 0; dt < 4; ++dt)
#pragma unroll
          for (int reg = 0; reg < 16; ++reg) op[(size_t)(32 * dt + (reg & 3) + 8 * (reg >> 2) + 4 * h) * 256] = St[dt][reg]; }
    __syncthreads();
}

constexpr int ML_Q = 0, ML_K = 33792, ML_KWT = 67584, ML_V = 104448, ML_S = 138240, ML_SC = 147456, ML_HS = 0;
constexpr int ML_PQ = 528, ML_PT = 144, ML_PH = 1040;
constexpr int IS_F = 0, IS_PM = 64, IS_RSP = 128, IS_NP = 192, IS_FL = 448, IS_CMAX = 449;
constexpr int SC_COLF = 512, SC_RDEN = 512, SC_QN = 576, SC_N = 1088, SC_CW = 576, SC_RAT = 1344;
static_assert(ML_SC + (576 + 1280) * 4 <= LDSCTL_OFF && 67 * 512 <= ML_V - ML_KWT, "mLSTM LDS map");
constexpr int MIMG_BYTES = 115712, MI_PIECES = 7232;
DI int mimg_lds_off(int idx) { return idx < 2112 ? ML_Q + idx * 16 : idx < 4416 ? ML_KWT + (idx - 2112) * 16 : idx < 6528 ? ML_V + (idx - 4416) * 16 : idx < 7104 ? ML_S + (idx - 6528) * 16 : ML_SC + (idx - 7104) * 16; }
DI float quad_bcast(float v, int cc) {
    const int x = __float_as_int(v); int y;
    switch (cc) { case 0: y = __builtin_amdgcn_mov_dpp(x, 0x00, 0xf, 0xf, true); break; case 1: y = __builtin_amdgcn_mov_dpp(x, 0x55, 0xf, 0xf, true); break;
                  case 2: y = __builtin_amdgcn_mov_dpp(x, 0xaa, 0xf, 0xf, true); break; default: y = __builtin_amdgcn_mov_dpp(x, 0xff, 0xf, 0xf, true); break; }
    return __int_as_float(y);
}
DI void ml_prep_unit(int l, int s, int hh, int c, LAS unsigned char* lds, int tid) {
    CArgs* A = kargs();
    const bf16* proj = (const bf16*)(A->ws + WS_PROJ); const float* sm = (const float*)(A->ws + WS_SMALL);
    const float* mcw = A->in[26] + (size_t)l * 4 * 1024; const float* mcb = A->in[27] + (size_t)l * 1024; const float* bif = A->in[31] + (size_t)l * 8;
    const int lane = tid & 63, w = __builtin_amdgcn_readfirstlane(tid >> 6), r = lane & 31, h = lane >> 5;
    const int c_ = tid & 255, seg = __builtin_amdgcn_readfirstlane(tid >> 8);
    LAS float* sc = (LAS float*)(lds + ML_SC);
    const int r0 = s * TP + 64 * c;
    { const bf16* pb = proj + ((ptrdiff_t)r0 - 3) * (ptrdiff_t)PPITCH + C_MX + hh * 256;
#pragma unroll
      for (int i = 0; i < 5; ++i) { const int idx = tid + 512 * i, row = idx >> 5; v4u x = {0u, 0u, 0u, 0u};
          if (idx < 2144) { if (64 * c - 3 + row >= 0) x = *(const v4u*)(pb + (unsigned)(row * PPITCH + 8 * (idx & 31))); *(LAS v4u*)(lds + ML_KWT + row * 512 + (idx & 31) * 16) = x; } }
      if (tid < 256) { const int ch0 = hh * 256 + tid;
          sc[SC_CW + tid] = mcw[ch0]; sc[SC_CW + 256 + tid] = mcw[1024 + ch0]; sc[SC_CW + 512 + tid] = mcw[2048 + ch0]; sc[SC_CW + 768 + tid] = mcw[3072 + ch0]; sc[SC_CW + 1024 + tid] = mcb[ch0]; }
      if (w == 0) {
          const float ig = sm[(size_t)(r0 + lane) * NSMALL + 16 + hh] + bif[hh];
          const float lf = logsig(sm[(size_t)(r0 + lane) * NSMALL + 20 + hh] + bif[4 + hh]);
          float F = lf;
#pragma unroll
          for (int o = 1; o < 64; o <<= 1) { const float t = __shfl_up(F, o); F += (lane >= o) ? t : 0.f; }
          const float colf = ig - F; float pm = colf;
#pragma unroll
          for (int o = 1; o < 64; o <<= 1) { const float t = __shfl_up(pm, o); pm = (lane >= o) ? fmaxf(pm, t) : pm; }
          sc[IS_F + lane] = F; sc[IS_PM + lane] = pm; sc[SC_COLF + lane] = colf;
          if (lane == 63) { sc[IS_FL] = F; sc[IS_CMAX] = pm; } } }
    float wq4[4], wk4[4], wv4[4];
    { const int wb = (64 * hh + (c_ >> 2)) * 16 + (c_ & 3);
#pragma unroll
      for (int cc = 0; cc < 4; ++cc) { wq4[cc] = A->in[28][(size_t)l * 4096 + wb + 4 * cc]; wk4[cc] = A->in[29][(size_t)l * 4096 + wb + 4 * cc] * 0.0625f; wv4[cc] = A->in[30][(size_t)l * 4096 + wb + 4 * cc]; } }
    __syncthreads();
    { const float cw0 = sc[SC_CW + c_], cw1 = sc[SC_CW + 256 + c_], cw2 = sc[SC_CW + 512 + c_], cw3 = sc[SC_CW + 768 + c_], cbv = sc[SC_CW + 1024 + c_];
      const LAS unsigned char* xp = lds + ML_KWT + (32 * seg) * 512 + c_ * 2;
      float x0 = bf2f(lds_u16(xp)), x1 = bf2f(lds_u16(xp + 512)), x2 = bf2f(lds_u16(xp + 1024));
#pragma unroll 8
      for (int t = 0; t < 32; ++t) {
          const float x3 = bf2f(lds_u16(xp + (3 + t) * 512));
          const float pre = cbv + cw0 * x0 + cw1 * x1 + cw2 * x2 + cw3 * x3, mc = pre * sigm(pre);
          float q = 0.f, k = 0.f, v = 0.f;
#pragma unroll
          for (int cc = 0; cc < 4; ++cc) { const float mcv = quad_bcast(mc, cc), xv = quad_bcast(x3, cc); q += mcv * wq4[cc]; k += mcv * wk4[cc]; v += xv * wv4[cc]; }
          const int j = 32 * seg + t;
          *(LAS unsigned short*)(lds + ML_Q + j * ML_PQ + c_ * 2) = (unsigned short)(pkbf(q, 0.f) & 0xffffu);
          *(LAS unsigned short*)(lds + ML_K + j * ML_PQ + c_ * 2) = (unsigned short)(pkbf(k, 0.f) & 0xffffu);
          *(LAS unsigned short*)(lds + ML_V + j * ML_PQ + c_ * 2) = (unsigned short)(pkbf(v, 0.f) & 0xffffu);
          if (c == TP / 64 - 1 && seg == 1 && t >= 29) A->out[O_P_MLC + (((size_t)l * NP + s) * 3 + (t - 29)) * 1024 + hh * 256 + c_] = x3;
          x0 = x1; x1 = x2; x2 = x3;
      } }
    __syncthreads();
    { const float cmax = sc[IS_CMAX]; float np = 0.f; v4u kk[4];
#pragma unroll
      for (int t8 = 0; t8 < 4; ++t8) { float kw[8];
#pragma unroll
          for (int t = 0; t < 8; ++t) { const int j = 32 * seg + 8 * t8 + t; kw[t] = bf2f(lds_u16(lds + ML_K + j * ML_PQ + c_ * 2)) * __expf(sc[SC_COLF + j] - cmax); np += kw[t]; }
          kk[t8].x = pkbf(kw[0], kw[1]); kk[t8].y = pkbf(kw[2], kw[3]); kk[t8].z = pkbf(kw[4], kw[5]); kk[t8].w = pkbf(kw[6], kw[7]); }
#pragma unroll
      for (int t8 = 0; t8 < 4; ++t8) *(LAS v4u*)(lds + ML_KWT + c_ * ML_PT + seg * 64 + t8 * 16) = kk[t8];
      sc[SC_QN + seg * 256 + c_] = np; }
    if (w < 3) { const int it = (w >= 1) ? 1 : 0, jt = (w == 2) ? 1 : 0; f32x16 a;
#pragma unroll
        for (int i = 0; i < 16; ++i) a[i] = 0.f;
#pragma unroll
        for (int s16 = 0; s16 < 16; ++s16) { a = MFMA32(frag16(lds + ML_Q + (32 * it + r) * ML_PQ + (16 * s16 + 8 * h) * 2), frag16(lds + ML_K + (32 * jt + r) * ML_PQ + (16 * s16 + 8 * h) * 2), a);
            if ((s16 & 3) == 3) asm volatile("" ::: "memory"); }
        const int j = 32 * jt + r; const float cf = sc[SC_COLF + j];
#pragma unroll
        for (int g = 0; g < 4; ++g) { const f32x4 pmv = *(const LAS f32x4*)(sc + IS_PM + 32 * it + 8 * g + 4 * h);
#pragma unroll
            for (int q = 0; q < 4; ++q) { const int i = 32 * it + 8 * g + 4 * h + q; const float val = (j <= i) ? a[4 * g + q] * __expf(cf - pmv[q]) : 0.f;
                *(LAS unsigned short*)(lds + ML_S + i * ML_PT + j * 2) = (unsigned short)(pkbf(val, 0.f) & 0xffffu); } } }
    __syncthreads();
    if (w == 0) { const int i = lane; float rs_ = 0.f;
#pragma unroll
        for (int k8 = 0; k8 < 8; ++k8) { const v4u sw = *(const LAS v4u*)(lds + ML_S + i * ML_PT + k8 * 16);
            const float t8 = (bflo_(sw.x) + bfhi_(sw.x)) + (bflo_(sw.y) + bfhi_(sw.y)) + (bflo_(sw.z) + bfhi_(sw.z)) + (bflo_(sw.w) + bfhi_(sw.w));
            rs_ += (k8 < 4 || i >= 32) ? t8 : 0.f; }
        sc[IS_RSP + i] = rs_; }
    if (tid < 256) sc[IS_NP + tid] = sc[SC_QN + tid] + sc[SC_QN + 256 + tid];
    __syncthreads();
    { unsigned char* img = A->ws + WS_MIMG + (size_t)((s * 4 + hh) * (TP / 64) + c) * MIMG_BYTES;
      for (int idx = tid; idx < MI_PIECES; idx += NTHREADS) *(v4u*)(img + (size_t)idx * 16) = *(const LAS v4u*)(lds + mimg_lds_off(idx)); }
    __syncthreads();
}

DI void ml_img_dma(const unsigned char* img, LAS unsigned char* lds, int ih, int w, int lane) {
    for (int k = w; k < MI_PIECES / 64; k += NWAVES) {
        const bool skip = ih ? (k < 16 || (k >= 102 && k < 106)) : ((k > 16 && k < 33) || (k > 106 && k < 111));
        if (!skip) __builtin_amdgcn_global_load_lds((const unsigned*)(img + (size_t)(64 * k + lane) * 16), (LAS unsigned*)(lds + mimg_lds_off(64 * k)), 16, 0, 0); }
}
#define ML_RAW_BARRIER() asm volatile("s_waitcnt lgkmcnt(0)\n\ts_barrier" ::: "memory")
#define ML_DSR128(dst, addr, off) asm volatile("ds_read_b128 %0, %1 offset:" #off : "=v"(dst) : "v"(addr))
#define ML_DSR2X64(dst, addr, o0, o1) asm volatile("ds_read2_b64 %0, %1 offset0:" #o0 " offset1:" #o1 : "=v"(dst) : "v"(addr))
#define ML_LWAIT(n, x) asm volatile("s_waitcnt lgkmcnt(" #n ")" : "+v"(x))
constexpr int ML_HB = 33792, ML_PHB = 528;
DI void ml_seq_unit(int l, int s, int hh, int ih, LAS unsigned char* lds, int tid) {
    CArgs* A = kargs();
    const bf16* proj = (const bf16*)(A->ws + WS_PROJ); bf16* ycat = (bf16*)(A->ws + WS_YCAT); unsigned char* ycat8 = A->ws + WS_YCAT; (void)ycat; (void)ycat8;
    const float* gn = A->in[32] + (size_t)l * 256;
    const unsigned char* img0 = A->ws + WS_MIMG + (size_t)((s * 4 + hh) * (TP / 64)) * MIMG_BYTES;
    const int w = __builtin_amdgcn_readfirstlane(tid >> 6);
    LAS float* sc = (LAS float*)(lds + ML_SC);
    f32x16 Ct[8];
#pragma unroll
    for (int dt = 0; dt < 8; ++dt)
#pragma unroll
        for (int i = 0; i < 16; ++i) Ct[dt][i] = 0.f;
    if (tid < 256) sc[SC_N + tid] = 0.f;
    float m = 0.f, sg = 1.f;
#ifdef PROBE_ABL
    const int abl = (kargs()->li == 1) ? PROBE_ABL : 0;
#else
    constexpr int abl = 0;
#endif
    __syncthreads();
    ml_img_dma(img0, lds, ih, w, tid & 63);
    for (int c = 0; c < TP / 64; ++c) {
        const int r0 = s * TP + 64 * c;
        if (c == 0) asm volatile("s_waitcnt vmcnt(0)" ::: "memory"); else asm volatile("s_waitcnt vmcnt(4)" ::: "memory");
        ML_RAW_BARRIER();
        { int tz_ = tid; asm volatile("" : "+v"(tz_)); const int i = tz_ & 63; float acc = 0.f;
#pragma unroll
          for (int k8 = 0; k8 < 4; ++k8) { const v4u qw = *(const LAS v4u*)(lds + ML_Q + i * ML_PQ + (32 * w + 8 * k8) * 2);
              const f32x4 n0 = *(const LAS f32x4*)(sc + SC_N + 32 * w + 8 * k8), n1 = *(const LAS f32x4*)(sc + SC_N + 32 * w + 8 * k8 + 4);
              acc += bflo_(qw.x) * n0.x + bfhi_(qw.x) * n0.y + bflo_(qw.y) * n0.z + bfhi_(qw.y) * n0.w + bflo_(qw.z) * n1.x + bfhi_(qw.z) * n1.y + bflo_(qw.w) * n1.z + bfhi_(qw.w) * n1.w; }
          sc[SC_QN + w * 64 + i] = acc;
          if (w == 1) sc[SC_RAT + i] = __expf(fminf(m - sc[IS_PM + i], 60.f)) * sg; }
        const float FL = sc[IS_FL], cmax = sc[IS_CMAX];
        const float cs = __expf(fminf(0.f, m - cmax)), s2 = __expf(fminf(0.f, cmax - m));
        v2u mo[4]; f32x4 gn4;
        { int tm_ = tid; asm volatile("" : "+v"(tm_)); const unsigned lo_ = 4u * (unsigned)(tm_ & 63);
          const bf16* mb_ = proj + (size_t)(r0 + 32 * ih + 4 * w) * PPITCH + C_MO + hh * 256;
#pragma unroll
          for (int q = 0; q < 4; ++q) mo[q] = *(const v2u*)(mb_ + (unsigned)(q * PPITCH) + lo_);
          gn4 = *(const f32x4*)(gn + lo_); }
        ML_RAW_BARRIER();
        f32x16 o0;
        { int tz_ = tid; asm volatile("" : "+v"(tz_)); const int lane = tz_ & 63, r = lane & 31, h = lane >> 5;
        if (w == 0) { const int i = lane; const float pmi = sc[IS_PM + i];
            float qn = 0.f;
#pragma unroll
            for (int p = 0; p < 8; ++p) qn += sc[SC_QN + p * 64 + i];
            const float den = __expf(fminf(0.f, m - pmi)) * qn + __expf(fminf(0.f, pmi - m)) * sc[IS_RSP + i];
            sc[SC_RDEN + i] = __expf(-fminf(fmaxf(m - pmi, 0.f), 60.f)) / fmaxf(fabsf(den), __expf(-(sc[IS_F + i] + fmaxf(m, pmi)))); }
        if (tz_ < 256) sc[SC_N + tz_] = cs * sc[SC_N + tz_] + s2 * sc[IS_NP + tz_];
#pragma unroll
        for (int i = 0; i < 16; ++i) o0[i] = 0.f;
        { const unsigned qa = (unsigned)(__UINTPTR_TYPE__)(lds + ML_Q + (32 * ih + r) * ML_PQ + 8 * h);
          v4u q0, q1, q2, q3;
          ML_DSR2X64(q0, qa, 0, 2);
          ML_DSR2X64(q1, qa, 4, 6);
          ML_DSR2X64(q2, qa, 8, 10);
          ML_DSR2X64(q3, qa, 12, 14);
          { const bf16x8 bfrag = pack_acc(Ct[0], 0); ML_LWAIT(3, q0); o0 = MFMA32(__builtin_bit_cast(bf16x8, q0), bfrag, o0); ML_DSR2X64(q0, qa, 16, 18); }
          { const bf16x8 bfrag = pack_acc(Ct[0], 1); ML_LWAIT(3, q1); o0 = MFMA32(__builtin_bit_cast(bf16x8, q1), bfrag, o0); ML_DSR2X64(q1, qa, 20, 22); }
          { const bf16x8 bfrag = pack_acc(Ct[1], 0); ML_LWAIT(3, q2); o0 = MFMA32(__builtin_bit_cast(bf16x8, q2), bfrag, o0); ML_DSR2X64(q2, qa, 24, 26); }
          { const bf16x8 bfrag = pack_acc(Ct[1], 1); ML_LWAIT(3, q3); o0 = MFMA32(__builtin_bit_cast(bf16x8, q3), bfrag, o0); ML_DSR2X64(q3, qa, 28, 30); }
          { const bf16x8 bfrag = pack_acc(Ct[2], 0); ML_LWAIT(3, q0); o0 = MFMA32(__builtin_bit_cast(bf16x8, q0), bfrag, o0); ML_DSR2X64(q0, qa, 32, 34); }
          { const bf16x8 bfrag = pack_acc(Ct[2], 1); ML_LWAIT(3, q1); o0 = MFMA32(__builtin_bit_cast(bf16x8, q1), bfrag, o0); ML_DSR2X64(q1, qa, 36, 38); }
          { const bf16x8 bfrag = pack_acc(Ct[3], 0); ML_LWAIT(3, q2); o0 = MFMA32(__builtin_bit_cast(bf16x8, q2), bfrag, o0); ML_DSR2X64(q2, qa, 40, 42); }
          { const bf16x8 bfrag = pack_acc(Ct[3], 1); ML_LWAIT(3, q3); o0 = MFMA32(__builtin_bit_cast(bf16x8, q3), bfrag, o0); ML_DSR2X64(q3, qa, 44, 46); }
          { const bf16x8 bfrag = pack_acc(Ct[4], 0); ML_LWAIT(3, q0); o0 = MFMA32(__builtin_bit_cast(bf16x8, q0), bfrag, o0); ML_DSR2X64(q0, qa, 48, 50); }
          { const bf16x8 bfrag = pack_acc(Ct[4], 1); ML_LWAIT(3, q1); o0 = MFMA32(__builtin_bit_cast(bf16x8, q1), bfrag, o0); ML_DSR2X64(q1, qa, 52, 54); }
          { const bf16x8 bfrag = pack_acc(Ct[5], 0); ML_LWAIT(3, q2); o0 = MFMA32(__builtin_bit_cast(bf16x8, q2), bfrag, o0); ML_DSR2X64(q2, qa, 56, 58); }
          { const bf16x8 bfrag = pack_acc(Ct[5], 1); ML_LWAIT(3, q3); o0 = MFMA32(__builtin_bit_cast(bf16x8, q3), bfrag, o0); ML_DSR2X64(q3, qa, 60, 62); }
          { const bf16x8 bfrag = pack_acc(Ct[6], 0); ML_LWAIT(3, q0); o0 = MFMA32(__builtin_bit_cast(bf16x8, q0), bfrag, o0); }
          { const bf16x8 bfrag = pack_acc(Ct[6], 1); ML_LWAIT(2, q1); o0 = MFMA32(__builtin_bit_cast(bf16x8, q1), bfrag, o0); }
          { const bf16x8 bfrag = pack_acc(Ct[7], 0); ML_LWAIT(1, q2); o0 = MFMA32(__builtin_bit_cast(bf16x8, q2), bfrag, o0); }
          { const bf16x8 bfrag = pack_acc(Ct[7], 1); ML_LWAIT(0, q3); o0 = MFMA32(__builtin_bit_cast(bf16x8, q3), bfrag, o0); }
        }
#pragma unroll
        for (int g = 0; g < 4; ++g) { const f32x4 p0 = *(const LAS f32x4*)(sc + SC_RAT + 32 * ih + 8 * g + 4 * h);
#pragma unroll
            for (int q = 0; q < 4; ++q) o0[4 * g + q] *= p0[q]; }
        sg *= cs;
        if (sg < 1e-12f) {
#pragma unroll
            for (int dt = 0; dt < 8; ++dt)
#pragma unroll
                for (int i = 0; i < 16; ++i) Ct[dt][i] *= sg;
            sg = 1.f; }
        const float vsc = s2 * __builtin_amdgcn_rcpf(sg);
        { const LAS unsigned char* vp = lds + ML_V + (8 * h) * ML_PQ + (32 * w + r) * 2;
          const unsigned ka = (unsigned)(__UINTPTR_TYPE__)(lds + ML_KWT + r * ML_PT + 16 * h);
          const LAS unsigned char* pp = lds + ML_S + (32 * ih + r) * ML_PT + 16 * h;
          v4u k0, k1, k2, k3;
          ML_DSR128(k0, ka, 0);
          ML_DSR128(k1, ka, 4608);
          ML_DSR128(k2, ka, 9216);
          ML_DSR128(k3, ka, 13824);
          { float vv[8];
#pragma unroll
            for (int jj = 0; jj < 8; ++jj) vv[jj] = bf2f(lds_u16(vp + (0 + jj) * ML_PQ));
            const v4u xu = {pkbf(vv[0], vv[1]), pkbf(vv[2], vv[3]), pkbf(vv[4], vv[5]), pkbf(vv[6], vv[7])};
            const v4u xs = {pkbf(vv[0] * vsc, vv[1] * vsc), pkbf(vv[2] * vsc, vv[3] * vsc), pkbf(vv[4] * vsc, vv[5] * vsc), pkbf(vv[6] * vsc, vv[7] * vsc)};
            const bf16x8 vf = __builtin_bit_cast(bf16x8, xu), vfs = __builtin_bit_cast(bf16x8, xs);
            o0 = MFMA32(frag16(pp + 0), vf, o0);
            ML_LWAIT(3, k0); Ct[0] = MFMA32(__builtin_bit_cast(bf16x8, k0), vfs, Ct[0]); ML_DSR128(k0, ka, 18432);
            ML_LWAIT(3, k1); Ct[1] = MFMA32(__builtin_bit_cast(bf16x8, k1), vfs, Ct[1]); ML_DSR128(k1, ka, 23040);
            ML_LWAIT(3, k2); Ct[2] = MFMA32(__builtin_bit_cast(bf16x8, k2), vfs, Ct[2]); ML_DSR128(k2, ka, 27648);
            ML_LWAIT(3, k3); Ct[3] = MFMA32(__builtin_bit_cast(bf16x8, k3), vfs, Ct[3]); ML_DSR128(k3, ka, 32256);
            ML_LWAIT(3, k0); Ct[4] = MFMA32(__builtin_bit_cast(bf16x8, k0), vfs, Ct[4]); ML_DSR128(k0, ka, 32);
            ML_LWAIT(3, k1); Ct[5] = MFMA32(__builtin_bit_cast(bf16x8, k1), vfs, Ct[5]); ML_DSR128(k1, ka, 4640);
            ML_LWAIT(3, k2); Ct[6] = MFMA32(__builtin_bit_cast(bf16x8, k2), vfs, Ct[6]); ML_DSR128(k2, ka, 9248);
            ML_LWAIT(3, k3); Ct[7] = MFMA32(__builtin_bit_cast(bf16x8, k3), vfs, Ct[7]); ML_DSR128(k3, ka, 13856);
          }
          { float vv[8];
#pragma unroll
            for (int jj = 0; jj < 8; ++jj) vv[jj] = bf2f(lds_u16(vp + (16 + jj) * ML_PQ));
            const v4u xu = {pkbf(vv[0], vv[1]), pkbf(vv[2], vv[3]), pkbf(vv[4], vv[5]), pkbf(vv[6], vv[7])};
            const v4u xs = {pkbf(vv[0] * vsc, vv[1] * vsc), pkbf(vv[2] * vsc, vv[3] * vsc), pkbf(vv[4] * vsc, vv[5] * vsc), pkbf(vv[6] * vsc, vv[7] * vsc)};
            const bf16x8 vf = __builtin_bit_cast(bf16x8, xu), vfs = __builtin_bit_cast(bf16x8, xs);
            o0 = MFMA32(frag16(pp + 32), vf, o0);
            ML_LWAIT(3, k0); Ct[0] = MFMA32(__builtin_bit_cast(bf16x8, k0), vfs, Ct[0]); ML_DSR128(k0, ka, 18464);
            ML_LWAIT(3, k1); Ct[1] = MFMA32(__builtin_bit_cast(bf16x8, k1), vfs, Ct[1]); ML_DSR128(k1, ka, 23072);
            ML_LWAIT(3, k2); Ct[2] = MFMA32(__builtin_bit_cast(bf16x8, k2), vfs, Ct[2]); ML_DSR128(k2, ka, 27680);
            ML_LWAIT(3, k3); Ct[3] = MFMA32(__builtin_bit_cast(bf16x8, k3), vfs, Ct[3]); ML_DSR128(k3, ka, 32288);
            ML_LWAIT(3, k0); Ct[4] = MFMA32(__builtin_bit_cast(bf16x8, k0), vfs, Ct[4]); ML_DSR128(k0, ka, 64);
            ML_LWAIT(3, k1); Ct[5] = MFMA32(__builtin_bit_cast(bf16x8, k1), vfs, Ct[5]); ML_DSR128(k1, ka, 4672);
            ML_LWAIT(3, k2); Ct[6] = MFMA32(__builtin_bit_cast(bf16x8, k2), vfs, Ct[6]); ML_DSR128(k2, ka, 9280);
            ML_LWAIT(3, k3); Ct[7] = MFMA32(__builtin_bit_cast(bf16x8, k3), vfs, Ct[7]); ML_DSR128(k3, ka, 13888);
          }
          { float vv[8];
#pragma unroll
            for (int jj = 0; jj < 8; ++jj) vv[jj] = bf2f(lds_u16(vp + (32 + jj) * ML_PQ));
            const v4u xu = {pkbf(vv[0], vv[1]), pkbf(vv[2], vv[3]), pkbf(vv[4], vv[5]), pkbf(vv[6], vv[7])};
            const v4u xs = {pkbf(vv[0] * vsc, vv[1] * vsc), pkbf(vv[2] * vsc, vv[3] * vsc), pkbf(vv[4] * vsc, vv[5] * vsc), pkbf(vv[6] * vsc, vv[7] * vsc)};
            const bf16x8 vf = __builtin_bit_cast(bf16x8, xu), vfs = __builtin_bit_cast(bf16x8, xs);
            if (ih == 1) o0 = MFMA32(frag16(pp + 64), vf, o0);
            ML_LWAIT(3, k0); Ct[0] = MFMA32(__builtin_bit_cast(bf16x8, k0), vfs, Ct[0]); ML_DSR128(k0, ka, 18496);
            ML_LWAIT(3, k1); Ct[1] = MFMA32(__builtin_bit_cast(bf16x8, k1), vfs, Ct[1]); ML_DSR128(k1, ka, 23104);
            ML_LWAIT(3, k2); Ct[2] = MFMA32(__builtin_bit_cast(bf16x8, k2), vfs, Ct[2]); ML_DSR128(k2, ka, 27712);
            ML_LWAIT(3, k3); Ct[3] = MFMA32(__builtin_bit_cast(bf16x8, k3), vfs, Ct[3]); ML_DSR128(k3, ka, 32320);
            ML_LWAIT(3, k0); Ct[4] = MFMA32(__builtin_bit_cast(bf16x8, k0), vfs, Ct[4]); ML_DSR128(k0, ka, 96);
            ML_LWAIT(3, k1); Ct[5] = MFMA32(__builtin_bit_cast(bf16x8, k1), vfs, Ct[5]); ML_DSR128(k1, ka, 4704);
            ML_LWAIT(3, k2); Ct[6] = MFMA32(__builtin_bit_cast(bf16x8, k2), vfs, Ct[6]); ML_DSR128(k2, ka, 9312);
            ML_LWAIT(3, k3); Ct[7] = MFMA32(__builtin_bit_cast(bf16x8, k3), vfs, Ct[7]); ML_DSR128(k3, ka, 13920);
          }
          { float vv[8];
#pragma unroll
            for (int jj = 0; jj < 8; ++jj) vv[jj] = bf2f(lds_u16(vp + (48 + jj) * ML_PQ));
            const v4u xu = {pkbf(vv[0], vv[1]), pkbf(vv[2], vv[3]), pkbf(vv[4], vv[5]), pkbf(vv[6], vv[7])};
            const v4u xs = {pkbf(vv[0] * vsc, vv[1] * vsc), pkbf(vv[2] * vsc, vv[3] * vsc), pkbf(vv[4] * vsc, vv[5] * vsc), pkbf(vv[6] * vsc, vv[7] * vsc)};
            const bf16x8 vf = __builtin_bit_cast(bf16x8, xu), vfs = __builtin_bit_cast(bf16x8, xs);
            if (ih == 1) o0 = MFMA32(frag16(pp + 96), vf, o0);
            ML_LWAIT(3, k0); Ct[0] = MFMA32(__builtin_bit_cast(bf16x8, k0), vfs, Ct[0]); ML_DSR128(k0, ka, 18528);
            ML_LWAIT(3, k1); Ct[1] = MFMA32(__builtin_bit_cast(bf16x8, k1), vfs, Ct[1]); ML_DSR128(k1, ka, 23136);
            ML_LWAIT(3, k2); Ct[2] = MFMA32(__builtin_bit_cast(bf16x8, k2), vfs, Ct[2]); ML_DSR128(k2, ka, 27744);
            ML_LWAIT(3, k3); Ct[3] = MFMA32(__builtin_bit_cast(bf16x8, k3), vfs, Ct[3]); ML_DSR128(k3, ka, 32352);
            ML_LWAIT(3, k0); Ct[4] = MFMA32(__builtin_bit_cast(bf16x8, k0), vfs, Ct[4]);
            ML_LWAIT(2, k1); Ct[5] = MFMA32(__builtin_bit_cast(bf16x8, k1), vfs, Ct[5]);
            ML_LWAIT(1, k2); Ct[6] = MFMA32(__builtin_bit_cast(bf16x8, k2), vfs, Ct[6]);
            ML_LWAIT(0, k3); Ct[7] = MFMA32(__builtin_bit_cast(bf16x8, k3), vfs, Ct[7]);
          }
          asm volatile("" ::: "memory"); }
        }
        m = FL + fmaxf(m, cmax);
        ML_RAW_BARRIER();
        { int tz_ = tid; asm volatile("" : "+v"(tz_)); const int lane = tz_ & 63, r = lane & 31, h = lane >> 5;
#pragma unroll
        for (int g = 0; g < 4; ++g) { const f32x4 d0 = *(const LAS f32x4*)(sc + SC_RDEN + 32 * ih + 8 * g + 4 * h);
#pragma unroll
            for (int q = 0; q < 4; ++q) { const int i = 8 * g + 4 * h + q;
                *(LAS unsigned short*)(lds + ML_HB + i * ML_PHB + (32 * w + r) * 2) = (unsigned short)(pkbf(o0[4 * g + q] * d0[q], 0.f) & 0xffffu); } }
        }
        float og[4][4];
#pragma unroll
        for (int q = 0; q < 4; ++q) { const v2u ow = mo[q];
            og[q][0] = sigm(__uint_as_float(ow.x << 16)) * gn4.x; og[q][1] = sigm(__uint_as_float(ow.x & 0xffff0000u)) * gn4.y;
            og[q][2] = sigm(__uint_as_float(ow.y << 16)) * gn4.z; og[q][3] = sigm(__uint_as_float(ow.y & 0xffff0000u)) * gn4.w; }
#pragma unroll
        for (int q = 0; q < 4; ++q) asm volatile("" : "+v"(og[q][0]), "+v"(og[q][1]), "+v"(og[q][2]), "+v"(og[q][3]));
        if (c + 1 < TP / 64 && !(abl & 1)) ml_img_dma(img0 + (size_t)(c + 1) * MIMG_BYTES, lds, ih, w, tid & 63);
        ML_RAW_BARRIER();
        { int tz_ = tid; asm volatile("" : "+v"(tz_)); const int lane = tz_ & 63;
#pragma unroll
        for (int q = 0; q < 4; ++q) { const int i = 4 * w + q; const size_t row = (size_t)(r0 + 32 * ih + i);
            const v2u hw = *(const LAS v2u*)(lds + ML_HB + i * ML_PHB + lane * 8);
            const float h0 = bflo_(hw.x), h1 = bfhi_(hw.x), h2 = bflo_(hw.y), h3 = bfhi_(hw.y);
            float ss = (h0 * h0 + h1 * h1) + (h2 * h2 + h3 * h3); ss = wave_sum(ss);
            const float rs = __builtin_amdgcn_rsqf(ss * (1.f / 256.f) + EPS);
                        *(unsigned*)(ycat8 + row * KBR + 2048 + hh * 256 + 4 * lane) = pg8::pk4_fp8(og[q][0] * (h0 * rs), og[q][1] * (h1 * rs), og[q][2] * (h2 * rs), og[q][3] * (h3 * rs)); }
        }
        ML_RAW_BARRIER();
    }
    { int tz_ = tid; asm volatile("" : "+v"(tz_)); const int lane = tz_ & 63, r = lane & 31, h = lane >> 5;
      const size_t bh = ((size_t)l * NP + s) * 4 + hh; float* cp = A->out + O_P_C + bh * 256 * 256 + 32 * w + r;
      if (ih == 0) {
#pragma unroll
      for (int dt = 0; dt < 8; ++dt)
#pragma unroll
          for (int reg = 0; reg < 16; ++reg) cp[(size_t)(32 * dt + (reg & 3) + 8 * (reg >> 2) + 4 * h) * 256] = Ct[dt][reg] * sg;
      if (tz_ < 256) A->out[O_P_N + bh * 256 + tz_] = sc[SC_N + tz_];
      if (tz_ == 0) A->out[O_P_M + bh] = m; } }
    __syncthreads();
}

constexpr int LR_WA = 0, LR_WX = 34816, LR_U = 69632, LR_UF = 87040, LR_AF = 119808, LR_SEG = 152576, LR_HC = 156672, LR_P = 272;
static_assert(LR_HC + 1024 <= LDSCTL_OFF, "LRU LDS map");
DI void lru_chunk_unit(int l, int s, int n, int dh, LAS unsigned char* lds, int tid) {
    CArgs* A = kargs();
    const bf16* proj = (const bf16*)(A->ws + WS_PROJ); unsigned char* ycat8 = A->ws + WS_YCAT;
    const float* cw = A->in[16] + (size_t)l * 4 * 1024 + n * 128; const float* cb = A->in[17] + (size_t)l * 1024 + n * 128;
    const float* wa = A->in[18] + ((size_t)l * 8 + n) * 128 * 128; const float* ba = A->in[19] + (size_t)l * 1024 + n * 128;
    const float* wx = A->in[20] + ((size_t)l * 8 + n) * 128 * 128; const float* bx = A->in[21] + (size_t)l * 1024 + n * 128;
    const float* lam = A->in[22] + (size_t)l * 1024 + n * 128;
    const int w = __builtin_amdgcn_readfirstlane(tid >> 6), seg = __builtin_amdgcn_readfirstlane(tid >> 7);
    for (int idx = tid; idx < 64 * 128; idx += NTHREADS) { const int c = idx >> 6, d = idx & 63;
        *(LAS unsigned short*)(lds + LR_WA + d * LR_P + c * 2) = (unsigned short)(pkbf(wa[c * 128 + 64 * dh + d], 0.f) & 0xffffu);
        *(LAS unsigned short*)(lds + LR_WX + d * LR_P + c * 2) = (unsigned short)(pkbf(wx[c * 128 + 64 * dh + d], 0.f) & 0xffffu); }
    if (tid < 256) *(LAS float*)(lds + LR_HC + tid * 4) = 0.f;
    const float w0 = cw[tid & 127], w1 = cw[1024 + (tid & 127)], w2 = cw[2048 + (tid & 127)], w3 = cw[3072 + (tid & 127)], bb = cb[tid & 127];
    const int dcol = 64 * dh + 32 * (w & 1) + (tid & 31);
    const float bav = ba[dcol], bxv = bx[dcol], ls = logsig(lam[dcol]);
    v4u pf[3];
#define LRU_PREFETCH(tn) do { int tp_ = tid; asm volatile("" : "+v"(tp_)); const bf16* pb_ = proj + ((ptrdiff_t)(s * TP + 64 * (tn)) - 3) * (ptrdiff_t)PPITCH + C_LRUX + n * 128; \
        _Pragma("unroll") for (int i_ = 0; i_ < 3; ++i_) { const int idx_ = tp_ + 512 * i_, row_ = idx_ >> 4; pf[i_] = (v4u){0u, 0u, 0u, 0u}; \
            if (idx_ < 1072 && 64 * (tn) - 3 + row_ >= 0) pf[i_] = *(const v4u*)(pb_ + (unsigned)(row_ * PPITCH + 8 * (idx_ & 15))); } } while (0)
    LRU_PREFETCH(0);
    __syncthreads();
    for (int tile = 0; tile < TP / 64; ++tile) {
        const int r0 = s * TP + 64 * tile;
        { int tz_ = tid; asm volatile("" : "+v"(tz_));
#pragma unroll
          for (int i = 0; i < 3; ++i) { const int idx = tz_ + 512 * i; if (idx < 1072) *(LAS v4u*)(lds + LR_AF + idx * 16) = pf[i]; } }
        WG_RAW_BARRIER();
        { int tz_ = tid; asm volatile("" : "+v"(tz_)); const int c = tz_ & 127;
          const LAS unsigned char* xp = lds + LR_AF + (16 * seg) * 256 + c * 2;
          float x0 = bf2f(lds_u16(xp)), x1 = bf2f(lds_u16(xp + 256)), x2 = bf2f(lds_u16(xp + 512));
#pragma unroll 8
          for (int t = 0; t < 16; ++t) { const float x3 = bf2f(lds_u16(xp + (3 + t) * 256)); const int j = 16 * seg + t;
              const float u = bb + w0 * x0 + w1 * x1 + w2 * x2 + w3 * x3;
              *(LAS unsigned short*)(lds + LR_U + j * LR_P + c * 2) = (unsigned short)(pkbf(u, 0.f) & 0xffffu);
              *(LAS float*)(lds + LR_UF + (j * 128 + c) * 4) = u;
              if (tile == TP / 64 - 1 && seg == 3 && t >= 13 && (c >> 6) == dh) A->out[O_P_LRUC + (((size_t)l * NP + s) * 3 + (t - 13)) * 1024 + n * 128 + c] = x3;
              x0 = x1; x1 = x2; x2 = x3; } }
        if (tile + 1 < TP / 64) LRU_PREFETCH(tile + 1);
        WG_RAW_BARRIER();
        if (w < 4) { int tz_ = tid; asm volatile("" : "+v"(tz_)); const int lane = tz_ & 63, r = lane & 31, h = lane >> 5;
          const int it = w >> 1, dtile = w & 1, dl = 32 * dtile + r, d = 64 * dh + dl;
          f32x16 ga, gx;
#pragma unroll
          for (int i = 0; i < 16; ++i) { ga[i] = 0.f; gx[i] = 0.f; }
#pragma unroll
          for (int s8 = 0; s8 < 8; ++s8) { const bf16x8 af = frag16(lds + LR_U + (32 * it + r) * LR_P + (16 * s8 + 8 * h) * 2);
              ga = MFMA32(af, frag16(lds + LR_WA + dl * LR_P + (16 * s8 + 8 * h) * 2), ga);
              gx = MFMA32(af, frag16(lds + LR_WX + dl * LR_P + (16 * s8 + 8 * h) * 2), gx); }
          float uu[16];
#pragma unroll
          for (int reg = 0; reg < 16; ++reg) { const int i = 32 * it + (reg & 3) + 8 * (reg >> 2) + 4 * h; uu[reg] = *(const LAS float*)(lds + LR_UF + (i * 128 + d) * 4); }
          asm volatile("" ::: "memory");
#pragma unroll
          for (int reg = 0; reg < 16; ++reg) { const int i = 32 * it + (reg & 3) + 8 * (reg >> 2) + 4 * h;
              const float rr = sigm(ga[reg] + bav), ii = sigm(gx[reg] + bxv), la = 8.f * rr * ls;
              LAS float* up = (LAS float*)(lds + LR_UF + (i * 128 + d) * 4);
              const float u = uu[reg];
              *(LAS float*)(lds + LR_AF + (i * 128 + d) * 4) = __expf(la);
              *up = lru_in_scale(la) * (ii * u); } }
        WG_RAW_BARRIER();
        float la_[8], lv_[8];
        { int tz_ = tid; asm volatile("" : "+v"(tz_)); const int dl = tz_ & 63, d = 64 * dh + dl;
          float Ap = 1.f, H = 0.f;
#pragma unroll
          for (int t = 0; t < 8; ++t) { const int i = 8 * w + t; la_[t] = *(const LAS float*)(lds + LR_AF + (i * 128 + d) * 4); lv_[t] = *(const LAS float*)(lds + LR_UF + (i * 128 + d) * 4); }
          asm volatile("" ::: "memory");
#pragma unroll
          for (int t = 0; t < 8; ++t) { H = la_[t] * H + lv_[t]; Ap *= la_[t]; }
          *(LAS float*)(lds + LR_SEG + (w * 64 + dl) * 4) = Ap; *(LAS float*)(lds + LR_SEG + 2048 + (w * 64 + dl) * 4) = H; }
        WG_RAW_BARRIER();
        { int tz_ = tid; asm volatile("" : "+v"(tz_)); const int dl = tz_ & 63;
          float hcur = *(const LAS float*)(lds + LR_HC + ((tile & 1) * 128 + dl) * 4);
          float pa_[7], ph_[7];
#pragma unroll
          for (int s2 = 0; s2 < 7; ++s2) { pa_[s2] = *(const LAS float*)(lds + LR_SEG + (s2 * 64 + dl) * 4); ph_[s2] = *(const LAS float*)(lds + LR_SEG + 2048 + (s2 * 64 + dl) * 4); }
          asm volatile("" ::: "memory");
#pragma unroll
          for (int s2 = 0; s2 < 7; ++s2) if (s2 < w) hcur = pa_[s2] * hcur + ph_[s2];
          unsigned char* yp = ycat8 + (size_t)(r0 + 8 * w) * KBR + n * 128 + 64 * dh + dl;
#pragma unroll
          for (int t = 0; t < 8; ++t) { hcur = la_[t] * hcur + lv_[t]; yp[(size_t)t * KBR] = (unsigned char)(pg8::pk4_fp8(hcur, 0.f, 0.f, 0.f) & 0xffu); }
          if (w == 7) { *(LAS float*)(lds + LR_HC + (((tile + 1) & 1) * 128 + dl) * 4) = hcur;
              if (tile == TP / 64 - 1) A->out[O_P_LRUH + ((size_t)l * NP + s) * 1024 + n * 128 + 64 * dh + dl] = hcur; } }
        WG_RAW_BARRIER();
    }
}

DI void lru_samp_unit(int l, int g, int n, LAS unsigned char* lds, int tid) {
    CArgs* A = kargs();
    const bf16* proj = (const bf16*)(A->ws + WS_PROJ); unsigned char* ycat8 = A->ws + WS_YCAT;
    const float* cw = A->in[16] + (size_t)l * 4 * 1024 + n * 128; const float* cb = A->in[17] + (size_t)l * 1024 + n * 128;
    const float* wa = A->in[18] + ((size_t)l * 8 + n) * 128 * 128; const float* ba = A->in[19] + (size_t)l * 1024 + n * 128;
    const float* wx = A->in[20] + ((size_t)l * 8 + n) * 128 * 128; const float* bx = A->in[21] + (size_t)l * 1024 + n * 128;
    const float* lam = A->in[22] + (size_t)l * 1024 + n * 128;
    const int w = __builtin_amdgcn_readfirstlane(tid >> 6), seg = __builtin_amdgcn_readfirstlane(tid >> 7);
    const int c = tid & 127, ch = n * 128 + c;
    float xs[4][7];
#pragma unroll
    for (int q = 0; q < 4; ++q) { const int b = 16 * g + 4 * seg + q;
#pragma unroll
        for (int j = 0; j < 3; ++j) xs[q][j] = A->in[5][(((size_t)l * NS + b) * 3 + j) * 1024 + ch];
#pragma unroll
        for (int t = 0; t < 4; ++t) xs[q][3 + t] = bf2f(proj[(size_t)(MP + b * TS + t) * PPITCH + C_LRUX + ch]); }
    const float w0 = cw[c], w1 = cw[1024 + c], w2 = cw[2048 + c], w3 = cw[3072 + c], bb = cb[c];
    const int dcol = 32 * (w & 3) + (tid & 31);
    const float bav = ba[dcol], bxv = bx[dcol], ls = logsig(lam[dcol]);
    float h0[4];
#pragma unroll
    for (int q = 0; q < 4; ++q) h0[q] = A->in[4][((size_t)l * NS + 16 * g + 4 * seg + q) * 1024 + ch];
    for (int idx = tid; idx < 128 * 128; idx += NTHREADS) { const int c2 = idx >> 7, d = idx & 127;
        *(LAS unsigned short*)(lds + LR_WA + d * LR_P + c2 * 2) = (unsigned short)(pkbf(wa[idx], 0.f) & 0xffffu);
        *(LAS unsigned short*)(lds + LR_WX + d * LR_P + c2 * 2) = (unsigned short)(pkbf(wx[idx], 0.f) & 0xffffu); }
#pragma unroll
    for (int q = 0; q < 4; ++q) { const int b = 16 * g + 4 * seg + q;
#pragma unroll
        for (int t = 0; t < 4; ++t) { const int j = 16 * seg + 4 * q + t; const float u = bb + w0 * xs[q][t] + w1 * xs[q][t + 1] + w2 * xs[q][t + 2] + w3 * xs[q][t + 3];
            *(LAS unsigned short*)(lds + LR_U + j * LR_P + c * 2) = (unsigned short)(pkbf(u, 0.f) & 0xffffu);
            *(LAS float*)(lds + LR_UF + (j * 128 + c) * 4) = u; }
#pragma unroll
        for (int j = 0; j < 3; ++j) A->out[O_S_LRUC + (((size_t)l * NS + b) * 3 + j) * 1024 + ch] = xs[q][4 + j]; }
    __syncthreads();
    { const int lane = tid & 63, r = lane & 31, h = lane >> 5, it = w >> 2, dtile = w & 3, d = 32 * dtile + r;
      f32x16 ga, gx;
#pragma unroll
      for (int i = 0; i < 16; ++i) { ga[i] = 0.f; gx[i] = 0.f; }
#pragma unroll
      for (int s8 = 0; s8 < 8; ++s8) { const bf16x8 af = frag16(lds + LR_U + (32 * it + r) * LR_P + (16 * s8 + 8 * h) * 2);
          ga = MFMA32(af, frag16(lds + LR_WA + d * LR_P + (16 * s8 + 8 * h) * 2), ga);
          gx = MFMA32(af, frag16(lds + LR_WX + d * LR_P + (16 * s8 + 8 * h) * 2), gx); }
#pragma unroll
      for (int reg = 0; reg < 16; ++reg) { const int i = 32 * it + (reg & 3) + 8 * (reg >> 2) + 4 * h;
          const float rr = sigm(ga[reg] + bav), ii = sigm(gx[reg] + bxv), la = 8.f * rr * ls;
          LAS float* up = (LAS float*)(lds + LR_UF + (i * 128 + d) * 4);
          const float u = *up;
          *(LAS float*)(lds + LR_AF + (i * 128 + d) * 4) = __expf(la);
          *up = lru_in_scale(la) * (ii * u); } }
    __syncthreads();
#pragma unroll
    for (int q = 0; q < 4; ++q) { const int b = 16 * g + 4 * seg + q; float hc = h0[q];
#pragma unroll
        for (int t = 0; t < 4; ++t) { const int j = 16 * seg + 4 * q + t;
            hc = *(const LAS float*)(lds + LR_AF + (j * 128 + c) * 4) * hc + *(const LAS float*)(lds + LR_UF + (j * 128 + c) * 4);
            ycat8[(size_t)(MP + b * TS + t) * KBR + ch] = (unsigned char)(pg8::pk4_fp8(hc, 0.f, 0.f, 0.f) & 0xffu); }
        A->out[O_S_LRUH + ((size_t)l * NS + b) * 1024 + ch] = hc; }
    __syncthreads();
}

#ifndef EN_PRO
#define EN_PRO 1
#endif
#ifndef EN_MOD
#define EN_MOD 1
#endif
#ifndef EN_NORM
#define EN_NORM 1
#endif
#ifndef EN_PROJ
#define EN_PROJ 1
#endif
#ifndef EN_MIX
#define EN_MIX 1
#endif
#ifndef EN_MERGE
#define EN_MERGE 1
#endif
#ifndef EN_OUT
#define EN_OUT 1
#endif
#ifndef EN_FF1
#define EN_FF1 1
#endif
#ifndef EN_FF2
#define EN_FF2 1
#endif
#ifndef EN_ML
#define EN_ML 1
#endif
#ifndef EN_GLA
#define EN_GLA 1
#endif
#ifndef EN_LRU
#define EN_LRU 1
#endif
#ifndef REP_MIXP
#define REP_MIXP 1
#endif
#ifndef REP_ML
#define REP_ML 1
#endif
#ifndef REP_GLA
#define REP_GLA 1
#endif
#ifndef REP_LRU
#define REP_LRU 1
#endif
#ifndef REP_MIXS
#define REP_MIXS 1
#endif
#ifndef REP_GEMM
#define REP_GEMM 1
#endif
#ifndef REP_PROJ
#define REP_PROJ REP_GEMM
#endif
#ifndef REP_MERGE
#define REP_MERGE REP_GEMM
#endif
#ifndef REP_OUT
#define REP_OUT REP_GEMM
#endif
#ifndef REP_FF1
#define REP_FF1 REP_GEMM
#endif
#ifndef REP_FF2
#define REP_FF2 REP_GEMM
#endif
#ifndef REP_PRO
#define REP_PRO 1
#endif
#ifndef REP_MIX
#define REP_MIX 1
#endif
#ifndef REP_NORM
#define REP_NORM 1
#endif
#define WSP(T, off) ((T*)(ws + (off)))

DI void conv_win(CArgs* A, unsigned char* ws, int l, LAS float* scr, int gw, int ngw, int lane, int gtid, int gthreads) {
    const float* w_in = A->in[15] + (size_t)l * D * DIN; bf16* wt_in = WSP(bf16, WS_WIN) + (size_t)l * NPROJ_PAD * D;
    transpose_job(w_in, DIN, D, 3072, wt_in, D, scr, gw, ngw, lane);
    unsigned char* wt8 = ws + (WS_WIN8_0 + (size_t)l * (WS_WIN8_1 - WS_WIN8_0));
    transpose_job_f8(w_in + 3088, DIN, D, 1024, wt8 + (size_t)3072 * D, D, 64.f, scr, gw, ngw, lane);
    transpose_job(w_in + 3088 + 1024, DIN, D, 1024, wt_in + (size_t)4096 * D, D, scr, gw, ngw, lane);
    transpose_job_f8(w_in + 3088 + 2048, DIN, D, 1024, wt8 + (size_t)5120 * D, D, 64.f, scr, gw, ngw, lane);
    transpose_job_f8(w_in + 6168, DIN, D, 6144, wt8 + (size_t)6144 * D, D, 64.f, scr, gw, ngw, lane);
    for (int i = gtid; i < 256 * D; i += gthreads) { const int j = i >> 11, k = i & 2047;
        const float v = j < 24 ? w_in[(size_t)k * DIN + (j < 16 ? 3072 + j : 6160 + (j - 16))] : 0.f;
        wt_in[(size_t)(NPROJ + j) * D + k] = (bf16)f2bf(v); }
}
DI void conv_rest(CArgs* A, unsigned char* ws, int l, LAS float* scr, int gw, int ngw, int lane, int what) {
    if (what & 1) {
    unsigned char* wt_br = ws + WS_WBR + (size_t)l * D * KBR;
    transpose_job_f8(A->in[33] + (size_t)l * 1024 * D, D, 1024, D, wt_br, KBR, 64.f, scr, gw, ngw, lane);
    transpose_job_f8(A->in[34] + (size_t)l * 1024 * D, D, 1024, D, wt_br + 1024, KBR, 64.f, scr, gw, ngw, lane);
    transpose_job_f8(A->in[35] + (size_t)l * 1024 * D, D, 1024, D, wt_br + 2048, KBR, 64.f, scr, gw, ngw, lane);
    transpose_job_f8(A->in[36] + (size_t)l * D * D, D, D, D, ws + WS_WOUT + (size_t)l * D * D, D, 64.f, scr, gw, ngw, lane); }
    if (what & 2) { const float* src = A->in[37] + (size_t)l * D * DFF; unsigned char* dst = ws + WS_WFF1 + (size_t)l * DFF * D;
      for (int it = gw; it < (D / 64) * (DFF / 32); it += ngw) transpose_item_f8(src, DFF, DFF, dst, D, 64.f, scr, it, lane); }
    if (what & 4) { const float* src = A->in[38] + (size_t)l * DFF * D; unsigned char* dst = ws + WS_WFF2 + (size_t)l * D * DFF;
      for (int it = gw; it < (DFF / 64) * (D / 32); it += ngw) transpose_item_f8(src, D, D, dst, DFF, 64.f, scr, it, lane); }
}
__global__ void __launch_bounds__(NTHREADS, 2) mk_fwd(Args a_unused) {
    extern __shared__ __attribute__((aligned(16))) unsigned char lds_raw[];
    LAS unsigned char* lds = (LAS unsigned char*)lds_raw;
    const int bid = blockIdx.x;
    constexpr int G = GRID, ngw = GRID * NWAVES;
#define TIDS() int tid_ = threadIdx.x; asm volatile("" : "+v"(tid_)); const int tid = tid_, lane = tid & 63, wave = __builtin_amdgcn_readfirstlane(tid >> 6), gw = bid * NWAVES + wave; (void)lane; (void)gw
    for (int u = threadIdx.x; u < (LDS_BYTES - LDSCTL_OFF) / 4; u += NTHREADS) ((LAS unsigned*)(lds + LDSCTL_OFF))[u] = 0u;
    __syncthreads();
    int lo, hi;
    { CArgs* A = kargs(); lo = A->ph_lo; hi = A->ph_hi;
      (void)xcd_barrier_post((unsigned*)(A->ws + WS_CTL) + CW_BAR + A->li * XCD_BAR_WORDS, (volatile LAS unsigned*)(lds + MISC_OFF) + 8); }
#define IN(k) (lo <= (k) && (k) < hi)
#define SEAM(k) do { if (IN(k) && IN((k) + 1)) { CArgs* Ab = kargs(); XcdBarrier bar; bar.bar = (unsigned*)(Ab->ws + WS_CTL) + CW_BAR + Ab->li * XCD_BAR_WORDS; bar.x = xb_xcc_id(); \
        bar.st = (volatile LAS unsigned*)(lds + MISC_OFF) + 8; xcd_barrier(bar); } } while (0)

    if (EN_PRO && IN(0)) for (int rep_ = 0; rep_ < REP_PRO; ++rep_) {
        if (rep_) __syncthreads();
        TIDS(); CArgs* A = kargs(); unsigned char* const ws = A->ws;
        LAS float* scr = (LAS float*)(lds + RING_OFF + wave * 16384);
        for (int l = 0; l < DEPTH; ++l) transpose_job(A->in[11] + (size_t)l * D * NADA, NADA, D, NADA, WSP(bf16, WS_WADA) + (size_t)l * NADA * D, D, scr, gw, ngw, lane);
        for (int l = 0; l < DEPTH; ++l) { conv_win(A, ws, l, scr, gw, ngw, lane, bid * NTHREADS + tid, G * NTHREADS); conv_rest(A, ws, l, scr, gw, ngw, lane, l == 0 ? 7 : 2); }
        bf16* csilu = WSP(bf16, WS_CSILU);
        for (int i = bid * NTHREADS + tid; i < 256 * D; i += G * NTHREADS) { const int r = i >> 11, c = i & 2047;
            float v = 0.f;
            if (r < NP) v = A->in[2][r * D + c]; else if (r < NB) v = A->in[3][(r - NP) * D + c];
            csilu[i] = (bf16)f2bf(r < NB ? v * sigm(v) : 0.f); }
    }
    SEAM(0);

    if (EN_MOD && IN(1)) {
        CArgs* A = kargs(); unsigned char* const ws = A->ws;
        pg8::Gemm g{WSP(bf16, WS_CSILU), WSP(bf16, WS_WADA), 256, 2 * NADA, D, D, D}; pg8::StaticOrder S; S.init(256, 2 * NADA, G, bid);
        pg8::EpiF32 E{WSP(float, WS_MOD), 2 * NADA, A->in[12]};
        pg8::gemm_phase<pg8::EpiF32, pg8::StaticOrder>(lds + RING_OFF, g, S, E, nullptr);
    }
    SEAM(1);

    for (int l = 0; l < DEPTH; ++l) {
        const int pb = 2 + 9 * l;
        if (EN_NORM && IN(pb + 0)) { TIDS(); CArgs* A = kargs(); unsigned char* const ws = A->ws;
            if (l == 0) norm_rows(A->in[0], A->in[1], true, A->in[13] + (size_t)l * D, WSP(float, WS_MOD) + (size_t)l * NADA, WSP(bf16, WS_XN), nullptr, nullptr, gw, ngw, lane, WSP(bf16, WS_XB), 0, nullptr, nullptr, nullptr, nullptr, ws + WS_XN8);
            else norm_rows(WSP(bf16, WS_XB), WSP(bf16, WS_XA) + (size_t)MP * D, false, A->in[13] + (size_t)l * D, WSP(float, WS_MOD) + (size_t)l * NADA, WSP(bf16, WS_XN), nullptr, nullptr, gw, ngw, lane, nullptr,
                           16, WSP(bf16, WS_GIMG), WSP(float, WS_MOD) + (size_t)(l - 1) * NADA + 10240, WSP(bf16, WS_XB) + (size_t)MP * D, nullptr, ws + WS_XN8); }
        SEAM(pb + 0);
        if (EN_PROJ && IN(pb + 1)) for (int rg_ = 0; rg_ < REP_PROJ; ++rg_) { CArgs* A = kargs(); unsigned char* const ws = A->ws;
            { pg8::Gemm g{WSP(bf16, WS_XN), WSP(bf16, WS_WIN) + (size_t)l * NPROJ_PAD * D, MTOT, NPROJ_PAD, D, D, D};
              pg8::TileMapOrder S; S.so.init(MTOT, 17 * 256, G, bid); S.t1 = 12; S.t2 = 16; S.s0 = 0; S.s1 = 4; S.s2 = 32;
              pg8::EpiProj E{WSP(bf16, WS_PROJ), WSP(float, WS_SMALL), 1.f, ws + WS_MG8};
              pg8::gemm_phase<pg8::EpiProj, pg8::TileMapOrder>(lds + RING_OFF, g, S, E, nullptr); }
            { pg8::Gemm g{(const bf16*)(ws + WS_XN8), (const bf16*)(ws + (WS_WIN8_0 + (size_t)l * (WS_WIN8_1 - WS_WIN8_0))), MTOT, NPROJ_PAD, D / 2, D / 2, D / 2};
              pg8::TileMapOrder S; S.so.init(MTOT, 32 * 256, G, bid); S.t1 = 4; S.t2 = 8; S.s0 = 12; S.s1 = 16; S.s2 = 16; S.nh = 72; S.sk = 2;
              pg8::EpiProj E{WSP(bf16, WS_PROJ), WSP(float, WS_SMALL), 1.f / 64.f, ws + WS_MG8};
              pg8::gemm_phase<pg8::EpiProj, pg8::TileMapOrder, true>(lds + RING_OFF, g, S, E, nullptr); } }
        SEAM(pb + 1);
        if (EN_MIX && IN(pb + 2)) {
            TIDS();
            for (int u = bid; u < 1024; u += G) { if (u < 512) ml_prep_unit(l, u >> 7, (u >> 5) & 3, u & 31, lds + RING_OFF, tid); else gla_prep_unit(l, (u - 512) >> 7, (u >> 5) & 3, u & 31, lds + RING_OFF, tid); }
        }
        SEAM(pb + 2);
        if (EN_MIX && IN(pb + 3)) for (int rep_ = 0; rep_ < REP_MIX; ++rep_) {
            if (rep_) __syncthreads();
            TIDS();
            LAS float* fl = (LAS float*)(lds + RING_OFF);
#ifdef PROBE_S
            if (kargs()->li == 1 && bid < 112) {} else
#endif
            if (bid < 112) { if (rep_ == 0 || REP_MIXP) {
            if (bid < 32) { if (EN_ML && (rep_ == 0 || REP_ML)) ml_seq_unit(l, bid >> 3, (bid >> 1) & 3, bid & 1, lds + RING_OFF, tid); }
            else if (bid < 48) { if (EN_GLA && (rep_ == 0 || REP_GLA)) gla_seq_unit(l, (bid - 32) >> 2, bid & 3, lds + RING_OFF, tid); }
            else if (bid < 112) { if (EN_LRU && (rep_ == 0 || REP_LRU)) lru_chunk_unit(l, (bid - 48) >> 4, ((bid - 48) >> 1) & 7, bid & 1, lds + RING_OFF, tid); }
            } }
            else if (rep_ == 0 || REP_MIXS) for (int v = bid - 112; v < 1280; v += G - 112) {
                if (v < 512) { if (EN_ML) ml_unit(l, NP + (v >> 2), v & 3, fl, tid, lane, wave); }
                else if (v < 1024) { if (EN_GLA) gla_unit(l, NP + ((v - 512) >> 2), v & 3, fl, tid, lane, wave); }
                else { if (EN_LRU && v < 1024 + 64) lru_samp_unit(l, (v - 1024) >> 3, v & 7, lds + RING_OFF, tid); }
            }
            if (l == 0 && bid >= 112 && rep_ == 0) {
                __syncthreads();
                CArgs* A = kargs(); LAS float* scr = (LAS float*)(lds + RING_OFF + wave * 16384);
                const float* src = A->in[38] + (size_t)DFF * D; unsigned char* dst = A->ws + WS_WFF2 + (size_t)D * DFF;
                for (int it = (bid - 112) * NWAVES + wave; it < (DFF / 64) * (D / 32); it += (G - 112) * NWAVES) transpose_item_f8(src, D, D, dst, DFF, 64.f, scr, it, lane);
                __syncthreads(); }
        }
        SEAM(pb + 3);
        if (EN_MERGE && IN(pb + 4)) for (int rg_ = 0; rg_ < REP_MERGE; ++rg_) { CArgs* A = kargs(); unsigned char* const ws = A->ws;
            { pg8::Gemm g{WSP(bf16, WS_YCAT), (const bf16*)(ws + WS_WBR + (size_t)l * D * KBR), MP, D, KBR / 2, KBR / 2, KBR / 2}; pg8::StaticOrder S; S.init(MP, D, G, bid);
              pg8::EpiMergeF8 E{ws + WS_MG8, ws + WS_MERGED, 8.f / 64.f};
              pg8::gemm_phase<pg8::EpiMergeF8, pg8::StaticOrder, true>(lds + RING_OFF, g, S, E, nullptr); }
            { pg8::Gemm g{WSP(bf16, WS_YCAT), (const bf16*)(ws + WS_WBR + (size_t)l * D * KBR), MTOT, D, 512, KBR / 2, KBR / 2}; pg8::SplitOrder S{MP / 256, MS / 256, D / 256, 3, 512, G, bid};
              pg8::EpiGateSlab E{ws + WS_MG8, (bf16*)(ws + WS_GIMG + 64 * MiB), 9, 1.f / 64.f};
              pg8::gemm_phase<pg8::EpiGateSlab, pg8::SplitOrder, true>(lds + RING_OFF, g, S, E, nullptr); } }
        SEAM(pb + 4);
        if (EN_OUT && IN(pb + 5)) for (int rg_ = 0; rg_ < REP_OUT; ++rg_) { CArgs* A = kargs(); unsigned char* const ws = A->ws;
            { TIDS();
              const bf16* sl = (const bf16*)(ws + WS_GIMG + 64 * MiB); unsigned char* mg = ws + WS_MERGED + (size_t)MP * D;
              for (int row = gw; row < MS; row += ngw) { const v2u* s4 = (const v2u*)(sl + (size_t)row * D) + lane;
#pragma unroll
                  for (int j = 0; j < 8; ++j) { const v2u w0 = s4[64 * j], w1 = s4[(size_t)(MS * D / 4) + 64 * j], w2 = s4[(size_t)2 * (MS * D / 4) + 64 * j];
                      const f32x4 v = (f32x4){bflo_(w0.x), bfhi_(w0.x), bflo_(w0.y), bfhi_(w0.y)} + (f32x4){bflo_(w1.x), bfhi_(w1.x), bflo_(w1.y), bfhi_(w1.y)} + (f32x4){bflo_(w2.x), bfhi_(w2.x), bflo_(w2.y), bfhi_(w2.y)};
                      *((unsigned*)(mg + (size_t)row * D) + lane + 64 * j) = pg8::pk4_fp8(8.f * v.x, 8.f * v.y, 8.f * v.z, 8.f * v.w); } } }
            { pg8::Gemm g{WSP(bf16, WS_MERGED), (const bf16*)(ws + WS_WOUT + (size_t)l * D * D), MP, D, D / 2, D / 2, D / 2}; pg8::StaticOrder S; S.init(MP, D, G, bid);
              pg8::EpiResid E{WSP(bf16, WS_XB), WSP(bf16, WS_XA), WSP(float, WS_MOD) + (size_t)l * NADA + 4096, 1.f / 512.f};
              pg8::gemm_phase<pg8::EpiResid, pg8::StaticOrder, true>(lds + RING_OFF, g, S, E, nullptr); }
            { CArgs* Ab = kargs(); XcdBarrier bar; bar.bar = (unsigned*)(Ab->ws + WS_CTL) + CW_BAR + Ab->li * XCD_BAR_WORDS; bar.x = xb_xcc_id(); bar.st = (volatile LAS unsigned*)(lds + MISC_OFF) + 8; xcd_barrier(bar); }
            { pg8::Gemm g{WSP(bf16, WS_MERGED), (const bf16*)(ws + WS_WOUT + (size_t)l * D * D), MTOT, D, D / 8, D / 2, D / 2}; pg8::SplitOrder S{MP / 256, MS / 256, D / 256, 4, D / 8, G, bid};
              pg8::EpiSlab E{WSP(bf16, WS_GIMG), D / 8, 1.f / 512.f};
              pg8::gemm_phase<pg8::EpiSlab, pg8::SplitOrder, true>(lds + RING_OFF, g, S, E, nullptr); } }
        SEAM(pb + 5);
        if (EN_NORM && IN(pb + 6)) { TIDS(); CArgs* A = kargs(); unsigned char* const ws = A->ws;
            norm_rows(WSP(bf16, WS_XA), WSP(bf16, WS_XB) + (size_t)MP * D, false, A->in[14] + (size_t)l * D, WSP(float, WS_MOD) + (size_t)l * NADA + 6144, WSP(bf16, WS_XN), nullptr, nullptr, gw, ngw, lane, nullptr,
                      4, WSP(bf16, WS_GIMG), WSP(float, WS_MOD) + (size_t)l * NADA + 4096, WSP(bf16, WS_XA) + (size_t)MP * D, ws + WS_XN); }
        SEAM(pb + 6);
        if (EN_FF1 && IN(pb + 7)) for (int rg_ = 0; rg_ < REP_FF1; ++rg_) { CArgs* A = kargs(); unsigned char* const ws = A->ws;
            pg8::Gemm g{WSP(bf16, WS_XN), (const bf16*)(ws + WS_WFF1 + (size_t)l * DFF * D), MTOT, DFF, D / 2, D / 2, D / 2}; pg8::StaticOrder S; S.init(MTOT, DFF, G, bid);
            pg8::EpiRelu2F8 E{ws + WS_HFF, DFF, 1.f / 64.f};
            pg8::gemm_phase<pg8::EpiRelu2F8, pg8::StaticOrder, true>(lds + RING_OFF, g, S, E, nullptr);
            if (l == 0 && (int)blockIdx.x >= 64 && rg_ == 0) {
                __syncthreads();
                CArgs* A2 = kargs(); int t_ = (int)threadIdx.x; asm volatile("" : "+v"(t_));
                const int wv_ = __builtin_amdgcn_readfirstlane(t_ >> 6);
                conv_rest(A2, A2->ws, 1, (LAS float*)(lds + RING_OFF + wv_ * 16384), ((int)blockIdx.x - 64) * NWAVES + wv_, (G - 64) * NWAVES, t_ & 63, 1);
                __syncthreads(); } }
        SEAM(pb + 7);
        if (EN_FF2 && IN(pb + 8)) for (int rg_ = 0; rg_ < REP_FF2; ++rg_) { CArgs* A = kargs(); unsigned char* const ws = A->ws;
            { pg8::Gemm g{WSP(bf16, WS_HFF), (const bf16*)(ws + WS_WFF2 + (size_t)l * D * DFF), MP, D, DFF / 2, DFF / 2, DFF / 2}; pg8::StaticOrder S; S.init(MP, D, G, bid);
              pg8::EpiResid E{WSP(bf16, WS_XA), WSP(bf16, WS_XB), WSP(float, WS_MOD) + (size_t)l * NADA + 10240, 1.f / 64.f};
              pg8::gemm_phase<pg8::EpiResid, pg8::StaticOrder, true>(lds + RING_OFF, g, S, E, nullptr); }
            { pg8::Gemm g{WSP(bf16, WS_HFF), (const bf16*)(ws + WS_WFF2 + (size_t)l * D * DFF), MTOT, D, DFF / 32, DFF / 2, DFF / 2}; pg8::SplitOrder S{MP / 256, MS / 256, D / 256, 16, DFF / 32, G, bid};
              pg8::EpiSlab E{WSP(bf16, WS_GIMG), DFF / 32, 1.f / 64.f};
              pg8::gemm_phase<pg8::EpiSlab, pg8::SplitOrder, true>(lds + RING_OFF, g, S, E, nullptr); } }
        SEAM(pb + 8);
    }
    if (EN_NORM && IN(20)) { TIDS(); CArgs* A = kargs(); unsigned char* const ws = A->ws;
        norm_rows(WSP(bf16, WS_XB), WSP(bf16, WS_XA) + (size_t)MP * D, false, A->in[39], nullptr, nullptr, A->out + O_YP, A->out + O_YS, gw, ngw, lane, nullptr,
                  16, WSP(bf16, WS_GIMG), WSP(float, WS_MOD) + (size_t)(DEPTH - 1) * NADA + 10240, WSP(bf16, WS_XB) + (size_t)MP * D); }
#undef IN
#undef SEAM
}

extern "C" void kernel_launch(void* const* d_in, const int* in_sizes, int n_in, void* d_out, int out_size, void* d_ws, size_t ws_size, hipStream_t stream) {
    static int grid = 0;
    if (grid == 0) {
        if (n_in != 40 || (size_t)out_size != O_END || ws_size < WS_END) { fprintf(stderr, "kernel_launch: unexpected shapes (n_in %d, out %d, ws %zu); nothing launched\n", n_in, out_size, ws_size); grid = -1; return; }
        if (hipFuncSetAttribute((const void*)mk_fwd, hipFuncAttributeMaxDynamicSharedMemorySize, LDS_BYTES) != hipSuccess) { fprintf(stderr, "kernel_launch: hipFuncSetAttribute failed\n"); grid = -1; return; }
        int per_cu = 0;
        if (hipOccupancyMaxActiveBlocksPerMultiprocessor(&per_cu, (const void*)mk_fwd, NTHREADS, LDS_BYTES) != hipSuccess || per_cu < 1)
            fprintf(stderr, "kernel_launch: note: occupancy query reports %d workgroups per CU\n", per_cu);
        (void)hipGetLastError();
        grid = GRID;
    }
    if (grid < 0) return;
    if (hipMemsetAsync((char*)d_ws + WS_CTL, 0, CTL_ZERO_BYTES, stream) != hipSuccess) { fprintf(stderr, "kernel_launch: hipMemsetAsync failed\n"); return; }
    Args a{};
    for (int i = 0; i < 40; ++i) a.in[i] = (const float*)d_in[i];
    a.out = (float*)d_out; a.ws = (unsigned char*)d_ws; a.pad = 0;
#ifndef PROBE_P
#define PROBE_P -1
#endif
#ifndef PROBE_G
#define PROBE_G 256
#endif
    int n_l = 0, lo_[4], hi_[4], fl_[4];
    if (N_LAUNCHES != 1) { for (int li = 0; li < PH_TOTAL; ++li) { a.ph_lo = li; a.ph_hi = li + 1; a.li = 0; a.pad = 0; hipLaunchKernelGGL(mk_fwd, dim3(grid), dim3(NTHREADS), LDS_BYTES, stream, a); } return; }
    if (PROBE_P < 0) { lo_[0] = 0; hi_[0] = PH_TOTAL; fl_[0] = grid; n_l = 1; }
#ifndef PROBE_Q
#define PROBE_Q PROBE_P
#endif
#ifdef PROBE_ABL
    else { lo_[0] = 0; hi_[0] = PROBE_P; fl_[0] = grid; lo_[1] = PROBE_P; hi_[1] = PROBE_Q + 1; fl_[1] = PROBE_G; lo_[2] = PROBE_P; hi_[2] = PH_TOTAL; fl_[2] = grid; n_l = 3; }
#else
    else { lo_[0] = 0; hi_[0] = PROBE_Q + 1; fl_[0] = grid; lo_[1] = PROBE_P; hi_[1] = PROBE_Q + 1; fl_[1] = PROBE_G; lo_[2] = PROBE_Q + 1; hi_[2] = PH_TOTAL; fl_[2] = grid; n_l = 3; }
#endif
    for (int li = 0; li < n_l; ++li) {
        a.ph_lo = lo_[li]; a.ph_hi = hi_[li]; a.li = li; a.pad = 0;
        hipLaunchKernelGGL(mk_fwd, dim3(fl_[li]), dim3(NTHREADS), LDS_BYTES, stream, a);
        const hipError_t le = hipPeekAtLastError();
        if (le != hipSuccess) { fprintf(stderr, "kernel_launch: launch %d failed: %s\n", li, hipGetErrorName(le)); break; }
    }
}
```

```cpp
#include <hip/hip_runtime.h>
#include <cstdio>
#include <cstdint>

constexpr int D = 2048, DEPTH = 2;
constexpr int NP = 4, TP = 2048, NS = 128, TS = 4;
constexpr int MP = NP * TP, MS = NS * TS, MTOT = MP + MS;
constexpr int NB = NP + NS;
constexpr int DIN = 12312, NPROJ = 12288, NPROJ_PAD = 12544, NSMALL = 24;
constexpr int PPITCH = 6144;
constexpr int C_LRUX = 0, C_GQ = 1024, C_GK = 1536, C_GV = 2048, C_GGATE = 3072, C_MX = 4096, C_MO = 5120, C_MG = 6144;
constexpr int DFF = 8192, NADA = 12288, KBR = 3072;
constexpr float EPS = 1e-6f;
#define MK_N_LAUNCHES 1
namespace pg8 {
#define PG8_LAS __attribute__((address_space(3)))
typedef unsigned short bf16_t;
typedef short bf16x8 __attribute__((ext_vector_type(8)));
typedef float f32x4 __attribute__((ext_vector_type(4)));
typedef unsigned u32x4 __attribute__((ext_vector_type(4)));
constexpr int BM = 256, BK = 64, HALF = 128, HTB = HALF * BK * 2  , STAGE_BYTES = 8 * HTB, NXCD = 8, WGM = 8;

__host__ __device__ __forceinline__ int lds_byte(int r, int c) { const int st = (r >> 4) * 2 + (c >> 5), rr = r & 15, cc = c & 31, ob = rr * 64 + cc * 2; return st * 1024 + (ob ^ (((ob >> 9) & 1) << 5)); }
__host__ __device__ __forceinline__ void stage_rc(int b, int& R, int& C) { const int st = b / 1024, sb = b % 1024, swz = sb ^ (((sb >> 9) & 1) << 5); R = (st >> 1) * 16 + swz / 64; C = (st & 1) * 32 + (swz % 64) / 2; }
__host__ __device__ __forceinline__ int perm32(int rho) { const int n = rho >> 4, i = rho & 15; return 8 * (i >> 2) + 4 * n + (i & 3); }

struct Unit { int pm, pn, koff; };
struct Gemm { const bf16_t* A; const bf16_t* Bt; int M, N, K, lda, ldb; };

struct StaticOrder {
    int nM, nN, nwg, G, c;
    __host__ __device__ void init(int M, int N, int G_, int c_) { nM = M / BM; nN = N / BM; nwg = nM * nN; G = G_; c = c_; }
    __host__ __device__ bool next(int i, Unit& u) const { return at((long)i * G + c, u); }
    __host__ __device__ bool at(long L, Unit& u) const {
        if (L >= nwg) return false;
        int wgid = (int)L; { const int q = nwg / NXCD, r = nwg % NXCD, xcd = wgid % NXCD, off = wgid / NXCD; wgid = (xcd < r ? xcd * (q + 1) : r * (q + 1) + (xcd - r) * q) + off; }
        const int nig = WGM * nN, gid = wgid / nig, fm = gid * WGM, gsz = (nM - fm) < WGM ? (nM - fm) : WGM;
        u.pm = fm + ((wgid % nig) % gsz); u.pn = (wgid % nig) / gsz; u.koff = 0; return true;
    }
    __device__ __forceinline__ void a_ready(const Unit&) const {}
    __device__ __forceinline__ void done(const Unit&) const {}
};
struct SplitOrder {
    int pm0, npm, nN, split, ksub, G, c;
    __device__ __forceinline__ bool next(int i, Unit& u) const {
        const int L = i * G + c, nt = npm * nN; if (L >= nt * split) return false;
        const int tile = L % nt, ks = L / nt; u.pm = pm0 + tile / nN; u.pn = tile % nN; u.koff = ks * ksub; return true;
    }
    __device__ __forceinline__ void a_ready(const Unit&) const {}
    __device__ __forceinline__ void done(const Unit&) const {}
};
struct TileMapOrder {
    StaticOrder so; int t1, t2, s0, s1, s2; int nh = 0, sk = 0;
    __device__ __forceinline__ bool next(int i, Unit& u) const {
        const int gl = so.G - nh, lt = (int)(so.c >= nh), early = lt * (int)(i < sk);
        const long L = early ? (long)i * gl + (so.c - nh) : (long)sk * gl + (long)(i - lt * sk) * so.G + so.c;
        if (!so.at(L, u)) return false; u.pn += s0 + (int)(u.pn >= t1) * (s1 - s0) + (int)(u.pn >= t2) * (s2 - s1); return true; }
    __device__ __forceinline__ void a_ready(const Unit&) const {}
    __device__ __forceinline__ void done(const Unit&) const {}
};


__device__ __forceinline__ unsigned cvt_pk_bf16(float lo, float hi) { unsigned r; asm volatile("v_cvt_pk_bf16_f32 %0, %1, %2" : "=v"(r) : "v"(lo), "v"(hi)); return r; }
typedef float f32x2 __attribute__((ext_vector_type(2)));
typedef int i32x4 __attribute__((ext_vector_type(4)));
typedef int i32x8 __attribute__((ext_vector_type(8)));
__device__ __forceinline__ unsigned pk4_fp8(float a, float b, float c, float d) { int w = __builtin_amdgcn_cvt_pk_fp8_f32(a, b, 0, false); w = __builtin_amdgcn_cvt_pk_fp8_f32(c, d, w, true); return (unsigned)w; }
__device__ __forceinline__ float bflo(unsigned w) { return __uint_as_float(w << 16); }
__device__ __forceinline__ float bfhi(unsigned w) { return __uint_as_float(w & 0xffff0000u); }

#define PG8_COORDS() int tz_ = threadIdx.x; asm volatile("" : "+v"(tz_)); const int wid_ = __builtin_amdgcn_readfirstlane(tz_ >> 6); \
    const int wr = wid_ >> 2, wc = wid_ & 3, fr = tz_ & 15, fq = (tz_ & 63) >> 4

struct EpiF32 {
    static constexpr bool PERM = false, AFTER_DRAIN = false; static constexpr int NMID = 0, MID1 = -1, MID2 = -1;
    float* C; int ldc; const float* bias;
    __device__ __forceinline__ void operator()(const f32x4 (&acc)[2][2][4][2], const Unit& u, int, int, int, int) const {
        PG8_COORDS();
        const int row0 = u.pm * BM + wr * 64 + fr, col0 = u.pn * BM + wc * 32 + 4 * fq;
        f32x4 bv[2][2];
#pragma unroll
        for (int bj = 0; bj < 2; ++bj)
#pragma unroll
            for (int n = 0; n < 2; ++n) bv[bj][n] = bias ? *(const f32x4*)(bias + col0 + bj * HALF + n * 16) : (f32x4){0.f, 0.f, 0.f, 0.f};
#pragma unroll
        for (int ai = 0; ai < 2; ++ai)
#pragma unroll
            for (int m = 0; m < 4; ++m) { float* rowp = C + (size_t)(row0 + ai * HALF + m * 16) * ldc + col0;
#pragma unroll
                for (int bj = 0; bj < 2; ++bj)
#pragma unroll
                    for (int n = 0; n < 2; ++n) *(f32x4*)(rowp + bj * HALF + n * 16) = acc[ai][bj][m][n] + bv[bj][n]; }
    }
    __device__ __forceinline__ void mid(f32x4 (&)[2][2][4][2], const Unit&, int, int, int, int, int) const {}
};

struct EpiProj {
    static constexpr bool PERM = true, AFTER_DRAIN = false; static constexpr int NMID = 0, MID1 = -1, MID2 = -1;
    bf16_t* O; float* sm; float ascale; unsigned char* mg8;
    __device__ __forceinline__ void operator()(const f32x4 (&acc)[2][2][4][2], const Unit& u, int, int, int, int) const {
        PG8_COORDS();
        const int row0 = u.pm * BM + wr * 64 + fr;
        if (u.pn < 24) {
            const int col0 = u.pn * BM + wc * 32 + 8 * fq;
#pragma unroll
            for (int ai = 0; ai < 2; ++ai)
#pragma unroll
                for (int m = 0; m < 4; ++m) { bf16_t* rowp = O + (size_t)(row0 + ai * HALF + m * 16) * 6144 + col0;
#pragma unroll
                    for (int bj = 0; bj < 2; ++bj) { const f32x4 v0 = acc[ai][bj][m][0] * ascale, v1 = acc[ai][bj][m][1] * ascale;
                        u32x4 w; w.x = cvt_pk_bf16(v0[0], v0[1]); w.y = cvt_pk_bf16(v0[2], v0[3]); w.z = cvt_pk_bf16(v1[0], v1[1]); w.w = cvt_pk_bf16(v1[2], v1[3]);
                        *(u32x4*)(rowp + bj * HALF) = w; } }
        } else if (u.pn < 48) {
            const int col0 = (u.pn - 24) * BM + wc * 32 + 8 * fq;
#pragma unroll
            for (int ai = 0; ai < 2; ++ai)
#pragma unroll
                for (int m = 0; m < 4; ++m) { unsigned char* rowp = mg8 + (size_t)(row0 + ai * HALF + m * 16) * 6144 + col0;
#pragma unroll
                    for (int bj = 0; bj < 2; ++bj) { const f32x4 v0 = acc[ai][bj][m][0] * ascale, v1 = acc[ai][bj][m][1] * ascale;
                        *(unsigned long long*)(rowp + bj * HALF) = (unsigned long long)pk4_fp8(v0[0], v0[1], v0[2], v0[3]) | ((unsigned long long)pk4_fp8(v1[0], v1[1], v1[2], v1[3]) << 32); } }
        } else {
#pragma unroll
            for (int ai = 0; ai < 2; ++ai)
#pragma unroll
                for (int m = 0; m < 4; ++m) { float* rowp = sm + (size_t)(row0 + ai * HALF + m * 16) * 24;
#pragma unroll
                    for (int n = 0; n < 2; ++n) { const int c = wc * 32 + 8 * fq + 4 * n;
                        if (c < 24) *(f32x4*)(rowp + c) = acc[ai][0][m][n]; } }
        }
    }
    __device__ __forceinline__ void mid(f32x4 (&)[2][2][4][2], const Unit&, int, int, int, int, int) const {}
};

template <int M1, int M2> struct EpiMergeT {
    static constexpr bool PERM = true, AFTER_DRAIN = false; static constexpr int NMID = 2, MID1 = M1, MID2 = M2;
    const unsigned char* proj; unsigned char* O; float ascale;
    static __device__ __forceinline__ void ld8(const unsigned char* p, float (&z)[8]) { const unsigned long long w = *(const unsigned long long*)p; const int lo = (int)(unsigned)w, hi = (int)(unsigned)(w >> 32);
        const f32x2 a = __builtin_amdgcn_cvt_pk_f32_fp8(lo, false), b = __builtin_amdgcn_cvt_pk_f32_fp8(lo, true), c = __builtin_amdgcn_cvt_pk_f32_fp8(hi, false), d = __builtin_amdgcn_cvt_pk_f32_fp8(hi, true);
        z[0] = a[0]; z[1] = a[1]; z[2] = b[0]; z[3] = b[1]; z[4] = c[0]; z[5] = c[1]; z[6] = d[0]; z[7] = d[1]; }
    static __device__ __forceinline__ float en(float z) { z = fminf(fmaxf(z, -30.f), 30.f); return __expf(-z); }
    __device__ __forceinline__ void mid(f32x4 (&acc)[2][2][4][2], const Unit& u, int t, int, int, int, int) const {
        PG8_COORDS();
        const int b = (t == MID1) ? 0 : 1;
        int row0 = u.pm * BM + wr * 64 + fr, col0 = u.pn * BM + wc * 32 + 8 * fq;
        asm volatile("" : "+v"(row0), "+v"(col0));
#pragma unroll
        for (int ai = 0; ai < 2; ++ai)
#pragma unroll
            for (int m = 0; m < 4; ++m) { const unsigned char* rowp = proj + (size_t)(row0 + ai * HALF + m * 16) * 6144 + 2048 * b + col0;
#pragma unroll
                for (int bj = 0; bj < 2; ++bj) { float za[8], zb[8]; ld8(rowp + bj * HALF, za); ld8(rowp + 2048 + bj * HALF, zb);
#pragma unroll
                    for (int j = 0; j < 8; ++j) { const float r = (1.f + en(zb[j])) / (1.f + en(za[j]));
                        acc[ai][bj][m][j >> 2][j & 3] *= r; } }
                asm volatile("" ::: "memory"); }
    }
    __device__ __forceinline__ void operator()(const f32x4 (&acc)[2][2][4][2], const Unit& u, int, int, int, int) const {
        PG8_COORDS();
        const int row0 = u.pm * BM + wr * 64 + fr, col0 = u.pn * BM + wc * 32 + 8 * fq;
#pragma unroll
        for (int ai = 0; ai < 2; ++ai)
#pragma unroll
            for (int m = 0; m < 4; ++m) { const size_t r = (size_t)(row0 + ai * HALF + m * 16); const unsigned char* gp = proj + r * 6144 + 4096 + col0; unsigned char* op = O + r * 2048 + col0;
#pragma unroll
                for (int bj = 0; bj < 2; ++bj) { float z[8], v[8]; ld8(gp + bj * HALF, z);
#pragma unroll
                    for (int j = 0; j < 8; ++j) v[j] = acc[ai][bj][m][j >> 2][j & 3] * ascale / (1.f + en(z[j]));
                    *(unsigned long long*)(op + bj * HALF) = (unsigned long long)pk4_fp8(v[0], v[1], v[2], v[3]) | ((unsigned long long)pk4_fp8(v[4], v[5], v[6], v[7]) << 32); }
                asm volatile("" ::: "memory"); }
    }
};

typedef EpiMergeT<16, 32> EpiMerge;
typedef EpiMergeT<8, 16> EpiMergeF8;

struct EpiResid {
    static constexpr bool PERM = false, AFTER_DRAIN = false; static constexpr int NMID = 0, MID1 = -1, MID2 = -1;
    const bf16_t* base; bf16_t* out; const float* gate; float ascale;
    __device__ __forceinline__ void operator()(const f32x4 (&acc)[2][2][4][2], const Unit& u, int, int, int, int) const {
        PG8_COORDS();
        const int row0 = u.pm * BM + wr * 64 + fr, col0 = u.pn * BM + wc * 32 + 4 * fq;
#pragma unroll
        for (int ai = 0; ai < 2; ++ai)
#pragma unroll
            for (int m = 0; m < 4; ++m) { const int row = row0 + ai * HALF + m * 16;
                const int cond = row < 8192 ? (row >> 11) : 4 + ((row - 8192) >> 2);
                const bf16_t* bp = base + (size_t)row * 2048 + col0; const float* gp = gate + (size_t)cond * 24576 + col0; bf16_t* op = out + (size_t)row * 2048 + col0;
#pragma unroll
                for (int bj = 0; bj < 2; ++bj)
#pragma unroll
                    for (int n = 0; n < 2; ++n) { const unsigned long long bw = *(const unsigned long long*)(bp + bj * HALF + n * 16); const unsigned b0 = (unsigned)bw, b1 = (unsigned)(bw >> 32);
                        const f32x4 bs = {bflo(b0), bfhi(b0), bflo(b1), bfhi(b1)}, gt = *(const f32x4*)(gp + bj * HALF + n * 16);
                        const f32x4 v = bs + gt * (acc[ai][bj][m][n] * ascale);
                        *(unsigned long long*)(op + bj * HALF + n * 16) = (unsigned long long)cvt_pk_bf16(v[0], v[1]) | ((unsigned long long)cvt_pk_bf16(v[2], v[3]) << 32); }
                asm volatile("" ::: "memory"); }
    }
    __device__ __forceinline__ void mid(f32x4 (&)[2][2][4][2], const Unit&, int, int, int, int, int) const {}
};

struct EpiSlab {
    static constexpr bool PERM = false, AFTER_DRAIN = false; static constexpr int NMID = 0, MID1 = -1, MID2 = -1;
    bf16_t* slab; int ksub; float ascale;
    __device__ __forceinline__ void operator()(const f32x4 (&acc)[2][2][4][2], const Unit& u, int, int, int, int) const {
        PG8_COORDS();
        const int row0 = u.pm * BM + wr * 64 + fr - 8192, col0 = u.pn * BM + wc * 32 + 4 * fq; bf16_t* sl = slab + (size_t)(u.koff / ksub) * 512 * 2048;
#pragma unroll
        for (int ai = 0; ai < 2; ++ai)
#pragma unroll
            for (int m = 0; m < 4; ++m) { bf16_t* op = sl + (size_t)(row0 + ai * HALF + m * 16) * 2048 + col0;
#pragma unroll
                for (int bj = 0; bj < 2; ++bj)
#pragma unroll
                    for (int n = 0; n < 2; ++n) { const f32x4 v = acc[ai][bj][m][n] * ascale; *(unsigned long long*)(op + bj * HALF + n * 16) = (unsigned long long)cvt_pk_bf16(v[0], v[1]) | ((unsigned long long)cvt_pk_bf16(v[2], v[3]) << 32); } }
    }
    __device__ __forceinline__ void mid(f32x4 (&)[2][2][4][2], const Unit&, int, int, int, int, int) const {}
};

struct EpiGateSlab {
    static constexpr bool PERM = false, AFTER_DRAIN = false; static constexpr int NMID = 0, MID1 = -1, MID2 = -1;
    const unsigned char* proj; bf16_t* slab; int kshift; float ascale;
    __device__ __forceinline__ void operator()(const f32x4 (&acc)[2][2][4][2], const Unit& u, int, int, int, int) const {
        PG8_COORDS();
        const int b = u.koff >> kshift, row0 = u.pm * BM + wr * 64 + fr, col0 = u.pn * BM + wc * 32 + 4 * fq; bf16_t* sl = slab + (size_t)b * 512 * 2048;
#pragma unroll
        for (int ai = 0; ai < 2; ++ai)
#pragma unroll
            for (int m = 0; m < 4; ++m) { const int row = row0 + ai * HALF + m * 16; const unsigned char* gp = proj + (size_t)row * 6144 + 2048 * b + col0; bf16_t* op = sl + (size_t)(row - 8192) * 2048 + col0;
#pragma unroll
                for (int bj = 0; bj < 2; ++bj)
#pragma unroll
                    for (int n = 0; n < 2; ++n) { const int gw = (int)*(const unsigned*)(gp + bj * HALF + n * 16); const f32x2 ga = __builtin_amdgcn_cvt_pk_f32_fp8(gw, false), gb = __builtin_amdgcn_cvt_pk_f32_fp8(gw, true);
                        f32x4 v = acc[ai][bj][m][n] * ascale;
                        v[0] /= 1.f + EpiMerge::en(ga[0]); v[1] /= 1.f + EpiMerge::en(ga[1]); v[2] /= 1.f + EpiMerge::en(gb[0]); v[3] /= 1.f + EpiMerge::en(gb[1]);
                        *(unsigned long long*)(op + bj * HALF + n * 16) = (unsigned long long)cvt_pk_bf16(v[0], v[1]) | ((unsigned long long)cvt_pk_bf16(v[2], v[3]) << 32); }
                asm volatile("" ::: "memory"); }
    }
    __device__ __forceinline__ void mid(f32x4 (&)[2][2][4][2], const Unit&, int, int, int, int, int) const {}
};

struct EpiRelu2 {
    static constexpr bool PERM = true, AFTER_DRAIN = false; static constexpr int NMID = 0, MID1 = -1, MID2 = -1;
    bf16_t* O; int ldc;
    __device__ __forceinline__ void operator()(const f32x4 (&acc)[2][2][4][2], const Unit& u, int, int, int, int) const {
        PG8_COORDS();
        const int row0 = u.pm * BM + wr * 64 + fr, col0 = u.pn * BM + wc * 32 + 8 * fq;
#pragma unroll
        for (int ai = 0; ai < 2; ++ai)
#pragma unroll
            for (int m = 0; m < 4; ++m) { bf16_t* rowp = O + (size_t)(row0 + ai * HALF + m * 16) * ldc + col0;
#pragma unroll
                for (int bj = 0; bj < 2; ++bj) { f32x4 v0 = acc[ai][bj][m][0], v1 = acc[ai][bj][m][1];
#pragma unroll
                    for (int j = 0; j < 4; ++j) { const float a = fmaxf(v0[j], 0.f), b = fmaxf(v1[j], 0.f); v0[j] = a * a; v1[j] = b * b; }
                    u32x4 w; w.x = cvt_pk_bf16(v0[0], v0[1]); w.y = cvt_pk_bf16(v0[2], v0[3]); w.z = cvt_pk_bf16(v1[0], v1[1]); w.w = cvt_pk_bf16(v1[2], v1[3]);
                    *(u32x4*)(rowp + bj * HALF) = w; } }
    }
    __device__ __forceinline__ void mid(f32x4 (&)[2][2][4][2], const Unit&, int, int, int, int, int) const {}
};


struct EpiRelu2F8 {
    static constexpr bool PERM = true, AFTER_DRAIN = false; static constexpr int NMID = 0, MID1 = -1, MID2 = -1;
    unsigned char* O; int ldc; float ascale;
    __device__ __forceinline__ void operator()(const f32x4 (&acc)[2][2][4][2], const Unit& u, int, int, int, int) const {
        PG8_COORDS();
        const int row0 = u.pm * BM + wr * 64 + fr, col0 = u.pn * BM + wc * 32 + 8 * fq;
#pragma unroll
        for (int ai = 0; ai < 2; ++ai)
#pragma unroll
            for (int m = 0; m < 4; ++m) { unsigned char* rowp = O + (size_t)(row0 + ai * HALF + m * 16) * ldc + col0;
#pragma unroll
                for (int bj = 0; bj < 2; ++bj) { f32x4 v0 = acc[ai][bj][m][0], v1 = acc[ai][bj][m][1];
#pragma unroll
                    for (int j = 0; j < 4; ++j) { const float a = fmaxf(v0[j] * ascale, 0.f), b = fmaxf(v1[j] * ascale, 0.f); v0[j] = a * a; v1[j] = b * b; }
                    unsigned long long w = (unsigned long long)pk4_fp8(v0[0], v0[1], v0[2], v0[3]) | ((unsigned long long)pk4_fp8(v1[0], v1[1], v1[2], v1[3]) << 32);
                    *(unsigned long long*)(rowp + bj * HALF) = w; } }
    }
    __device__ __forceinline__ void mid(f32x4 (&)[2][2][4][2], const Unit&, int, int, int, int, int) const {}
};
template <class Epi, class Sched, bool FP8 = false, bool STAMP = false>
__device__ __forceinline__ void gemm_phase(PG8_LAS unsigned char* lds, const Gemm g, const Sched& S, const Epi& E, unsigned long long* stamps) {
    int tid_ = threadIdx.x; asm volatile("" : "+v"(tid_));
    const int tid = tid_, wid = __builtin_amdgcn_readfirstlane(tid >> 6), lane = tid & 63, wr = wid >> 2, wc = wid & 3, fr = lane & 15, fq = lane >> 4;
    const int K = g.K, nt = K / BK;
    int ts_lo = 0, ts_hi = 0, nts = 0; const unsigned long long rt_entry = STAMP ? (unsigned long long)wall_clock64() : 0ull;
#define PG8_STAMP() do { if (STAMP && wid == 0 && nts < 64) { const unsigned long long _c = (unsigned long long)clock64(); \
        ts_lo = (lane == nts) ? (int)(unsigned)_c : ts_lo; ts_hi = (lane == nts) ? (int)(unsigned)(_c >> 32) : ts_hi; ++nts; } } while (0)
    PG8_STAMP();
    unsigned voffA[2], voffB[2];
#pragma unroll
    for (int i = 0; i < 2; ++i) { int R, C; stage_rc(tid * 16 + i * 8192, R, C); const int Rb = Epi::PERM ? ((R & ~31) + perm32(R & 31)) : R;
        voffA[i] = (unsigned)(R * g.lda + C) * 2u; voffB[i] = (unsigned)(Rb * g.ldb + C) * 2u; }
    const size_t kstep = (size_t)(BK * 2);
    const size_t hstepA = (size_t)HALF * g.lda * 2, hstepB = (size_t)HALF * g.ldb * 2;
    const size_t tstepA = 2 * hstepA, tstepB = 2 * hstepB;
    const unsigned ldsw = (unsigned)wid * 1024u;
    const int aoff = lds_byte(wr * 64 + fr, fq * 8), boff = lds_byte(wc * 32 + fr, fq * 8);
#define PG8_SA(b, h) (((b) * 2 + (h)) * HTB)
#define PG8_SB(b, h) ((4 + (b) * 2 + (h)) * HTB)
#define PG8_STAGE(bufoff, gbase, voff) do { _Pragma("unroll") for (int _i = 0; _i < 2; ++_i) \
        __builtin_amdgcn_global_load_lds((const unsigned*)((const char*)(gbase) + (voff)[_i]), (PG8_LAS unsigned*)(lds + (bufoff) + ldsw + _i * 8192), 16, 0, 0); } while (0)
#define PG8_LDA(dst, b, h) do { _Pragma("unroll") for (int m = 0; m < 4; ++m) { \
        if constexpr (FP8) { const i32x4 lo_ = *(const PG8_LAS i32x4*)(lds + PG8_SA(b, h) + aoff + m * 2048), hi_ = *(const PG8_LAS i32x4*)(lds + PG8_SA(b, h) + aoff + m * 2048 + 1024); dst##8[m] = __builtin_shufflevector(lo_, hi_, 0, 1, 2, 3, 4, 5, 6, 7); } \
        else { _Pragma("unroll") for (int k = 0; k < 2; ++k) dst[m][k] = *(const PG8_LAS bf16x8*)(lds + PG8_SA(b, h) + aoff + m * 2048 + k * 1024); } } } while (0)
#define PG8_LDB(dst, b, h) do { _Pragma("unroll") for (int n = 0; n < 2; ++n) { \
        if constexpr (FP8) { const i32x4 lo_ = *(const PG8_LAS i32x4*)(lds + PG8_SB(b, h) + boff + n * 2048), hi_ = *(const PG8_LAS i32x4*)(lds + PG8_SB(b, h) + boff + n * 2048 + 1024); dst##8[n] = __builtin_shufflevector(lo_, hi_, 0, 1, 2, 3, 4, 5, 6, 7); } \
        else { _Pragma("unroll") for (int k = 0; k < 2; ++k) dst[n][k] = *(const PG8_LAS bf16x8*)(lds + PG8_SB(b, h) + boff + n * 2048 + k * 1024); } } } while (0)
#define PG8_MMA(ai, bj, At, Bt) do { __builtin_amdgcn_s_setprio(1); _Pragma("unroll") for (int m = 0; m < 4; ++m) _Pragma("unroll") for (int n = 0; n < 2; ++n) { \
        if constexpr (FP8) asm volatile("v_mfma_scale_f32_16x16x128_f8f6f4 %0, %1, %2, %0, %3, %3 op_sel_hi:[0,0,0]" : "+v"(acc[ai][bj][m][n]) : "v"(Bt##8[n]), "v"(At##8[m]), "v"(one_scale)); \
        else { _Pragma("unroll") for (int k = 0; k < 2; ++k) acc[ai][bj][m][n] = __builtin_amdgcn_mfma_f32_16x16x32_bf16(Bt[n][k], At[m][k], acc[ai][bj][m][n], 0, 0, 0); } } \
        __builtin_amdgcn_s_setprio(0); } while (0)
#define PG8_WAIT_V(n) asm volatile("s_waitcnt vmcnt(" #n ")" ::: "memory")
#define PG8_WAIT_L(n) asm volatile("s_waitcnt lgkmcnt(" #n ")" ::: "memory")
#define PG8_BAR __builtin_amdgcn_s_barrier()
#define PG8_SCHED __builtin_amdgcn_sched_barrier(0)
    Unit cur, nxt; int ui = 0;
    if (!S.next(0, cur)) return;
    f32x4 acc[2][2][4][2];
#pragma unroll
    for (int a = 0; a < 2; ++a)
#pragma unroll
        for (int b = 0; b < 2; ++b)
#pragma unroll
            for (int m = 0; m < 4; ++m)
#pragma unroll
                for (int n = 0; n < 2; ++n) acc[a][b][m][n] = (f32x4){0.f, 0.f, 0.f, 0.f};
    bf16x8 At[4][2], B0[2][2], B1[2][2]; i32x8 At8[4], B08[2], B18[2]; const int one_scale = 0x7f7f7f7f;
    const char* cA = (const char*)g.A + (size_t)cur.pm * tstepA + (size_t)cur.koff * 2; const char* cB = (const char*)g.Bt + (size_t)cur.pn * tstepB + (size_t)cur.koff * 2;
    S.a_ready(cur);
    PG8_STAGE(PG8_SB(0, 0), cB, voffB); PG8_STAGE(PG8_SA(0, 0), cA, voffA); PG8_STAGE(PG8_SB(0, 1), cB + hstepB, voffB); PG8_STAGE(PG8_SA(0, 1), cA + hstepA, voffA);
    if (wr == 1) PG8_BAR;
    PG8_WAIT_V(4); PG8_BAR;
    PG8_STAGE(PG8_SB(1, 0), cB + kstep, voffB); PG8_STAGE(PG8_SA(1, 0), cA + kstep, voffA); PG8_STAGE(PG8_SB(1, 1), cB + hstepB + kstep, voffB);
    PG8_WAIT_V(6); PG8_BAR;
    PG8_STAMP();
    for (;;) {
        const bool has_next = S.next(ui + 1, nxt);
        const char* nA = has_next ? (const char*)g.A + (size_t)nxt.pm * tstepA + (size_t)nxt.koff * 2 : cA; const char* nB = has_next ? (const char*)g.Bt + (size_t)nxt.pn * tstepB + (size_t)nxt.koff * 2 : cB;
        for (int t = 0; t < nt; t += 2) {
            const bool last = (t == nt - 2);
            const char* a1 = cA + (size_t)(t + 1) * kstep;
            const char* a2 = last ? nA : cA + (size_t)(t + 2) * kstep; const char* b2 = last ? nB : cB + (size_t)(t + 2) * kstep;
            const char* a3 = a2 + kstep; const char* b3 = b2 + kstep;
            if (last && has_next) S.a_ready(nxt);
            if constexpr (Epi::NMID > 0) { if (t == Epi::MID1 || t == Epi::MID2) E.mid(acc, cur, t, wr, wc, fr, fq); }
            PG8_LDB(B0, 0, 0); PG8_SCHED; PG8_LDA(At, 0, 0); PG8_STAGE(PG8_SA(1, 1), a1 + hstepA, voffA);
            PG8_WAIT_L(8); PG8_BAR; PG8_WAIT_L(0); PG8_MMA(0, 0, At, B0); PG8_BAR; PG8_SCHED;
            PG8_LDB(B1, 0, 1); PG8_STAGE(PG8_SB(0, 0), b2, voffB);
            PG8_BAR; PG8_WAIT_L(0); PG8_MMA(0, 1, At, B1); PG8_BAR;
            PG8_LDA(At, 0, 1); PG8_STAGE(PG8_SA(0, 0), a2, voffA);
            PG8_BAR; PG8_WAIT_L(0); PG8_MMA(1, 0, At, B0); PG8_BAR; PG8_SCHED;
            PG8_STAGE(PG8_SB(0, 1), b2 + hstepB, voffB);
            PG8_WAIT_V(6); PG8_BAR; PG8_MMA(1, 1, At, B1); PG8_BAR;
            PG8_LDB(B0, 1, 0); PG8_SCHED; PG8_LDA(At, 1, 0); PG8_STAGE(PG8_SA(0, 1), a2 + hstepA, voffA);
            PG8_WAIT_L(8); PG8_BAR; PG8_WAIT_L(0); PG8_MMA(0, 0, At, B0); PG8_BAR; PG8_SCHED;
            PG8_LDB(B1, 1, 1); PG8_STAGE(PG8_SB(1, 0), b3, voffB);
            PG8_BAR; PG8_WAIT_L(0); PG8_MMA(0, 1, At, B1); PG8_BAR;
            PG8_LDA(At, 1, 1); PG8_STAGE(PG8_SA(1, 0), a3, voffA);
            PG8_BAR; PG8_WAIT_L(0); PG8_MMA(1, 0, At, B0); PG8_BAR; PG8_SCHED;
            PG8_STAGE(PG8_SB(1, 1), b3 + hstepB, voffB);
            PG8_WAIT_V(6); PG8_BAR; PG8_MMA(1, 1, At, B1); PG8_BAR;
        }
        PG8_STAMP();
        if constexpr (FP8) asm volatile("s_nop 15\n\ts_nop 15" ::: "memory");
        if constexpr (!Epi::AFTER_DRAIN) { E(acc, cur, wr, wc, fr, fq); S.done(cur); }
        PG8_STAMP();
        if (!has_next) break;
#pragma unroll
        for (int a = 0; a < 2; ++a)
#pragma unroll
            for (int b = 0; b < 2; ++b)
#pragma unroll
                for (int m = 0; m < 4; ++m)
#pragma unroll
                    for (int n = 0; n < 2; ++n) acc[a][b][m][n] = (f32x4){0.f, 0.f, 0.f, 0.f};
        cur = nxt; cA = nA; cB = nB; ++ui;
    }
    PG8_WAIT_V(0);
    if (wr == 0) PG8_BAR;
    PG8_BAR;
    if constexpr (Epi::AFTER_DRAIN) { E.fused(acc, cur, wr, wc, fr, fq, lds, wid, lane); S.done(cur); }
    PG8_STAMP();
    if (STAMP && wid == 0) { stamps[lane] = lane < nts ? (((unsigned long long)(unsigned)ts_hi << 32) | (unsigned)ts_lo) : 0ull;
        if (lane == 62) stamps[62] = rt_entry; if (lane == 63) stamps[63] = (unsigned long long)wall_clock64(); }
#undef PG8_STAMP
#undef PG8_SA
#undef PG8_SB
#undef PG8_STAGE
#undef PG8_LDA
#undef PG8_LDB
#undef PG8_MMA
#undef PG8_WAIT_V
#undef PG8_WAIT_L
#undef PG8_BAR
#undef PG8_SCHED
}
}

#define GAS __attribute__((address_space(1)))
#define LAS __attribute__((address_space(3)))
#define DI __device__ __forceinline__
typedef unsigned short bf16;
typedef unsigned v4u __attribute__((ext_vector_type(4)));
typedef unsigned v2u __attribute__((ext_vector_type(2)));
typedef float f32x4 __attribute__((ext_vector_type(4)));
#define RLX_AGENT __ATOMIC_RELAXED, __HIP_MEMORY_SCOPE_AGENT
#define LDS_WAIT() asm volatile("s_waitcnt lgkmcnt(0)" ::: "memory")

constexpr int NWAVES = 8, NTHREADS = 512, GRID = 256;
#ifndef MK_N_LAUNCHES
#define MK_N_LAUNCHES 1
#endif
constexpr int PH_TOTAL = 21;
constexpr int N_LAUNCHES = MK_N_LAUNCHES;

constexpr size_t O_YP = 0, O_YS = O_YP + (size_t)MP * D, O_P_LRUH = O_YS + (size_t)MS * D, O_P_LRUC = O_P_LRUH + (size_t)DEPTH * NP * 1024,
    O_P_GLA = O_P_LRUC + (size_t)DEPTH * NP * 3 * 1024, O_P_C = O_P_GLA + (size_t)DEPTH * NP * 4 * 128 * 256, O_P_N = O_P_C + (size_t)DEPTH * NP * 4 * 256 * 256,
    O_P_M = O_P_N + (size_t)DEPTH * NP * 4 * 256, O_P_MLC = O_P_M + (size_t)DEPTH * NP * 4, O_S_LRUH = O_P_MLC + (size_t)DEPTH * NP * 3 * 1024,
    O_S_LRUC = O_S_LRUH + (size_t)DEPTH * NS * 1024, O_S_GLA = O_S_LRUC + (size_t)DEPTH * NS * 3 * 1024, O_S_C = O_S_GLA + (size_t)DEPTH * NS * 4 * 128 * 256,
    O_S_N = O_S_C + (size_t)DEPTH * NS * 4 * 256 * 256, O_S_M = O_S_N + (size_t)DEPTH * NS * 4 * 256, O_S_MLC = O_S_M + (size_t)DEPTH * NS * 4,
    O_END = O_S_MLC + (size_t)DEPTH * NS * 3 * 1024;
static_assert(O_END == 123798560, "output size");

constexpr size_t MiB = 1u << 20;
constexpr size_t WS_CTL = 0, CTL_ZERO_BYTES = 1 * MiB;
constexpr size_t WS_WADA = 2 * MiB, WS_WIN = 98 * MiB, WS_WBR = 196 * MiB, WS_WOUT = 220 * MiB, WS_WFF1 = 236 * MiB, WS_WFF2 = 300 * MiB;
constexpr size_t WS_CSILU = 364 * MiB, WS_MOD = 365 * MiB, WS_XA = 389 * MiB, WS_XB = 457 * MiB, WS_XN = 525 * MiB, WS_MERGED = 559 * MiB, WS_YCAT = 593 * MiB,
    WS_SMALL = 644 * MiB, WS_PROJ = 645 * MiB, WS_HFF = 849 * MiB, WS_GIMG = 985 * MiB, WS_MIMG = 1008 * MiB, WS_END = 1100 * MiB;
static_assert(WS_WADA + (size_t)2 * NADA * D * 2 <= WS_WIN && WS_WIN + (size_t)2 * NPROJ_PAD * D * 2 <= WS_WBR && WS_WBR + (size_t)2 * D * KBR * 2 <= WS_WOUT &&
              WS_WOUT + (size_t)2 * D * D * 2 <= WS_WFF1 && WS_WFF1 + (size_t)2 * DFF * D * 2 <= WS_WFF2 && WS_WFF2 + (size_t)2 * DFF * D * 2 <= WS_CSILU &&
              WS_CSILU + (size_t)256 * D * 2 <= WS_MOD && WS_MOD + (size_t)256 * 2 * NADA * 4 <= WS_XA && WS_XA + (size_t)MTOT * D * 4 <= WS_XB && WS_XB + (size_t)MTOT * D * 4 <= WS_XN &&
              WS_XN + (size_t)MTOT * D * 2 <= WS_MERGED && WS_MERGED + (size_t)MTOT * D * 2 <= WS_YCAT && WS_YCAT + (size_t)MTOT * KBR * 2 <= WS_SMALL &&
              WS_SMALL + (size_t)MTOT * NSMALL * 4 <= WS_PROJ && WS_PROJ + (size_t)MTOT * NPROJ * 2 <= WS_HFF && WS_HFF + (size_t)MTOT * DFF * 2 <= WS_GIMG && WS_GIMG + (size_t)512 * 46080 <= WS_MIMG && WS_MIMG + (size_t)512 * 115712 <= WS_END, "d_ws map");
constexpr size_t WS_WIN8_0 = WS_WFF1 + 32 * MiB, WS_WIN8_1 = WS_WFF2 + 32 * MiB, WS_XN8 = WS_HFF + 72 * MiB;
static_assert((size_t)2 * DFF * D <= 32 * MiB && (size_t)NPROJ_PAD * D <= 32 * MiB && (size_t)MTOT * DFF <= 72 * MiB && WS_XN8 + (size_t)MTOT * D <= WS_GIMG, "fp8 copies fit in the free halves");
constexpr size_t WS_MG8 = WS_PROJ + 104 * MiB;
static_assert((size_t)MTOT * PPITCH * 2 <= 104 * MiB && WS_MG8 + (size_t)MTOT * 6144 <= WS_HFF, "proj / gate buffers");
constexpr int CW_BAR = 4096;

constexpr int RING_OFF = 0, RING_BYTES = 131072;
constexpr int LDS_BYTES = 163840;
constexpr int LDSCTL_OFF = LDS_BYTES - 1024, MISC_OFF = LDSCTL_OFF + 320;

DI float bf2f(bf16 b) { return __uint_as_float(((unsigned)b) << 16); }
DI unsigned f2bf(float f) { unsigned u = __float_as_uint(f); return (u + 0x7fffu + ((u >> 16) & 1u)) >> 16; }
typedef float f32x2v __attribute__((ext_vector_type(2)));
typedef __bf16 bf16x2v __attribute__((ext_vector_type(2)));
DI unsigned pkbf(float a, float b) { const f32x2v v = {a, b}; const bf16x2v r = __builtin_convertvector(v, bf16x2v); return __builtin_bit_cast(unsigned, r); }
DI unsigned pk2(float lo, float hi) { return f2bf(lo) | (f2bf(hi) << 16); }
DI float bflo_(unsigned w) { return __uint_as_float(w << 16); }
DI float bfhi_(unsigned w) { return __uint_as_float(w & 0xffff0000u); }
DI float sigm(float x) { return __builtin_amdgcn_rcpf(1.f + __expf(-x)); }
DI float lru_in_scale(float la) { const float t = 2.f * la;
    const float em = (t > -0.125f) ? -t * (1.f + t * (0.5f + t * (0.16666667f + t * (0.041666668f + t * 0.0083333338f)))) : 1.f - __expf(t);
    return __builtin_amdgcn_sqrtf(em); }
DI float logsig(float x) { return fminf(x, 0.f) - __logf(1.f + __expf(-fabsf(x))); }
template <int CTRL, int ROWMASK> DI float dpp_f(float v) { return __int_as_float(__builtin_amdgcn_update_dpp(0, __float_as_int(v), CTRL, ROWMASK, 0xf, false)); }
DI float wave_sum(float v) {
    v += dpp_f<0xB1, 0xf>(v);
    v += dpp_f<0x4E, 0xf>(v);
    v += dpp_f<0x141, 0xf>(v);
    v += dpp_f<0x140, 0xf>(v);
    v += dpp_f<0x142, 0xa>(v);
    v += dpp_f<0x143, 0xc>(v);
    return __int_as_float(__builtin_amdgcn_readlane(__float_as_int(v), 63));
}

#define XB_TMO      128
#define XB_XCNT(j)  (256  + 64 * (j))
#define XB_XSUB(j)  (1280 + 64 * (j))
#define XB_XGEN(j)  (2304 + 64 * (j))
#define XB_TOP      3328
#define XB_TOPGEN   3392
#define XCD_BAR_WORDS 3456
#define XB_SPIN_CAP (1u << 18)

__device__ __forceinline__ unsigned xb_ld(unsigned* p)              { return __hip_atomic_load(p, __ATOMIC_RELAXED, __HIP_MEMORY_SCOPE_AGENT); }
__device__ __forceinline__ unsigned xb_add(unsigned* p, unsigned v) { return __hip_atomic_fetch_add(p, v, __ATOMIC_RELAXED, __HIP_MEMORY_SCOPE_AGENT); }
__device__ __forceinline__ unsigned xb_xcc_id() { return (unsigned)__builtin_amdgcn_s_getreg((3 << 11) | 20) & 0xFu; }
#define XB_SPIN(cond, bar) do { unsigned _sp = 0; while (cond) { __builtin_amdgcn_s_sleep(1); \
    if ((++_sp & 255u) == 0u) { if (xb_ld(&(bar)[XB_TMO])) break; if (_sp > XB_SPIN_CAP) { atomicAdd(&(bar)[XB_TMO], 1u); break; } } } } while (0)

struct XcdBarrier {
    unsigned* bar; unsigned x;
    volatile LAS unsigned* st;
};
__device__ __forceinline__ XcdBarrier xcd_barrier_post(unsigned* bar, volatile LAS unsigned* st) {
    XcdBarrier b; b.bar = bar; b.x = xb_xcc_id(); b.st = st;
    if (threadIdx.x == 0) (void)xb_add(&bar[XB_XCNT(b.x)], 1u);
    return b;
}
__device__ __forceinline__ void xcd_barrier_complete(unsigned* bar, unsigned x, unsigned& nloc, unsigned& nx) {
    const unsigned G = gridDim.x * gridDim.y * gridDim.z;
    unsigned sum, cnt, mine, sp = 0u;
    for (;;) {
        sum = 0u; cnt = 0u; mine = 0u;
#pragma unroll
        for (unsigned j = 0; j < 16; ++j) { const unsigned c = xb_ld(&bar[XB_XCNT(j)]); sum += c; cnt += (c > 0u) ? 1u : 0u; mine = (j == x) ? c : mine; }
        if (sum == G) break;
        __builtin_amdgcn_s_sleep(1);
        if ((++sp & 255u) == 0u) { if (xb_ld(&bar[XB_TMO])) break; if (sp > XB_SPIN_CAP) { atomicAdd(&bar[XB_TMO], 1u); break; } }
    }
    nloc = mine > 0u ? mine : 1u; nx = cnt > 0u ? cnt : 1u;
}
__device__ __forceinline__ void xcd_barrier(const XcdBarrier& b) {
    asm volatile("s_waitcnt vmcnt(0)" ::: "memory");
    __syncthreads();
    if (threadIdx.x == 0) {
        unsigned* bar = b.bar;
        __builtin_amdgcn_s_waitcnt(0);
        unsigned nloc = b.st[0], nx = b.st[1];
        if (nloc == 0u) { xcd_barrier_complete(bar, b.x, nloc, nx); b.st[0] = nloc; b.st[1] = nx; }
        const unsigned old = xb_add(&bar[XB_XSUB(b.x)], 1u);
        const unsigned gen = old / nloc;
        if (old + 1u == (gen + 1u) * nloc) {
            __builtin_amdgcn_fence(__ATOMIC_RELEASE, "agent");
            asm volatile("s_waitcnt vmcnt(0)" ::: "memory");
            const unsigned og = xb_add(&bar[XB_TOP], 1u);
            const unsigned tg = og / nx;
            if (og + 1u == (tg + 1u) * nx) xb_add(&bar[XB_TOPGEN], 1u);
            else XB_SPIN(xb_ld(&bar[XB_TOPGEN]) == tg, bar);
            __builtin_amdgcn_fence(__ATOMIC_ACQUIRE, "agent");
            xb_add(&bar[XB_XGEN(b.x)], 1u);
            asm volatile("s_waitcnt vmcnt(0)" ::: "memory");
        } else {
            XB_SPIN(xb_ld(&bar[XB_XGEN(b.x)]) == gen, bar);
            __builtin_amdgcn_fence(__ATOMIC_ACQUIRE, "agent");
            asm volatile("s_waitcnt vmcnt(0)" ::: "memory");
        }
    }
    __syncthreads();
}

struct Args { const float* in[40]; float* out; unsigned char* ws; int ph_lo, ph_hi, li, pad; };
typedef __attribute__((address_space(4))) const Args CArgs;
__device__ __forceinline__ CArgs* kargs() { CArgs* p = (CArgs*)__builtin_amdgcn_kernarg_segment_ptr(); asm volatile("" : "+s"(p)); return p; }

DI void transpose_item(const float* src, int src_ld, int ncols, bf16* dst, int dst_ld, LAS float* scr, int item, int lane) {
    const int nblk = ncols / 32, kb = item / nblk, nb = item % nblk, k0 = 64 * kb, n0 = 32 * nb;
#pragma unroll 8
    for (int i = 0; i < 32; ++i) { const int kk = 2 * i + (lane >> 5); scr[kk * 33 + (lane & 31)] = __builtin_nontemporal_load(src + (size_t)(k0 + kk) * src_ld + n0 + (lane & 31)); }
    LDS_WAIT(); asm volatile("" ::: "memory");
    const int c = lane & 7;
#pragma unroll
    for (int j = 0; j < 4; ++j) { const int n = (lane >> 3) + 8 * j; const LAS float* s = scr + (8 * c) * 33 + n;
        v4u o; o.x = pk2(s[0 * 33], s[1 * 33]); o.y = pk2(s[2 * 33], s[3 * 33]); o.z = pk2(s[4 * 33], s[5 * 33]); o.w = pk2(s[6 * 33], s[7 * 33]);
        *(v4u*)(dst + (size_t)(n0 + n) * dst_ld + k0 + 8 * c) = o; }
    LDS_WAIT(); asm volatile("" ::: "memory");
}
DI void transpose_item_f8(const float* src, int src_ld, int ncols, unsigned char* dst, int dst_ld, float scale, LAS float* scr, int item, int lane) {
    const int nblk = ncols / 32, kb = item / nblk, nb = item % nblk, k0 = 64 * kb, n0 = 32 * nb;
#pragma unroll 8
    for (int i = 0; i < 32; ++i) { const int kk = 2 * i + (lane >> 5); scr[kk * 33 + (lane & 31)] = __builtin_nontemporal_load(src + (size_t)(k0 + kk) * src_ld + n0 + (lane & 31)); }
    LDS_WAIT(); asm volatile("" ::: "memory");
    const int c = lane & 7;
#pragma unroll
    for (int j = 0; j < 4; ++j) { const int n = (lane >> 3) + 8 * j; const LAS float* s = scr + (8 * c) * 33 + n;
        v2u o; o.x = pg8::pk4_fp8(s[0 * 33] * scale, s[1 * 33] * scale, s[2 * 33] * scale, s[3 * 33] * scale); o.y = pg8::pk4_fp8(s[4 * 33] * scale, s[5 * 33] * scale, s[6 * 33] * scale, s[7 * 33] * scale);
        *(v2u*)(dst + (size_t)(n0 + n) * dst_ld + k0 + 8 * c) = o; }
    LDS_WAIT(); asm volatile("" ::: "memory");
}
DI void transpose_job_f8(const float* src, int src_ld, int K, int ncols, unsigned char* dst, int dst_ld, float scale, LAS float* scr, int gw, int ngw, int lane) {
    const int nitems = (K / 64) * (ncols / 32);
    for (int it = gw; it < nitems; it += ngw) transpose_item_f8(src, src_ld, ncols, dst, dst_ld, scale, scr, it, lane);
}
DI void transpose_job(const float* src, int src_ld, int K, int ncols, bf16* dst, int dst_ld, LAS float* scr, int gw, int ngw, int lane) {
    const int nitems = (K / 64) * (ncols / 32);
    for (int it = gw; it < nitems; it += ngw) transpose_item(src, src_ld, ncols, dst, dst_ld, scr, it, lane);
}

DI void norm_rows(const void* xp, const void* xs, bool in_f32, const float* g, const float* modp  ,
                  bf16* out_bf, float* outp, float* outs, int gw, int ngw, int lane, bf16* copy_out = nullptr,
                  int nslab = 0, const bf16* slab = nullptr, const float* sgate = nullptr, bf16* xs_out = nullptr, unsigned char* out_f8 = nullptr, unsigned char* out_f8_also = nullptr) {
    for (int row = gw; row < MTOT; row += ngw) {
        f32x4 v[8]; float ss = 0.f;
        if (in_f32) { const float* xr = row < MP ? (const float*)xp + (size_t)row * D : (const float*)xs + (size_t)(row - MP) * D; const f32x4* x4 = (const f32x4*)xr + lane;
#pragma unroll
            for (int j = 0; j < 8; ++j) v[j] = x4[64 * j];
            if (copy_out) {
#pragma unroll
                for (int j = 0; j < 8; ++j) { v2u w; w.x = pkbf(v[j].x, v[j].y); w.y = pkbf(v[j].z, v[j].w); *((v2u*)(copy_out + (size_t)row * D) + lane + 64 * j) = w; } }
        } else { const bf16* xr = row < MP ? (const bf16*)xp + (size_t)row * D : (const bf16*)xs + (size_t)(row - MP) * D; const v2u* x2 = (const v2u*)xr + lane;
#pragma unroll
            for (int j = 0; j < 8; ++j) { const v2u w = x2[64 * j]; v[j] = (f32x4){bflo_(w.x), bfhi_(w.x), bflo_(w.y), bfhi_(w.y)}; } }
        const int cond = row < MP ? (row >> 11) : NP + ((row - MP) >> 2);
        if (nslab > 0 && row >= MP) {
            const v2u* s4 = (const v2u*)(slab + (size_t)(row - MP) * D) + lane; const f32x4* gt4 = (const f32x4*)(sgate + (size_t)cond * 24576) + lane;
            v2u* xo = (v2u*)(xs_out + (size_t)(row - MP) * D) + lane;
#pragma unroll
            for (int j = 0; j < 8; ++j) { f32x4 a = {0.f, 0.f, 0.f, 0.f};
                for (int k = 0; k < nslab; ++k) { const v2u w = s4[(size_t)k * (MS * D / 4) + 64 * j]; a += (f32x4){bflo_(w.x), bfhi_(w.x), bflo_(w.y), bfhi_(w.y)}; }
                v[j] = v[j] + gt4[64 * j] * a; v2u w; w.x = pkbf(v[j].x, v[j].y); w.y = pkbf(v[j].z, v[j].w); xo[64 * j] = w; }
        }
#pragma unroll
        for (int j = 0; j < 8; ++j) ss += (v[j].x * v[j].x + v[j].y * v[j].y) + (v[j].z * v[j].z + v[j].w * v[j].w);
        ss = wave_sum(ss);
        const float r = __builtin_amdgcn_rsqf(ss * (1.f / D) + EPS);
        const f32x4* g4 = (const f32x4*)g + lane;
#pragma unroll
        for (int j = 0; j < 8; ++j) {
            f32x4 y = v[j] * r * g4[64 * j];
            if (modp) { const f32x4* m4 = (const f32x4*)(modp + (size_t)cond * 24576) + lane; const f32x4 sh = m4[64 * j], sc = m4[512 + 64 * j]; y = y * (1.f + sc) + sh; }
            if (out_f8_also) *((unsigned*)(out_f8_also + (size_t)row * D) + lane + 64 * j) = pg8::pk4_fp8(y.x, y.y, y.z, y.w);
            if (out_f8) *((unsigned*)(out_f8 + (size_t)row * D) + lane + 64 * j) = pg8::pk4_fp8(y.x, y.y, y.z, y.w);
            else if (out_bf) { v2u w; w.x = pk2(y.x, y.y); w.y = pk2(y.z, y.w); *((v2u*)(out_bf + (size_t)row * D) + lane + 64 * j) = w; }
            else { float* o = row < MP ? outp + (size_t)row * D : outs + (size_t)(row - MP) * D; *((f32x4*)o + lane + 64 * j) = y; }
        }
    }
}

DI float* out_state(float* out, int s, int l, size_t off_p, size_t off_s, size_t per) {
    return s < NP ? out + off_p + ((size_t)l * NP + s) * per : out + off_s + ((size_t)l * NS + (s - NP)) * per;
}

DI void lru_unit(int l, bool prompt, int grp, int n, LAS float* lds, int tid) {
    CArgs* A = kargs();
    LAS float* u_s = lds; LAS float* a_s = lds + 2048; LAS float* v_s = lds + 4096;
    const bf16* proj = (const bf16*)(A->ws + WS_PROJ); bf16* ycat = (bf16*)(A->ws + WS_YCAT); unsigned char* ycat8 = A->ws + WS_YCAT; (void)ycat; (void)ycat8;
    const float* cw = A->in[16] + (size_t)l * 4 * 1024; const float* cb = A->in[17] + (size_t)l * 1024;
    const float* wa = A->in[18] + ((size_t)l * 8 + n) * 128 * 128; const float* ba = A->in[19] + (size_t)l * 1024 + n * 128;
    const float* wx = A->in[20] + ((size_t)l * 8 + n) * 128 * 128; const float* bx = A->in[21] + (size_t)l * 1024 + n * 128;
    const float* lam = A->in[22] + (size_t)l * 1024 + n * 128;
    const float* st_h = A->in[4]; const float* st_c = A->in[5];
    const int ntiles = prompt ? TP / 16 : 1;
    const int c = tid & 127, rg = tid >> 7, ch = n * 128 + c;
    float h = 0.f;
    for (int tile = 0; tile < ntiles; ++tile) {
        {
            const float w0 = cw[ch], w1 = cw[1024 + ch], w2 = cw[2048 + ch], w3 = cw[3072 + ch], bb = cb[ch];
#pragma unroll
            for (int q = 0; q < 4; ++q) {
                const int r = 4 * rg + q;
                int s, t, T, row0;
                if (prompt) { s = grp; t = tile * 16 + r; T = TP; row0 = grp * TP; } else { s = NP + 4 * grp + (r >> 2); t = r & 3; T = TS; row0 = MP + (4 * grp + (r >> 2)) * TS; }
                float x[4];
#pragma unroll
                for (int jj = 0; jj < 4; ++jj) { const int tp = t - 3 + jj;
                    if (tp >= 0) x[jj] = bf2f(proj[(size_t)(row0 + tp) * PPITCH + C_LRUX + ch]);
                    else x[jj] = prompt ? 0.f : st_c[(((size_t)l * NS + (s - NP)) * 3 + (3 + tp)) * 1024 + ch]; }
                u_s[r * 128 + c] = bb + w0 * x[0] + w1 * x[1] + w2 * x[2] + w3 * x[3];
                if (t >= T - 3) out_state(A->out, s, l, O_P_LRUC, O_S_LRUC, 3 * 1024)[(size_t)(t - (T - 3)) * 1024 + ch] = x[3];
            }
        }
        __syncthreads();
        {
            float aa[4], ax[4];
#pragma unroll
            for (int q = 0; q < 4; ++q) { aa[q] = ba[c]; ax[q] = bx[c]; }
#pragma unroll 16
            for (int cc = 0; cc < 128; ++cc) { const float wa_ = wa[cc * 128 + c], wx_ = wx[cc * 128 + c];
#pragma unroll
                for (int q = 0; q < 4; ++q) { const float uq = u_s[(4 * rg + q) * 128 + cc]; aa[q] += uq * wa_; ax[q] += uq * wx_; } }
            const float ls = logsig(lam[c]);
#pragma unroll
            for (int q = 0; q < 4; ++q) { const int r = 4 * rg + q; const float rr = sigm(aa[q]), ii = sigm(ax[q]), la = 8.f * rr * ls;
                a_s[r * 128 + c] = __expf(la); v_s[r * 128 + c] = lru_in_scale(la) * (ii * u_s[r * 128 + c]); }
        }
        __syncthreads();
        if (prompt) {
            if (tid < 128) {
#pragma unroll 4
                for (int r = 0; r < 16; ++r) { h = a_s[r * 128 + c] * h + v_s[r * 128 + c];
                    ycat[(size_t)(grp * TP + tile * 16 + r) * KBR + ch] = (bf16)f2bf(h); }
            }
        } else {
            const int b = 4 * grp + rg; float hh = st_h[((size_t)l * NS + b) * 1024 + ch];
#pragma unroll
            for (int t = 0; t < 4; ++t) { const int r = rg * 4 + t; hh = a_s[r * 128 + c] * hh + v_s[r * 128 + c];
                ycat[(size_t)(MP + b * TS + t) * KBR + ch] = (bf16)f2bf(hh); }
            A->out[O_S_LRUH + ((size_t)l * NS + b) * 1024 + ch] = hh;
        }
    }
    if (prompt && tid < 128) A->out[O_P_LRUH + ((size_t)l * NP + grp) * 1024 + ch] = h;
    __syncthreads();
}

DI void gla_unit(int l, int s, int hh, LAS float* lds, int tid, int lane, int wave) {
    CArgs* A = kargs();
    const int b = s - NP, row0 = MP + b * TS;
    const bf16* proj = (const bf16*)(A->ws + WS_PROJ); bf16* ycat = (bf16*)(A->ws + WS_YCAT); unsigned char* ycat8 = A->ws + WS_YCAT; (void)ycat; (void)ycat8;     const float* sm = (const float*)(A->ws + WS_SMALL);
    const float* wg2 = A->in[23] + (size_t)l * 16 * 512; const float* bg = A->in[24] + (size_t)l * 512; const float* gn = A->in[25] + (size_t)l * 256;
    LAS float* eg_s = lds; LAS float* q_s = lds + 512; LAS float* k_s = lds + 1024; LAS float* v_s = lds + 1536; LAS float* part = lds + 2560;
    f32x4 S[16];
    { const f32x4* sp = (const f32x4*)(A->in[6] + ((((size_t)l * NS + b) * 4 + hh) * 128 + 16 * wave) * 256) + lane;
#pragma unroll
      for (int dd = 0; dd < 16; ++dd) S[dd] = __builtin_nontemporal_load(sp + dd * 64); }
    for (int i = tid; i < 4 * 128; i += NTHREADS) { const int tb = i >> 7, d = i & 127, col = hh * 128 + d; const size_t row = (size_t)(row0 + tb);
        float z = bg[col];
#pragma unroll
        for (int r = 0; r < 16; ++r) z += sm[row * NSMALL + r] * wg2[r * 512 + col];
        eg_s[i] = __expf(logsig(z) * (1.f / 16.f));
        q_s[i] = bf2f(proj[row * PPITCH + C_GQ + col]) * 0.08838834764831845f;
        k_s[i] = bf2f(proj[row * PPITCH + C_GK + col]); }
    for (int i = tid; i < 4 * 256; i += NTHREADS) { const int tb = i >> 8, ee = i & 255; v_s[i] = bf2f(proj[(size_t)(row0 + tb) * PPITCH + C_GV + hh * 256 + ee]); }
    __syncthreads();
#pragma unroll
    for (int tb = 0; tb < 4; ++tb) {
        const f32x4 v4 = *(const LAS f32x4*)(v_s + tb * 256 + 4 * lane); f32x4 po = {0.f, 0.f, 0.f, 0.f};
        const LAS float* egp = eg_s + tb * 128 + 16 * wave; const LAS float* kp = k_s + tb * 128 + 16 * wave; const LAS float* qp = q_s + tb * 128 + 16 * wave;
#pragma unroll
        for (int d4 = 0; d4 < 4; ++d4) { const f32x4 eg4 = *(const LAS f32x4*)(egp + 4 * d4), k4 = *(const LAS f32x4*)(kp + 4 * d4), q4 = *(const LAS f32x4*)(qp + 4 * d4);
            S[4 * d4 + 0] = S[4 * d4 + 0] * eg4.x + v4 * k4.x; po += S[4 * d4 + 0] * q4.x;
            S[4 * d4 + 1] = S[4 * d4 + 1] * eg4.y + v4 * k4.y; po += S[4 * d4 + 1] * q4.y;
            S[4 * d4 + 2] = S[4 * d4 + 2] * eg4.z + v4 * k4.z; po += S[4 * d4 + 2] * q4.z;
            S[4 * d4 + 3] = S[4 * d4 + 3] * eg4.w + v4 * k4.w; po += S[4 * d4 + 3] * q4.w; }
        *(LAS f32x4*)(part + (tb * 8 + wave) * 256 + 4 * lane) = po;
    }
    { f32x4* op = (f32x4*)(A->out + O_S_GLA + ((((size_t)l * NS + b) * 4 + hh) * 128 + 16 * wave) * 256) + lane;
#pragma unroll
      for (int dd = 0; dd < 16; ++dd) __builtin_nontemporal_store(S[dd], op + dd * 64); }
    __syncthreads();
    if (wave < 4) { const int tb = wave; const size_t row = (size_t)(row0 + tb);
        f32x4 ov = {0.f, 0.f, 0.f, 0.f};
#pragma unroll
        for (int w8 = 0; w8 < 8; ++w8) ov += *(const LAS f32x4*)(part + (tb * 8 + w8) * 256 + 4 * lane);
        float ss = (ov.x * ov.x + ov.y * ov.y) + (ov.z * ov.z + ov.w * ov.w); ss = wave_sum(ss);
        const float rs = __builtin_amdgcn_rsqf(ss * (1.f / 256.f) + EPS);
        const f32x4 g4 = *(const f32x4*)(gn + 4 * lane);
        const v2u gw = *(const v2u*)(proj + row * PPITCH + C_GGATE + hh * 256 + 4 * lane);
        const float z0 = __uint_as_float(gw.x << 16), z1 = __uint_as_float(gw.x & 0xffff0000u), z2 = __uint_as_float(gw.y << 16), z3 = __uint_as_float(gw.y & 0xffff0000u);
                *(unsigned*)(ycat8 + row * KBR + 1024 + hh * 256 + 4 * lane) = pg8::pk4_fp8(ov.x * rs * g4.x * (z0 * sigm(z0)), ov.y * rs * g4.y * (z1 * sigm(z1)), ov.z * rs * g4.z * (z2 * sigm(z2)), ov.w * rs * g4.w * (z3 * sigm(z3))); }
    __syncthreads();
}

DI void ml_unit(int l, int s, int hh, LAS float* lds, int tid, int lane, int wave) {
    CArgs* A = kargs();
    const int b = s - NP, row0 = MP + b * TS;
    const bf16* proj = (const bf16*)(A->ws + WS_PROJ); bf16* ycat = (bf16*)(A->ws + WS_YCAT); unsigned char* ycat8 = A->ws + WS_YCAT; (void)ycat; (void)ycat8;     const float* sm = (const float*)(A->ws + WS_SMALL);
    const float* mcw = A->in[26] + (size_t)l * 4 * 1024; const float* mcb = A->in[27] + (size_t)l * 1024;
    const float* wq = A->in[28] + (size_t)l * 256 * 16; const float* wk = A->in[29] + (size_t)l * 256 * 16; const float* wv = A->in[30] + (size_t)l * 256 * 16;
    const float* bif = A->in[31] + (size_t)l * 8; const float* gn = A->in[32] + (size_t)l * 256;
    LAS float* mx_s = lds; LAS float* mc_s = lds + 1792; LAS float* q_s = lds + 2816; LAS float* k_s = lds + 3840; LAS float* v_s = lds + 4864;
    LAS float* ig_s = lds + 5888; LAS float* lf_s = lds + 5896; LAS float* part = lds + 5904;
    const size_t bh = ((size_t)l * NS + b) * 4 + hh;
    f32x4 C[32];
    { const f32x4* cp = (const f32x4*)(A->in[7] + (bh * 256 + 32 * wave) * 256) + lane;
#pragma unroll
      for (int dd = 0; dd < 32; ++dd) C[dd] = __builtin_nontemporal_load(cp + dd * 64); }
    float nn[4]; { const f32x4 n4 = *(const f32x4*)(A->in[8] + bh * 256 + 4 * lane); nn[0] = n4.x; nn[1] = n4.y; nn[2] = n4.z; nn[3] = n4.w; }
    float m = A->in[9][bh];
    const int c0 = tid & 255, ch0 = hh * 256 + c0, wb0 = (64 * hh + (c0 >> 2)) * 16 + (c0 & 3);
    const float cw0 = mcw[ch0], cw1 = mcw[1024 + ch0], cw2 = mcw[2048 + ch0], cw3 = mcw[3072 + ch0], cbv = mcb[ch0];
    float wq4[4], wk4[4], wv4[4];
#pragma unroll
    for (int cc = 0; cc < 4; ++cc) { wq4[cc] = wq[wb0 + 4 * cc]; wk4[cc] = wk[wb0 + 4 * cc] * 0.0625f; wv4[cc] = wv[wb0 + 4 * cc]; }
    float gi = 0.f, gf = 0.f; if (tid < 4) { gi = sm[(size_t)(row0 + tid) * NSMALL + 16 + hh] + bif[hh]; gf = sm[(size_t)(row0 + tid) * NSMALL + 20 + hh] + bif[4 + hh]; }
    for (int i = tid; i < 7 * 256; i += NTHREADS) { const int tr = i >> 8, c = i & 255, tp = tr - 3, ch = hh * 256 + c;
        const float x = tp >= 0 ? bf2f(proj[(size_t)(row0 + tp) * PPITCH + C_MX + ch]) : A->in[10][(((size_t)l * NS + b) * 3 + (3 + tp)) * 1024 + ch];
        mx_s[i] = x;
        if (tp >= 1) A->out[O_S_MLC + (((size_t)l * NS + b) * 3 + (tp - 1)) * 1024 + ch] = x; }
    __syncthreads();
    for (int i = tid; i < 4 * 256; i += NTHREADS) { const int tb = i >> 8, c = i & 255;
        const float acc = cbv + cw0 * mx_s[tb * 256 + c] + cw1 * mx_s[(tb + 1) * 256 + c] + cw2 * mx_s[(tb + 2) * 256 + c] + cw3 * mx_s[(tb + 3) * 256 + c];
        mc_s[i] = acc * sigm(acc); }
    __syncthreads();
    for (int i = tid; i < 4 * 256; i += NTHREADS) { const int tb = i >> 8, c = i & 255, nq = c >> 2;
        float q = 0.f, k = 0.f, v = 0.f;
#pragma unroll
        for (int cc = 0; cc < 4; ++cc) { const float mcv = mc_s[tb * 256 + 4 * nq + cc], mxv = mx_s[(tb + 3) * 256 + 4 * nq + cc];
            q += mcv * wq4[cc]; k += mcv * wk4[cc]; v += mxv * wv4[cc]; }
        q_s[i] = q; k_s[i] = k; v_s[i] = v; }
    if (tid < 4) { ig_s[tid] = gi; lf_s[tid] = logsig(gf); }
    __syncthreads();
    for (int tb = 0; tb < 4; ++tb) {
        const float lf = lf_s[tb], ig = ig_s[tb];
        const float mnew = fmaxf(lf + m, ig), fdec = __expf(lf + m - mnew), iw = __expf(ig - mnew); m = mnew;
        const f32x4 k4n = *(const LAS f32x4*)(k_s + tb * 256 + 4 * lane), q4n = *(const LAS f32x4*)(q_s + tb * 256 + 4 * lane);
        nn[0] = fdec * nn[0] + iw * k4n.x; nn[1] = fdec * nn[1] + iw * k4n.y; nn[2] = fdec * nn[2] + iw * k4n.z; nn[3] = fdec * nn[3] + iw * k4n.w;
        const float den = wave_sum((q4n.x * nn[0] + q4n.y * nn[1]) + (q4n.z * nn[2] + q4n.w * nn[3]));
        if (tid == 0) ig_s[4 + tb] = 1.f / fmaxf(fabsf(den), __expf(-m));
        const f32x4 v4 = *(const LAS f32x4*)(v_s + tb * 256 + 4 * lane) * iw; f32x4 pn = {0.f, 0.f, 0.f, 0.f};
        const LAS float* kp = k_s + tb * 256 + 32 * wave; const LAS float* qp = q_s + tb * 256 + 32 * wave;
#pragma unroll
        for (int d4 = 0; d4 < 8; ++d4) { const f32x4 k4 = *(const LAS f32x4*)(kp + 4 * d4), q4 = *(const LAS f32x4*)(qp + 4 * d4);
            C[4 * d4 + 0] = C[4 * d4 + 0] * fdec + v4 * k4.x; pn += C[4 * d4 + 0] * q4.x;
            C[4 * d4 + 1] = C[4 * d4 + 1] * fdec + v4 * k4.y; pn += C[4 * d4 + 1] * q4.y;
            C[4 * d4 + 2] = C[4 * d4 + 2] * fdec + v4 * k4.z; pn += C[4 * d4 + 2] * q4.z;
            C[4 * d4 + 3] = C[4 * d4 + 3] * fdec + v4 * k4.w; pn += C[4 * d4 + 3] * q4.w; }
        *(LAS f32x4*)(part + (tb * 8 + wave) * 256 + 4 * lane) = pn;
    }
    { f32x4* cp = (f32x4*)(A->out + O_S_C + (bh * 256 + 32 * wave) * 256) + lane;
#pragma unroll
      for (int dd = 0; dd < 32; ++dd) __builtin_nontemporal_store(C[dd], cp + dd * 64);
      if (wave == 0) { f32x4 n4; n4.x = nn[0]; n4.y = nn[1]; n4.z = nn[2]; n4.w = nn[3]; *(f32x4*)(A->out + O_S_N + bh * 256 + 4 * lane) = n4; }
      if (tid == 0) A->out[O_S_M + bh] = m; }
    __syncthreads();
    if (wave < 4) { const int tb = wave; const size_t row = (size_t)(row0 + tb);
        f32x4 hv = {0.f, 0.f, 0.f, 0.f};
#pragma unroll
        for (int w8 = 0; w8 < 8; ++w8) hv += *(const LAS f32x4*)(part + (tb * 8 + w8) * 256 + 4 * lane);
        const float rd = ig_s[4 + tb];
        hv = hv * rd;
        float ss = (hv.x * hv.x + hv.y * hv.y) + (hv.z * hv.z + hv.w * hv.w); ss = wave_sum(ss);
        const float rs = __builtin_amdgcn_rsqf(ss * (1.f / 256.f) + EPS);
        const f32x4 g4 = *(const f32x4*)(gn + 4 * lane);
        const v2u ow = *(const v2u*)(proj + row * PPITCH + C_MO + hh * 256 + 4 * lane);
        const float z0 = __uint_as_float(ow.x << 16), z1 = __uint_as_float(ow.x & 0xffff0000u), z2 = __uint_as_float(ow.y << 16), z3 = __uint_as_float(ow.y & 0xffff0000u);
                *(unsigned*)(ycat8 + row * KBR + 2048 + hh * 256 + 4 * lane) = pg8::pk4_fp8(sigm(z0) * (hv.x * rs * g4.x), sigm(z1) * (hv.y * rs * g4.y), sigm(z2) * (hv.z * rs * g4.z), sigm(z3) * (hv.w * rs * g4.w)); }
    __syncthreads();
}

typedef short bf16x8 __attribute__((ext_vector_type(8)));
typedef float f32x16 __attribute__((ext_vector_type(16)));
#define GL_DSR128(dst, addr, off) asm volatile("ds_read_b128 %0, %1 offset:" #off : "=v"(dst) : "v"(addr))
#define GL_DSR2X64(dst, addr, o0, o1) asm volatile("ds_read2_b64 %0, %1 offset0:" #o0 " offset1:" #o1 : "=v"(dst) : "v"(addr))
#define GL_LWAIT(n, x) asm volatile("s_waitcnt lgkmcnt(" #n ")" : "+v"(x))
#define WG_RAW_BARRIER() asm volatile("s_waitcnt lgkmcnt(0)\n\ts_barrier" ::: "memory")
#define MFMA32(a, b, c) __builtin_amdgcn_mfma_f32_32x32x16_bf16((a), (b), (c), 0, 0, 0)
DI bf16x8 frag16(const LAS unsigned char* p) { return *(const LAS bf16x8*)p; }
DI bf16x8 frag8x2(const LAS unsigned char* p) { const v2u lo = *(const LAS v2u*)p, hi = *(const LAS v2u*)(p + 16);
    const v4u w = {lo.x, lo.y, hi.x, hi.y}; return __builtin_bit_cast(bf16x8, w); }
DI bf16x8 pack_acc(const f32x16& x, int s) {
    const v4u w = {pkbf(x[8 * s + 0], x[8 * s + 1]), pkbf(x[8 * s + 2], x[8 * s + 3]), pkbf(x[8 * s + 4], x[8 * s + 5]), pkbf(x[8 * s + 6], x[8 * s + 7])};
    return __builtin_bit_cast(bf16x8, w); }
DI unsigned short lds_u16(const LAS unsigned char* p) { return *(const LAS unsigned short*)p; }

constexpr int GL_QE = 0, GL_KE = 17408, GL_KDT = 34816, GL_V = 53248, GL_A = 87040, GL_SM = 96256, GL_SEG = 100352, GL_DEC = 102400, GL_OS = 0;
constexpr int GL_PQ = 272, GL_PT = 144, GL_PV = 528, GL_PO = 1040;
constexpr int GIMG_BYTES = 46080, GI_Q = 0, GI_K = 17408, GI_A = 35840, GI_D = 45056, GI_PIECES = 2848;
DI int gimg_lds_off(int idx) {
    return idx < 1088 ? GL_QE + idx * 16 : idx < 2240 ? GL_KDT + (idx - 1088) * 16 : idx < 2816 ? GL_A + (idx - 2240) * 16 : GL_DEC + (idx - 2816) * 16;
}
DI void gla_prep_unit(int l, int s, int hh, int c, LAS unsigned char* lds, int tid) {
    CArgs* A = kargs();
    const bf16* proj = (const bf16*)(A->ws + WS_PROJ); const float* sm = (const float*)(A->ws + WS_SMALL);
    const float* wg2 = A->in[23] + (size_t)l * 16 * 512; const float* bg = A->in[24] + (size_t)l * 512;
    const int lane = tid & 63, w = __builtin_amdgcn_readfirstlane(tid >> 6), r = lane & 31, h = lane >> 5;
    const int d_ = tid & 127, seg = __builtin_amdgcn_readfirstlane(tid >> 7);
    float wg[16];
#pragma unroll
    for (int q = 0; q < 16; ++q) wg[q] = wg2[q * 512 + hh * 128 + d_];
    const float bgv = bg[hh * 128 + d_];
    const int r0 = s * TP + 64 * c;
#pragma unroll
    for (int i = 0; i < 2; ++i) { const int idx = tid + 512 * i, row = idx >> 4, ch = idx & 15; const bf16* rp = proj + (size_t)(r0 + row) * PPITCH + hh * 128 + 8 * ch;
        *(LAS v4u*)(lds + GL_QE + row * GL_PQ + ch * 16) = *(const v4u*)(rp + C_GQ); *(LAS v4u*)(lds + GL_KE + row * GL_PQ + ch * 16) = *(const v4u*)(rp + C_GK); }
    if (tid < 256) { const int row = tid >> 2, qd = tid & 3; *(LAS f32x4*)(lds + GL_SM + row * 64 + qd * 16) = *(const f32x4*)(sm + (size_t)(r0 + row) * NSMALL + 4 * qd); }
    __syncthreads();
    float b[16]; float run = 0.f;
#pragma unroll
    for (int t = 0; t < 16; ++t) { const LAS f32x4* sp = (const LAS f32x4*)(lds + GL_SM + (16 * seg + t) * 64);
        const f32x4 s0 = sp[0], s1 = sp[1], s2 = sp[2], s3 = sp[3];
        float z = bgv;
        z += s0.x * wg[0] + s0.y * wg[1] + s0.z * wg[2] + s0.w * wg[3]; z += s1.x * wg[4] + s1.y * wg[5] + s1.z * wg[6] + s1.w * wg[7];
        z += s2.x * wg[8] + s2.y * wg[9] + s2.z * wg[10] + s2.w * wg[11]; z += s3.x * wg[12] + s3.y * wg[13] + s3.z * wg[14] + s3.w * wg[15];
        run += logsig(z) * (1.f / 16.f); b[t] = run; }
    *(LAS float*)(lds + GL_SEG + (seg * 128 + d_) * 4) = run;
    __syncthreads();
    { float pre = 0.f, tot = 0.f;
#pragma unroll
      for (int s2 = 0; s2 < 4; ++s2) { const float x = *(const LAS float*)(lds + GL_SEG + (s2 * 128 + d_) * 4); tot += x; pre += (s2 < seg) ? x : 0.f; }
      float kd[16];
#pragma unroll
      for (int t = 0; t < 16; ++t) { const int j = 16 * seg + t; const float bb = b[t] + pre;
          const float qraw = bf2f(*(const LAS unsigned short*)(lds + GL_QE + j * GL_PQ + d_ * 2)), kraw = bf2f(*(const LAS unsigned short*)(lds + GL_KE + j * GL_PQ + d_ * 2));
          const float qe = qraw * 0.08838834764831845f * __expf(bb), ke = kraw * __expf(-bb); kd[t] = kraw * __expf(tot - bb);
          *(LAS unsigned short*)(lds + GL_QE + j * GL_PQ + d_ * 2) = (unsigned short)(pkbf(qe, 0.f) & 0xffffu);
          *(LAS unsigned short*)(lds + GL_KE + j * GL_PQ + d_ * 2) = (unsigned short)(pkbf(ke, 0.f) & 0xffffu); }
      v4u k0, k1; k0.x = pkbf(kd[0], kd[1]); k0.y = pkbf(kd[2], kd[3]); k0.z = pkbf(kd[4], kd[5]); k0.w = pkbf(kd[6], kd[7]);
      k1.x = pkbf(kd[8], kd[9]); k1.y = pkbf(kd[10], kd[11]); k1.z = pkbf(kd[12], kd[13]); k1.w = pkbf(kd[14], kd[15]);
      *(LAS v4u*)(lds + GL_KDT + d_ * GL_PT + seg * 32) = k0; *(LAS v4u*)(lds + GL_KDT + d_ * GL_PT + seg * 32 + 16) = k1;
      if (seg == 0) *(LAS float*)(lds + GL_DEC + d_ * 4) = __expf(tot); }
    __syncthreads();
    if (w < 3) { const int it = (w >= 1) ? 1 : 0, jt = (w == 2) ? 1 : 0; f32x16 a;
#pragma unroll
        for (int i = 0; i < 16; ++i) a[i] = 0.f;
#pragma unroll
        for (int s8 = 0; s8 < 8; ++s8) a = MFMA32(frag16(lds + GL_QE + (32 * it + r) * GL_PQ + (16 * s8 + 8 * h) * 2), frag16(lds + GL_KE + (32 * jt + r) * GL_PQ + (16 * s8 + 8 * h) * 2), a);
#pragma unroll
        for (int reg = 0; reg < 16; ++reg) { const int i = 32 * it + (reg & 3) + 8 * (reg >> 2) + 4 * h, j = 32 * jt + r;
            *(LAS unsigned short*)(lds + GL_A + i * GL_PT + j * 2) = (unsigned short)(pkbf(j <= i ? a[reg] : 0.f, 0.f) & 0xffffu); } }
    __syncthreads();
    { unsigned char* img = A->ws + WS_GIMG + (size_t)((s * 4 + hh) * (TP / 64) + c) * GIMG_BYTES;
      for (int idx = tid; idx < GI_PIECES; idx += NTHREADS) *(v4u*)(img + idx * 16) = *(const LAS v4u*)(lds + gimg_lds_off(idx)); }
    __syncthreads();
}

DI void gla_seq_unit(int l, int s, int hh, LAS unsigned char* lds, int tid) {
    CArgs* A = kargs();
    const bf16* proj = (const bf16*)(A->ws + WS_PROJ); bf16* ycat = (bf16*)(A->ws + WS_YCAT); unsigned char* ycat8 = A->ws + WS_YCAT; (void)ycat; (void)ycat8;
    const float* gn = A->in[25] + (size_t)l * 256;
    const unsigned char* img0 = A->ws + WS_GIMG + (size_t)((s * 4 + hh) * (TP / 64)) * GIMG_BYTES;
    const int w = __builtin_amdgcn_readfirstlane(tid >> 6);
    f32x16 St[4];
#pragma unroll
    for (int dt = 0; dt < 4; ++dt)
#pragma unroll
        for (int i = 0; i < 16; ++i) St[dt][i] = 0.f;
    v4u pi[6], pv[4];
#define GLA_PREFETCH(cn) do { int tp_ = tid; asm volatile("" : "+v"(tp_)); const unsigned char* ib_ = img0 + (size_t)(cn) * GIMG_BYTES; \
        _Pragma("unroll") for (int i_ = 0; i_ < 6; ++i_) { const int idx_ = tp_ + 512 * i_; pi[i_] = (v4u){0u, 0u, 0u, 0u}; if (idx_ < GI_PIECES) pi[i_] = *(const v4u*)(ib_ + (unsigned)idx_ * 16u); } \
        const bf16* vb_ = proj + (size_t)(s * TP + 64 * (cn)) * PPITCH + C_GV + hh * 256; \
        _Pragma("unroll") for (int i_ = 0; i_ < 4; ++i_) { const int idx_ = tp_ + 512 * i_; pv[i_] = *(const v4u*)(vb_ + (unsigned)((idx_ >> 5) * PPITCH + 8 * (idx_ & 31))); } } while (0)
    GLA_PREFETCH(0);
    for (int c = 0; c < TP / 64; ++c) {
        const int r0 = s * TP + 64 * c;
        { int tz_ = tid; asm volatile("" : "+v"(tz_));
#pragma unroll
          for (int i = 0; i < 6; ++i) { const int idx = tz_ + 512 * i; if (idx < GI_PIECES) *(LAS v4u*)(lds + gimg_lds_off(idx)) = pi[i]; }
#pragma unroll
          for (int i = 0; i < 4; ++i) { const int idx = tz_ + 512 * i; *(LAS v4u*)(lds + GL_V + (idx >> 5) * GL_PV + (idx & 31) * 16) = pv[i]; } }
        WG_RAW_BARRIER();
        if (c + 1 < TP / 64) GLA_PREFETCH(c + 1);
        v2u gwv[8];
#pragma unroll
        for (int q = 0; q < 8; ++q) gwv[q] = *(const v2u*)(proj + (size_t)(r0 + 8 * w + q) * PPITCH + C_GGATE + hh * 256 + 4 * (tid & 63));
        f32x16 o0, o1;
        { int tz_ = tid; asm volatile("" : "+v"(tz_)); const int lane = tz_ & 63, r = lane & 31, h = lane >> 5;
#pragma unroll
        for (int i = 0; i < 16; ++i) { o0[i] = 0.f; o1[i] = 0.f; }
        { const unsigned qa = (unsigned)(__UINTPTR_TYPE__)(lds + GL_QE + r * GL_PQ + 8 * h), qb = qa + 32 * GL_PQ;
          v4u f0, f1, f2, f3;
          GL_DSR2X64(f0, qa, 0, 2);
          GL_DSR2X64(f1, qb, 0, 2);
          GL_DSR2X64(f2, qa, 4, 6);
          GL_DSR2X64(f3, qb, 4, 6);
          { const bf16x8 bfrag = pack_acc(St[0], 0);
            GL_LWAIT(3, f0); o0 = MFMA32(__builtin_bit_cast(bf16x8, f0), bfrag, o0); GL_DSR2X64(f0, qa, 8, 10);
            GL_LWAIT(3, f1); o1 = MFMA32(__builtin_bit_cast(bf16x8, f1), bfrag, o1); GL_DSR2X64(f1, qb, 8, 10);
          }
          { const bf16x8 bfrag = pack_acc(St[0], 1);
            GL_LWAIT(3, f2); o0 = MFMA32(__builtin_bit_cast(bf16x8, f2), bfrag, o0); GL_DSR2X64(f2, qa, 12, 14);
            GL_LWAIT(3, f3); o1 = MFMA32(__builtin_bit_cast(bf16x8, f3), bfrag, o1); GL_DSR2X64(f3, qb, 12, 14);
          }
          { const bf16x8 bfrag = pack_acc(St[1], 0);
            GL_LWAIT(3, f0); o0 = MFMA32(__builtin_bit_cast(bf16x8, f0), bfrag, o0); GL_DSR2X64(f0, qa, 16, 18);
            GL_LWAIT(3, f1); o1 = MFMA32(__builtin_bit_cast(bf16x8, f1), bfrag, o1); GL_DSR2X64(f1, qb, 16, 18);
          }
          { const bf16x8 bfrag = pack_acc(St[1], 1);
            GL_LWAIT(3, f2); o0 = MFMA32(__builtin_bit_cast(bf16x8, f2), bfrag, o0); GL_DSR2X64(f2, qa, 20, 22);
            GL_LWAIT(3, f3); o1 = MFMA32(__builtin_bit_cast(bf16x8, f3), bfrag, o1); GL_DSR2X64(f3, qb, 20, 22);
          }
          { const bf16x8 bfrag = pack_acc(St[2], 0);
            GL_LWAIT(3, f0); o0 = MFMA32(__builtin_bit_cast(bf16x8, f0), bfrag, o0); GL_DSR2X64(f0, qa, 24, 26);
            GL_LWAIT(3, f1); o1 = MFMA32(__builtin_bit_cast(bf16x8, f1), bfrag, o1); GL_DSR2X64(f1, qb, 24, 26);
          }
          { const bf16x8 bfrag = pack_acc(St[2], 1);
            GL_LWAIT(3, f2); o0 = MFMA32(__builtin_bit_cast(bf16x8, f2), bfrag, o0); GL_DSR2X64(f2, qa, 28, 30);
            GL_LWAIT(3, f3); o1 = MFMA32(__builtin_bit_cast(bf16x8, f3), bfrag, o1); GL_DSR2X64(f3, qb, 28, 30);
          }
          { const bf16x8 bfrag = pack_acc(St[3], 0);
            GL_LWAIT(3, f0); o0 = MFMA32(__builtin_bit_cast(bf16x8, f0), bfrag, o0);
            GL_LWAIT(2, f1); o1 = MFMA32(__builtin_bit_cast(bf16x8, f1), bfrag, o1);
          }
          { const bf16x8 bfrag = pack_acc(St[3], 1);
            GL_LWAIT(1, f2); o0 = MFMA32(__builtin_bit_cast(bf16x8, f2), bfrag, o0);
            GL_LWAIT(0, f3); o1 = MFMA32(__builtin_bit_cast(bf16x8, f3), bfrag, o1);
          }
        }
        { const unsigned aa = (unsigned)(__UINTPTR_TYPE__)(lds + GL_A + r * GL_PT + 16 * h), ka = (unsigned)(__UINTPTR_TYPE__)(lds + GL_KDT + r * GL_PT + 16 * h);
          v4u f0, f1, f2, f3;
          GL_DSR128(f0, aa, 0);
          GL_DSR128(f1, aa, 4608);
          GL_DSR128(f2, ka, 0);
          GL_DSR128(f3, ka, 4608);
#pragma unroll
          for (int dt = 0; dt < 4; ++dt)
#pragma unroll
              for (int g = 0; g < 4; ++g) { const f32x4 dc = *(const LAS f32x4*)(lds + GL_DEC + (32 * dt + 8 * g + 4 * h) * 4);
                  St[dt][4 * g + 0] *= dc.x; St[dt][4 * g + 1] *= dc.y; St[dt][4 * g + 2] *= dc.z; St[dt][4 * g + 3] *= dc.w; }
          { v4u x; const LAS unsigned char* vp = lds + GL_V + (0 + 8 * h) * GL_PV + (32 * w + r) * 2;
            x.x = (unsigned)lds_u16(vp) | ((unsigned)lds_u16(vp + GL_PV) << 16); x.y = (unsigned)lds_u16(vp + 2 * GL_PV) | ((unsigned)lds_u16(vp + 3 * GL_PV) << 16);
            x.z = (unsigned)lds_u16(vp + 4 * GL_PV) | ((unsigned)lds_u16(vp + 5 * GL_PV) << 16); x.w = (unsigned)lds_u16(vp + 6 * GL_PV) | ((unsigned)lds_u16(vp + 7 * GL_PV) << 16);
            const bf16x8 vf = __builtin_bit_cast(bf16x8, x);
            GL_LWAIT(3, f0); o0 = MFMA32(__builtin_bit_cast(bf16x8, f0), vf, o0); GL_DSR128(f0, ka, 9216);
            GL_LWAIT(3, f1); o1 = MFMA32(__builtin_bit_cast(bf16x8, f1), vf, o1); GL_DSR128(f1, ka, 13824);
            GL_LWAIT(3, f2); St[0] = MFMA32(__builtin_bit_cast(bf16x8, f2), vf, St[0]); GL_DSR128(f2, aa, 32);
            GL_LWAIT(3, f3); St[1] = MFMA32(__builtin_bit_cast(bf16x8, f3), vf, St[1]); GL_DSR128(f3, aa, 4640);
            GL_LWAIT(3, f0); St[2] = MFMA32(__builtin_bit_cast(bf16x8, f0), vf, St[2]); GL_DSR128(f0, ka, 32);
            GL_LWAIT(3, f1); St[3] = MFMA32(__builtin_bit_cast(bf16x8, f1), vf, St[3]); GL_DSR128(f1, ka, 4640);
          }
          { v4u x; const LAS unsigned char* vp = lds + GL_V + (16 + 8 * h) * GL_PV + (32 * w + r) * 2;
            x.x = (unsigned)lds_u16(vp) | ((unsigned)lds_u16(vp + GL_PV) << 16); x.y = (unsigned)lds_u16(vp + 2 * GL_PV) | ((unsigned)lds_u16(vp + 3 * GL_PV) << 16);
            x.z = (unsigned)lds_u16(vp + 4 * GL_PV) | ((unsigned)lds_u16(vp + 5 * GL_PV) << 16); x.w = (unsigned)lds_u16(vp + 6 * GL_PV) | ((unsigned)lds_u16(vp + 7 * GL_PV) << 16);
            const bf16x8 vf = __builtin_bit_cast(bf16x8, x);
            GL_LWAIT(3, f2); o0 = MFMA32(__builtin_bit_cast(bf16x8, f2), vf, o0); GL_DSR128(f2, ka, 9248);
            GL_LWAIT(3, f3); o1 = MFMA32(__builtin_bit_cast(bf16x8, f3), vf, o1); GL_DSR128(f3, ka, 13856);
            GL_LWAIT(3, f0); St[0] = MFMA32(__builtin_bit_cast(bf16x8, f0), vf, St[0]); GL_DSR128(f0, aa, 4672);
            GL_LWAIT(3, f1); St[1] = MFMA32(__builtin_bit_cast(bf16x8, f1), vf, St[1]); GL_DSR128(f1, ka, 64);
            GL_LWAIT(3, f2); St[2] = MFMA32(__builtin_bit_cast(bf16x8, f2), vf, St[2]); GL_DSR128(f2, ka, 4672);
            GL_LWAIT(3, f3); St[3] = MFMA32(__builtin_bit_cast(bf16x8, f3), vf, St[3]); GL_DSR128(f3, ka, 9280);
          }
          { v4u x; const LAS unsigned char* vp = lds + GL_V + (32 + 8 * h) * GL_PV + (32 * w + r) * 2;
            x.x = (unsigned)lds_u16(vp) | ((unsigned)lds_u16(vp + GL_PV) << 16); x.y = (unsigned)lds_u16(vp + 2 * GL_PV) | ((unsigned)lds_u16(vp + 3 * GL_PV) << 16);
            x.z = (unsigned)lds_u16(vp + 4 * GL_PV) | ((unsigned)lds_u16(vp + 5 * GL_PV) << 16); x.w = (unsigned)lds_u16(vp + 6 * GL_PV) | ((unsigned)lds_u16(vp + 7 * GL_PV) << 16);
            const bf16x8 vf = __builtin_bit_cast(bf16x8, x);
            GL_LWAIT(3, f0); o1 = MFMA32(__builtin_bit_cast(bf16x8, f0), vf, o1); GL_DSR128(f0, ka, 13888);
            GL_LWAIT(3, f1); St[0] = MFMA32(__builtin_bit_cast(bf16x8, f1), vf, St[0]); GL_DSR128(f1, aa, 4704);
            GL_LWAIT(3, f2); St[1] = MFMA32(__builtin_bit_cast(bf16x8, f2), vf, St[1]); GL_DSR128(f2, ka, 96);
            GL_LWAIT(3, f3); St[2] = MFMA32(__builtin_bit_cast(bf16x8, f3), vf, St[2]); GL_DSR128(f3, ka, 4704);
            GL_LWAIT(3, f0); St[3] = MFMA32(__builtin_bit_cast(bf16x8, f0), vf, St[3]); GL_DSR128(f0, ka, 9312);
          }
          { v4u x; const LAS unsigned char* vp = lds + GL_V + (48 + 8 * h) * GL_PV + (32 * w + r) * 2;
            x.x = (unsigned)lds_u16(vp) | ((unsigned)lds_u16(vp + GL_PV) << 16); x.y = (unsigned)lds_u16(vp + 2 * GL_PV) | ((unsigned)lds_u16(vp + 3 * GL_PV) << 16);
            x.z = (unsigned)lds_u16(vp + 4 * GL_PV) | ((unsigned)lds_u16(vp + 5 * GL_PV) << 16); x.w = (unsigned)lds_u16(vp + 6 * GL_PV) | ((unsigned)lds_u16(vp + 7 * GL_PV) << 16);
            const bf16x8 vf = __builtin_bit_cast(bf16x8, x);
            GL_LWAIT(3, f1); o1 = MFMA32(__builtin_bit_cast(bf16x8, f1), vf, o1); GL_DSR128(f1, ka, 13920);
            GL_LWAIT(3, f2); St[0] = MFMA32(__builtin_bit_cast(bf16x8, f2), vf, St[0]);
            GL_LWAIT(2, f3); St[1] = MFMA32(__builtin_bit_cast(bf16x8, f3), vf, St[1]);
            GL_LWAIT(1, f0); St[2] = MFMA32(__builtin_bit_cast(bf16x8, f0), vf, St[2]);
            GL_LWAIT(0, f1); St[3] = MFMA32(__builtin_bit_cast(bf16x8, f1), vf, St[3]);
          }
          asm volatile("" ::: "memory"); }
        }
        WG_RAW_BARRIER();
        { int tz_ = tid; asm volatile("" : "+v"(tz_)); const int lane = tz_ & 63, r = lane & 31, h = lane >> 5;
#pragma unroll
        for (int reg = 0; reg < 16; ++reg) { const int i = (reg & 3) + 8 * (reg >> 2) + 4 * h;
            *(LAS float*)(lds + GL_OS + i * GL_PO + (32 * w + r) * 4) = o0[reg]; *(LAS float*)(lds + GL_OS + (32 + i) * GL_PO + (32 * w + r) * 4) = o1[reg]; } }
        WG_RAW_BARRIER();
        { int tz_ = tid; asm volatile("" : "+v"(tz_)); const int lane = tz_ & 63;
        const f32x4 gn4 = *(const f32x4*)(gn + 4 * lane);
#pragma unroll
        for (int q = 0; q < 8; ++q) { const int i = 8 * w + q; const size_t row = (size_t)(r0 + i);
            const f32x4 ov = *(const LAS f32x4*)(lds + GL_OS + i * GL_PO + lane * 16);
            float ss = (ov.x * ov.x + ov.y * ov.y) + (ov.z * ov.z + ov.w * ov.w); ss = wave_sum(ss);
            const float rs = __builtin_amdgcn_rsqf(ss * (1.f / 256.f) + EPS);
            const v2u gw = gwv[q];
            const float z0 = __uint_as_float(gw.x << 16), z1 = __uint_as_float(gw.x & 0xffff0000u), z2 = __uint_as_float(gw.y << 16), z3 = __uint_as_float(gw.y & 0xffff0000u);
                        *(unsigned*)(ycat8 + row * KBR + 1024 + hh * 256 + 4 * lane) = pg8::pk4_fp8(ov.x * rs * gn4.x * (z0 * sigm(z0)), ov.y * rs * gn4.y * (z1 * sigm(z1)), ov.z * rs * gn4.z * (z2 * sigm(z2)), ov.w * rs * gn4.w * (z3 * sigm(z3))); } }
        WG_RAW_BARRIER();
    }
    { int tz_ = tid; asm volatile("" : "+v"(tz_)); const int lane = tz_ & 63, r = lane & 31, h = lane >> 5;
      float* op = A->out + O_P_GLA + (((size_t)l * NP + s) * 4 + hh) * 128 * 256 + 32 * w + r;
#pragma unroll
      for (int dt = 0; dt < 4; ++dt)
#pragma unroll
          for (int reg = 0; reg < 16; ++reg) op[(size_t)(32 * dt + (reg & 3) + 8 * (reg >> 2) + 4 * h) * 256] = St[dt][reg]; }
    __syncthreads();
}

constexpr int ML_Q = 0, ML_K = 33792, ML_KWT = 67584, ML_V = 104448, ML_S = 138240, ML_SC = 147456, ML_HS = 0;
constexpr int ML_PQ = 528, ML_PT = 144, ML_PH = 1040;
constexpr int IS_F = 0, IS_PM = 64, IS_RSP = 128, IS_NP = 192, IS_FL = 448, IS_CMAX = 449;
constexpr int SC_COLF = 512, SC_RDEN = 512, SC_QN = 576, SC_N = 1088, SC_CW = 576, SC_RAT = 1344;
static_assert(ML_SC + (576 + 1280) * 4 <= LDSCTL_OFF && 67 * 512 <= ML_V - ML_KWT, "mLSTM LDS map");
constexpr int MIMG_BYTES = 115712, MI_PIECES = 7232;
DI int mimg_lds_off(int idx) { return idx < 2112 ? ML_Q + idx * 16 : idx < 4416 ? ML_KWT + (idx - 2112) * 16 : idx < 6528 ? ML_V + (idx - 4416) * 16 : idx < 7104 ? ML_S + (idx - 6528) * 16 : ML_SC + (idx - 7104) * 16; }
DI float quad_bcast(float v, int cc) {
    const int x = __float_as_int(v); int y;
    switch (cc) { case 0: y = __builtin_amdgcn_mov_dpp(x, 0x00, 0xf, 0xf, true); break; case 1: y = __builtin_amdgcn_mov_dpp(x, 0x55, 0xf, 0xf, true); break;
                  case 2: y = __builtin_amdgcn_mov_dpp(x, 0xaa, 0xf, 0xf, true); break; default: y = __builtin_amdgcn_mov_dpp(x, 0xff, 0xf, 0xf, true); break; }
    return __int_as_float(y);
}
DI void ml_prep_unit(int l, int s, int hh, int c, LAS unsigned char* lds, int tid) {
    CArgs* A = kargs();
    const bf16* proj = (const bf16*)(A->ws + WS_PROJ); const float* sm = (const float*)(A->ws + WS_SMALL);
    const float* mcw = A->in[26] + (size_t)l * 4 * 1024; const float* mcb = A->in[27] + (size_t)l * 1024; const float* bif = A->in[31] + (size_t)l * 8;
    const int lane = tid & 63, w = __builtin_amdgcn_readfirstlane(tid >> 6), r = lane & 31, h = lane >> 5;
    const int c_ = tid & 255, seg = __builtin_amdgcn_readfirstlane(tid >> 8);
    LAS float* sc = (LAS float*)(lds + ML_SC);
    const int r0 = s * TP + 64 * c;
    { const bf16* pb = proj + ((ptrdiff_t)r0 - 3) * (ptrdiff_t)PPITCH + C_MX + hh * 256;
#pragma unroll
      for (int i = 0; i < 5; ++i) { const int idx = tid + 512 * i, row = idx >> 5; v4u x = {0u, 0u, 0u, 0u};
          if (idx < 2144) { if (64 * c - 3 + row >= 0) x = *(const v4u*)(pb + (unsigned)(row * PPITCH + 8 * (idx & 31))); *(LAS v4u*)(lds + ML_KWT + row * 512 + (idx & 31) * 16) = x; } }
      if (tid < 256) { const int ch0 = hh * 256 + tid;
          sc[SC_CW + tid] = mcw[ch0]; sc[SC_CW + 256 + tid] = mcw[1024 + ch0]; sc[SC_CW + 512 + tid] = mcw[2048 + ch0]; sc[SC_CW + 768 + tid] = mcw[3072 + ch0]; sc[SC_CW + 1024 + tid] = mcb[ch0]; }
      if (w == 0) {
          const float ig = sm[(size_t)(r0 + lane) * NSMALL + 16 + hh] + bif[hh];
          const float lf = logsig(sm[(size_t)(r0 + lane) * NSMALL + 20 + hh] + bif[4 + hh]);
          float F = lf;
#pragma unroll
          for (int o = 1; o < 64; o <<= 1) { const float t = __shfl_up(F, o); F += (lane >= o) ? t : 0.f; }
          const float colf = ig - F; float pm = colf;
#pragma unroll
          for (int o = 1; o < 64; o <<= 1) { const float t = __shfl_up(pm, o); pm = (lane >= o) ? fmaxf(pm, t) : pm; }
          sc[IS_F + lane] = F; sc[IS_PM + lane] = pm; sc[SC_COLF + lane] = colf;
          if (lane == 63) { sc[IS_FL] = F; sc[IS_CMAX] = pm; } } }
    float wq4[4], wk4[4], wv4[4];
    { const int wb = (64 * hh + (c_ >> 2)) * 16 + (c_ & 3);
#pragma unroll
      for (int cc = 0; cc < 4; ++cc) { wq4[cc] = A->in[28][(size_t)l * 4096 + wb + 4 * cc]; wk4[cc] = A->in[29][(size_t)l * 4096 + wb + 4 * cc] * 0.0625f; wv4[cc] = A->in[30][(size_t)l * 4096 + wb + 4 * cc]; } }
    __syncthreads();
    { const float cw0 = sc[SC_CW + c_], cw1 = sc[SC_CW + 256 + c_], cw2 = sc[SC_CW + 512 + c_], cw3 = sc[SC_CW + 768 + c_], cbv = sc[SC_CW + 1024 + c_];
      const LAS unsigned char* xp = lds + ML_KWT + (32 * seg) * 512 + c_ * 2;
      float x0 = bf2f(lds_u16(xp)), x1 = bf2f(lds_u16(xp + 512)), x2 = bf2f(lds_u16(xp + 1024));
#pragma unroll 8
      for (int t = 0; t < 32; ++t) {
          const float x3 = bf2f(lds_u16(xp + (3 + t) * 512));
          const float pre = cbv + cw0 * x0 + cw1 * x1 + cw2 * x2 + cw3 * x3, mc = pre * sigm(pre);
          float q = 0.f, k = 0.f, v = 0.f;
#pragma unroll
          for (int cc = 0; cc < 4; ++cc) { const float mcv = quad_bcast(mc, cc), xv = quad_bcast(x3, cc); q += mcv * wq4[cc]; k += mcv * wk4[cc]; v += xv * wv4[cc]; }
          const int j = 32 * seg + t;
          *(LAS unsigned short*)(lds + ML_Q + j * ML_PQ + c_ * 2) = (unsigned short)(pkbf(q, 0.f) & 0xffffu);
          *(LAS unsigned short*)(lds + ML_K + j * ML_PQ + c_ * 2) = (unsigned short)(pkbf(k, 0.f) & 0xffffu);
          *(LAS unsigned short*)(lds + ML_V + j * ML_PQ + c_ * 2) = (unsigned short)(pkbf(v, 0.f) & 0xffffu);
          if (c == TP / 64 - 1 && seg == 1 && t >= 29) A->out[O_P_MLC + (((size_t)l * NP + s) * 3 + (t - 29)) * 1024 + hh * 256 + c_] = x3;
          x0 = x1; x1 = x2; x2 = x3;
      } }
    __syncthreads();
    { const float cmax = sc[IS_CMAX]; float np = 0.f; v4u kk[4];
#pragma unroll
      for (int t8 = 0; t8 < 4; ++t8) { float kw[8];
#pragma unroll
          for (int t = 0; t < 8; ++t) { const int j = 32 * seg + 8 * t8 + t; kw[t] = bf2f(lds_u16(lds + ML_K + j * ML_PQ + c_ * 2)) * __expf(sc[SC_COLF + j] - cmax); np += kw[t]; }
          kk[t8].x = pkbf(kw[0], kw[1]); kk[t8].y = pkbf(kw[2], kw[3]); kk[t8].z = pkbf(kw[4], kw[5]); kk[t8].w = pkbf(kw[6], kw[7]); }
#pragma unroll
      for (int t8 = 0; t8 < 4; ++t8) *(LAS v4u*)(lds + ML_KWT + c_ * ML_PT + seg * 64 + t8 * 16) = kk[t8];
      sc[SC_QN + seg * 256 + c_] = np; }
    if (w < 3) { const int it = (w >= 1) ? 1 : 0, jt = (w == 2) ? 1 : 0; f32x16 a;
#pragma unroll
        for (int i = 0; i < 16; ++i) a[i] = 0.f;
#pragma unroll
        for (int s16 = 0; s16 < 16; ++s16) { a = MFMA32(frag16(lds + ML_Q + (32 * it + r) * ML_PQ + (16 * s16 + 8 * h) * 2), frag16(lds + ML_K + (32 * jt + r) * ML_PQ + (16 * s16 + 8 * h) * 2), a);
            if ((s16 & 3) == 3) asm volatile("" ::: "memory"); }
        const int j = 32 * jt + r; const float cf = sc[SC_COLF + j];
#pragma unroll
        for (int g = 0; g < 4; ++g) { const f32x4 pmv = *(const LAS f32x4*)(sc + IS_PM + 32 * it + 8 * g + 4 * h);
#pragma unroll
            for (int q = 0; q < 4; ++q) { const int i = 32 * it + 8 * g + 4 * h + q; const float val = (j <= i) ? a[4 * g + q] * __expf(cf - pmv[q]) : 0.f;
                *(LAS unsigned short*)(lds + ML_S + i * ML_PT + j * 2) = (unsigned short)(pkbf(val, 0.f) & 0xffffu); } } }
    __syncthreads();
    if (w == 0) { const int i = lane; float rs_ = 0.f;
#pragma unroll
        for (int k8 = 0; k8 < 8; ++k8) { const v4u sw = *(const LAS v4u*)(lds + ML_S + i * ML_PT + k8 * 16);
            const float t8 = (bflo_(sw.x) + bfhi_(sw.x)) + (bflo_(sw.y) + bfhi_(sw.y)) + (bflo_(sw.z) + bfhi_(sw.z)) + (bflo_(sw.w) + bfhi_(sw.w));
            rs_ += (k8 < 4 || i >= 32) ? t8 : 0.f; }
        sc[IS_RSP + i] = rs_; }
    if (tid < 256) sc[IS_NP + tid] = sc[SC_QN + tid] + sc[SC_QN + 256 + tid];
    __syncthreads();
    { unsigned char* img = A->ws + WS_MIMG + (size_t)((s * 4 + hh) * (TP / 64) + c) * MIMG_BYTES;
      for (int idx = tid; idx < MI_PIECES; idx += NTHREADS) *(v4u*)(img + (size_t)idx * 16) = *(const LAS v4u*)(lds + mimg_lds_off(idx)); }
    __syncthreads();
}

DI void ml_img_dma(const unsigned char* img, LAS unsigned char* lds, int ih, int w, int lane) {
    for (int k = w; k < MI_PIECES / 64; k += NWAVES) {
        const bool skip = ih ? (k < 16 || (k >= 102 && k < 106)) : ((k > 16 && k < 33) || (k > 106 && k < 111));
        if (!skip) __builtin_amdgcn_global_load_lds((const unsigned*)(img + (size_t)(64 * k + lane) * 16), (LAS unsigned*)(lds + mimg_lds_off(64 * k)), 16, 0, 0); }
}
#define ML_RAW_BARRIER() asm volatile("s_waitcnt lgkmcnt(0)\n\ts_barrier" ::: "memory")
#define ML_DSR128(dst, addr, off) asm volatile("ds_read_b128 %0, %1 offset:" #off : "=v"(dst) : "v"(addr))
#define ML_DSR2X64(dst, addr, o0, o1) asm volatile("ds_read2_b64 %0, %1 offset0:" #o0 " offset1:" #o1 : "=v"(dst) : "v"(addr))
#define ML_LWAIT(n, x) asm volatile("s_waitcnt lgkmcnt(" #n ")" : "+v"(x))
constexpr int ML_HB = 33792, ML_PHB = 528;
DI void ml_seq_unit(int l, int s, int hh, int ih, LAS unsigned char* lds, int tid) {
    CArgs* A = kargs();
    const bf16* proj = (const bf16*)(A->ws + WS_PROJ); bf16* ycat = (bf16*)(A->ws + WS_YCAT); unsigned char* ycat8 = A->ws + WS_YCAT; (void)ycat; (void)ycat8;
    const float* gn = A->in[32] + (size_t)l * 256;
    const unsigned char* img0 = A->ws + WS_MIMG + (size_t)((s * 4 + hh) * (TP / 64)) * MIMG_BYTES;
    const int w = __builtin_amdgcn_readfirstlane(tid >> 6);
    LAS float* sc = (LAS float*)(lds + ML_SC);
    f32x16 Ct[8];
#pragma unroll
    for (int dt = 0; dt < 8; ++dt)
#pragma unroll
        for (int i = 0; i < 16; ++i) Ct[dt][i] = 0.f;
    if (tid < 256) sc[SC_N + tid] = 0.f;
    float m = 0.f, sg = 1.f;
#ifdef PROBE_ABL
    const int abl = (kargs()->li == 1) ? PROBE_ABL : 0;
#else
    constexpr int abl = 0;
#endif
    __syncthreads();
    ml_img_dma(img0, lds, ih, w, tid & 63);
    for (int c = 0; c < TP / 64; ++c) {
        const int r0 = s * TP + 64 * c;
        if (c == 0) asm volatile("s_waitcnt vmcnt(0)" ::: "memory"); else asm volatile("s_waitcnt vmcnt(4)" ::: "memory");
        ML_RAW_BARRIER();
        { int tz_ = tid; asm volatile("" : "+v"(tz_)); const int i = tz_ & 63; float acc = 0.f;
#pragma unroll
          for (int k8 = 0; k8 < 4; ++k8) { const v4u qw = *(const LAS v4u*)(lds + ML_Q + i * ML_PQ + (32 * w + 8 * k8) * 2);
              const f32x4 n0 = *(const LAS f32x4*)(sc + SC_N + 32 * w + 8 * k8), n1 = *(const LAS f32x4*)(sc + SC_N + 32 * w + 8 * k8 + 4);
              acc += bflo_(qw.x) * n0.x + bfhi_(qw.x) * n0.y + bflo_(qw.y) * n0.z + bfhi_(qw.y) * n0.w + bflo_(qw.z) * n1.x + bfhi_(qw.z) * n1.y + bflo_(qw.w) * n1.z + bfhi_(qw.w) * n1.w; }
          sc[SC_QN + w * 64 + i] = acc;
          if (w == 1) sc[SC_RAT + i] = __expf(fminf(m - sc[IS_PM + i], 60.f)) * sg; }
        const float FL = sc[IS_FL], cmax = sc[IS_CMAX];
        const float cs = __expf(fminf(0.f, m - cmax)), s2 = __expf(fminf(0.f, cmax - m));
        v2u mo[4]; f32x4 gn4;
        { int tm_ = tid; asm volatile("" : "+v"(tm_)); const unsigned lo_ = 4u * (unsigned)(tm_ & 63);
          const bf16* mb_ = proj + (size_t)(r0 + 32 * ih + 4 * w) * PPITCH + C_MO + hh * 256;
#pragma unroll
          for (int q = 0; q < 4; ++q) mo[q] = *(const v2u*)(mb_ + (unsigned)(q * PPITCH) + lo_);
          gn4 = *(const f32x4*)(gn + lo_); }
        ML_RAW_BARRIER();
        f32x16 o0;
        { int tz_ = tid; asm volatile("" : "+v"(tz_)); const int lane = tz_ & 63, r = lane & 31, h = lane >> 5;
        if (w == 0) { const int i = lane; const float pmi = sc[IS_PM + i];
            float qn = 0.f;
#pragma unroll
            for (int p = 0; p < 8; ++p) qn += sc[SC_QN + p * 64 + i];
            const float den = __expf(fminf(0.f, m - pmi)) * qn + __expf(fminf(0.f, pmi - m)) * sc[IS_RSP + i];
            sc[SC_RDEN + i] = __expf(-fminf(fmaxf(m - pmi, 0.f), 60.f)) / fmaxf(fabsf(den), __expf(-(sc[IS_F + i] + fmaxf(m, pmi)))); }
        if (tz_ < 256) sc[SC_N + tz_] = cs * sc[SC_N + tz_] + s2 * sc[IS_NP + tz_];
#pragma unroll
        for (int i = 0; i < 16; ++i) o0[i] = 0.f;
        { const unsigned qa = (unsigned)(__UINTPTR_TYPE__)(lds + ML_Q + (32 * ih + r) * ML_PQ + 8 * h);
          v4u q0, q1, q2, q3;
          ML_DSR2X64(q0, qa, 0, 2);
          ML_DSR2X64(q1, qa, 4, 6);
          ML_DSR2X64(q2, qa, 8, 10);
          ML_DSR2X64(q3, qa, 12, 14);
          { const bf16x8 bfrag = pack_acc(Ct[0], 0); ML_LWAIT(3, q0); o0 = MFMA32(__builtin_bit_cast(bf16x8, q0), bfrag, o0); ML_DSR2X64(q0, qa, 16, 18); }
          { const bf16x8 bfrag = pack_acc(Ct[0], 1); ML_LWAIT(3, q1); o0 = MFMA32(__builtin_bit_cast(bf16x8, q1), bfrag, o0); ML_DSR2X64(q1, qa, 20, 22); }
          { const bf16x8 bfrag = pack_acc(Ct[1], 0); ML_LWAIT(3, q2); o0 = MFMA32(__builtin_bit_cast(bf16x8, q2), bfrag, o0); ML_DSR2X64(q2, qa, 24, 26); }
          { const bf16x8 bfrag = pack_acc(Ct[1], 1); ML_LWAIT(3, q3); o0 = MFMA32(__builtin_bit_cast(bf16x8, q3), bfrag, o0); ML_DSR2X64(q3, qa, 28, 30); }
          { const bf16x8 bfrag = pack_acc(Ct[2], 0); ML_LWAIT(3, q0); o0 = MFMA32(__builtin_bit_cast(bf16x8, q0), bfrag, o0); ML_DSR2X64(q0, qa, 32, 34); }
          { const bf16x8 bfrag = pack_acc(Ct[2], 1); ML_LWAIT(3, q1); o0 = MFMA32(__builtin_bit_cast(bf16x8, q1), bfrag, o0); ML_DSR2X64(q1, qa, 36, 38); }
          { const bf16x8 bfrag = pack_acc(Ct[3], 0); ML_LWAIT(3, q2); o0 = MFMA32(__builtin_bit_cast(bf16x8, q2), bfrag, o0); ML_DSR2X64(q2, qa, 40, 42); }
          { const bf16x8 bfrag = pack_acc(Ct[3], 1); ML_LWAIT(3, q3); o0 = MFMA32(__builtin_bit_cast(bf16x8, q3), bfrag, o0); ML_DSR2X64(q3, qa, 44, 46); }
          { const bf16x8 bfrag = pack_acc(Ct[4], 0); ML_LWAIT(3, q0); o0 = MFMA32(__builtin_bit_cast(bf16x8, q0), bfrag, o0); ML_DSR2X64(q0, qa, 48, 50); }
          { const bf16x8 bfrag = pack_acc(Ct[4], 1); ML_LWAIT(3, q1); o0 = MFMA32(__builtin_bit_cast(bf16x8, q1), bfrag, o0); ML_DSR2X64(q1, qa, 52, 54); }
          { const bf16x8 bfrag = pack_acc(Ct[5], 0); ML_LWAIT(3, q2); o0 = MFMA32(__builtin_bit_cast(bf16x8, q2), bfrag, o0); ML_DSR2X64(q2, qa, 56, 58); }
          { const bf16x8 bfrag = pack_acc(Ct[5], 1); ML_LWAIT(3, q3); o0 = MFMA32(__builtin_bit_cast(bf16x8, q3), bfrag, o0); ML_DSR2X64(q3, qa, 60, 62); }
          { const bf16x8 bfrag = pack_acc(Ct[6], 0); ML_LWAIT(3, q0); o0 = MFMA32(__builtin_bit_cast(bf16x8, q0), bfrag, o0); }
          { const bf16x8 bfrag = pack_acc(Ct[6], 1); ML_LWAIT(2, q1); o0 = MFMA32(__builtin_bit_cast(bf16x8, q1), bfrag, o0); }
          { const bf16x8 bfrag = pack_acc(Ct[7], 0); ML_LWAIT(1, q2); o0 = MFMA32(__builtin_bit_cast(bf16x8, q2), bfrag, o0); }
          { const bf16x8 bfrag = pack_acc(Ct[7], 1); ML_LWAIT(0, q3); o0 = MFMA32(__builtin_bit_cast(bf16x8, q3), bfrag, o0); }
        }
#pragma unroll
        for (int g = 0; g < 4; ++g) { const f32x4 p0 = *(const LAS f32x4*)(sc + SC_RAT + 32 * ih + 8 * g + 4 * h);
#pragma unroll
            for (int q = 0; q < 4; ++q) o0[4 * g + q] *= p0[q]; }
        sg *= cs;
        if (sg < 1e-12f) {
#pragma unroll
            for (int dt = 0; dt < 8; ++dt)
#pragma unroll
                for (int i = 0; i < 16; ++i) Ct[dt][i] *= sg;
            sg = 1.f; }
        const float vsc = s2 * __builtin_amdgcn_rcpf(sg);
        { const LAS unsigned char* vp = lds + ML_V + (8 * h) * ML_PQ + (32 * w + r) * 2;
          const unsigned ka = (unsigned)(__UINTPTR_TYPE__)(lds + ML_KWT + r * ML_PT + 16 * h);
          const LAS unsigned char* pp = lds + ML_S + (32 * ih + r) * ML_PT + 16 * h;
          v4u k0, k1, k2, k3;
          ML_DSR128(k0, ka, 0);
          ML_DSR128(k1, ka, 4608);
          ML_DSR128(k2, ka, 9216);
          ML_DSR128(k3, ka, 13824);
          { float vv[8];
#pragma unroll
            for (int jj = 0; jj < 8; ++jj) vv[jj] = bf2f(lds_u16(vp + (0 + jj) * ML_PQ));
            const v4u xu = {pkbf(vv[0], vv[1]), pkbf(vv[2], vv[3]), pkbf(vv[4], vv[5]), pkbf(vv[6], vv[7])};
            const v4u xs = {pkbf(vv[0] * vsc, vv[1] * vsc), pkbf(vv[2] * vsc, vv[3] * vsc), pkbf(vv[4] * vsc, vv[5] * vsc), pkbf(vv[6] * vsc, vv[7] * vsc)};
            const bf16x8 vf = __builtin_bit_cast(bf16x8, xu), vfs = __builtin_bit_cast(bf16x8, xs);
            o0 = MFMA32(frag16(pp + 0), vf, o0);
            ML_LWAIT(3, k0); Ct[0] = MFMA32(__builtin_bit_cast(bf16x8, k0), vfs, Ct[0]); ML_DSR128(k0, ka, 18432);
            ML_LWAIT(3, k1); Ct[1] = MFMA32(__builtin_bit_cast(bf16x8, k1), vfs, Ct[1]); ML_DSR128(k1, ka, 23040);
            ML_LWAIT(3, k2); Ct[2] = MFMA32(__builtin_bit_cast(bf16x8, k2), vfs, Ct[2]); ML_DSR128(k2, ka, 27648);
            ML_LWAIT(3, k3); Ct[3] = MFMA32(__builtin_bit_cast(bf16x8, k3), vfs, Ct[3]); ML_DSR128(k3, ka, 32256);
            ML_LWAIT(3, k0); Ct[4] = MFMA32(__builtin_bit_cast(bf16x8, k0), vfs, Ct[4]); ML_DSR128(k0, ka, 32);
            ML_LWAIT(3, k1); Ct[5] = MFMA32(__builtin_bit_cast(bf16x8, k1), vfs, Ct[5]); ML_DSR128(k1, ka, 4640);
            ML_LWAIT(3, k2); Ct[6] = MFMA32(__builtin_bit_cast(bf16x8, k2), vfs, Ct[6]); ML_DSR128(k2, ka, 9248);
            ML_LWAIT(3, k3); Ct[7] = MFMA32(__builtin_bit_cast(bf16x8, k3), vfs, Ct[7]); ML_DSR128(k3, ka, 13856);
          }
          { float vv[8];
#pragma unroll
            for (int jj = 0; jj < 8; ++jj) vv[jj] = bf2f(lds_u16(vp + (16 + jj) * ML_PQ));
            const v4u xu = {pkbf(vv[0], vv[1]), pkbf(vv[2], vv[3]), pkbf(vv[4], vv[5]), pkbf(vv[6], vv[7])};
            const v4u xs = {pkbf(vv[0] * vsc, vv[1] * vsc), pkbf(vv[2] * vsc, vv[3] * vsc), pkbf(vv[4] * vsc, vv[5] * vsc), pkbf(vv[6] * vsc, vv[7] * vsc)};
            const bf16x8 vf = __builtin_bit_cast(bf16x8, xu), vfs = __builtin_bit_cast(bf16x8, xs);
            o0 = MFMA32(frag16(pp + 32), vf, o0);
            ML_LWAIT(3, k0); Ct[0] = MFMA32(__builtin_bit_cast(bf16x8, k0), vfs, Ct[0]); ML_DSR128(k0, ka, 18464);
            ML_LWAIT(3, k1); Ct[1] = MFMA32(__builtin_bit_cast(bf16x8, k1), vfs, Ct[1]); ML_DSR128(k1, ka, 23072);
            ML_LWAIT(3, k2); Ct[2] = MFMA32(__builtin_bit_cast(bf16x8, k2), vfs, Ct[2]); ML_DSR128(k2, ka, 27680);
            ML_LWAIT(3, k3); Ct[3] = MFMA32(__builtin_bit_cast(bf16x8, k3), vfs, Ct[3]); ML_DSR128(k3, ka, 32288);
            ML_LWAIT(3, k0); Ct[4] = MFMA32(__builtin_bit_cast(bf16x8, k0), vfs, Ct[4]); ML_DSR128(k0, ka, 64);
            ML_LWAIT(3, k1); Ct[5] = MFMA32(__builtin_bit_cast(bf16x8, k1), vfs, Ct[5]); ML_DSR128(k1, ka, 4672);
            ML_LWAIT(3, k2); Ct[6] = MFMA32(__builtin_bit_cast(bf16x8, k2), vfs, Ct[6]); ML_DSR128(k2, ka, 9280);
            ML_LWAIT(3, k3); Ct[7] = MFMA32(__builtin_bit_cast(bf16x8, k3), vfs, Ct[7]); ML_DSR128(k3, ka, 13888);
          }
          { float vv[8];
#pragma unroll
            for (int jj = 0; jj < 8; ++jj) vv[jj] = bf2f(lds_u16(vp + (32 + jj) * ML_PQ));
            const v4u xu = {pkbf(vv[0], vv[1]), pkbf(vv[2], vv[3]), pkbf(vv[4], vv[5]), pkbf(vv[6], vv[7])};
            const v4u xs = {pkbf(vv[0] * vsc, vv[1] * vsc), pkbf(vv[2] * vsc, vv[3] * vsc), pkbf(vv[4] * vsc, vv[5] * vsc), pkbf(vv[6] * vsc, vv[7] * vsc)};
            const bf16x8 vf = __builtin_bit_cast(bf16x8, xu), vfs = __builtin_bit_cast(bf16x8, xs);
            if (ih == 1) o0 = MFMA32(frag16(pp + 64), vf, o0);
            ML_LWAIT(3, k0); Ct[0] = MFMA32(__builtin_bit_cast(bf16x8, k0), vfs, Ct[0]); ML_DSR128(k0, ka, 18496);
            ML_LWAIT(3, k1); Ct[1] = MFMA32(__builtin_bit_cast(bf16x8, k1), vfs, Ct[1]); ML_DSR128(k1, ka, 23104);
            ML_LWAIT(3, k2); Ct[2] = MFMA32(__builtin_bit_cast(bf16x8, k2), vfs, Ct[2]); ML_DSR128(k2, ka, 27712);
            ML_LWAIT(3, k3); Ct[3] = MFMA32(__builtin_bit_cast(bf16x8, k3), vfs, Ct[3]); ML_DSR128(k3, ka, 32320);
            ML_LWAIT(3, k0); Ct[4] = MFMA32(__builtin_bit_cast(bf16x8, k0), vfs, Ct[4]); ML_DSR128(k0, ka, 96);
            ML_LWAIT(3, k1); Ct[5] = MFMA32(__builtin_bit_cast(bf16x8, k1), vfs, Ct[5]); ML_DSR128(k1, ka, 4704);
            ML_LWAIT(3, k2); Ct[6] = MFMA32(__builtin_bit_cast(bf16x8, k2), vfs, Ct[6]); ML_DSR128(k2, ka, 9312);
            ML_LWAIT(3, k3); Ct[7] = MFMA32(__builtin_bit_cast(bf16x8, k3), vfs, Ct[7]); ML_DSR128(k3, ka, 13920);
          }
          { float vv[8];
#pragma unroll
            for (int jj = 0; jj < 8; ++jj) vv[jj] = bf2f(lds_u16(vp + (48 + jj) * ML_PQ));
            const v4u xu = {pkbf(vv[0], vv[1]), pkbf(vv[2], vv[3]), pkbf(vv[4], vv[5]), pkbf(vv[6], vv[7])};
            const v4u xs = {pkbf(vv[0] * vsc, vv[1] * vsc), pkbf(vv[2] * vsc, vv[3] * vsc), pkbf(vv[4] * vsc, vv[5] * vsc), pkbf(vv[6] * vsc, vv[7] * vsc)};
            const bf16x8 vf = __builtin_bit_cast(bf16x8, xu), vfs = __builtin_bit_cast(bf16x8, xs);
            if (ih == 1) o0 = MFMA32(frag16(pp + 96), vf, o0);
            ML_LWAIT(3, k0); Ct[0] = MFMA32(__builtin_bit_cast(bf16x8, k0), vfs, Ct[0]); ML_DSR128(k0, ka, 18528);
            ML_LWAIT(3, k1); Ct[1] = MFMA32(__builtin_bit_cast(bf16x8, k1), vfs, Ct[1]); ML_DSR128(k1, ka, 23136);
            ML_LWAIT(3, k2); Ct[2] = MFMA32(__builtin_bit_cast(bf16x8, k2), vfs, Ct[2]); ML_DSR128(k2, ka, 27744);
            ML_LWAIT(3, k3); Ct[3] = MFMA32(__builtin_bit_cast(bf16x8, k3), vfs, Ct[3]); ML_DSR128(k3, ka, 32352);
            ML_LWAIT(3, k0); Ct[4] = MFMA32(__builtin_bit_cast(bf16x8, k0), vfs, Ct[4]);
            ML_LWAIT(2, k1); Ct[5] = MFMA32(__builtin_bit_cast(bf16x8, k1), vfs, Ct[5]);
            ML_LWAIT(1, k2); Ct[6] = MFMA32(__builtin_bit_cast(bf16x8, k2), vfs, Ct[6]);
            ML_LWAIT(0, k3); Ct[7] = MFMA32(__builtin_bit_cast(bf16x8, k3), vfs, Ct[7]);
          }
          asm volatile("" ::: "memory"); }
        }
        m = FL + fmaxf(m, cmax);
        ML_RAW_BARRIER();
        { int tz_ = tid; asm volatile("" : "+v"(tz_)); const int lane = tz_ & 63, r = lane & 31, h = lane >> 5;
#pragma unroll
        for (int g = 0; g < 4; ++g) { const f32x4 d0 = *(const LAS f32x4*)(sc + SC_RDEN + 32 * ih + 8 * g + 4 * h);
#pragma unroll
            for (int q = 0; q < 4; ++q) { const int i = 8 * g + 4 * h + q;
                *(LAS unsigned short*)(lds + ML_HB + i * ML_PHB + (32 * w + r) * 2) = (unsigned short)(pkbf(o0[4 * g + q] * d0[q], 0.f) & 0xffffu); } }
        }
        float og[4][4];
#pragma unroll
        for (int q = 0; q < 4; ++q) { const v2u ow = mo[q];
            og[q][0] = sigm(__uint_as_float(ow.x << 16)) * gn4.x; og[q][1] = sigm(__uint_as_float(ow.x & 0xffff0000u)) * gn4.y;
            og[q][2] = sigm(__uint_as_float(ow.y << 16)) * gn4.z; og[q][3] = sigm(__uint_as_float(ow.y & 0xffff0000u)) * gn4.w; }
#pragma unroll
        for (int q = 0; q < 4; ++q) asm volatile("" : "+v"(og[q][0]), "+v"(og[q][1]), "+v"(og[q][2]), "+v"(og[q][3]));
        if (c + 1 < TP / 64 && !(abl & 1)) ml_img_dma(img0 + (size_t)(c + 1) * MIMG_BYTES, lds, ih, w, tid & 63);
        ML_RAW_BARRIER();
        { int tz_ = tid; asm volatile("" : "+v"(tz_)); const int lane = tz_ & 63;
#pragma unroll
        for (int q = 0; q < 4; ++q) { const int i = 4 * w + q; const size_t row = (size_t)(r0 + 32 * ih + i);
            const v2u hw = *(const LAS v2u*)(lds + ML_HB + i * ML_PHB + lane * 8);
            const float h0 = bflo_(hw.x), h1 = bfhi_(hw.x), h2 = bflo_(hw.y), h3 = bfhi_(hw.y);
            float ss = (h0 * h0 + h1 * h1) + (h2 * h2 + h3 * h3); ss = wave_sum(ss);
            const float rs = __builtin_amdgcn_rsqf(ss * (1.f / 256.f) + EPS);
                        *(unsigned*)(ycat8 + row * KBR + 2048 + hh * 256 + 4 * lane) = pg8::pk4_fp8(og[q][0] * (h0 * rs), og[q][1] * (h1 * rs), og[q][2] * (h2 * rs), og[q][3] * (h3 * rs)); }
        }
        ML_RAW_BARRIER();
    }
    { int tz_ = tid; asm volatile("" : "+v"(tz_)); const int lane = tz_ & 63, r = lane & 31, h = lane >> 5;
      const size_t bh = ((size_t)l * NP + s) * 4 + hh; float* cp = A->out + O_P_C + bh * 256 * 256 + 32 * w + r;
      if (ih == 0) {
#pragma unroll
      for (int dt = 0; dt < 8; ++dt)
#pragma unroll
          for (int reg = 0; reg < 16; ++reg) cp[(size_t)(32 * dt + (reg & 3) + 8 * (reg >> 2) + 4 * h) * 256] = Ct[dt][reg] * sg;
      if (tz_ < 256) A->out[O_P_N + bh * 256 + tz_] = sc[SC_N + tz_];
      if (tz_ == 0) A->out[O_P_M + bh] = m; } }
    __syncthreads();
}

constexpr int LR_WA = 0, LR_WX = 34816, LR_U = 69632, LR_UF = 87040, LR_AF = 119808, LR_SEG = 152576, LR_HC = 156672, LR_P = 272;
static_assert(LR_HC + 1024 <= LDSCTL_OFF, "LRU LDS map");
DI void lru_chunk_unit(int l, int s, int n, int dh, LAS unsigned char* lds, int tid) {
    CArgs* A = kargs();
    const bf16* proj = (const bf16*)(A->ws + WS_PROJ); unsigned char* ycat8 = A->ws + WS_YCAT;
    const float* cw = A->in[16] + (size_t)l * 4 * 1024 + n * 128; const float* cb = A->in[17] + (size_t)l * 1024 + n * 128;
    const float* wa = A->in[18] + ((size_t)l * 8 + n) * 128 * 128; const float* ba = A->in[19] + (size_t)l * 1024 + n * 128;
    const float* wx = A->in[20] + ((size_t)l * 8 + n) * 128 * 128; const float* bx = A->in[21] + (size_t)l * 1024 + n * 128;
    const float* lam = A->in[22] + (size_t)l * 1024 + n * 128;
    const int w = __builtin_amdgcn_readfirstlane(tid >> 6), seg = __builtin_amdgcn_readfirstlane(tid >> 7);
    for (int idx = tid; idx < 64 * 128; idx += NTHREADS) { const int c = idx >> 6, d = idx & 63;
        *(LAS unsigned short*)(lds + LR_WA + d * LR_P + c * 2) = (unsigned short)(pkbf(wa[c * 128 + 64 * dh + d], 0.f) & 0xffffu);
        *(LAS unsigned short*)(lds + LR_WX + d * LR_P + c * 2) = (unsigned short)(pkbf(wx[c * 128 + 64 * dh + d], 0.f) & 0xffffu); }
    if (tid < 256) *(LAS float*)(lds + LR_HC + tid * 4) = 0.f;
    const float w0 = cw[tid & 127], w1 = cw[1024 + (tid & 127)], w2 = cw[2048 + (tid & 127)], w3 = cw[3072 + (tid & 127)], bb = cb[tid & 127];
    const int dcol = 64 * dh + 32 * (w & 1) + (tid & 31);
    const float bav = ba[dcol], bxv = bx[dcol], ls = logsig(lam[dcol]);
    v4u pf[3];
#define LRU_PREFETCH(tn) do { int tp_ = tid; asm volatile("" : "+v"(tp_)); const bf16* pb_ = proj + ((ptrdiff_t)(s * TP + 64 * (tn)) - 3) * (ptrdiff_t)PPITCH + C_LRUX + n * 128; \
        _Pragma("unroll") for (int i_ = 0; i_ < 3; ++i_) { const int idx_ = tp_ + 512 * i_, row_ = idx_ >> 4; pf[i_] = (v4u){0u, 0u, 0u, 0u}; \
            if (idx_ < 1072 && 64 * (tn) - 3 + row_ >= 0) pf[i_] = *(const v4u*)(pb_ + (unsigned)(row_ * PPITCH + 8 * (idx_ & 15))); } } while (0)
    LRU_PREFETCH(0);
    __syncthreads();
    for (int tile = 0; tile < TP / 64; ++tile) {
        const int r0 = s * TP + 64 * tile;
        { int tz_ = tid; asm volatile("" : "+v"(tz_));
#pragma unroll
          for (int i = 0; i < 3; ++i) { const int idx = tz_ + 512 * i; if (idx < 1072) *(LAS v4u*)(lds + LR_AF + idx * 16) = pf[i]; } }
        WG_RAW_BARRIER();
        { int tz_ = tid; asm volatile("" : "+v"(tz_)); const int c = tz_ & 127;
          const LAS unsigned char* xp = lds + LR_AF + (16 * seg) * 256 + c * 2;
          float x0 = bf2f(lds_u16(xp)), x1 = bf2f(lds_u16(xp + 256)), x2 = bf2f(lds_u16(xp + 512));
#pragma unroll 8
          for (int t = 0; t < 16; ++t) { const float x3 = bf2f(lds_u16(xp + (3 + t) * 256)); const int j = 16 * seg + t;
              const float u = bb + w0 * x0 + w1 * x1 + w2 * x2 + w3 * x3;
              *(LAS unsigned short*)(lds + LR_U + j * LR_P + c * 2) = (unsigned short)(pkbf(u, 0.f) & 0xffffu);
              *(LAS float*)(lds + LR_UF + (j * 128 + c) * 4) = u;
              if (tile == TP / 64 - 1 && seg == 3 && t >= 13 && (c >> 6) == dh) A->out[O_P_LRUC + (((size_t)l * NP + s) * 3 + (t - 13)) * 1024 + n * 128 + c] = x3;
              x0 = x1; x1 = x2; x2 = x3; } }
        if (tile + 1 < TP / 64) LRU_PREFETCH(tile + 1);
        WG_RAW_BARRIER();
        if (w < 4) { int tz_ = tid; asm volatile("" : "+v"(tz_)); const int lane = tz_ & 63, r = lane & 31, h = lane >> 5;
          const int it = w >> 1, dtile = w & 1, dl = 32 * dtile + r, d = 64 * dh + dl;
          f32x16 ga, gx;
#pragma unroll
          for (int i = 0; i < 16; ++i) { ga[i] = 0.f; gx[i] = 0.f; }
#pragma unroll
          for (int s8 = 0; s8 < 8; ++s8) { const bf16x8 af = frag16(lds + LR_U + (32 * it + r) * LR_P + (16 * s8 + 8 * h) * 2);
              ga = MFMA32(af, frag16(lds + LR_WA + dl * LR_P + (16 * s8 + 8 * h) * 2), ga);
              gx = MFMA32(af, frag16(lds + LR_WX + dl * LR_P + (16 * s8 + 8 * h) * 2), gx); }
          float uu[16];
#pragma unroll
          for (int reg = 0; reg < 16; ++reg) { const int i = 32 * it + (reg & 3) + 8 * (reg >> 2) + 4 * h; uu[reg] = *(const LAS float*)(lds + LR_UF + (i * 128 + d) * 4); }
          asm volatile("" ::: "memory");
#pragma unroll
          for (int reg = 0; reg < 16; ++reg) { const int i = 32 * it + (reg & 3) + 8 * (reg >> 2) + 4 * h;
              const float rr = sigm(ga[reg] + bav), ii = sigm(gx[reg] + bxv), la = 8.f * rr * ls;
              LAS float* up = (LAS float*)(lds + LR_UF + (i * 128 + d) * 4);
              const float u = uu[reg];
              *(LAS float*)(lds + LR_AF + (i * 128 + d) * 4) = __expf(la);
              *up = lru_in_scale(la) * (ii * u); } }
        WG_RAW_BARRIER();
        float la_[8], lv_[8];
        { int tz_ = tid; asm volatile("" : "+v"(tz_)); const int dl = tz_ & 63, d = 64 * dh + dl;
          float Ap = 1.f, H = 0.f;
#pragma unroll
          for (int t = 0; t < 8; ++t) { const int i = 8 * w + t; la_[t] = *(const LAS float*)(lds + LR_AF + (i * 128 + d) * 4); lv_[t] = *(const LAS float*)(lds + LR_UF + (i * 128 + d) * 4); }
          asm volatile("" ::: "memory");
#pragma unroll
          for (int t = 0; t < 8; ++t) { H = la_[t] * H + lv_[t]; Ap *= la_[t]; }
          *(LAS float*)(lds + LR_SEG + (w * 64 + dl) * 4) = Ap; *(LAS float*)(lds + LR_SEG + 2048 + (w * 64 + dl) * 4) = H; }
        WG_RAW_BARRIER();
        { int tz_ = tid; asm volatile("" : "+v"(tz_)); const int dl = tz_ & 63;
          float hcur = *(const LAS float*)(lds + LR_HC + ((tile & 1) * 128 + dl) * 4);
          float pa_[7], ph_[7];
#pragma unroll
          for (int s2 = 0; s2 < 7; ++s2) { pa_[s2] = *(const LAS float*)(lds + LR_SEG + (s2 * 64 + dl) * 4); ph_[s2] = *(const LAS float*)(lds + LR_SEG + 2048 + (s2 * 64 + dl) * 4); }
          asm volatile("" ::: "memory");
#pragma unroll
          for (int s2 = 0; s2 < 7; ++s2) if (s2 < w) hcur = pa_[s2] * hcur + ph_[s2];
          unsigned char* yp = ycat8 + (size_t)(r0 + 8 * w) * KBR + n * 128 + 64 * dh + dl;
#pragma unroll
          for (int t = 0; t < 8; ++t) { hcur = la_[t] * hcur + lv_[t]; yp[(size_t)t * KBR] = (unsigned char)(pg8::pk4_fp8(hcur, 0.f, 0.f, 0.f) & 0xffu); }
          if (w == 7) { *(LAS float*)(lds + LR_HC + (((tile + 1) & 1) * 128 + dl) * 4) = hcur;
              if (tile == TP / 64 - 1) A->out[O_P_LRUH + ((size_t)l * NP + s) * 1024 + n * 128 + 64 * dh + dl] = hcur; } }
        WG_RAW_BARRIER();
    }
}

DI void lru_samp_unit(int l, int g, int n, LAS unsigned char* lds, int tid) {
    CArgs* A = kargs();
    const bf16* proj = (const bf16*)(A->ws + WS_PROJ); unsigned char* ycat8 = A->ws + WS_YCAT;
    const float* cw = A->in[16] + (size_t)l * 4 * 1024 + n * 128; const float* cb = A->in[17] + (size_t)l * 1024 + n * 128;
    const float* wa = A->in[18] + ((size_t)l * 8 + n) * 128 * 128; const float* ba = A->in[19] + (size_t)l * 1024 + n * 128;
    const float* wx = A->in[20] + ((size_t)l * 8 + n) * 128 * 128; const float* bx = A->in[21] + (size_t)l * 1024 + n * 128;
    const float* lam = A->in[22] + (size_t)l * 1024 + n * 128;
    const int w = __builtin_amdgcn_readfirstlane(tid >> 6), seg = __builtin_amdgcn_readfirstlane(tid >> 7);
    const int c = tid & 127, ch = n * 128 + c;
    float xs[4][7];
#pragma unroll
    for (int q = 0; q < 4; ++q) { const int b = 16 * g + 4 * seg + q;
#pragma unroll
        for (int j = 0; j < 3; ++j) xs[q][j] = A->in[5][(((size_t)l * NS + b) * 3 + j) * 1024 + ch];
#pragma unroll
        for (int t = 0; t < 4; ++t) xs[q][3 + t] = bf2f(proj[(size_t)(MP + b * TS + t) * PPITCH + C_LRUX + ch]); }
    const float w0 = cw[c], w1 = cw[1024 + c], w2 = cw[2048 + c], w3 = cw[3072 + c], bb = cb[c];
    const int dcol = 32 * (w & 3) + (tid & 31);
    const float bav = ba[dcol], bxv = bx[dcol], ls = logsig(lam[dcol]);
    float h0[4];
#pragma unroll
    for (int q = 0; q < 4; ++q) h0[q] = A->in[4][((size_t)l * NS + 16 * g + 4 * seg + q) * 1024 + ch];
    for (int idx = tid; idx < 128 * 128; idx += NTHREADS) { const int c2 = idx >> 7, d = idx & 127;
        *(LAS unsigned short*)(lds + LR_WA + d * LR_P + c2 * 2) = (unsigned short)(pkbf(wa[idx], 0.f) & 0xffffu);
        *(LAS unsigned short*)(lds + LR_WX + d * LR_P + c2 * 2) = (unsigned short)(pkbf(wx[idx], 0.f) & 0xffffu); }
#pragma unroll
    for (int q = 0; q < 4; ++q) { const int b = 16 * g + 4 * seg + q;
#pragma unroll
        for (int t = 0; t < 4; ++t) { const int j = 16 * seg + 4 * q + t; const float u = bb + w0 * xs[q][t] + w1 * xs[q][t + 1] + w2 * xs[q][t + 2] + w3 * xs[q][t + 3];
            *(LAS unsigned short*)(lds + LR_U + j * LR_P + c * 2) = (unsigned short)(pkbf(u, 0.f) & 0xffffu);
            *(LAS float*)(lds + LR_UF + (j * 128 + c) * 4) = u; }
#pragma unroll
        for (int j = 0; j < 3; ++j) A->out[O_S_LRUC + (((size_t)l * NS + b) * 3 + j) * 1024 + ch] = xs[q][4 + j]; }
    __syncthreads();
    { const int lane = tid & 63, r = lane & 31, h = lane >> 5, it = w >> 2, dtile = w & 3, d = 32 * dtile + r;
      f32x16 ga, gx;
#pragma unroll
      for (int i = 0; i < 16; ++i) { ga[i] = 0.f; gx[i] = 0.f; }
#pragma unroll
      for (int s8 = 0; s8 < 8; ++s8) { const bf16x8 af = frag16(lds + LR_U + (32 * it + r) * LR_P + (16 * s8 + 8 * h) * 2);
          ga = MFMA32(af, frag16(lds + LR_WA + d * LR_P + (16 * s8 + 8 * h) * 2), ga);
          gx = MFMA32(af, frag16(lds + LR_WX + d * LR_P + (16 * s8 + 8 * h) * 2), gx); }
#pragma unroll
      for (int reg = 0; reg < 16; ++reg) { const int i = 32 * it + (reg & 3) + 8 * (reg >> 2) + 4 * h;
          const float rr = sigm(ga[reg] + bav), ii = sigm(gx[reg] + bxv), la = 8.f * rr * ls;
          LAS float* up = (LAS float*)(lds + LR_UF + (i * 128 + d) * 4);
          const float u = *up;
          *(LAS float*)(lds + LR_AF + (i * 128 + d) * 4) = __expf(la);
          *up = lru_in_scale(la) * (ii * u); } }
    __syncthreads();
#pragma unroll
    for (int q = 0; q < 4; ++q) { const int b = 16 * g + 4 * seg + q; float hc = h0[q];
#pragma unroll
        for (int t = 0; t < 4; ++t) { const int j = 16 * seg + 4 * q + t;
            hc = *(const LAS float*)(lds + LR_AF + (j * 128 + c) * 4) * hc + *(const LAS float*)(lds + LR_UF + (j * 128 + c) * 4);
            ycat8[(size_t)(MP + b * TS + t) * KBR + ch] = (unsigned char)(pg8::pk4_fp8(hc, 0.f, 0.f, 0.f) & 0xffu); }
        A->out[O_S_LRUH + ((size_t)l * NS + b) * 1024 + ch] = hc; }
    __syncthreads();
}

#ifndef EN_PRO
#define EN_PRO 1
#endif
#ifndef EN_MOD
#define EN_MOD 1
#endif
#ifndef EN_NORM
#define EN_NORM 1
#endif
#ifndef EN_PROJ
#define EN_PROJ 1
#endif
#ifndef EN_MIX
#define EN_MIX 1
#endif
#ifndef EN_MERGE
#define EN_MERGE 1
#endif
#ifndef EN_OUT
#define EN_OUT 1
#endif
#ifndef EN_FF1
#define EN_FF1 1
#endif
#ifndef EN_FF2
#define EN_FF2 1
#endif
#ifndef EN_ML
#define EN_ML 1
#endif
#ifndef EN_GLA
#define EN_GLA 1
#endif
#ifndef EN_LRU
#define EN_LRU 1
#endif
#ifndef REP_MIXP
#define REP_MIXP 1
#endif
#ifndef REP_ML
#define REP_ML 1
#endif
#ifndef REP_GLA
#define REP_GLA 1
#endif
#ifndef REP_LRU
#define REP_LRU 1
#endif
#ifndef REP_MIXS
#define REP_MIXS 1
#endif
#ifndef REP_GEMM
#define REP_GEMM 1
#endif
#ifndef REP_PROJ
#define REP_PROJ REP_GEMM
#endif
#ifndef REP_MERGE
#define REP_MERGE REP_GEMM
#endif
#ifndef REP_OUT
#define REP_OUT REP_GEMM
#endif
#ifndef REP_FF1
#define REP_FF1 REP_GEMM
#endif
#ifndef REP_FF2
#define REP_FF2 REP_GEMM
#endif
#ifndef REP_PRO
#define REP_PRO 1
#endif
#ifndef REP_MIX
#define REP_MIX 1
#endif
#ifndef REP_NORM
#define REP_NORM 1
#endif
#define WSP(T, off) ((T*)(ws + (off)))

DI void conv_win(CArgs* A, unsigned char* ws, int l, LAS float* scr, int gw, int ngw, int lane, int gtid, int gthreads) {
    const float* w_in = A->in[15] + (size_t)l * D * DIN; bf16* wt_in = WSP(bf16, WS_WIN) + (size_t)l * NPROJ_PAD * D;
    transpose_job(w_in, DIN, D, 3072, wt_in, D, scr, gw, ngw, lane);
    unsigned char* wt8 = ws + (WS_WIN8_0 + (size_t)l * (WS_WIN8_1 - WS_WIN8_0));
    transpose_job_f8(w_in + 3088, DIN, D, 1024, wt8 + (size_t)3072 * D, D, 64.f, scr, gw, ngw, lane);
    transpose_job(w_in + 3088 + 1024, DIN, D, 1024, wt_in + (size_t)4096 * D, D, scr, gw, ngw, lane);
    transpose_job_f8(w_in + 3088 + 2048, DIN, D, 1024, wt8 + (size_t)5120 * D, D, 64.f, scr, gw, ngw, lane);
    transpose_job_f8(w_in + 6168, DIN, D, 6144, wt8 + (size_t)6144 * D, D, 64.f, scr, gw, ngw, lane);
    for (int i = gtid; i < 256 * D; i += gthreads) { const int j = i >> 11, k = i & 2047;
        const float v = j < 24 ? w_in[(size_t)k * DIN + (j < 16 ? 3072 + j : 6160 + (j - 16))] : 0.f;
        wt_in[(size_t)(NPROJ + j) * D + k] = (bf16)f2bf(v); }
}
DI void conv_rest(CArgs* A, unsigned char* ws, int l, LAS float* scr, int gw, int ngw, int lane, bool with_ff2) {
    unsigned char* wt_br = ws + WS_WBR + (size_t)l * D * KBR;
    transpose_job_f8(A->in[33] + (size_t)l * 1024 * D, D, 1024, D, wt_br, KBR, 64.f, scr, gw, ngw, lane);
    transpose_job_f8(A->in[34] + (size_t)l * 1024 * D, D, 1024, D, wt_br + 1024, KBR, 64.f, scr, gw, ngw, lane);
    transpose_job_f8(A->in[35] + (size_t)l * 1024 * D, D, 1024, D, wt_br + 2048, KBR, 64.f, scr, gw, ngw, lane);
    transpose_job_f8(A->in[36] + (size_t)l * D * D, D, D, D, ws + WS_WOUT + (size_t)l * D * D, D, 64.f, scr, gw, ngw, lane);
    if (with_ff2) { const float* src = A->in[37] + (size_t)l * D * DFF; unsigned char* dst = ws + WS_WFF1 + (size_t)l * DFF * D;
      for (int it = gw; it < (D / 64) * (DFF / 32); it += ngw) transpose_item_f8(src, DFF, DFF, dst, D, 64.f, scr, it, lane); }
    if (with_ff2) { const float* src = A->in[38] + (size_t)l * DFF * D; unsigned char* dst = ws + WS_WFF2 + (size_t)l * D * DFF;
      for (int it = gw; it < (DFF / 64) * (D / 32); it += ngw) transpose_item_f8(src, D, D, dst, DFF, 64.f, scr, it, lane); }
}
__global__ void __launch_bounds__(NTHREADS, 2) mk_fwd(Args a_unused) {
    extern __shared__ __attribute__((aligned(16))) unsigned char lds_raw[];
    LAS unsigned char* lds = (LAS unsigned char*)lds_raw;
    const int bid = blockIdx.x;
    constexpr int G = GRID, ngw = GRID * NWAVES;
#define TIDS() int tid_ = threadIdx.x; asm volatile("" : "+v"(tid_)); const int tid = tid_, lane = tid & 63, wave = __builtin_amdgcn_readfirstlane(tid >> 6), gw = bid * NWAVES + wave; (void)lane; (void)gw
    for (int u = threadIdx.x; u < (LDS_BYTES - LDSCTL_OFF) / 4; u += NTHREADS) ((LAS unsigned*)(lds + LDSCTL_OFF))[u] = 0u;
    __syncthreads();
    int lo, hi;
    { CArgs* A = kargs(); lo = A->ph_lo; hi = A->ph_hi;
      (void)xcd_barrier_post((unsigned*)(A->ws + WS_CTL) + CW_BAR + A->li * XCD_BAR_WORDS, (volatile LAS unsigned*)(lds + MISC_OFF) + 8); }
#define IN(k) (lo <= (k) && (k) < hi)
#define SEAM(k) do { if (IN(k) && IN((k) + 1)) { CArgs* Ab = kargs(); XcdBarrier bar; bar.bar = (unsigned*)(Ab->ws + WS_CTL) + CW_BAR + Ab->li * XCD_BAR_WORDS; bar.x = xb_xcc_id(); \
        bar.st = (volatile LAS unsigned*)(lds + MISC_OFF) + 8; xcd_barrier(bar); } } while (0)

    if (EN_PRO && IN(0)) for (int rep_ = 0; rep_ < REP_PRO; ++rep_) {
        if (rep_) __syncthreads();
        TIDS(); CArgs* A = kargs(); unsigned char* const ws = A->ws;
        LAS float* scr = (LAS float*)(lds + RING_OFF + wave * 16384);
        for (int l = 0; l < DEPTH; ++l) transpose_job(A->in[11] + (size_t)l * D * NADA, NADA, D, NADA, WSP(bf16, WS_WADA) + (size_t)l * NADA * D, D, scr, gw, ngw, lane);
        for (int l = 0; l < DEPTH; ++l) { conv_win(A, ws, l, scr, gw, ngw, lane, bid * NTHREADS + tid, G * NTHREADS); conv_rest(A, ws, l, scr, gw, ngw, lane, l == 0); }
        bf16* csilu = WSP(bf16, WS_CSILU);
        for (int i = bid * NTHREADS + tid; i < 256 * D; i += G * NTHREADS) { const int r = i >> 11, c = i & 2047;
            float v = 0.f;
            if (r < NP) v = A->in[2][r * D + c]; else if (r < NB) v = A->in[3][(r - NP) * D + c];
            csilu[i] = (bf16)f2bf(r < NB ? v * sigm(v) : 0.f); }
    }
    SEAM(0);

    if (EN_MOD && IN(1)) {
        CArgs* A = kargs(); unsigned char* const ws = A->ws;
        pg8::Gemm g{WSP(bf16, WS_CSILU), WSP(bf16, WS_WADA), 256, 2 * NADA, D, D, D}; pg8::StaticOrder S; S.init(256, 2 * NADA, G, bid);
        pg8::EpiF32 E{WSP(float, WS_MOD), 2 * NADA, A->in[12]};
        pg8::gemm_phase<pg8::EpiF32, pg8::StaticOrder>(lds + RING_OFF, g, S, E, nullptr);
    }
    SEAM(1);

    for (int l = 0; l < DEPTH; ++l) {
        const int pb = 2 + 9 * l;
        if (EN_NORM && IN(pb + 0)) { TIDS(); CArgs* A = kargs(); unsigned char* const ws = A->ws;
            if (l == 0) norm_rows(A->in[0], A->in[1], true, A->in[13] + (size_t)l * D, WSP(float, WS_MOD) + (size_t)l * NADA, WSP(bf16, WS_XN), nullptr, nullptr, gw, ngw, lane, WSP(bf16, WS_XB), 0, nullptr, nullptr, nullptr, nullptr, ws + WS_XN8);
            else norm_rows(WSP(bf16, WS_XB), WSP(bf16, WS_XA) + (size_t)MP * D, false, A->in[13] + (size_t)l * D, WSP(float, WS_MOD) + (size_t)l * NADA, WSP(bf16, WS_XN), nullptr, nullptr, gw, ngw, lane, nullptr,
                           16, WSP(bf16, WS_GIMG), WSP(float, WS_MOD) + (size_t)(l - 1) * NADA + 10240, WSP(bf16, WS_XB) + (size_t)MP * D, nullptr, ws + WS_XN8); }
        SEAM(pb + 0);
        if (EN_PROJ && IN(pb + 1)) for (int rg_ = 0; rg_ < REP_PROJ; ++rg_) { CArgs* A = kargs(); unsigned char* const ws = A->ws;
            { pg8::Gemm g{WSP(bf16, WS_XN), WSP(bf16, WS_WIN) + (size_t)l * NPROJ_PAD * D, MTOT, NPROJ_PAD, D, D, D};
              pg8::TileMapOrder S; S.so.init(MTOT, 17 * 256, G, bid); S.t1 = 12; S.t2 = 16; S.s0 = 0; S.s1 = 4; S.s2 = 32;
              pg8::EpiProj E{WSP(bf16, WS_PROJ), WSP(float, WS_SMALL), 1.f, ws + WS_MG8};
              pg8::gemm_phase<pg8::EpiProj, pg8::TileMapOrder>(lds + RING_OFF, g, S, E, nullptr); }
            { pg8::Gemm g{(const bf16*)(ws + WS_XN8), (const bf16*)(ws + (WS_WIN8_0 + (size_t)l * (WS_WIN8_1 - WS_WIN8_0))), MTOT, NPROJ_PAD, D / 2, D / 2, D / 2};
              pg8::TileMapOrder S; S.so.init(MTOT, 32 * 256, G, bid); S.t1 = 4; S.t2 = 8; S.s0 = 12; S.s1 = 16; S.s2 = 16; S.nh = 72; S.sk = 2;
              pg8::EpiProj E{WSP(bf16, WS_PROJ), WSP(float, WS_SMALL), 1.f / 64.f, ws + WS_MG8};
              pg8::gemm_phase<pg8::EpiProj, pg8::TileMapOrder, true>(lds + RING_OFF, g, S, E, nullptr); } }
        SEAM(pb + 1);
        if (EN_MIX && IN(pb + 2)) {
            TIDS();
            for (int u = bid; u < 1024; u += G) { if (u < 512) ml_prep_unit(l, u >> 7, (u >> 5) & 3, u & 31, lds + RING_OFF, tid); else gla_prep_unit(l, (u - 512) >> 7, (u >> 5) & 3, u & 31, lds + RING_OFF, tid); }
        }
        SEAM(pb + 2);
        if (EN_MIX && IN(pb + 3)) for (int rep_ = 0; rep_ < REP_MIX; ++rep_) {
            if (rep_) __syncthreads();
            TIDS();
            LAS float* fl = (LAS float*)(lds + RING_OFF);
#ifdef PROBE_S
            if (kargs()->li == 1 && bid < 112) {} else
#endif
            if (bid < 112) { if (rep_ == 0 || REP_MIXP) {
            if (bid < 32) { if (EN_ML && (rep_ == 0 || REP_ML)) ml_seq_unit(l, bid >> 3, (bid >> 1) & 3, bid & 1, lds + RING_OFF, tid); }
            else if (bid < 48) { if (EN_GLA && (rep_ == 0 || REP_GLA)) gla_seq_unit(l, (bid - 32) >> 2, bid & 3, lds + RING_OFF, tid); }
            else if (bid < 112) { if (EN_LRU && (rep_ == 0 || REP_LRU)) lru_chunk_unit(l, (bid - 48) >> 4, ((bid - 48) >> 1) & 7, bid & 1, lds + RING_OFF, tid); }
            } }
            else if (rep_ == 0 || REP_MIXS) for (int v = bid - 112; v < 1280; v += G - 112) {
                if (v < 512) { if (EN_ML) ml_unit(l, NP + (v >> 2), v & 3, fl, tid, lane, wave); }
                else if (v < 1024) { if (EN_GLA) gla_unit(l, NP + ((v - 512) >> 2), v & 3, fl, tid, lane, wave); }
                else { if (EN_LRU && v < 1024 + 64) lru_samp_unit(l, (v - 1024) >> 3, v & 7, lds + RING_OFF, tid); }
            }
            if (bid >= 112 && rep_ == 0) {
                __syncthreads();
                CArgs* A = kargs(); LAS float* scr = (LAS float*)(lds + RING_OFF + wave * 16384);
                const float* src = (l == 0 ? A->in[38] : A->in[37]) + (size_t)DFF * D; unsigned char* dst = A->ws + (l == 0 ? WS_WFF2 : WS_WFF1) + (size_t)D * DFF;
                const int sld = l == 0 ? D : DFF, dld = l == 0 ? DFF : D;
                for (int it = (bid - 112) * NWAVES + wave; it < (DFF / 64) * (D / 32); it += (G - 112) * NWAVES) transpose_item_f8(src, sld, sld, dst, dld, 64.f, scr, it, lane);
                __syncthreads(); }
        }
        SEAM(pb + 3);
        if (EN_MERGE && IN(pb + 4)) for (int rg_ = 0; rg_ < REP_MERGE; ++rg_) { CArgs* A = kargs(); unsigned char* const ws = A->ws;
            { pg8::Gemm g{WSP(bf16, WS_YCAT), (const bf16*)(ws + WS_WBR + (size_t)l * D * KBR), MP, D, KBR / 2, KBR / 2, KBR / 2}; pg8::StaticOrder S; S.init(MP, D, G, bid);
              pg8::EpiMergeF8 E{ws + WS_MG8, ws + WS_MERGED, 8.f / 64.f};
              pg8::gemm_phase<pg8::EpiMergeF8, pg8::StaticOrder, true>(lds + RING_OFF, g, S, E, nullptr); }
            { pg8::Gemm g{WSP(bf16, WS_YCAT), (const bf16*)(ws + WS_WBR + (size_t)l * D * KBR), MTOT, D, 512, KBR / 2, KBR / 2}; pg8::SplitOrder S{MP / 256, MS / 256, D / 256, 3, 512, G, bid};
              pg8::EpiGateSlab E{ws + WS_MG8, (bf16*)(ws + WS_GIMG + 64 * MiB), 9, 1.f / 64.f};
              pg8::gemm_phase<pg8::EpiGateSlab, pg8::SplitOrder, true>(lds + RING_OFF, g, S, E, nullptr); } }
        SEAM(pb + 4);
        if (EN_OUT && IN(pb + 5)) for (int rg_ = 0; rg_ < REP_OUT; ++rg_) { CArgs* A = kargs(); unsigned char* const ws = A->ws;
            { TIDS();
              const bf16* sl = (const bf16*)(ws + WS_GIMG + 64 * MiB); unsigned char* mg = ws + WS_MERGED + (size_t)MP * D;
              for (int row = gw; row < MS; row += ngw) { const v2u* s4 = (const v2u*)(sl + (size_t)row * D) + lane;
#pragma unroll
                  for (int j = 0; j < 8; ++j) { const v2u w0 = s4[64 * j], w1 = s4[(size_t)(MS * D / 4) + 64 * j], w2 = s4[(size_t)2 * (MS * D / 4) + 64 * j];
                      const f32x4 v = (f32x4){bflo_(w0.x), bfhi_(w0.x), bflo_(w0.y), bfhi_(w0.y)} + (f32x4){bflo_(w1.x), bfhi_(w1.x), bflo_(w1.y), bfhi_(w1.y)} + (f32x4){bflo_(w2.x), bfhi_(w2.x), bflo_(w2.y), bfhi_(w2.y)};
                      *((unsigned*)(mg + (size_t)row * D) + lane + 64 * j) = pg8::pk4_fp8(8.f * v.x, 8.f * v.y, 8.f * v.z, 8.f * v.w); } } }
            { pg8::Gemm g{WSP(bf16, WS_MERGED), (const bf16*)(ws + WS_WOUT + (size_t)l * D * D), MP, D, D / 2, D / 2, D / 2}; pg8::StaticOrder S; S.init(MP, D, G, bid);
              pg8::EpiResid E{WSP(bf16, WS_XB), WSP(bf16, WS_XA), WSP(float, WS_MOD) + (size_t)l * NADA + 4096, 1.f / 512.f};
              pg8::gemm_phase<pg8::EpiResid, pg8::StaticOrder, true>(lds + RING_OFF, g, S, E, nullptr); }
            { CArgs* Ab = kargs(); XcdBarrier bar; bar.bar = (unsigned*)(Ab->ws + WS_CTL) + CW_BAR + Ab->li * XCD_BAR_WORDS; bar.x = xb_xcc_id(); bar.st = (volatile LAS unsigned*)(lds + MISC_OFF) + 8; xcd_barrier(bar); }
            { pg8::Gemm g{WSP(bf16, WS_MERGED), (const bf16*)(ws + WS_WOUT + (size_t)l * D * D), MTOT, D, D / 8, D / 2, D / 2}; pg8::SplitOrder S{MP / 256, MS / 256, D / 256, 4, D / 8, G, bid};
              pg8::EpiSlab E{WSP(bf16, WS_GIMG), D / 8, 1.f / 512.f};
              pg8::gemm_phase<pg8::EpiSlab, pg8::SplitOrder, true>(lds + RING_OFF, g, S, E, nullptr); } }
        SEAM(pb + 5);
        if (EN_NORM && IN(pb + 6)) { TIDS(); CArgs* A = kargs(); unsigned char* const ws = A->ws;
            norm_rows(WSP(bf16, WS_XA), WSP(bf16, WS_XB) + (size_t)MP * D, false, A->in[14] + (size_t)l * D, WSP(float, WS_MOD) + (size_t)l * NADA + 6144, WSP(bf16, WS_XN), nullptr, nullptr, gw, ngw, lane, nullptr,
                      4, WSP(bf16, WS_GIMG), WSP(float, WS_MOD) + (size_t)l * NADA + 4096, WSP(bf16, WS_XA) + (size_t)MP * D, ws + WS_XN); }
        SEAM(pb + 6);
        if (EN_FF1 && IN(pb + 7)) for (int rg_ = 0; rg_ < REP_FF1; ++rg_) { CArgs* A = kargs(); unsigned char* const ws = A->ws;
            pg8::Gemm g{WSP(bf16, WS_XN), (const bf16*)(ws + WS_WFF1 + (size_t)l * DFF * D), MTOT, DFF, D / 2, D / 2, D / 2}; pg8::StaticOrder S; S.init(MTOT, DFF, G, bid);
            pg8::EpiRelu2F8 E{ws + WS_HFF, DFF, 1.f / 64.f};
            pg8::gemm_phase<pg8::EpiRelu2F8, pg8::StaticOrder, true>(lds + RING_OFF, g, S, E, nullptr); }
        SEAM(pb + 7);
        if (EN_FF2 && IN(pb + 8)) for (int rg_ = 0; rg_ < REP_FF2; ++rg_) { CArgs* A = kargs(); unsigned char* const ws = A->ws;
            { pg8::Gemm g{WSP(bf16, WS_HFF), (const bf16*)(ws + WS_WFF2 + (size_t)l * D * DFF), MP, D, DFF / 2, DFF / 2, DFF / 2}; pg8::StaticOrder S; S.init(MP, D, G, bid);
              pg8::EpiResid E{WSP(bf16, WS_XA), WSP(bf16, WS_XB), WSP(float, WS_MOD) + (size_t)l * NADA + 10240, 1.f / 64.f};
              pg8::gemm_phase<pg8::EpiResid, pg8::StaticOrder, true>(lds + RING_OFF, g, S, E, nullptr); }
            { pg8::Gemm g{WSP(bf16, WS_HFF), (const bf16*)(ws + WS_WFF2 + (size_t)l * D * DFF), MTOT, D, DFF / 32, DFF / 2, DFF / 2}; pg8::SplitOrder S{MP / 256, MS / 256, D / 256, 16, DFF / 32, G, bid};
              pg8::EpiSlab E{WSP(bf16, WS_GIMG), DFF / 32, 1.f / 64.f};
              pg8::gemm_phase<pg8::EpiSlab, pg8::SplitOrder, true>(lds + RING_OFF, g, S, E, nullptr); } }
        SEAM(pb + 8);
    }
    if (EN_NORM && IN(20)) { TIDS(); CArgs* A = kargs(); unsigned char* const ws = A->ws;
        norm_rows(WSP(bf16, WS_XB), WSP(bf16, WS_XA) + (size_t)MP * D, false, A->in[39], nullptr, nullptr, A->out + O_YP, A->out + O_YS, gw, ngw, lane, nullptr,
                  16, WSP(bf16, WS_GIMG), WSP(float, WS_MOD) + (size_t)(DEPTH - 1) * NADA + 10240, WSP(bf16, WS_XB) + (size_t)MP * D); }
#undef IN
#undef SEAM
}

extern "C" void kernel_launch(void* const* d_in, const int* in_sizes, int n_in, void* d_out, int out_size, void* d_ws, size_t ws_size, hipStream_t stream) {
    static int grid = 0;
    if (grid == 0) {
        if (n_in != 40 || (size_t)out_size != O_END || ws_size < WS_END) { fprintf(stderr, "kernel_launch: unexpected shapes (n_in %d, out %d, ws %zu); nothing launched\n", n_in, out_size, ws_size); grid = -1; return; }
        if (hipFuncSetAttribute((const void*)mk_fwd, hipFuncAttributeMaxDynamicSharedMemorySize, LDS_BYTES) != hipSuccess) { fprintf(stderr, "kernel_launch: hipFuncSetAttribute failed\n"); grid = -1; return; }
        int per_cu = 0;
        if (hipOccupancyMaxActiveBlocksPerMultiprocessor(&per_cu, (const void*)mk_fwd, NTHREADS, LDS_BYTES) != hipSuccess || per_cu < 1)
            fprintf(stderr, "kernel_launch: note: occupancy query reports %d workgroups per CU\n", per_cu);
        (void)hipGetLastError();
        grid = GRID;
    }
    if (grid < 0) return;
    if (hipMemsetAsync((char*)d_ws + WS_CTL, 0, CTL_ZERO_BYTES, stream) != hipSuccess) { fprintf(stderr, "kernel_launch: hipMemsetAsync failed\n"); return; }
    Args a{};
    for (int i = 0; i < 40; ++i) a.in[i] = (const float*)d_in[i];
    a.out = (float*)d_out; a.ws = (unsigned char*)d_ws; a.pad = 0;
#ifndef PROBE_P
#define PROBE_P -1
#endif
#ifndef PROBE_G
#define PROBE_G 256
#endif
    int n_l = 0, lo_[4], hi_[4], fl_[4];
    if (N_LAUNCHES != 1) { for (int li = 0; li < PH_TOTAL; ++li) { a.ph_lo = li; a.ph_hi = li + 1; a.li = 0; a.pad = 0; hipLaunchKernelGGL(mk_fwd, dim3(grid), dim3(NTHREADS), LDS_BYTES, stream, a); } return; }
    if (PROBE_P < 0) { lo_[0] = 0; hi_[0] = PH_TOTAL; fl_[0] = grid; n_l = 1; }
#ifndef PROBE_Q
#define PROBE_Q PROBE_P
#endif
#ifdef PROBE_ABL
    else { lo_[0] = 0; hi_[0] = PROBE_P; fl_[0] = grid; lo_[1] = PROBE_P; hi_[1] = PROBE_Q + 1; fl_[1] = PROBE_G; lo_[2] = PROBE_P; hi_[2] = PH_TOTAL; fl_[2] = grid; n_l = 3; }
#else
    else { lo_[0] = 0; hi_[0] = PROBE_Q + 1; fl_[0] = grid; lo_[1] = PROBE_P; hi_[1] = PROBE_Q + 1; fl_[1] = PROBE_G; lo_[2] = PROBE_Q + 1; hi_[2] = PH_TOTAL; fl_[2] = grid; n_l = 3; }
#endif
    for (int li = 0; li < n_l; ++li) {
        a.ph_lo = lo_[li]; a.ph_hi = hi_[li]; a.li = li; a.pad = 0;
        hipLaunchKernelGGL(mk_fwd, dim3(fl_[li]), dim3(NTHREADS), LDS_BYTES, stream, a);
        const hipError_t le = hipPeekAtLastError();
        if (le != hipSuccess) { fprintf(stderr, "kernel_launch: launch %d failed: %s\n", li, hipGetErrorName(le)); break; }
    }
}
```

```cpp
#include <hip/hip_runtime.h>
#include <cstdio>
#include <cstdint>

constexpr int D = 2048, DEPTH = 2;
constexpr int NP = 4, TP = 2048, NS = 128, TS = 4;
constexpr int MP = NP * TP, MS = NS * TS, MTOT = MP + MS;
constexpr int NB = NP + NS;
constexpr int DIN = 12312, NPROJ = 12288, NPROJ_PAD = 12544, NSMALL = 24;
constexpr int PPITCH = 6144;
constexpr int C_LRUX = 0, C_GQ = 1024, C_GK = 1536, C_GV = 2048, C_GGATE = 3072, C_MX = 4096, C_MO = 5120, C_MG = 6144;
constexpr int DFF = 8192, NADA = 12288, KBR = 3072;
constexpr float EPS = 1e-6f;
#define MK_N_LAUNCHES 1
namespace pg8 {
#define PG8_LAS __attribute__((address_space(3)))
typedef unsigned short bf16_t;
typedef short bf16x8 __attribute__((ext_vector_type(8)));
typedef float f32x4 __attribute__((ext_vector_type(4)));
typedef unsigned u32x4 __attribute__((ext_vector_type(4)));
constexpr int BM = 256, BK = 64, HALF = 128, HTB = HALF * BK * 2  , STAGE_BYTES = 8 * HTB, NXCD = 8, WGM = 8;

__host__ __device__ __forceinline__ int lds_byte(int r, int c) { const int st = (r >> 4) * 2 + (c >> 5), rr = r & 15, cc = c & 31, ob = rr * 64 + cc * 2; return st * 1024 + (ob ^ (((ob >> 9) & 1) << 5)); }
__host__ __device__ __forceinline__ void stage_rc(int b, int& R, int& C) { const int st = b / 1024, sb = b % 1024, swz = sb ^ (((sb >> 9) & 1) << 5); R = (st >> 1) * 16 + swz / 64; C = (st & 1) * 32 + (swz % 64) / 2; }
__host__ __device__ __forceinline__ int perm32(int rho) { const int n = rho >> 4, i = rho & 15; return 8 * (i >> 2) + 4 * n + (i & 3); }

struct Unit { int pm, pn, koff; };
struct Gemm { const bf16_t* A; const bf16_t* Bt; int M, N, K, lda, ldb; };

struct StaticOrder {
    int nM, nN, nwg, G, c;
    __host__ __device__ void init(int M, int N, int G_, int c_) { nM = M / BM; nN = N / BM; nwg = nM * nN; G = G_; c = c_; }
    __host__ __device__ bool next(int i, Unit& u) const { return at((long)i * G + c, u); }
    __host__ __device__ bool at(long L, Unit& u) const {
        if (L >= nwg) return false;
        int wgid = (int)L; { const int q = nwg / NXCD, r = nwg % NXCD, xcd = wgid % NXCD, off = wgid / NXCD; wgid = (xcd < r ? xcd * (q + 1) : r * (q + 1) + (xcd - r) * q) + off; }
        const int nig = WGM * nN, gid = wgid / nig, fm = gid * WGM, gsz = (nM - fm) < WGM ? (nM - fm) : WGM;
        u.pm = fm + ((wgid % nig) % gsz); u.pn = (wgid % nig) / gsz; u.koff = 0; return true;
    }
    __device__ __forceinline__ void a_ready(const Unit&) const {}
    __device__ __forceinline__ void done(const Unit&) const {}
};
struct SplitOrder {
    int pm0, npm, nN, split, ksub, G, c;
    __device__ __forceinline__ bool next(int i, Unit& u) const {
        const int L = i * G + c, nt = npm * nN; if (L >= nt * split) return false;
        const int tile = L % nt, ks = L / nt; u.pm = pm0 + tile / nN; u.pn = tile % nN; u.koff = ks * ksub; return true;
    }
    __device__ __forceinline__ void a_ready(const Unit&) const {}
    __device__ __forceinline__ void done(const Unit&) const {}
};
struct TileMapOrder {
    StaticOrder so; int t1, t2, s0, s1, s2; int nh = 0, sk = 0;
    __device__ __forceinline__ bool next(int i, Unit& u) const {
        const int gl = so.G - nh, lt = (int)(so.c >= nh), early = lt * (int)(i < sk);
        const long L = early ? (long)i * gl + (so.c - nh) : (long)sk * gl + (long)(i - lt * sk) * so.G + so.c;
        if (!so.at(L, u)) return false; u.pn += s0 + (int)(u.pn >= t1) * (s1 - s0) + (int)(u.pn >= t2) * (s2 - s1); return true; }
    __device__ __forceinline__ void a_ready(const Unit&) const {}
    __device__ __forceinline__ void done(const Unit&) const {}
};


__device__ __forceinline__ unsigned cvt_pk_bf16(float lo, float hi) { unsigned r; asm volatile("v_cvt_pk_bf16_f32 %0, %1, %2" : "=v"(r) : "v"(lo), "v"(hi)); return r; }
typedef float f32x2 __attribute__((ext_vector_type(2)));
typedef int i32x4 __attribute__((ext_vector_type(4)));
typedef int i32x8 __attribute__((ext_vector_type(8)));
__device__ __forceinline__ unsigned pk4_fp8(float a, float b, float c, float d) { int w = __builtin_amdgcn_cvt_pk_fp8_f32(a, b, 0, false); w = __builtin_amdgcn_cvt_pk_fp8_f32(c, d, w, true); return (unsigned)w; }
__device__ __forceinline__ float bflo(unsigned w) { return __uint_as_float(w << 16); }
__device__ __forceinline__ float bfhi(unsigned w) { return __uint_as_float(w & 0xffff0000u); }

#define PG8_COORDS() int tz_ = threadIdx.x; asm volatile("" : "+v"(tz_)); const int wid_ = __builtin_amdgcn_readfirstlane(tz_ >> 6); \
    const int wr = wid_ >> 2, wc = wid_ & 3, fr = tz_ & 15, fq = (tz_ & 63) >> 4

struct EpiF32 {
    static constexpr bool PERM = false, AFTER_DRAIN = false; static constexpr int NMID = 0, MID1 = -1, MID2 = -1;
    float* C; int ldc; const float* bias;
    __device__ __forceinline__ void operator()(const f32x4 (&acc)[2][2][4][2], const Unit& u, int, int, int, int) const {
        PG8_COORDS();
        const int row0 = u.pm * BM + wr * 64 + fr, col0 = u.pn * BM + wc * 32 + 4 * fq;
        f32x4 bv[2][2];
#pragma unroll
        for (int bj = 0; bj < 2; ++bj)
#pragma unroll
            for (int n = 0; n < 2; ++n) bv[bj][n] = bias ? *(const f32x4*)(bias + col0 + bj * HALF + n * 16) : (f32x4){0.f, 0.f, 0.f, 0.f};
#pragma unroll
        for (int ai = 0; ai < 2; ++ai)
#pragma unroll
            for (int m = 0; m < 4; ++m) { float* rowp = C + (size_t)(row0 + ai * HALF + m * 16) * ldc + col0;
#pragma unroll
                for (int bj = 0; bj < 2; ++bj)
#pragma unroll
                    for (int n = 0; n < 2; ++n) *(f32x4*)(rowp + bj * HALF + n * 16) = acc[ai][bj][m][n] + bv[bj][n]; }
    }
    __device__ __forceinline__ void mid(f32x4 (&)[2][2][4][2], const Unit&, int, int, int, int, int) const {}
};

struct EpiProj {
    static constexpr bool PERM = true, AFTER_DRAIN = false; static constexpr int NMID = 0, MID1 = -1, MID2 = -1;
    bf16_t* O; float* sm; float ascale; unsigned char* mg8;
    __device__ __forceinline__ void operator()(const f32x4 (&acc)[2][2][4][2], const Unit& u, int, int, int, int) const {
        PG8_COORDS();
        const int row0 = u.pm * BM + wr * 64 + fr;
        if (u.pn < 24) {
            const int col0 = u.pn * BM + wc * 32 + 8 * fq;
#pragma unroll
            for (int ai = 0; ai < 2; ++ai)
#pragma unroll
                for (int m = 0; m < 4; ++m) { bf16_t* rowp = O + (size_t)(row0 + ai * HALF + m * 16) * 6144 + col0;
#pragma unroll
                    for (int bj = 0; bj < 2; ++bj) { const f32x4 v0 = acc[ai][bj][m][0] * ascale, v1 = acc[ai][bj][m][1] * ascale;
                        u32x4 w; w.x = cvt_pk_bf16(v0[0], v0[1]); w.y = cvt_pk_bf16(v0[2], v0[3]); w.z = cvt_pk_bf16(v1[0], v1[1]); w.w = cvt_pk_bf16(v1[2], v1[3]);
                        *(u32x4*)(rowp + bj * HALF) = w; } }
        } else if (u.pn < 48) {
            const int col0 = (u.pn - 24) * BM + wc * 32 + 8 * fq;
#pragma unroll
            for (int ai = 0; ai < 2; ++ai)
#pragma unroll
                for (int m = 0; m < 4; ++m) { unsigned char* rowp = mg8 + (size_t)(row0 + ai * HALF + m * 16) * 6144 + col0;
#pragma unroll
                    for (int bj = 0; bj < 2; ++bj) { const f32x4 v0 = acc[ai][bj][m][0] * ascale, v1 = acc[ai][bj][m][1] * ascale;
                        *(unsigned long long*)(rowp + bj * HALF) = (unsigned long long)pk4_fp8(v0[0], v0[1], v0[2], v0[3]) | ((unsigned long long)pk4_fp8(v1[0], v1[1], v1[2], v1[3]) << 32); } }
        } else {
#pragma unroll
            for (int ai = 0; ai < 2; ++ai)
#pragma unroll
                for (int m = 0; m < 4; ++m) { float* rowp = sm + (size_t)(row0 + ai * HALF + m * 16) * 24;
#pragma unroll
                    for (int n = 0; n < 2; ++n) { const int c = wc * 32 + 8 * fq + 4 * n;
                        if (c < 24) *(f32x4*)(rowp + c) = acc[ai][0][m][n]; } }
        }
    }
    __device__ __forceinline__ void mid(f32x4 (&)[2][2][4][2], const Unit&, int, int, int, int, int) const {}
};

template <int M1, int M2> struct EpiMergeT {
    static constexpr bool PERM = true, AFTER_DRAIN = false; static constexpr int NMID = 2, MID1 = M1, MID2 = M2;
    const unsigned char* proj; unsigned char* O; float ascale;
    static __device__ __forceinline__ void ld8(const unsigned char* p, float (&z)[8]) { const unsigned long long w = *(const unsigned long long*)p; const int lo = (int)(unsigned)w, hi = (int)(unsigned)(w >> 32);
        const f32x2 a = __builtin_amdgcn_cvt_pk_f32_fp8(lo, false), b = __builtin_amdgcn_cvt_pk_f32_fp8(lo, true), c = __builtin_amdgcn_cvt_pk_f32_fp8(hi, false), d = __builtin_amdgcn_cvt_pk_f32_fp8(hi, true);
        z[0] = a[0]; z[1] = a[1]; z[2] = b[0]; z[3] = b[1]; z[4] = c[0]; z[5] = c[1]; z[6] = d[0]; z[7] = d[1]; }
    static __device__ __forceinline__ float en(float z) { z = fminf(fmaxf(z, -30.f), 30.f); return __expf(-z); }
    __device__ __forceinline__ void mid(f32x4 (&acc)[2][2][4][2], const Unit& u, int t, int, int, int, int) const {
        PG8_COORDS();
        const int b = (t == MID1) ? 0 : 1;
        int row0 = u.pm * BM + wr * 64 + fr, col0 = u.pn * BM + wc * 32 + 8 * fq;
        asm volatile("" : "+v"(row0), "+v"(col0));
#pragma unroll
        for (int ai = 0; ai < 2; ++ai)
#pragma unroll
            for (int m = 0; m < 4; ++m) { const unsigned char* rowp = proj + (size_t)(row0 + ai * HALF + m * 16) * 6144 + 2048 * b + col0;
#pragma unroll
                for (int bj = 0; bj < 2; ++bj) { float za[8], zb[8]; ld8(rowp + bj * HALF, za); ld8(rowp + 2048 + bj * HALF, zb);
#pragma unroll
                    for (int j = 0; j < 8; ++j) { const float r = (1.f + en(zb[j])) / (1.f + en(za[j]));
                        acc[ai][bj][m][j >> 2][j & 3] *= r; } }
                asm volatile("" ::: "memory"); }
    }
    __device__ __forceinline__ void operator()(const f32x4 (&acc)[2][2][4][2], const Unit& u, int, int, int, int) const {
        PG8_COORDS();
        const int row0 = u.pm * BM + wr * 64 + fr, col0 = u.pn * BM + wc * 32 + 8 * fq;
#pragma unroll
        for (int ai = 0; ai < 2; ++ai)
#pragma unroll
            for (int m = 0; m < 4; ++m) { const size_t r = (size_t)(row0 + ai * HALF + m * 16); const unsigned char* gp = proj + r * 6144 + 4096 + col0; unsigned char* op = O + r * 2048 + col0;
#pragma unroll
                for (int bj = 0; bj < 2; ++bj) { float z[8], v[8]; ld8(gp + bj * HALF, z);
#pragma unroll
                    for (int j = 0; j < 8; ++j) v[j] = acc[ai][bj][m][j >> 2][j & 3] * ascale / (1.f + en(z[j]));
                    *(unsigned long long*)(op + bj * HALF) = (unsigned long long)pk4_fp8(v[0], v[1], v[2], v[3]) | ((unsigned long long)pk4_fp8(v[4], v[5], v[6], v[7]) << 32); }
                asm volatile("" ::: "memory"); }
    }
};

typedef EpiMergeT<16, 32> EpiMerge;
typedef EpiMergeT<8, 16> EpiMergeF8;

struct EpiResid {
    static constexpr bool PERM = false, AFTER_DRAIN = false; static constexpr int NMID = 0, MID1 = -1, MID2 = -1;
    const bf16_t* base; bf16_t* out; const float* gate; float ascale;
    __device__ __forceinline__ void operator()(const f32x4 (&acc)[2][2][4][2], const Unit& u, int, int, int, int) const {
        PG8_COORDS();
        const int row0 = u.pm * BM + wr * 64 + fr, col0 = u.pn * BM + wc * 32 + 4 * fq;
#pragma unroll
        for (int ai = 0; ai < 2; ++ai)
#pragma unroll
            for (int m = 0; m < 4; ++m) { const int row = row0 + ai * HALF + m * 16;
                const int cond = row < 8192 ? (row >> 11) : 4 + ((row - 8192) >> 2);
                const bf16_t* bp = base + (size_t)row * 2048 + col0; const float* gp = gate + (size_t)cond * 24576 + col0; bf16_t* op = out + (size_t)row * 2048 + col0;
#pragma unroll
                for (int bj = 0; bj < 2; ++bj)
#pragma unroll
                    for (int n = 0; n < 2; ++n) { const unsigned long long bw = *(const unsigned long long*)(bp + bj * HALF + n * 16); const unsigned b0 = (unsigned)bw, b1 = (unsigned)(bw >> 32);
                        const f32x4 bs = {bflo(b0), bfhi(b0), bflo(b1), bfhi(b1)}, gt = *(const f32x4*)(gp + bj * HALF + n * 16);
                        const f32x4 v = bs + gt * (acc[ai][bj][m][n] * ascale);
                        *(unsigned long long*)(op + bj * HALF + n * 16) = (unsigned long long)cvt_pk_bf16(v[0], v[1]) | ((unsigned long long)cvt_pk_bf16(v[2], v[3]) << 32); }
                asm volatile("" ::: "memory"); }
    }
    __device__ __forceinline__ void mid(f32x4 (&)[2][2][4][2], const Unit&, int, int, int, int, int) const {}
};

struct EpiSlab {
    static constexpr bool PERM = false, AFTER_DRAIN = false; static constexpr int NMID = 0, MID1 = -1, MID2 = -1;
    bf16_t* slab; int ksub; float ascale;
    __device__ __forceinline__ void operator()(const f32x4 (&acc)[2][2][4][2], const Unit& u, int, int, int, int) const {
        PG8_COORDS();
        const int row0 = u.pm * BM + wr * 64 + fr - 8192, col0 = u.pn * BM + wc * 32 + 4 * fq; bf16_t* sl = slab + (size_t)(u.koff / ksub) * 512 * 2048;
#pragma unroll
        for (int ai = 0; ai < 2; ++ai)
#pragma unroll
            for (int m = 0; m < 4; ++m) { bf16_t* op = sl + (size_t)(row0 + ai * HALF + m * 16) * 2048 + col0;
#pragma unroll
                for (int bj = 0; bj < 2; ++bj)
#pragma unroll
                    for (int n = 0; n < 2; ++n) { const f32x4 v = acc[ai][bj][m][n] * ascale; *(unsigned long long*)(op + bj * HALF + n * 16) = (unsigned long long)cvt_pk_bf16(v[0], v[1]) | ((unsigned long long)cvt_pk_bf16(v[2], v[3]) << 32); } }
    }
    __device__ __forceinline__ void mid(f32x4 (&)[2][2][4][2], const Unit&, int, int, int, int, int) const {}
};

struct EpiGateSlab {
    static constexpr bool PERM = false, AFTER_DRAIN = false; static constexpr int NMID = 0, MID1 = -1, MID2 = -1;
    const unsigned char* proj; bf16_t* slab; int kshift; float ascale;
    __device__ __forceinline__ void operator()(const f32x4 (&acc)[2][2][4][2], const Unit& u, int, int, int, int) const {
        PG8_COORDS();
        const int b = u.koff >> kshift, row0 = u.pm * BM + wr * 64 + fr, col0 = u.pn * BM + wc * 32 + 4 * fq; bf16_t* sl = slab + (size_t)b * 512 * 2048;
#pragma unroll
        for (int ai = 0; ai < 2; ++ai)
#pragma unroll
            for (int m = 0; m < 4; ++m) { const int row = row0 + ai * HALF + m * 16; const unsigned char* gp = proj + (size_t)row * 6144 + 2048 * b + col0; bf16_t* op = sl + (size_t)(row - 8192) * 2048 + col0;
#pragma unroll
                for (int bj = 0; bj < 2; ++bj)
#pragma unroll
                    for (int n = 0; n < 2; ++n) { const int gw = (int)*(const unsigned*)(gp + bj * HALF + n * 16); const f32x2 ga = __builtin_amdgcn_cvt_pk_f32_fp8(gw, false), gb = __builtin_amdgcn_cvt_pk_f32_fp8(gw, true);
                        f32x4 v = acc[ai][bj][m][n] * ascale;
                        v[0] /= 1.f + EpiMerge::en(ga[0]); v[1] /= 1.f + EpiMerge::en(ga[1]); v[2] /= 1.f + EpiMerge::en(gb[0]); v[3] /= 1.f + EpiMerge::en(gb[1]);
                        *(unsigned long long*)(op + bj * HALF + n * 16) = (unsigned long long)cvt_pk_bf16(v[0], v[1]) | ((unsigned long long)cvt_pk_bf16(v[2], v[3]) << 32); }
                asm volatile("" ::: "memory"); }
    }
    __device__ __forceinline__ void mid(f32x4 (&)[2][2][4][2], const Unit&, int, int, int, int, int) const {}
};

struct EpiRelu2 {
    static constexpr bool PERM = true, AFTER_DRAIN = false; static constexpr int NMID = 0, MID1 = -1, MID2 = -1;
    bf16_t* O; int ldc;
    __device__ __forceinline__ void operator()(const f32x4 (&acc)[2][2][4][2], const Unit& u, int, int, int, int) const {
        PG8_COORDS();
        const int row0 = u.pm * BM + wr * 64 + fr, col0 = u.pn * BM + wc * 32 + 8 * fq;
#pragma unroll
        for (int ai = 0; ai < 2; ++ai)
#pragma unroll
            for (int m = 0; m < 4; ++m) { bf16_t* rowp = O + (size_t)(row0 + ai * HALF + m * 16) * ldc + col0;
#pragma unroll
                for (int bj = 0; bj < 2; ++bj) { f32x4 v0 = acc[ai][bj][m][0], v1 = acc[ai][bj][m][1];
#pragma unroll
                    for (int j = 0; j < 4; ++j) { const float a = fmaxf(v0[j], 0.f), b = fmaxf(v1[j], 0.f); v0[j] = a * a; v1[j] = b * b; }
                    u32x4 w; w.x = cvt_pk_bf16(v0[0], v0[1]); w.y = cvt_pk_bf16(v0[2], v0[3]); w.z = cvt_pk_bf16(v1[0], v1[1]); w.w = cvt_pk_bf16(v1[2], v1[3]);
                    *(u32x4*)(rowp + bj * HALF) = w; } }
    }
    __device__ __forceinline__ void mid(f32x4 (&)[2][2][4][2], const Unit&, int, int, int, int, int) const {}
};


struct EpiRelu2F8 {
    static constexpr bool PERM = true, AFTER_DRAIN = false; static constexpr int NMID = 0, MID1 = -1, MID2 = -1;
    unsigned char* O; int ldc; float ascale;
    __device__ __forceinline__ void operator()(const f32x4 (&acc)[2][2][4][2], const Unit& u, int, int, int, int) const {
        PG8_COORDS();
        const int row0 = u.pm * BM + wr * 64 + fr, col0 = u.pn * BM + wc * 32 + 8 * fq;
#pragma unroll
        for (int ai = 0; ai < 2; ++ai)
#pragma unroll
            for (int m = 0; m < 4; ++m) { unsigned char* rowp = O + (size_t)(row0 + ai * HALF + m * 16) * ldc + col0;
#pragma unroll
                for (int bj = 0; bj < 2; ++bj) { f32x4 v0 = acc[ai][bj][m][0], v1 = acc[ai][bj][m][1];
#pragma unroll
                    for (int j = 0; j < 4; ++j) { const float a = fmaxf(v0[j] * ascale, 0.f), b = fmaxf(v1[j] * ascale, 0.f); v0[j] = a * a; v1[j] = b * b; }
                    unsigned long long w = (unsigned long long)pk4_fp8(v0[0], v0[1], v0[2], v0[3]) | ((unsigned long long)pk4_fp8(v1[0], v1[1], v1[2], v1[3]) << 32);
                    *(unsigned long long*)(rowp + bj * HALF) = w; } }
    }
    __device__ __forceinline__ void mid(f32x4 (&)[2][2][4][2], const Unit&, int, int, int, int, int) const {}
};
template <class Epi, class Sched, bool FP8 = false, bool STAMP = false>
__device__ __forceinline__ void gemm_phase(PG8_LAS unsigned char* lds, const Gemm g, const Sched& S, const Epi& E, unsigned long long* stamps) {
    int tid_ = threadIdx.x; asm volatile("" : "+v"(tid_));
    const int tid = tid_, wid = __builtin_amdgcn_readfirstlane(tid >> 6), lane = tid & 63, wr = wid >> 2, wc = wid & 3, fr = lane & 15, fq = lane >> 4;
    const int K = g.K, nt = K / BK;
    int ts_lo = 0, ts_hi = 0, nts = 0; const unsigned long long rt_entry = STAMP ? (unsigned long long)wall_clock64() : 0ull;
#define PG8_STAMP() do { if (STAMP && wid == 0 && nts < 64) { const unsigned long long _c = (unsigned long long)clock64(); \
        ts_lo = (lane == nts) ? (int)(unsigned)_c : ts_lo; ts_hi = (lane == nts) ? (int)(unsigned)(_c >> 32) : ts_hi; ++nts; } } while (0)
    PG8_STAMP();
    unsigned voffA[2], voffB[2];
#pragma unroll
    for (int i = 0; i < 2; ++i) { int R, C; stage_rc(tid * 16 + i * 8192, R, C); const int Rb = Epi::PERM ? ((R & ~31) + perm32(R & 31)) : R;
        voffA[i] = (unsigned)(R * g.lda + C) * 2u; voffB[i] = (unsigned)(Rb * g.ldb + C) * 2u; }
    const size_t kstep = (size_t)(BK * 2);
    const size_t hstepA = (size_t)HALF * g.lda * 2, hstepB = (size_t)HALF * g.ldb * 2;
    const size_t tstepA = 2 * hstepA, tstepB = 2 * hstepB;
    const unsigned ldsw = (unsigned)wid * 1024u;
    const int aoff = lds_byte(wr * 64 + fr, fq * 8), boff = lds_byte(wc * 32 + fr, fq * 8);
#define PG8_SA(b, h) (((b) * 2 + (h)) * HTB)
#define PG8_SB(b, h) ((4 + (b) * 2 + (h)) * HTB)
#define PG8_STAGE(bufoff, gbase, voff) do { _Pragma("unroll") for (int _i = 0; _i < 2; ++_i) \
        __builtin_amdgcn_global_load_lds((const unsigned*)((const char*)(gbase) + (voff)[_i]), (PG8_LAS unsigned*)(lds + (bufoff) + ldsw + _i * 8192), 16, 0, 0); } while (0)
#define PG8_LDA(dst, b, h) do { _Pragma("unroll") for (int m = 0; m < 4; ++m) { \
        if constexpr (FP8) { const i32x4 lo_ = *(const PG8_LAS i32x4*)(lds + PG8_SA(b, h) + aoff + m * 2048), hi_ = *(const PG8_LAS i32x4*)(lds + PG8_SA(b, h) + aoff + m * 2048 + 1024); dst##8[m] = __builtin_shufflevector(lo_, hi_, 0, 1, 2, 3, 4, 5, 6, 7); } \
        else { _Pragma("unroll") for (int k = 0; k < 2; ++k) dst[m][k] = *(const PG8_LAS bf16x8*)(lds + PG8_SA(b, h) + aoff + m * 2048 + k * 1024); } } } while (0)
#define PG8_LDB(dst, b, h) do { _Pragma("unroll") for (int n = 0; n < 2; ++n) { \
        if constexpr (FP8) { const i32x4 lo_ = *(const PG8_LAS i32x4*)(lds + PG8_SB(b, h) + boff + n * 2048), hi_ = *(const PG8_LAS i32x4*)(lds + PG8_SB(b, h) + boff + n * 2048 + 1024); dst##8[n] = __builtin_shufflevector(lo_, hi_, 0, 1, 2, 3, 4, 5, 6, 7); } \
        else { _Pragma("unroll") for (int k = 0; k < 2; ++k) dst[n][k] = *(const PG8_LAS bf16x8*)(lds + PG8_SB(b, h) + boff + n * 2048 + k * 1024); } } } while (0)
#define PG8_MMA(ai, bj, At, Bt) do { __builtin_amdgcn_s_setprio(1); _Pragma("unroll") for (int m = 0; m < 4; ++m) _Pragma("unroll") for (int n = 0; n < 2; ++n) { \
        if constexpr (FP8) asm volatile("v_mfma_scale_f32_16x16x128_f8f6f4 %0, %1, %2, %0, %3, %3 op_sel_hi:[0,0,0]" : "+v"(acc[ai][bj][m][n]) : "v"(Bt##8[n]), "v"(At##8[m]), "v"(one_scale)); \
        else { _Pragma("unroll") for (int k = 0; k < 2; ++k) acc[ai][bj][m][n] = __builtin_amdgcn_mfma_f32_16x16x32_bf16(Bt[n][k], At[m][k], acc[ai][bj][m][n], 0, 0, 0); } } \
        __builtin_amdgcn_s_setprio(0); } while (0)
#define PG8_WAIT_V(n) asm volatile("s_waitcnt vmcnt(" #n ")" ::: "memory")
#define PG8_WAIT_L(n) asm volatile("s_waitcnt lgkmcnt(" #n ")" ::: "memory")
#define PG8_BAR __builtin_amdgcn_s_barrier()
#define PG8_SCHED __builtin_amdgcn_sched_barrier(0)
    Unit cur, nxt; int ui = 0;
    if (!S.next(0, cur)) return;
    f32x4 acc[2][2][4][2];
#pragma unroll
    for (int a = 0; a < 2; ++a)
#pragma unroll
        for (int b = 0; b < 2; ++b)
#pragma unroll
            for (int m = 0; m < 4; ++m)
#pragma unroll
                for (int n = 0; n < 2; ++n) acc[a][b][m][n] = (f32x4){0.f, 0.f, 0.f, 0.f};
    bf16x8 At[4][2], B0[2][2], B1[2][2]; i32x8 At8[4], B08[2], B18[2]; const int one_scale = 0x7f7f7f7f;
    const char* cA = (const char*)g.A + (size_t)cur.pm * tstepA + (size_t)cur.koff * 2; const char* cB = (const char*)g.Bt + (size_t)cur.pn * tstepB + (size_t)cur.koff * 2;
    S.a_ready(cur);
    PG8_STAGE(PG8_SB(0, 0), cB, voffB); PG8_STAGE(PG8_SA(0, 0), cA, voffA); PG8_STAGE(PG8_SB(0, 1), cB + hstepB, voffB); PG8_STAGE(PG8_SA(0, 1), cA + hstepA, voffA);
    if (wr == 1) PG8_BAR;
    PG8_WAIT_V(4); PG8_BAR;
    PG8_STAGE(PG8_SB(1, 0), cB + kstep, voffB); PG8_STAGE(PG8_SA(1, 0), cA + kstep, voffA); PG8_STAGE(PG8_SB(1, 1), cB + hstepB + kstep, voffB);
    PG8_WAIT_V(6); PG8_BAR;
    PG8_STAMP();
    for (;;) {
        const bool has_next = S.next(ui + 1, nxt);
        const char* nA = has_next ? (const char*)g.A + (size_t)nxt.pm * tstepA + (size_t)nxt.koff * 2 : cA; const char* nB = has_next ? (const char*)g.Bt + (size_t)nxt.pn * tstepB + (size_t)nxt.koff * 2 : cB;
        for (int t = 0; t < nt; t += 2) {
            const bool last = (t == nt - 2);
            const char* a1 = cA + (size_t)(t + 1) * kstep;
            const char* a2 = last ? nA : cA + (size_t)(t + 2) * kstep; const char* b2 = last ? nB : cB + (size_t)(t + 2) * kstep;
            const char* a3 = a2 + kstep; const char* b3 = b2 + kstep;
            if (last && has_next) S.a_ready(nxt);
            if constexpr (Epi::NMID > 0) { if (t == Epi::MID1 || t == Epi::MID2) E.mid(acc, cur, t, wr, wc, fr, fq); }
            PG8_LDB(B0, 0, 0); PG8_SCHED; PG8_LDA(At, 0, 0); PG8_STAGE(PG8_SA(1, 1), a1 + hstepA, voffA);
            PG8_WAIT_L(8); PG8_BAR; PG8_WAIT_L(0); PG8_MMA(0, 0, At, B0); PG8_BAR; PG8_SCHED;
            PG8_LDB(B1, 0, 1); PG8_STAGE(PG8_SB(0, 0), b2, voffB);
            PG8_BAR; PG8_WAIT_L(0); PG8_MMA(0, 1, At, B1); PG8_BAR;
            PG8_LDA(At, 0, 1); PG8_STAGE(PG8_SA(0, 0), a2, voffA);
            PG8_BAR; PG8_WAIT_L(0); PG8_MMA(1, 0, At, B0); PG8_BAR; PG8_SCHED;
            PG8_STAGE(PG8_SB(0, 1), b2 + hstepB, voffB);
            PG8_WAIT_V(6); PG8_BAR; PG8_MMA(1, 1, At, B1); PG8_BAR;
            PG8_LDB(B0, 1, 0); PG8_SCHED; PG8_LDA(At, 1, 0); PG8_STAGE(PG8_SA(0, 1), a2 + hstepA, voffA);
            PG8_WAIT_L(8); PG8_BAR; PG8_WAIT_L(0); PG8_MMA(0, 0, At, B0); PG8_BAR; PG8_SCHED;
            PG8_LDB(B1, 1, 1); PG8_STAGE(PG8_SB(1, 0), b3, voffB);
            PG8_BAR; PG8_WAIT_L(0); PG8_MMA(0, 1, At, B1); PG8_BAR;
            PG8_LDA(At, 1, 1); PG8_STAGE(PG8_SA(1, 0), a3, voffA);
            PG8_BAR; PG8_WAIT_L(0); PG8_MMA(1, 0, At, B0); PG8_BAR; PG8_SCHED;
            PG8_STAGE(PG8_SB(1, 1), b3 + hstepB, voffB);
            PG8_WAIT_V(6); PG8_BAR; PG8_MMA(1, 1, At, B1); PG8_BAR;
        }
        PG8_STAMP();
        if constexpr (FP8) asm volatile("s_nop 15\n\ts_nop 15" ::: "memory");
        if constexpr (!Epi::AFTER_DRAIN) { E(acc, cur, wr, wc, fr, fq); S.done(cur); }
        PG8_STAMP();
        if (!has_next) break;
#pragma unroll
        for (int a = 0; a < 2; ++a)
#pragma unroll
            for (int b = 0; b < 2; ++b)
#pragma unroll
                for (int m = 0; m < 4; ++m)
#pragma unroll
                    for (int n = 0; n < 2; ++n) acc[a][b][m][n] = (f32x4){0.f, 0.f, 0.f, 0.f};
        cur = nxt; cA = nA; cB = nB; ++ui;
    }
    PG8_WAIT_V(0);
    if (wr == 0) PG8_BAR;
    PG8_BAR;
    if constexpr (Epi::AFTER_DRAIN) { E.fused(acc, cur, wr, wc, fr, fq, lds, wid, lane); S.done(cur); }
    PG8_STAMP();
    if (STAMP && wid == 0) { stamps[lane] = lane < nts ? (((unsigned long long)(unsigned)ts_hi << 32) | (unsigned)ts_lo) : 0ull;
        if (lane == 62) stamps[62] = rt_entry; if (lane == 63) stamps[63] = (unsigned long long)wall_clock64(); }
#undef PG8_STAMP
#undef PG8_SA
#undef PG8_SB
#undef PG8_STAGE
#undef PG8_LDA
#undef PG8_LDB
#undef PG8_MMA
#undef PG8_WAIT_V
#undef PG8_WAIT_L
#undef PG8_BAR
#undef PG8_SCHED
}
}

#define GAS __attribute__((address_space(1)))
#define LAS __attribute__((address_space(3)))
#define DI __device__ __forceinline__
typedef unsigned short bf16;
typedef unsigned v4u __attribute__((ext_vector_type(4)));
typedef unsigned v2u __attribute__((ext_vector_type(2)));
typedef float f32x4 __attribute__((ext_vector_type(4)));
#define RLX_AGENT __ATOMIC_RELAXED, __HIP_MEMORY_SCOPE_AGENT
#define LDS_WAIT() asm volatile("s_waitcnt lgkmcnt(0)" ::: "memory")

constexpr int NWAVES = 8, NTHREADS = 512, GRID = 256;
#ifndef MK_N_LAUNCHES
#define MK_N_LAUNCHES 1
#endif
constexpr int PH_TOTAL = 21;
constexpr int N_LAUNCHES = MK_N_LAUNCHES;

constexpr size_t O_YP = 0, O_YS = O_YP + (size_t)MP * D, O_P_LRUH = O_YS + (size_t)MS * D, O_P_LRUC = O_P_LRUH + (size_t)DEPTH * NP * 1024,
    O_P_GLA = O_P_LRUC + (size_t)DEPTH * NP * 3 * 1024, O_P_C = O_P_GLA + (size_t)DEPTH * NP * 4 * 128 * 256, O_P_N = O_P_C + (size_t)DEPTH * NP * 4 * 256 * 256,
    O_P_M = O_P_N + (size_t)DEPTH * NP * 4 * 256, O_P_MLC = O_P_M + (size_t)DEPTH * NP * 4, O_S_LRUH = O_P_MLC + (size_t)DEPTH * NP * 3 * 1024,
    O_S_LRUC = O_S_LRUH + (size_t)DEPTH * NS * 1024, O_S_GLA = O_S_LRUC + (size_t)DEPTH * NS * 3 * 1024, O_S_C = O_S_GLA + (size_t)DEPTH * NS * 4 * 128 * 256,
    O_S_N = O_S_C + (size_t)DEPTH * NS * 4 * 256 * 256, O_S_M = O_S_N + (size_t)DEPTH * NS * 4 * 256, O_S_MLC = O_S_M + (size_t)DEPTH * NS * 4,
    O_END = O_S_MLC + (size_t)DEPTH * NS * 3 * 1024;
static_assert(O_END == 123798560, "output size");

constexpr size_t MiB = 1u << 20;
constexpr size_t WS_CTL = 0, CTL_ZERO_BYTES = 1 * MiB;
constexpr size_t WS_WADA = 2 * MiB, WS_WIN = 98 * MiB, WS_WBR = 196 * MiB, WS_WOUT = 220 * MiB, WS_WFF1 = 236 * MiB, WS_WFF2 = 300 * MiB;
constexpr size_t WS_CSILU = 364 * MiB, WS_MOD = 365 * MiB, WS_XA = 389 * MiB, WS_XB = 457 * MiB, WS_XN = 525 * MiB, WS_MERGED = 559 * MiB, WS_YCAT = 593 * MiB,
    WS_SMALL = 644 * MiB, WS_PROJ = 645 * MiB, WS_HFF = 849 * MiB, WS_GIMG = 985 * MiB, WS_MIMG = 1008 * MiB, WS_END = 1100 * MiB;
static_assert(WS_WADA + (size_t)2 * NADA * D * 2 <= WS_WIN && WS_WIN + (size_t)2 * NPROJ_PAD * D * 2 <= WS_WBR && WS_WBR + (size_t)2 * D * KBR * 2 <= WS_WOUT &&
              WS_WOUT + (size_t)2 * D * D * 2 <= WS_WFF1 && WS_WFF1 + (size_t)2 * DFF * D * 2 <= WS_WFF2 && WS_WFF2 + (size_t)2 * DFF * D * 2 <= WS_CSILU &&
              WS_CSILU + (size_t)256 * D * 2 <= WS_MOD && WS_MOD + (size_t)256 * 2 * NADA * 4 <= WS_XA && WS_XA + (size_t)MTOT * D * 4 <= WS_XB && WS_XB + (size_t)MTOT * D * 4 <= WS_XN &&
              WS_XN + (size_t)MTOT * D * 2 <= WS_MERGED && WS_MERGED + (size_t)MTOT * D * 2 <= WS_YCAT && WS_YCAT + (size_t)MTOT * KBR * 2 <= WS_SMALL &&
              WS_SMALL + (size_t)MTOT * NSMALL * 4 <= WS_PROJ && WS_PROJ + (size_t)MTOT * NPROJ * 2 <= WS_HFF && WS_HFF + (size_t)MTOT * DFF * 2 <= WS_GIMG && WS_GIMG + (size_t)512 * 46080 <= WS_MIMG && WS_MIMG + (size_t)512 * 115712 <= WS_END, "d_ws map");
constexpr size_t WS_WIN8_0 = WS_WFF1 + 32 * MiB, WS_WIN8_1 = WS_WFF2 + 32 * MiB, WS_XN8 = WS_HFF + 72 * MiB;
static_assert((size_t)2 * DFF * D <= 32 * MiB && (size_t)NPROJ_PAD * D <= 32 * MiB && (size_t)MTOT * DFF <= 72 * MiB && WS_XN8 + (size_t)MTOT * D <= WS_GIMG, "fp8 copies fit in the free halves");
constexpr size_t WS_MG8 = WS_PROJ + 104 * MiB;
static_assert((size_t)MTOT * PPITCH * 2 <= 104 * MiB && WS_MG8 + (size_t)MTOT * 6144 <= WS_HFF, "proj / gate buffers");
constexpr int CW_BAR = 4096;

constexpr int RING_OFF = 0, RING_BYTES = 131072;
constexpr int LDS_BYTES = 163840;
constexpr int LDSCTL_OFF = LDS_BYTES - 1024, MISC_OFF = LDSCTL_OFF + 320;

DI float bf2f(bf16 b) { return __uint_as_float(((unsigned)b) << 16); }
DI unsigned f2bf(float f) { unsigned u = __float_as_uint(f); return (u + 0x7fffu + ((u >> 16) & 1u)) >> 16; }
typedef float f32x2v __attribute__((ext_vector_type(2)));
typedef __bf16 bf16x2v __attribute__((ext_vector_type(2)));
DI unsigned pkbf(float a, float b) { const f32x2v v = {a, b}; const bf16x2v r = __builtin_convertvector(v, bf16x2v); return __builtin_bit_cast(unsigned, r); }
DI unsigned pk2(float lo, float hi) { return f2bf(lo) | (f2bf(hi) << 16); }
DI float bflo_(unsigned w) { return __uint_as_float(w << 16); }
DI float bfhi_(unsigned w) { return __uint_as_float(w & 0xffff0000u); }
DI float sigm(float x) { return __builtin_amdgcn_rcpf(1.f + __expf(-x)); }
DI float lru_in_scale(float la) { const float t = 2.f * la;
    const float em = (t > -0.125f) ? -t * (1.f + t * (0.5f + t * (0.16666667f + t * (0.041666668f + t * 0.0083333338f)))) : 1.f - __expf(t);
    return __builtin_amdgcn_sqrtf(em); }
DI float logsig(float x) { return fminf(x, 0.f) - __logf(1.f + __expf(-fabsf(x))); }
template <int CTRL, int ROWMASK> DI float dpp_f(float v) { return __int_as_float(__builtin_amdgcn_update_dpp(0, __float_as_int(v), CTRL, ROWMASK, 0xf, false)); }
DI float wave_sum(float v) {
    v += dpp_f<0xB1, 0xf>(v);
    v += dpp_f<0x4E, 0xf>(v);
    v += dpp_f<0x141, 0xf>(v);
    v += dpp_f<0x140, 0xf>(v);
    v += dpp_f<0x142, 0xa>(v);
    v += dpp_f<0x143, 0xc>(v);
    return __int_as_float(__builtin_amdgcn_readlane(__float_as_int(v), 63));
}

#define XB_TMO      128
#define XB_XCNT(j)  (256  + 64 * (j))
#define XB_XSUB(j)  (1280 + 64 * (j))
#define XB_XGEN(j)  (2304 + 64 * (j))
#define XB_TOP      3328
#define XB_TOPGEN   3392
#define XCD_BAR_WORDS 3456
#define XB_SPIN_CAP (1u << 18)

__device__ __forceinline__ unsigned xb_ld(unsigned* p)              { return __hip_atomic_load(p, __ATOMIC_RELAXED, __HIP_MEMORY_SCOPE_AGENT); }
__device__ __forceinline__ unsigned xb_add(unsigned* p, unsigned v) { return __hip_atomic_fetch_add(p, v, __ATOMIC_RELAXED, __HIP_MEMORY_SCOPE_AGENT); }
__device__ __forceinline__ unsigned xb_xcc_id() { return (unsigned)__builtin_amdgcn_s_getreg((3 << 11) | 20) & 0xFu; }
#define XB_SPIN(cond, bar) do { unsigned _sp = 0; while (cond) { __builtin_amdgcn_s_sleep(1); \
    if ((++_sp & 255u) == 0u) { if (xb_ld(&(bar)[XB_TMO])) break; if (_sp > XB_SPIN_CAP) { atomicAdd(&(bar)[XB_TMO], 1u); break; } } } } while (0)

struct XcdBarrier {
    unsigned* bar; unsigned x;
    volatile LAS unsigned* st;
};
__device__ __forceinline__ XcdBarrier xcd_barrier_post(unsigned* bar, volatile LAS unsigned* st) {
    XcdBarrier b; b.bar = bar; b.x = xb_xcc_id(); b.st = st;
    if (threadIdx.x == 0) (void)xb_add(&bar[XB_XCNT(b.x)], 1u);
    return b;
}
__device__ __forceinline__ void xcd_barrier_complete(unsigned* bar, unsigned x, unsigned& nloc, unsigned& nx) {
    const unsigned G = gridDim.x * gridDim.y * gridDim.z;
    unsigned sum, cnt, mine, sp = 0u;
    for (;;) {
        sum = 0u; cnt = 0u; mine = 0u;
#pragma unroll
        for (unsigned j = 0; j < 16; ++j) { const unsigned c = xb_ld(&bar[XB_XCNT(j)]); sum += c; cnt += (c > 0u) ? 1u : 0u; mine = (j == x) ? c : mine; }
        if (sum == G) break;
        __builtin_amdgcn_s_sleep(1);
        if ((++sp & 255u) == 0u) { if (xb_ld(&bar[XB_TMO])) break; if (sp > XB_SPIN_CAP) { atomicAdd(&bar[XB_TMO], 1u); break; } }
    }
    nloc = mine > 0u ? mine : 1u; nx = cnt > 0u ? cnt : 1u;
}
__device__ __forceinline__ void xcd_barrier(const XcdBarrier& b) {
    asm volatile("s_waitcnt vmcnt(0)" ::: "memory");
    __syncthreads();
    if (threadIdx.x == 0) {
        unsigned* bar = b.bar;
        __builtin_amdgcn_s_waitcnt(0);
        unsigned nloc = b.st[0], nx = b.st[1];
        if (nloc == 0u) { xcd_barrier_complete(bar, b.x, nloc, nx); b.st[0] = nloc; b.st[1] = nx; }
        const unsigned old = xb_add(&bar[XB_XSUB(b.x)], 1u);
        const unsigned gen = old / nloc;
        if (old + 1u == (gen + 1u) * nloc) {
            __builtin_amdgcn_fence(__ATOMIC_RELEASE, "agent");
            asm volatile("s_waitcnt vmcnt(0)" ::: "memory");
            const unsigned og = xb_add(&bar[XB_TOP], 1u);
            const unsigned tg = og / nx;
            if (og + 1u == (tg + 1u) * nx) xb_add(&bar[XB_TOPGEN], 1u);
            else XB_SPIN(xb_ld(&bar[XB_TOPGEN]) == tg, bar);
            __builtin_amdgcn_fence(__ATOMIC_ACQUIRE, "agent");
            xb_add(&bar[XB_XGEN(b.x)], 1u);
            asm volatile("s_waitcnt vmcnt(0)" ::: "memory");
        } else {
            XB_SPIN(xb_ld(&bar[XB_XGEN(b.x)]) == gen, bar);
            __builtin_amdgcn_fence(__ATOMIC_ACQUIRE, "agent");
            asm volatile("s_waitcnt vmcnt(0)" ::: "memory");
        }
    }
    __syncthreads();
}

struct Args { const float* in[40]; float* out; unsigned char* ws; int ph_lo, ph_hi, li, pad; };
typedef __attribute__((address_space(4))) const Args CArgs;
__device__ __forceinline__ CArgs* kargs() { CArgs* p = (CArgs*)__builtin_amdgcn_kernarg_segment_ptr(); asm volatile("" : "+s"(p)); return p; }

DI void transpose_item(const float* src, int src_ld, int ncols, bf16* dst, int dst_ld, LAS float* scr, int item, int lane) {
    const int nblk = ncols / 32, kb = item / nblk, nb = item % nblk, k0 = 64 * kb, n0 = 32 * nb;
#pragma unroll 8
    for (int i = 0; i < 32; ++i) { const int kk = 2 * i + (lane >> 5); scr[kk * 33 + (lane & 31)] = __builtin_nontemporal_load(src + (size_t)(k0 + kk) * src_ld + n0 + (lane & 31)); }
    LDS_WAIT(); asm volatile("" ::: "memory");
    const int c = lane & 7;
#pragma unroll
    for (int j = 0; j < 4; ++j) { const int n = (lane >> 3) + 8 * j; const LAS float* s = scr + (8 * c) * 33 + n;
        v4u o; o.x = pk2(s[0 * 33], s[1 * 33]); o.y = pk2(s[2 * 33], s[3 * 33]); o.z = pk2(s[4 * 33], s[5 * 33]); o.w = pk2(s[6 * 33], s[7 * 33]);
        *(v4u*)(dst + (size_t)(n0 + n) * dst_ld + k0 + 8 * c) = o; }
    LDS_WAIT(); asm volatile("" ::: "memory");
}
DI void transpose_item_f8(const float* src, int src_ld, int ncols, unsigned char* dst, int dst_ld, float scale, LAS float* scr, int item, int lane) {
    const int nblk = ncols / 32, kb = item / nblk, nb = item % nblk, k0 = 64 * kb, n0 = 32 * nb;
#pragma unroll 8
    for (int i = 0; i < 32; ++i) { const int kk = 2 * i + (lane >> 5); scr[kk * 33 + (lane & 31)] = __builtin_nontemporal_load(src + (size_t)(k0 + kk) * src_ld + n0 + (lane & 31)); }
    LDS_WAIT(); asm volatile("" ::: "memory");
    const int c = lane & 7;
#pragma unroll
    for (int j = 0; j < 4; ++j) { const int n = (lane >> 3) + 8 * j; const LAS float* s = scr + (8 * c) * 33 + n;
        v2u o; o.x = pg8::pk4_fp8(s[0 * 33] * scale, s[1 * 33] * scale, s[2 * 33] * scale, s[3 * 33] * scale); o.y = pg8::pk4_fp8(s[4 * 33] * scale, s[5 * 33] * scale, s[6 * 33] * scale, s[7 * 33] * scale);
        *(v2u*)(dst + (size_t)(n0 + n) * dst_ld + k0 + 8 * c) = o; }
    LDS_WAIT(); asm volatile("" ::: "memory");
}
DI void transpose_job_f8(const float* src, int src_ld, int K, int ncols, unsigned char* dst, int dst_ld, float scale, LAS float* scr, int gw, int ngw, int lane) {
    const int nitems = (K / 64) * (ncols / 32);
    for (int it = gw; it < nitems; it += ngw) transpose_item_f8(src, src_ld, ncols, dst, dst_ld, scale, scr, it, lane);
}
DI void transpose_job(const float* src, int src_ld, int K, int ncols, bf16* dst, int dst_ld, LAS float* scr, int gw, int ngw, int lane) {
    const int nitems = (K / 64) * (ncols / 32);
    for (int it = gw; it < nitems; it += ngw) transpose_item(src, src_ld, ncols, dst, dst_ld, scr, it, lane);
}

DI void norm_rows(const void* xp, const void* xs, bool in_f32, const float* g, const float* modp  ,
                  bf16* out_bf, float* outp, float* outs, int gw, int ngw, int lane, bf16* copy_out = nullptr,
                  int nslab = 0, const bf16* slab = nullptr, const float* sgate = nullptr, bf16* xs_out = nullptr, unsigned char* out_f8 = nullptr, unsigned char* out_f8_also = nullptr) {
    for (int row = gw; row < MTOT; row += ngw) {
        f32x4 v[8]; float ss = 0.f;
        if (in_f32) { const float* xr = row < MP ? (const float*)xp + (size_t)row * D : (const float*)xs + (size_t)(row - MP) * D; const f32x4* x4 = (const f32x4*)xr + lane;
#pragma unroll
            for (int j = 0; j < 8; ++j) v[j] = x4[64 * j];
            if (copy_out) {
#pragma unroll
                for (int j = 0; j < 8; ++j) { v2u w; w.x = pkbf(v[j].x, v[j].y); w.y = pkbf(v[j].z, v[j].w); *((v2u*)(copy_out + (size_t)row * D) + lane + 64 * j) = w; } }
        } else { const bf16* xr = row < MP ? (const bf16*)xp + (size_t)row * D : (const bf16*)xs + (size_t)(row - MP) * D; const v2u* x2 = (const v2u*)xr + lane;
#pragma unroll
            for (int j = 0; j < 8; ++j) { const v2u w = x2[64 * j]; v[j] = (f32x4){bflo_(w.x), bfhi_(w.x), bflo_(w.y), bfhi_(w.y)}; } }
        const int cond = row < MP ? (row >> 11) : NP + ((row - MP) >> 2);
        if (nslab > 0 && row >= MP) {
            const v2u* s4 = (const v2u*)(slab + (size_t)(row - MP) * D) + lane; const f32x4* gt4 = (const f32x4*)(sgate + (size_t)cond * 24576) + lane;
            v2u* xo = (v2u*)(xs_out + (size_t)(row - MP) * D) + lane;
#pragma unroll
            for (int j = 0; j < 8; ++j) { f32x4 a = {0.f, 0.f, 0.f, 0.f};
                for (int k = 0; k < nslab; ++k) { const v2u w = s4[(size_t)k * (MS * D / 4) + 64 * j]; a += (f32x4){bflo_(w.x), bfhi_(w.x), bflo_(w.y), bfhi_(w.y)}; }
                v[j] = v[j] + gt4[64 * j] * a; v2u w; w.x = pkbf(v[j].x, v[j].y); w.y = pkbf(v[j].z, v[j].w); xo[64 * j] = w; }
        }
#pragma unroll
        for (int j = 0; j < 8; ++j) ss += (v[j].x * v[j].x + v[j].y * v[j].y) + (v[j].z * v[j].z + v[j].w * v[j].w);
        ss = wave_sum(ss);
        const float r = __builtin_amdgcn_rsqf(ss * (1.f / D) + EPS);
        const f32x4* g4 = (const f32x4*)g + lane;
#pragma unroll
        for (int j = 0; j < 8; ++j) {
            f32x4 y = v[j] * r * g4[64 * j];
            if (modp) { const f32x4* m4 = (const f32x4*)(modp + (size_t)cond * 24576) + lane; const f32x4 sh = m4[64 * j], sc = m4[512 + 64 * j]; y = y * (1.f + sc) + sh; }
            if (out_f8_also) *((unsigned*)(out_f8_also + (size_t)row * D) + lane + 64 * j) = pg8::pk4_fp8(y.x, y.y, y.z, y.w);
            if (out_f8) *((unsigned*)(out_f8 + (size_t)row * D) + lane + 64 * j) = pg8::pk4_fp8(y.x, y.y, y.z, y.w);
            else if (out_bf) { v2u w; w.x = pk2(y.x, y.y); w.y = pk2(y.z, y.w); *((v2u*)(out_bf + (size_t)row * D) + lane + 64 * j) = w; }
            else { float* o = row < MP ? outp + (size_t)row * D : outs + (size_t)(row - MP) * D; *((f32x4*)o + lane + 64 * j) = y; }
        }
    }
}

DI float* out_state(float* out, int s, int l, size_t off_p, size_t off_s, size_t per) {
    return s < NP ? out + off_p + ((size_t)l * NP + s) * per : out + off_s + ((size_t)l * NS + (s - NP)) * per;
}

DI void lru_unit(int l, bool prompt, int grp, int n, LAS float* lds, int tid) {
    CArgs* A = kargs();
    LAS float* u_s = lds; LAS float* a_s = lds + 2048; LAS float* v_s = lds + 4096;
    const bf16* proj = (const bf16*)(A->ws + WS_PROJ); bf16* ycat = (bf16*)(A->ws + WS_YCAT); unsigned char* ycat8 = A->ws + WS_YCAT; (void)ycat; (void)ycat8;
    const float* cw = A->in[16] + (size_t)l * 4 * 1024; const float* cb = A->in[17] + (size_t)l * 1024;
    const float* wa = A->in[18] + ((size_t)l * 8 + n) * 128 * 128; const float* ba = A->in[19] + (size_t)l * 1024 + n * 128;
    const float* wx = A->in[20] + ((size_t)l * 8 + n) * 128 * 128; const float* bx = A->in[21] + (size_t)l * 1024 + n * 128;
    const float* lam = A->in[22] + (size_t)l * 1024 + n * 128;
    const float* st_h = A->in[4]; const float* st_c = A->in[5];
    const int ntiles = prompt ? TP / 16 : 1;
    const int c = tid & 127, rg = tid >> 7, ch = n * 128 + c;
    float h = 0.f;
    for (int tile = 0; tile < ntiles; ++tile) {
        {
            const float w0 = cw[ch], w1 = cw[1024 + ch], w2 = cw[2048 + ch], w3 = cw[3072 + ch], bb = cb[ch];
#pragma unroll
            for (int q = 0; q < 4; ++q) {
                const int r = 4 * rg + q;
                int s, t, T, row0;
                if (prompt) { s = grp; t = tile * 16 + r; T = TP; row0 = grp * TP; } else { s = NP + 4 * grp + (r >> 2); t = r & 3; T = TS; row0 = MP + (4 * grp + (r >> 2)) * TS; }
                float x[4];
#pragma unroll
                for (int jj = 0; jj < 4; ++jj) { const int tp = t - 3 + jj;
                    if (tp >= 0) x[jj] = bf2f(proj[(size_t)(row0 + tp) * PPITCH + C_LRUX + ch]);
                    else x[jj] = prompt ? 0.f : st_c[(((size_t)l * NS + (s - NP)) * 3 + (3 + tp)) * 1024 + ch]; }
                u_s[r * 128 + c] = bb + w0 * x[0] + w1 * x[1] + w2 * x[2] + w3 * x[3];
                if (t >= T - 3) out_state(A->out, s, l, O_P_LRUC, O_S_LRUC, 3 * 1024)[(size_t)(t - (T - 3)) * 1024 + ch] = x[3];
            }
        }
        __syncthreads();
        {
            float aa[4], ax[4];
#pragma unroll
            for (int q = 0; q < 4; ++q) { aa[q] = ba[c]; ax[q] = bx[c]; }
#pragma unroll 16
            for (int cc = 0; cc < 128; ++cc) { const float wa_ = wa[cc * 128 + c], wx_ = wx[cc * 128 + c];
#pragma unroll
                for (int q = 0; q < 4; ++q) { const float uq = u_s[(4 * rg + q) * 128 + cc]; aa[q] += uq * wa_; ax[q] += uq * wx_; } }
            const float ls = logsig(lam[c]);
#pragma unroll
            for (int q = 0; q < 4; ++q) { const int r = 4 * rg + q; const float rr = sigm(aa[q]), ii = sigm(ax[q]), la = 8.f * rr * ls;
                a_s[r * 128 + c] = __expf(la); v_s[r * 128 + c] = lru_in_scale(la) * (ii * u_s[r * 128 + c]); }
        }
        __syncthreads();
        if (prompt) {
            if (tid < 128) {
#pragma unroll 4
                for (int r = 0; r < 16; ++r) { h = a_s[r * 128 + c] * h + v_s[r * 128 + c];
                    ycat[(size_t)(grp * TP + tile * 16 + r) * KBR + ch] = (bf16)f2bf(h); }
            }
        } else {
            const int b = 4 * grp + rg; float hh = st_h[((size_t)l * NS + b) * 1024 + ch];
#pragma unroll
            for (int t = 0; t < 4; ++t) { const int r = rg * 4 + t; hh = a_s[r * 128 + c] * hh + v_s[r * 128 + c];
                ycat[(size_t)(MP + b * TS + t) * KBR + ch] = (bf16)f2bf(hh); }
            A->out[O_S_LRUH + ((size_t)l * NS + b) * 1024 + ch] = hh;
        }
    }
    if (prompt && tid < 128) A->out[O_P_LRUH + ((size_t)l * NP + grp) * 1024 + ch] = h;
    __syncthreads();
}

DI void gla_unit(int l, int s, int hh, LAS float* lds, int tid, int lane, int wave) {
    CArgs* A = kargs();
    const int b = s - NP, row0 = MP + b * TS;
    const bf16* proj = (const bf16*)(A->ws + WS_PROJ); bf16* ycat = (bf16*)(A->ws + WS_YCAT); unsigned char* ycat8 = A->ws + WS_YCAT; (void)ycat; (void)ycat8;     const float* sm = (const float*)(A->ws + WS_SMALL);
    const float* wg2 = A->in[23] + (size_t)l * 16 * 512; const float* bg = A->in[24] + (size_t)l * 512; const float* gn = A->in[25] + (size_t)l * 256;
    LAS float* eg_s = lds; LAS float* q_s = lds + 512; LAS float* k_s = lds + 1024; LAS float* v_s = lds + 1536; LAS float* part = lds + 2560;
    f32x4 S[16];
    { const f32x4* sp = (const f32x4*)(A->in[6] + ((((size_t)l * NS + b) * 4 + hh) * 128 + 16 * wave) * 256) + lane;
#pragma unroll
      for (int dd = 0; dd < 16; ++dd) S[dd] = __builtin_nontemporal_load(sp + dd * 64); }
    for (int i = tid; i < 4 * 128; i += NTHREADS) { const int tb = i >> 7, d = i & 127, col = hh * 128 + d; const size_t row = (size_t)(row0 + tb);
        float z = bg[col];
#pragma unroll
        for (int r = 0; r < 16; ++r) z += sm[row * NSMALL + r] * wg2[r * 512 + col];
        eg_s[i] = __expf(logsig(z) * (1.f / 16.f));
        q_s[i] = bf2f(proj[row * PPITCH + C_GQ + col]) * 0.08838834764831845f;
        k_s[i] = bf2f(proj[row * PPITCH + C_GK + col]); }
    for (int i = tid; i < 4 * 256; i += NTHREADS) { const int tb = i >> 8, ee = i & 255; v_s[i] = bf2f(proj[(size_t)(row0 + tb) * PPITCH + C_GV + hh * 256 + ee]); }
    __syncthreads();
#pragma unroll
    for (int tb = 0; tb < 4; ++tb) {
        const f32x4 v4 = *(const LAS f32x4*)(v_s + tb * 256 + 4 * lane); f32x4 po = {0.f, 0.f, 0.f, 0.f};
        const LAS float* egp = eg_s + tb * 128 + 16 * wave; const LAS float* kp = k_s + tb * 128 + 16 * wave; const LAS float* qp = q_s + tb * 128 + 16 * wave;
#pragma unroll
        for (int d4 = 0; d4 < 4; ++d4) { const f32x4 eg4 = *(const LAS f32x4*)(egp + 4 * d4), k4 = *(const LAS f32x4*)(kp + 4 * d4), q4 = *(const LAS f32x4*)(qp + 4 * d4);
            S[4 * d4 + 0] = S[4 * d4 + 0] * eg4.x + v4 * k4.x; po += S[4 * d4 + 0] * q4.x;
            S[4 * d4 + 1] = S[4 * d4 + 1] * eg4.y + v4 * k4.y; po += S[4 * d4 + 1] * q4.y;
            S[4 * d4 + 2] = S[4 * d4 + 2] * eg4.z + v4 * k4.z; po += S[4 * d4 + 2] * q4.z;
            S[4 * d4 + 3] = S[4 * d4 + 3] * eg4.w + v4 * k4.w; po += S[4 * d4 + 3] * q4.w; }
        *(LAS f32x4*)(part + (tb * 8 + wave) * 256 + 4 * lane) = po;
    }
    { f32x4* op = (f32x4*)(A->out + O_S_GLA + ((((size_t)l * NS + b) * 4 + hh) * 128 + 16 * wave) * 256) + lane;
#pragma unroll
      for (int dd = 0; dd < 16; ++dd) __builtin_nontemporal_store(S[dd], op + dd * 64); }
    __syncthreads();
    if (wave < 4) { const int tb = wave; const size_t row = (size_t)(row0 + tb);
        f32x4 ov = {0.f, 0.f, 0.f, 0.f};
#pragma unroll
        for (int w8 = 0; w8 < 8; ++w8) ov += *(const LAS f32x4*)(part + (tb * 8 + w8) * 256 + 4 * lane);
        float ss = (ov.x * ov.x + ov.y * ov.y) + (ov.z * ov.z + ov.w * ov.w); ss = wave_sum(ss);
        const float rs = __builtin_amdgcn_rsqf(ss * (1.f / 256.f) + EPS);
        const f32x4 g4 = *(const f32x4*)(gn + 4 * lane);
        const v2u gw = *(const v2u*)(proj + row * PPITCH + C_GGATE + hh * 256 + 4 * lane);
        const float z0 = __uint_as_float(gw.x << 16), z1 = __uint_as_float(gw.x & 0xffff0000u), z2 = __uint_as_float(gw.y << 16), z3 = __uint_as_float(gw.y & 0xffff0000u);
                *(unsigned*)(ycat8 + row * KBR + 1024 + hh * 256 + 4 * lane) = pg8::pk4_fp8(ov.x * rs * g4.x * (z0 * sigm(z0)), ov.y * rs * g4.y * (z1 * sigm(z1)), ov.z * rs * g4.z * (z2 * sigm(z2)), ov.w * rs * g4.w * (z3 * sigm(z3))); }
    __syncthreads();
}

DI void ml_unit(int l, int s, int hh, LAS float* lds, int tid, int lane, int wave) {
    CArgs* A = kargs();
    const int b = s - NP, row0 = MP + b * TS;
    const bf16* proj = (const bf16*)(A->ws + WS_PROJ); bf16* ycat = (bf16*)(A->ws + WS_YCAT); unsigned char* ycat8 = A->ws + WS_YCAT; (void)ycat; (void)ycat8;     const float* sm = (const float*)(A->ws + WS_SMALL);
    const float* mcw = A->in[26] + (size_t)l * 4 * 1024; const float* mcb = A->in[27] + (size_t)l * 1024;
    const float* wq = A->in[28] + (size_t)l * 256 * 16; const float* wk = A->in[29] + (size_t)l * 256 * 16; const float* wv = A->in[30] + (size_t)l * 256 * 16;
    const float* bif = A->in[31] + (size_t)l * 8; const float* gn = A->in[32] + (size_t)l * 256;
    LAS float* mx_s = lds; LAS float* mc_s = lds + 1792; LAS float* q_s = lds + 2816; LAS float* k_s = lds + 3840; LAS float* v_s = lds + 4864;
    LAS float* ig_s = lds + 5888; LAS float* lf_s = lds + 5896; LAS float* part = lds + 5904;
    const size_t bh = ((size_t)l * NS + b) * 4 + hh;
    f32x4 C[32];
    { const f32x4* cp = (const f32x4*)(A->in[7] + (bh * 256 + 32 * wave) * 256) + lane;
#pragma unroll
      for (int dd = 0; dd < 32; ++dd) C[dd] = __builtin_nontemporal_load(cp + dd * 64); }
    float nn[4]; { const f32x4 n4 = *(const f32x4*)(A->in[8] + bh * 256 + 4 * lane); nn[0] = n4.x; nn[1] = n4.y; nn[2] = n4.z; nn[3] = n4.w; }
    float m = A->in[9][bh];
    const int c0 = tid & 255, ch0 = hh * 256 + c0, wb0 = (64 * hh + (c0 >> 2)) * 16 + (c0 & 3);
    const float cw0 = mcw[ch0], cw1 = mcw[1024 + ch0], cw2 = mcw[2048 + ch0], cw3 = mcw[3072 + ch0], cbv = mcb[ch0];
    float wq4[4], wk4[4], wv4[4];
#pragma unroll
    for (int cc = 0; cc < 4; ++cc) { wq4[cc] = wq[wb0 + 4 * cc]; wk4[cc] = wk[wb0 + 4 * cc] * 0.0625f; wv4[cc] = wv[wb0 + 4 * cc]; }
    float gi = 0.f, gf = 0.f; if (tid < 4) { gi = sm[(size_t)(row0 + tid) * NSMALL + 16 + hh] + bif[hh]; gf = sm[(size_t)(row0 + tid) * NSMALL + 20 + hh] + bif[4 + hh]; }
    for (int i = tid; i < 7 * 256; i += NTHREADS) { const int tr = i >> 8, c = i & 255, tp = tr - 3, ch = hh * 256 + c;
        const float x = tp >= 0 ? bf2f(proj[(size_t)(row0 + tp) * PPITCH + C_MX + ch]) : A->in[10][(((size_t)l * NS + b) * 3 + (3 + tp)) * 1024 + ch];
        mx_s[i] = x;
        if (tp >= 1) A->out[O_S_MLC + (((size_t)l * NS + b) * 3 + (tp - 1)) * 1024 + ch] = x; }
    __syncthreads();
    for (int i = tid; i < 4 * 256; i += NTHREADS) { const int tb = i >> 8, c = i & 255;
        const float acc = cbv + cw0 * mx_s[tb * 256 + c] + cw1 * mx_s[(tb + 1) * 256 + c] + cw2 * mx_s[(tb + 2) * 256 + c] + cw3 * mx_s[(tb + 3) * 256 + c];
        mc_s[i] = acc * sigm(acc); }
    __syncthreads();
    for (int i = tid; i < 4 * 256; i += NTHREADS) { const int tb = i >> 8, c = i & 255, nq = c >> 2;
        float q = 0.f, k = 0.f, v = 0.f;
#pragma unroll
        for (int cc = 0; cc < 4; ++cc) { const float mcv = mc_s[tb * 256 + 4 * nq + cc], mxv = mx_s[(tb + 3) * 256 + 4 * nq + cc];
            q += mcv * wq4[cc]; k += mcv * wk4[cc]; v += mxv * wv4[cc]; }
        q_s[i] = q; k_s[i] = k; v_s[i] = v; }
    if (tid < 4) { ig_s[tid] = gi; lf_s[tid] = logsig(gf); }
    __syncthreads();
    for (int tb = 0; tb < 4; ++tb) {
        const float lf = lf_s[tb], ig = ig_s[tb];
        const float mnew = fmaxf(lf + m, ig), fdec = __expf(lf + m - mnew), iw = __expf(ig - mnew); m = mnew;
        const f32x4 k4n = *(const LAS f32x4*)(k_s + tb * 256 + 4 * lane), q4n = *(const LAS f32x4*)(q_s + tb * 256 + 4 * lane);
        nn[0] = fdec * nn[0] + iw * k4n.x; nn[1] = fdec * nn[1] + iw * k4n.y; nn[2] = fdec * nn[2] + iw * k4n.z; nn[3] = fdec * nn[3] + iw * k4n.w;
        const float den = wave_sum((q4n.x * nn[0] + q4n.y * nn[1]) + (q4n.z * nn[2] + q4n.w * nn[3]));
        if (tid == 0) ig_s[4 + tb] = 1.f / fmaxf(fabsf(den), __expf(-m));
        const f32x4 v4 = *(const LAS f32x4*)(v_s + tb * 256 + 4 * lane) * iw; f32x4 pn = {0.f, 0.f, 0.f, 0.f};
        const LAS float* kp = k_s + tb * 256 + 32 * wave; const LAS float* qp = q_s + tb * 256 + 32 * wave;
#pragma unroll
        for (int d4 = 0; d4 < 8; ++d4) { const f32x4 k4 = *(const LAS f32x4*)(kp + 4 * d4), q4 = *(const LAS f32x4*)(qp + 4 * d4);
            C[4 * d4 + 0] = C[4 * d4 + 0] * fdec + v4 * k4.x; pn += C[4 * d4 + 0] * q4.x;
            C[4 * d4 + 1] = C[4 * d4 + 1] * fdec + v4 * k4.y; pn += C[4 * d4 + 1] * q4.y;
            C[4 * d4 + 2] = C[4 * d4 + 2] * fdec + v4 * k4.z; pn += C[4 * d4 + 2] * q4.z;
            C[4 * d4 + 3] = C[4 * d4 + 3] * fdec + v4 * k4.w; pn += C[4 * d4 + 3] * q4.w; }
        *(LAS f32x4*)(part + (tb * 8 + wave) * 256 + 4 * lane) = pn;
    }
    { f32x4* cp = (f32x4*)(A->out + O_S_C + (bh * 256 + 32 * wave) * 256) + lane;
#pragma unroll
      for (int dd = 0; dd < 32; ++dd) __builtin_nontemporal_store(C[dd], cp + dd * 64);
      if (wave == 0) { f32x4 n4; n4.x = nn[0]; n4.y = nn[1]; n4.z = nn[2]; n4.w = nn[3]; *(f32x4*)(A->out + O_S_N + bh * 256 + 4 * lane) = n4; }
      if (tid == 0) A->out[O_S_M + bh] = m; }
    __syncthreads();
    if (wave < 4) { const int tb = wave; const size_t row = (size_t)(row0 + tb);
        f32x4 hv = {0.f, 0.f, 0.f, 0.f};
#pragma unroll
        for (int w8 = 0; w8 < 8; ++w8) hv += *(const LAS f32x4*)(part + (tb * 8 + w8) * 256 + 4 * lane);
        const float rd = ig_s[4 + tb];
        hv = hv * rd;
        float ss = (hv.x * hv.x + hv.y * hv.y) + (hv.z * hv.z + hv.w * hv.w); ss = wave_sum(ss);
        const float rs = __builtin_amdgcn_rsqf(ss * (1.f / 256.f) + EPS);
        const f32x4 g4 = *(const f32x4*)(gn + 4 * lane);
        const v2u ow = *(const v2u*)(proj + row * PPITCH + C_MO + hh * 256 + 4 * lane);
        const float z0 = __uint_as_float(ow.x << 16), z1 = __uint_as_float(ow.x & 0xffff0000u), z2 = __uint_as_float(ow.y << 16), z3 = __uint_as_float(ow.y & 0xffff0000u);
                *(unsigned*)(ycat8 + row * KBR + 2048 + hh * 256 + 4 * lane) = pg8::pk4_fp8(sigm(z0) * (hv.x * rs * g4.x), sigm(z1) * (hv.y * rs * g4.y), sigm(z2) * (hv.z * rs * g4.z), sigm(z3) * (hv.w * rs * g4.w)); }
    __syncthreads();
}

typedef short bf16x8 __attribute__((ext_vector_type(8)));
typedef float f32x16 __attribute__((ext_vector_type(16)));
#define GL_DSR128(dst, addr, off) asm volatile("ds_read_b128 %0, %1 offset:" #off : "=v"(dst) : "v"(addr))
#define GL_DSR2X64(dst, addr, o0, o1) asm volatile("ds_read2_b64 %0, %1 offset0:" #o0 " offset1:" #o1 : "=v"(dst) : "v"(addr))
#define GL_LWAIT(n, x) asm volatile("s_waitcnt lgkmcnt(" #n ")" : "+v"(x))
#define WG_RAW_BARRIER() asm volatile("s_waitcnt lgkmcnt(0)\n\ts_barrier" ::: "memory")
#define MFMA32(a, b, c) __builtin_amdgcn_mfma_f32_32x32x16_bf16((a), (b), (c), 0, 0, 0)
DI bf16x8 frag16(const LAS unsigned char* p) { return *(const LAS bf16x8*)p; }
DI bf16x8 frag8x2(const LAS unsigned char* p) { const v2u lo = *(const LAS v2u*)p, hi = *(const LAS v2u*)(p + 16);
    const v4u w = {lo.x, lo.y, hi.x, hi.y}; return __builtin_bit_cast(bf16x8, w); }
DI bf16x8 pack_acc(const f32x16& x, int s) {
    const v4u w = {pkbf(x[8 * s + 0], x[8 * s + 1]), pkbf(x[8 * s + 2], x[8 * s + 3]), pkbf(x[8 * s + 4], x[8 * s + 5]), pkbf(x[8 * s + 6], x[8 * s + 7])};
    return __builtin_bit_cast(bf16x8, w); }
DI unsigned short lds_u16(const LAS unsigned char* p) { return *(const LAS unsigned short*)p; }

constexpr int GL_QE = 0, GL_KE = 17408, GL_KDT = 34816, GL_V = 53248, GL_A = 87040, GL_SM = 96256, GL_SEG = 100352, GL_DEC = 102400, GL_OS = 0;
constexpr int GL_PQ = 272, GL_PT = 144, GL_PV = 528, GL_PO = 1040;
constexpr int GIMG_BYTES = 46080, GI_Q = 0, GI_K = 17408, GI_A = 35840, GI_D = 45056, GI_PIECES = 2848;
DI int gimg_lds_off(int idx) {
    return idx < 1088 ? GL_QE + idx * 16 : idx < 2240 ? GL_KDT + (idx - 1088) * 16 : idx < 2816 ? GL_A + (idx - 2240) * 16 : GL_DEC + (idx - 2816) * 16;
}
DI void gla_prep_unit(int l, int s, int hh, int c, LAS unsigned char* lds, int tid) {
    CArgs* A = kargs();
    const bf16* proj = (const bf16*)(A->ws + WS_PROJ); const float* sm = (const float*)(A->ws + WS_SMALL);
    const float* wg2 = A->in[23] + (size_t)l * 16 * 512; const float* bg = A->in[24] + (size_t)l * 512;
    const int lane = tid & 63, w = __builtin_amdgcn_readfirstlane(tid >> 6), r = lane & 31, h = lane >> 5;
    const int d_ = tid & 127, seg = __builtin_amdgcn_readfirstlane(tid >> 7);
    float wg[16];
#pragma unroll
    for (int q = 0; q < 16; ++q) wg[q] = wg2[q * 512 + hh * 128 + d_];
    const float bgv = bg[hh * 128 + d_];
    const int r0 = s * TP + 64 * c;
#pragma unroll
    for (int i = 0; i < 2; ++i) { const int idx = tid + 512 * i, row = idx >> 4, ch = idx & 15; const bf16* rp = proj + (size_t)(r0 + row) * PPITCH + hh * 128 + 8 * ch;
        *(LAS v4u*)(lds + GL_QE + row * GL_PQ + ch * 16) = *(const v4u*)(rp + C_GQ); *(LAS v4u*)(lds + GL_KE + row * GL_PQ + ch * 16) = *(const v4u*)(rp + C_GK); }
    if (tid < 256) { const int row = tid >> 2, qd = tid & 3; *(LAS f32x4*)(lds + GL_SM + row * 64 + qd * 16) = *(const f32x4*)(sm + (size_t)(r0 + row) * NSMALL + 4 * qd); }
    __syncthreads();
    float b[16]; float run = 0.f;
#pragma unroll
    for (int t = 0; t < 16; ++t) { const LAS f32x4* sp = (const LAS f32x4*)(lds + GL_SM + (16 * seg + t) * 64);
        const f32x4 s0 = sp[0], s1 = sp[1], s2 = sp[2], s3 = sp[3];
        float z = bgv;
        z += s0.x * wg[0] + s0.y * wg[1] + s0.z * wg[2] + s0.w * wg[3]; z += s1.x * wg[4] + s1.y * wg[5] + s1.z * wg[6] + s1.w * wg[7];
        z += s2.x * wg[8] + s2.y * wg[9] + s2.z * wg[10] + s2.w * wg[11]; z += s3.x * wg[12] + s3.y * wg[13] + s3.z * wg[14] + s3.w * wg[15];
        run += logsig(z) * (1.f / 16.f); b[t] = run; }
    *(LAS float*)(lds + GL_SEG + (seg * 128 + d_) * 4) = run;
    __syncthreads();
    { float pre = 0.f, tot = 0.f;
#pragma unroll
      for (int s2 = 0; s2 < 4; ++s2) { const float x = *(const LAS float*)(lds + GL_SEG + (s2 * 128 + d_) * 4); tot += x; pre += (s2 < seg) ? x : 0.f; }
      float kd[16];
#pragma unroll
      for (int t = 0; t < 16; ++t) { const int j = 16 * seg + t; const float bb = b[t] + pre;
          const float qraw = bf2f(*(const LAS unsigned short*)(lds + GL_QE + j * GL_PQ + d_ * 2)), kraw = bf2f(*(const LAS unsigned short*)(lds + GL_KE + j * GL_PQ + d_ * 2));
          const float qe = qraw * 0.08838834764831845f * __expf(bb), ke = kraw * __expf(-bb); kd[t] = kraw * __expf(tot - bb);
          *(LAS unsigned short*)(lds + GL_QE + j * GL_PQ + d_ * 2) = (unsigned short)(pkbf(qe, 0.f) & 0xffffu);
          *(LAS unsigned short*)(lds + GL_KE + j * GL_PQ + d_ * 2) = (unsigned short)(pkbf(ke, 0.f) & 0xffffu); }
      v4u k0, k1; k0.x = pkbf(kd[0], kd[1]); k0.y = pkbf(kd[2], kd[3]); k0.z = pkbf(kd[4], kd[5]); k0.w = pkbf(kd[6], kd[7]);
      k1.x = pkbf(kd[8], kd[9]); k1.y = pkbf(kd[10], kd[11]); k1.z = pkbf(kd[12], kd[13]); k1.w = pkbf(kd[14], kd[15]);
      *(LAS v4u*)(lds + GL_KDT + d_ * GL_PT + seg * 32) = k0; *(LAS v4u*)(lds + GL_KDT + d_ * GL_PT + seg * 32 + 16) = k1;
      if (seg == 0) *(LAS float*)(lds + GL_DEC + d_ * 4) = __expf(tot); }
    __syncthreads();
    if (w < 3) { const int it = (w >= 1) ? 1 : 0, jt = (w == 2) ? 1 : 0; f32x16 a;
#pragma unroll
        for (int i = 0; i < 16; ++i) a[i] = 0.f;
#pragma unroll
        for (int s8 = 0; s8 < 8; ++s8) a = MFMA32(frag16(lds + GL_QE + (32 * it + r) * GL_PQ + (16 * s8 + 8 * h) * 2), frag16(lds + GL_KE + (32 * jt + r) * GL_PQ + (16 * s8 + 8 * h) * 2), a);
#pragma unroll
        for (int reg = 0; reg < 16; ++reg) { const int i = 32 * it + (reg & 3) + 8 * (reg >> 2) + 4 * h, j = 32 * jt + r;
            *(LAS unsigned short*)(lds + GL_A + i * GL_PT + j * 2) = (unsigned short)(pkbf(j <= i ? a[reg] : 0.f, 0.f) & 0xffffu); } }
    __syncthreads();
    { unsigned char* img = A->ws + WS_GIMG + (size_t)((s * 4 + hh) * (TP / 64) + c) * GIMG_BYTES;
      for (int idx = tid; idx < GI_PIECES; idx += NTHREADS) *(v4u*)(img + idx * 16) = *(const LAS v4u*)(lds + gimg_lds_off(idx)); }
    __syncthreads();
}

DI void gla_seq_unit(int l, int s, int hh, LAS unsigned char* lds, int tid) {
    CArgs* A = kargs();
    const bf16* proj = (const bf16*)(A->ws + WS_PROJ); bf16* ycat = (bf16*)(A->ws + WS_YCAT); unsigned char* ycat8 = A->ws + WS_YCAT; (void)ycat; (void)ycat8;
    const float* gn = A->in[25] + (size_t)l * 256;
    const unsigned char* img0 = A->ws + WS_GIMG + (size_t)((s * 4 + hh) * (TP / 64)) * GIMG_BYTES;
    const int w = __builtin_amdgcn_readfirstlane(tid >> 6);
    f32x16 St[4];
#pragma unroll
    for (int dt = 0; dt < 4; ++dt)
#pragma unroll
        for (int i = 0; i < 16; ++i) St[dt][i] = 0.f;
    v4u pi[6], pv[4];
#define GLA_PREFETCH(cn) do { int tp_ = tid; asm volatile("" : "+v"(tp_)); const unsigned char* ib_ = img0 + (size_t)(cn) * GIMG_BYTES; \
        _Pragma("unroll") for (int i_ = 0; i_ < 6; ++i_) { const int idx_ = tp_ + 512 * i_; pi[i_] = (v4u){0u, 0u, 0u, 0u}; if (idx_ < GI_PIECES) pi[i_] = *(const v4u*)(ib_ + (unsigned)idx_ * 16u); } \
        const bf16* vb_ = proj + (size_t)(s * TP + 64 * (cn)) * PPITCH + C_GV + hh * 256; \
        _Pragma("unroll") for (int i_ = 0; i_ < 4; ++i_) { const int idx_ = tp_ + 512 * i_; pv[i_] = *(const v4u*)(vb_ + (unsigned)((idx_ >> 5) * PPITCH + 8 * (idx_ & 31))); } } while (0)
    GLA_PREFETCH(0);
    for (int c = 0; c < TP / 64; ++c) {
        const int r0 = s * TP + 64 * c;
        { int tz_ = tid; asm volatile("" : "+v"(tz_));
#pragma unroll
          for (int i = 0; i < 6; ++i) { const int idx = tz_ + 512 * i; if (idx < GI_PIECES) *(LAS v4u*)(lds + gimg_lds_off(idx)) = pi[i]; }
#pragma unroll
          for (int i = 0; i < 4; ++i) { const int idx = tz_ + 512 * i; *(LAS v4u*)(lds + GL_V + (idx >> 5) * GL_PV + (idx & 31) * 16) = pv[i]; } }
        WG_RAW_BARRIER();
        if (c + 1 < TP / 64) GLA_PREFETCH(c + 1);
        v2u gwv[8];
#pragma unroll
        for (int q = 0; q < 8; ++q) gwv[q] = *(const v2u*)(proj + (size_t)(r0 + 8 * w + q) * PPITCH + C_GGATE + hh * 256 + 4 * (tid & 63));
        f32x16 o0, o1;
        { int tz_ = tid; asm volatile("" : "+v"(tz_)); const int lane = tz_ & 63, r = lane & 31, h = lane >> 5;
#pragma unroll
        for (int i = 0; i < 16; ++i) { o0[i] = 0.f; o1[i] = 0.f; }
        { const unsigned qa = (unsigned)(__UINTPTR_TYPE__)(lds + GL_QE + r * GL_PQ + 8 * h), qb = qa + 32 * GL_PQ;
          v4u f0, f1, f2, f3;
          GL_DSR2X64(f0, qa, 0, 2);
          GL_DSR2X64(f1, qb, 0, 2);
          GL_DSR2X64(f2, qa, 4, 6);
          GL_DSR2X64(f3, qb, 4, 6);
          { const bf16x8 bfrag = pack_acc(St[0], 0);
            GL_LWAIT(3, f0); o0 = MFMA32(__builtin_bit_cast(bf16x8, f0), bfrag, o0); GL_DSR2X64(f0, qa, 8, 10);
            GL_LWAIT(3, f1); o1 = MFMA32(__builtin_bit_cast(bf16x8, f1), bfrag, o1); GL_DSR2X64(f1, qb, 8, 10);
          }
          { const bf16x8 bfrag = pack_acc(St[0], 1);
            GL_LWAIT(3, f2); o0 = MFMA32(__builtin_bit_cast(bf16x8, f2), bfrag, o0); GL_DSR2X64(f2, qa, 12, 14);
            GL_LWAIT(3, f3); o1 = MFMA32(__builtin_bit_cast(bf16x8, f3), bfrag, o1); GL_DSR2X64(f3, qb, 12, 14);
          }
          { const bf16x8 bfrag = pack_acc(St[1], 0);
            GL_LWAIT(3, f0); o0 = MFMA32(__builtin_bit_cast(bf16x8, f0), bfrag, o0); GL_DSR2X64(f0, qa, 16, 18);
            GL_LWAIT(3, f1); o1 = MFMA32(__builtin_bit_cast(bf16x8, f1), bfrag, o1); GL_DSR2X64(f1, qb, 16, 18);
          }
          { const bf16x8 bfrag = pack_acc(St[1], 1);
            GL_LWAIT(3, f2); o0 = MFMA32(__builtin_bit_cast(bf16x8, f2), bfrag, o0); GL_DSR2X64(f2, qa, 20, 22);
            GL_LWAIT(3, f3); o1 = MFMA32(__builtin_bit_cast(bf16x8, f3), bfrag, o1); GL_DSR2X64(f3, qb, 20, 22);
          }
          { const bf16x8 bfrag = pack_acc(St[2], 0);
            GL_LWAIT(3, f0); o0 = MFMA32(__builtin_bit_cast(bf16x8, f0), bfrag, o0); GL_DSR2X64(f0, qa, 24, 26);
            GL_LWAIT(3, f1); o1 = MFMA32(__builtin_bit_cast(bf16x8, f1), bfrag, o1); GL_DSR2X64(f1, qb, 24, 26);
          }
          { const bf16x8 bfrag = pack_acc(St[2], 1);
            GL_LWAIT(3, f2); o0 = MFMA32(__builtin_bit_cast(bf16x8, f2), bfrag, o0); GL_DSR2X64(f2, qa, 28, 30);
            GL_LWAIT(3, f3); o1 = MFMA32(__builtin_bit_cast(bf16x8, f3), bfrag, o1); GL_DSR2X64(f3, qb, 28, 30);
          }
          { const bf16x8 bfrag = pack_acc(St[3], 0);
            GL_LWAIT(3, f0); o0 = MFMA32(__builtin_bit_cast(bf16x8, f0), bfrag, o0);
            GL_LWAIT(2, f1); o1 = MFMA32(__builtin_bit_cast(bf16x8, f1), bfrag, o1);
          }
          { const bf16x8 bfrag = pack_acc(St[3], 1);
            GL_LWAIT(1, f2); o0 = MFMA32(__builtin_bit_cast(bf16x8, f2), bfrag, o0);
            GL_LWAIT(0, f3); o1 = MFMA32(__builtin_bit_cast(bf16x8, f3), bfrag, o1);
          }
        }
        { const unsigned aa = (unsigned)(__UINTPTR_TYPE__)(lds + GL_A + r * GL_PT + 16 * h), ka = (unsigned)(__UINTPTR_TYPE__)(lds + GL_KDT + r * GL_PT + 16 * h);
          v4u f0, f1, f2, f3;
          GL_DSR128(f0, aa, 0);
          GL_DSR128(f1, aa, 4608);
          GL_DSR128(f2, ka, 0);
          GL_DSR128(f3, ka, 4608);
#pragma unroll
          for (int dt = 0; dt < 4; ++dt)
#pragma unroll
              for (int g = 0; g < 4; ++g) { const f32x4 dc = *(const LAS f32x4*)(lds + GL_DEC + (32 * dt + 8 * g + 4 * h) * 4);
                  St[dt][4 * g + 0] *= dc.x; St[dt][4 * g + 1] *= dc.y; St[dt][4 * g + 2] *= dc.z; St[dt][4 * g + 3] *= dc.w; }
          { v4u x; const LAS unsigned char* vp = lds + GL_V + (0 + 8 * h) * GL_PV + (32 * w + r) * 2;
            x.x = (unsigned)lds_u16(vp) | ((unsigned)lds_u16(vp + GL_PV) << 16); x.y = (unsigned)lds_u16(vp + 2 * GL_PV) | ((unsigned)lds_u16(vp + 3 * GL_PV) << 16);
            x.z = (unsigned)lds_u16(vp + 4 * GL_PV) | ((unsigned)lds_u16(vp + 5 * GL_PV) << 16); x.w = (unsigned)lds_u16(vp + 6 * GL_PV) | ((unsigned)lds_u16(vp + 7 * GL_PV) << 16);
            const bf16x8 vf = __builtin_bit_cast(bf16x8, x);
            GL_LWAIT(3, f0); o0 = MFMA32(__builtin_bit_cast(bf16x8, f0), vf, o0); GL_DSR128(f0, ka, 9216);
            GL_LWAIT(3, f1); o1 = MFMA32(__builtin_bit_cast(bf16x8, f1), vf, o1); GL_DSR128(f1, ka, 13824);
            GL_LWAIT(3, f2); St[0] = MFMA32(__builtin_bit_cast(bf16x8, f2), vf, St[0]); GL_DSR128(f2, aa, 32);
            GL_LWAIT(3, f3); St[1] = MFMA32(__builtin_bit_cast(bf16x8, f3), vf, St[1]); GL_DSR128(f3, aa, 4640);
            GL_LWAIT(3, f0); St[2] = MFMA32(__builtin_bit_cast(bf16x8, f0), vf, St[2]); GL_DSR128(f0, ka, 32);
            GL_LWAIT(3, f1); St[3] = MFMA32(__builtin_bit_cast(bf16x8, f1), vf, St[3]); GL_DSR128(f1, ka, 4640);
          }
          { v4u x; const LAS unsigned char* vp = lds + GL_V + (16 + 8 * h) * GL_PV + (32 * w + r) * 2;
            x.x = (unsigned)lds_u16(vp) | ((unsigned)lds_u16(vp + GL_PV) << 16); x.y = (unsigned)lds_u16(vp + 2 * GL_PV) | ((unsigned)lds_u16(vp + 3 * GL_PV) << 16);
            x.z = (unsigned)lds_u16(vp + 4 * GL_PV) | ((unsigned)lds_u16(vp + 5 * GL_PV) << 16); x.w = (unsigned)lds_u16(vp + 6 * GL_PV) | ((unsigned)lds_u16(vp + 7 * GL_PV) << 16);
            const bf16x8 vf = __builtin_bit_cast(bf16x8, x);
            GL_LWAIT(3, f2); o0 = MFMA32(__builtin_bit_cast(bf16x8, f2), vf, o0); GL_DSR128(f2, ka, 9248);
            GL_LWAIT(3, f3); o1 = MFMA32(__builtin_bit_cast(bf16x8, f3), vf, o1); GL_DSR128(f3, ka, 13856);
            GL_LWAIT(3, f0); St[0] = MFMA32(__builtin_bit_cast(bf16x8, f0), vf, St[0]); GL_DSR128(f0, aa, 4672);
            GL_LWAIT(3, f1); St[1] = MFMA32(__builtin_bit_cast(bf16x8, f1), vf, St[1]); GL_DSR128(f1, ka, 64);
            GL_LWAIT(3, f2); St[2] = MFMA32(__builtin_bit_cast(bf16x8, f2), vf, St[2]); GL_DSR128(f2, ka, 4672);
            GL_LWAIT(3, f3); St[3] = MFMA32(__builtin_bit_cast(bf16x8, f3), vf, St[3]); GL_DSR128(f3, ka, 9280);
          }
          { v4u x; const LAS unsigned char* vp = lds + GL_V + (32 + 8 * h) * GL_PV + (32 * w + r) * 2;
            x.x = (unsigned)lds_u16(vp) | ((unsigned)lds_u16(vp + GL_PV) << 16); x.y = (unsigned)lds_u16(vp + 2 * GL_PV) | ((unsigned)lds_u16(vp + 3 * GL_PV) << 16);
            x.z = (unsigned)lds_u16(vp + 4 * GL_PV) | ((unsigned)lds_u16(vp + 5 * GL_PV) << 16); x.w = (unsigned)lds_u16(vp + 6 * GL_PV) | ((unsigned)lds_u16(vp + 7 * GL_PV) << 16);
            const bf16x8 vf = __builtin_bit_cast(bf16x8, x);
            GL_LWAIT(3, f0); o1 = MFMA32(__builtin_bit_cast(bf16x8, f0), vf, o1); GL_DSR128(f0, ka, 13888);
            GL_LWAIT(3, f1); St[0] = MFMA32(__builtin_bit_cast(bf16x8, f1), vf, St[0]); GL_DSR128(f1, aa, 4704);
            GL_LWAIT(3, f2); St[1] = MFMA32(__builtin_bit_cast(bf16x8, f2), vf, St[1]); GL_DSR128(f2, ka, 96);
            GL_LWAIT(3, f3); St[2] = MFMA32(__builtin_bit_cast(bf16x8, f3), vf, St[2]); GL_DSR128(f3, ka, 4704);
            GL_LWAIT(3, f0); St[3] = MFMA32(__builtin_bit_cast(bf16x8, f0), vf, St[3]); GL_DSR128(f0, ka, 9312);
          }
          { v4u x; const LAS unsigned char* vp = lds + GL_V + (48 + 8 * h) * GL_PV + (32 * w + r) * 2;
            x.x = (unsigned)lds_u16(vp) | ((unsigned)lds_u16(vp + GL_PV) << 16); x.y = (unsigned)lds_u16(vp + 2 * GL_PV) | ((unsigned)lds_u16(vp + 3 * GL_PV) << 16);
            x.z = (unsigned)lds_u16(vp + 4 * GL_PV) | ((unsigned)lds_u16(vp + 5 * GL_PV) << 16); x.w = (unsigned)lds_u16(vp + 6 * GL_PV) | ((unsigned)lds_u16(vp + 7 * GL_PV) << 16);
            const bf16x8 vf = __builtin_bit_cast(bf16x8, x);
            GL_LWAIT(3, f1); o1 = MFMA32(__builtin_bit_cast(bf16x8, f1), vf, o1); GL_DSR128(f1, ka, 13920);
            GL_LWAIT(3, f2); St[0] = MFMA32(__builtin_bit_cast(bf16x8, f2), vf, St[0]);
            GL_LWAIT(2, f3); St[1] = MFMA32(__builtin_bit_cast(bf16x8, f3), vf, St[1]);
            GL_LWAIT(1, f0); St[2] = MFMA32(__builtin_bit_cast(bf16x8, f0), vf, St[2]);
            GL_LWAIT(0, f1); St[3] = MFMA32(__builtin_bit_cast(bf16x8, f1), vf, St[3]);
          }
          asm volatile("" ::: "memory"); }
        }
        WG_RAW_BARRIER();
        { int tz_ = tid; asm volatile("" : "+v"(tz_)); const int lane = tz_ & 63, r = lane & 31, h = lane >> 5;
#pragma unroll
        for (int reg = 0; reg < 16; ++reg) { const int i = (reg & 3) + 8 * (reg >> 2) + 4 * h;
            *(LAS float*)(lds + GL_OS + i * GL_PO + (32 * w + r) * 4) = o0[reg]; *(LAS float*)(lds + GL_OS + (32 + i) * GL_PO + (32 * w + r) * 4) = o1[reg]; } }
        WG_RAW_BARRIER();
        { int tz_ = tid; asm volatile("" : "+v"(tz_)); const int lane = tz_ & 63;
        const f32x4 gn4 = *(const f32x4*)(gn + 4 * lane);
#pragma unroll
        for (int q = 0; q < 8; ++q) { const int i = 8 * w + q; const size_t row = (size_t)(r0 + i);
            const f32x4 ov = *(const LAS f32x4*)(lds + GL_OS + i * GL_PO + lane * 16);
            float ss = (ov.x * ov.x + ov.y * ov.y) + (ov.z * ov.z + ov.w * ov.w); ss = wave_sum(ss);
            const float rs = __builtin_amdgcn_rsqf(ss * (1.f / 256.f) + EPS);
            const v2u gw = gwv[q];
            const float z0 = __uint_as_float(gw.x << 16), z1 = __uint_as_float(gw.x & 0xffff0000u), z2 = __uint_as_float(gw.y << 16), z3 = __uint_as_float(gw.y & 0xffff0000u);
                        *(unsigned*)(ycat8 + row * KBR + 1024 + hh * 256 + 4 * lane) = pg8::pk4_fp8(ov.x * rs * gn4.x * (z0 * sigm(z0)), ov.y * rs * gn4.y * (z1 * sigm(z1)), ov.z * rs * gn4.z * (z2 * sigm(z2)), ov.w * rs * gn4.w * (z3 * sigm(z3))); } }
        WG_RAW_BARRIER();
    }
    { int tz_ = tid; asm volatile("" : "+v"(tz_)); const int lane = tz_ & 63, r = lane & 31, h = lane >> 5;
      float* op = A->out + O_P_GLA + (((size_t)l * NP + s) * 4 + hh) * 128 * 256 + 32 * w + r;
#pragma unroll
      for (int dt = 0; dt < 4; ++dt)
#pragma unroll
          for (int reg = 0; reg < 16; ++reg) op[(size_t)(32 * dt + (reg & 3) + 8 * (reg >> 2) + 4 * h) * 256] = St[dt][reg]; }
    __syncthreads();
}

constexpr int ML_Q = 0, ML_K = 33792, ML_KWT = 67584, ML_V = 104448, ML_S = 138240, ML_SC = 147456, ML_HS = 0;
constexpr int ML_PQ = 528, ML_PT = 144, ML_PH = 1040;
constexpr int IS_F = 0, IS_PM = 64, IS_RSP = 128, IS_NP = 192, IS_FL = 448, IS_CMAX = 449;
constexpr int SC_COLF = 512, SC_RDEN = 512, SC_QN = 576, SC_N = 1088, SC_CW = 576, SC_RAT = 1344;
static_assert(ML_SC + (576 + 1280) * 4 <= LDSCTL_OFF && 67 * 512 <= ML_V - ML_KWT, "mLSTM LDS map");
constexpr int MIMG_BYTES = 115712, MI_PIECES = 7232;
DI int mimg_lds_off(int idx) { return idx < 2112 ? ML_Q + idx * 16 : idx < 4416 ? ML_KWT + (idx - 2112) * 16 : idx < 6528 ? ML_V + (idx - 4416) * 16 : idx < 7104 ? ML_S + (idx - 6528) * 16 : ML_SC + (idx - 7104) * 16; }
DI float quad_bcast(float v, int cc) {
    const int x = __float_as_int(v); int y;
    switch (cc) { case 0: y = __builtin_amdgcn_mov_dpp(x, 0x00, 0xf, 0xf, true); break; case 1: y = __builtin_amdgcn_mov_dpp(x, 0x55, 0xf, 0xf, true); break;
                  case 2: y = __builtin_amdgcn_mov_dpp(x, 0xaa, 0xf, 0xf, true); break; default: y = __builtin_amdgcn_mov_dpp(x, 0xff, 0xf, 0xf, true); break; }
    return __int_as_float(y);
}
DI void ml_prep_unit(int l, int s, int hh, int c, LAS unsigned char* lds, int tid) {
    CArgs* A = kargs();
    const bf16* proj = (const bf16*)(A->ws + WS_PROJ); const float* sm = (const float*)(A->ws + WS_SMALL);
    const float* mcw = A->in[26] + (size_t)l * 4 * 1024; const float* mcb = A->in[27] + (size_t)l * 1024; const float* bif = A->in[31] + (size_t)l * 8;
    const int lane = tid & 63, w = __builtin_amdgcn_readfirstlane(tid >> 6), r = lane & 31, h = lane >> 5;
    const int c_ = tid & 255, seg = __builtin_amdgcn_readfirstlane(tid >> 8);
    LAS float* sc = (LAS float*)(lds + ML_SC);
    const int r0 = s * TP + 64 * c;
    { const bf16* pb = proj + ((ptrdiff_t)r0 - 3) * (ptrdiff_t)PPITCH + C_MX + hh * 256;
#pragma unroll
      for (int i = 0; i < 5; ++i) { const int idx = tid + 512 * i, row = idx >> 5; v4u x = {0u, 0u, 0u, 0u};
          if (idx < 2144) { if (64 * c - 3 + row >= 0) x = *(const v4u*)(pb + (unsigned)(row * PPITCH + 8 * (idx & 31))); *(LAS v4u*)(lds + ML_KWT + row * 512 + (idx & 31) * 16) = x; } }
      if (tid < 256) { const int ch0 = hh * 256 + tid;
          sc[SC_CW + tid] = mcw[ch0]; sc[SC_CW + 256 + tid] = mcw[1024 + ch0]; sc[SC_CW + 512 + tid] = mcw[2048 + ch0]; sc[SC_CW + 768 + tid] = mcw[3072 + ch0]; sc[SC_CW + 1024 + tid] = mcb[ch0]; }
      if (w == 0) {
          const float ig = sm[(size_t)(r0 + lane) * NSMALL + 16 + hh] + bif[hh];
          const float lf = logsig(sm[(size_t)(r0 + lane) * NSMALL + 20 + hh] + bif[4 + hh]);
          float F = lf;
#pragma unroll
          for (int o = 1; o < 64; o <<= 1) { const float t = __shfl_up(F, o); F += (lane >= o) ? t : 0.f; }
          const float colf = ig - F; float pm = colf;
#pragma unroll
          for (int o = 1; o < 64; o <<= 1) { const float t = __shfl_up(pm, o); pm = (lane >= o) ? fmaxf(pm, t) : pm; }
          sc[IS_F + lane] = F; sc[IS_PM + lane] = pm; sc[SC_COLF + lane] = colf;
          if (lane == 63) { sc[IS_FL] = F; sc[IS_CMAX] = pm; } } }
    float wq4[4], wk4[4], wv4[4];
    { const int wb = (64 * hh + (c_ >> 2)) * 16 + (c_ & 3);
#pragma unroll
      for (int cc = 0; cc < 4; ++cc) { wq4[cc] = A->in[28][(size_t)l * 4096 + wb + 4 * cc]; wk4[cc] = A->in[29][(size_t)l * 4096 + wb + 4 * cc] * 0.0625f; wv4[cc] = A->in[30][(size_t)l * 4096 + wb + 4 * cc]; } }
    __syncthreads();
    { const float cw0 = sc[SC_CW + c_], cw1 = sc[SC_CW + 256 + c_], cw2 = sc[SC_CW + 512 + c_], cw3 = sc[SC_CW + 768 + c_], cbv = sc[SC_CW + 1024 + c_];
      const LAS unsigned char* xp = lds + ML_KWT + (32 * seg) * 512 + c_ * 2;
      float x0 = bf2f(lds_u16(xp)), x1 = bf2f(lds_u16(xp + 512)), x2 = bf2f(lds_u16(xp + 1024));
#pragma unroll 8
      for (int t = 0; t < 32; ++t) {
          const float x3 = bf2f(lds_u16(xp + (3 + t) * 512));
          const float pre = cbv + cw0 * x0 + cw1 * x1 + cw2 * x2 + cw3 * x3, mc = pre * sigm(pre);
          float q = 0.f, k = 0.f, v = 0.f;
#pragma unroll
          for (int cc = 0; cc < 4; ++cc) { const float mcv = quad_bcast(mc, cc), xv = quad_bcast(x3, cc); q += mcv * wq4[cc]; k += mcv * wk4[cc]; v += xv * wv4[cc]; }
          const int j = 32 * seg + t;
          *(LAS unsigned short*)(lds + ML_Q + j * ML_PQ + c_ * 2) = (unsigned short)(pkbf(q, 0.f) & 0xffffu);
          *(LAS unsigned short*)(lds + ML_K + j * ML_PQ + c_ * 2) = (unsigned short)(pkbf(k, 0.f) & 0xffffu);
          *(LAS unsigned short*)(lds + ML_V + j * ML_PQ + c_ * 2) = (unsigned short)(pkbf(v, 0.f) & 0xffffu);
          if (c == TP / 64 - 1 && seg == 1 && t >= 29) A->out[O_P_MLC + (((size_t)l * NP + s) * 3 + (t - 29)) * 1024 + hh * 256 + c_] = x3;
          x0 = x1; x1 = x2; x2 = x3;
      } }
    __syncthreads();
    { const float cmax = sc[IS_CMAX]; float np = 0.f; v4u kk[4];
#pragma unroll
      for (int t8 = 0; t8 < 4; ++t8) { float kw[8];
#pragma unroll
          for (int t = 0; t < 8; ++t) { const int j = 32 * seg + 8 * t8 + t; kw[t] = bf2f(lds_u16(lds + ML_K + j * ML_PQ + c_ * 2)) * __expf(sc[SC_COLF + j] - cmax); np += kw[t]; }
          kk[t8].x = pkbf(kw[0], kw[1]); kk[t8].y = pkbf(kw[2], kw[3]); kk[t8].z = pkbf(kw[4], kw[5]); kk[t8].w = pkbf(kw[6], kw[7]); }
#pragma unroll
      for (int t8 = 0; t8 < 4; ++t8) *(LAS v4u*)(lds + ML_KWT + c_ * ML_PT + seg * 64 + t8 * 16) = kk[t8];
      sc[SC_QN + seg * 256 + c_] = np; }
    if (w < 3) { const int it = (w >= 1) ? 1 : 0, jt = (w == 2) ? 1 : 0; f32x16 a;
#pragma unroll
        for (int i = 0; i < 16; ++i) a[i] = 0.f;
#pragma unroll
        for (int s16 = 0; s16 < 16; ++s16) { a = MFMA32(frag16(lds + ML_Q + (32 * it + r) * ML_PQ + (16 * s16 + 8 * h) * 2), frag16(lds + ML_K + (32 * jt + r) * ML_PQ + (16 * s16 + 8 * h) * 2), a);
            if ((s16 & 3) == 3) asm volatile("" ::: "memory"); }
        const int j = 32 * jt + r; const float cf = sc[SC_COLF + j];
#pragma unroll
        for (int g = 0; g < 4; ++g) { const f32x4 pmv = *(const LAS f32x4*)(sc + IS_PM + 32 * it + 8 * g + 4 * h);
#pragma unroll
            for (int q = 0; q < 4; ++q) { const int i = 32 * it + 8 * g + 4 * h + q; const float val = (j <= i) ? a[4 * g + q] * __expf(cf - pmv[q]) : 0.f;
                *(LAS unsigned short*)(lds + ML_S + i * ML_PT + j * 2) = (unsigned short)(pkbf(val, 0.f) & 0xffffu); } } }
    __syncthreads();
    if (w == 0) { const int i = lane; float rs_ = 0.f;
#pragma unroll
        for (int k8 = 0; k8 < 8; ++k8) { const v4u sw = *(const LAS v4u*)(lds + ML_S + i * ML_PT + k8 * 16);
            const float t8 = (bflo_(sw.x) + bfhi_(sw.x)) + (bflo_(sw.y) + bfhi_(sw.y)) + (bflo_(sw.z) + bfhi_(sw.z)) + (bflo_(sw.w) + bfhi_(sw.w));
            rs_ += (k8 < 4 || i >= 32) ? t8 : 0.f; }
        sc[IS_RSP + i] = rs_; }
    if (tid < 256) sc[IS_NP + tid] = sc[SC_QN + tid] + sc[SC_QN + 256 + tid];
    __syncthreads();
    { unsigned char* img = A->ws + WS_MIMG + (size_t)((s * 4 + hh) * (TP / 64) + c) * MIMG_BYTES;
      for (int idx = tid; idx < MI_PIECES; idx += NTHREADS) *(v4u*)(img + (size_t)idx * 16) = *(const LAS v4u*)(lds + mimg_lds_off(idx)); }
    __syncthreads();
}

DI void ml_img_dma(const unsigned char* img, LAS unsigned char* lds, int ih, int w, int lane) {
    for (int k = w; k < MI_PIECES / 64; k += NWAVES) {
        const bool skip = ih ? (k < 16 || (k >= 102 && k < 106)) : ((k > 16 && k < 33) || (k > 106 && k < 111));
        if (!skip) __builtin_amdgcn_global_load_lds((const unsigned*)(img + (size_t)(64 * k + lane) * 16), (LAS unsigned*)(lds + mimg_lds_off(64 * k)), 16, 0, 0); }
}
#define ML_RAW_BARRIER() asm volatile("s_waitcnt lgkmcnt(0)\n\ts_barrier" ::: "memory")
#define ML_DSR128(dst, addr, off) asm volatile("ds_read_b128 %0, %1 offset:" #off : "=v"(dst) : "v"(addr))
#define ML_DSR2X64(dst, addr, o0, o1) asm volatile("ds_read2_b64 %0, %1 offset0:" #o0 " offset1:" #o1 : "=v"(dst) : "v"(addr))
#define ML_LWAIT(n, x) asm volatile("s_waitcnt lgkmcnt(" #n ")" : "+v"(x))
constexpr int ML_HB = 33792, ML_PHB = 528;
DI void ml_seq_unit(int l, int s, int hh, int ih, LAS unsigned char* lds, int tid) {
    CArgs* A = kargs();
    const bf16* proj = (const bf16*)(A->ws + WS_PROJ); bf16* ycat = (bf16*)(A->ws + WS_YCAT); unsigned char* ycat8 = A->ws + WS_YCAT; (void)ycat; (void)ycat8;
    const float* gn = A->in[32] + (size_t)l * 256;
    const unsigned char* img0 = A->ws + WS_MIMG + (size_t)((s * 4 + hh) * (TP / 64)) * MIMG_BYTES;
    const int w = __builtin_amdgcn_readfirstlane(tid >> 6);
    LAS float* sc = (LAS float*)(lds + ML_SC);
    f32x16 Ct[8];
#pragma unroll
    for (int dt = 0; dt < 8; ++dt)
#pragma unroll
        for (int i = 0; i < 16; ++i) Ct[dt][i] = 0.f;
    if (tid < 256) sc[SC_N + tid] = 0.f;
    float m = 0.f, sg = 1.f;
#ifdef PROBE_ABL
    const int abl = (kargs()->li == 1) ? PROBE_ABL : 0;
#else
    constexpr int abl = 0;
#endif
    __syncthreads();
    ml_img_dma(img0, lds, ih, w, tid & 63);
    for (int c = 0; c < TP / 64; ++c) {
        const int r0 = s * TP + 64 * c;
        if (c == 0) asm volatile("s_waitcnt vmcnt(0)" ::: "memory"); else asm volatile("s_waitcnt vmcnt(4)" ::: "memory");
        ML_RAW_BARRIER();
        { int tz_ = tid; asm volatile("" : "+v"(tz_)); const int i = tz_ & 63; float acc = 0.f;
#pragma unroll
          for (int k8 = 0; k8 < 4; ++k8) { const v4u qw = *(const LAS v4u*)(lds + ML_Q + i * ML_PQ + (32 * w + 8 * k8) * 2);
              const f32x4 n0 = *(const LAS f32x4*)(sc + SC_N + 32 * w + 8 * k8), n1 = *(const LAS f32x4*)(sc + SC_N + 32 * w + 8 * k8 + 4);
              acc += bflo_(qw.x) * n0.x + bfhi_(qw.x) * n0.y + bflo_(qw.y) * n0.z + bfhi_(qw.y) * n0.w + bflo_(qw.z) * n1.x + bfhi_(qw.z) * n1.y + bflo_(qw.w) * n1.z + bfhi_(qw.w) * n1.w; }
          sc[SC_QN + w * 64 + i] = acc;
          if (w == 1) sc[SC_RAT + i] = __expf(fminf(m - sc[IS_PM + i], 60.f)) * sg; }
        const float FL = sc[IS_FL], cmax = sc[IS_CMAX];
        const float cs = __expf(fminf(0.f, m - cmax)), s2 = __expf(fminf(0.f, cmax - m));
        v2u mo[4]; f32x4 gn4;
        { int tm_ = tid; asm volatile("" : "+v"(tm_)); const unsigned lo_ = 4u * (unsigned)(tm_ & 63);
          const bf16* mb_ = proj + (size_t)(r0 + 32 * ih + 4 * w) * PPITCH + C_MO + hh * 256;
#pragma unroll
          for (int q = 0; q < 4; ++q) mo[q] = *(const v2u*)(mb_ + (unsigned)(q * PPITCH) + lo_);
          gn4 = *(const f32x4*)(gn + lo_); }
        ML_RAW_BARRIER();
        f32x16 o0;
        { int tz_ = tid; asm volatile("" : "+v"(tz_)); const int lane = tz_ & 63, r = lane & 31, h = lane >> 5;
        if (w == 0) { const int i = lane; const float pmi = sc[IS_PM + i];
            float qn = 0.f;
#pragma unroll
            for (int p = 0; p < 8; ++p) qn += sc[SC_QN + p * 64 + i];
            const float den = __expf(fminf(0.f, m - pmi)) * qn + __expf(fminf(0.f, pmi - m)) * sc[IS_RSP + i];
            sc[SC_RDEN + i] = __expf(-fminf(fmaxf(m - pmi, 0.f), 60.f)) / fmaxf(fabsf(den), __expf(-(sc[IS_F + i] + fmaxf(m, pmi)))); }
        if (tz_ < 256) sc[SC_N + tz_] = cs * sc[SC_N + tz_] + s2 * sc[IS_NP + tz_];
#pragma unroll
        for (int i = 0; i < 16; ++i) o0[i] = 0.f;
        { const unsigned qa = (unsigned)(__UINTPTR_TYPE__)(lds + ML_Q + (32 * ih + r) * ML_PQ + 8 * h);
          v4u q0, q1, q2, q3;
          ML_DSR2X64(q0, qa, 0, 2);
          ML_DSR2X64(q1, qa, 4, 6);
          ML_DSR2X64(q2, qa, 8, 10);
          ML_DSR2X64(q3, qa, 12, 14);
          { const bf16x8 bfrag = pack_acc(Ct[0], 0); ML_LWAIT(3, q0); o0 = MFMA32(__builtin_bit_cast(bf16x8, q0), bfrag, o0); ML_DSR2X64(q0, qa, 16, 18); }
          { const bf16x8 bfrag = pack_acc(Ct[0], 1); ML_LWAIT(3, q1); o0 = MFMA32(__builtin_bit_cast(bf16x8, q1), bfrag, o0); ML_DSR2X64(q1, qa, 20, 22); }
          { const bf16x8 bfrag = pack_acc(Ct[1], 0); ML_LWAIT(3, q2); o0 = MFMA32(__builtin_bit_cast(bf16x8, q2), bfrag, o0); ML_DSR2X64(q2, qa, 24, 26); }
          { const bf16x8 bfrag = pack_acc(Ct[1], 1); ML_LWAIT(3, q3); o0 = MFMA32(__builtin_bit_cast(bf16x8, q3), bfrag, o0); ML_DSR2X64(q3, qa, 28, 30); }
          { const bf16x8 bfrag = pack_acc(Ct[2], 0); ML_LWAIT(3, q0); o0 = MFMA32(__builtin_bit_cast(bf16x8, q0), bfrag, o0); ML_DSR2X64(q0, qa, 32, 34); }
          { const bf16x8 bfrag = pack_acc(Ct[2], 1); ML_LWAIT(3, q1); o0 = MFMA32(__builtin_bit_cast(bf16x8, q1), bfrag, o0); ML_DSR2X64(q1, qa, 36, 38); }
          { const bf16x8 bfrag = pack_acc(Ct[3], 0); ML_LWAIT(3, q2); o0 = MFMA32(__builtin_bit_cast(bf16x8, q2), bfrag, o0); ML_DSR2X64(q2, qa, 40, 42); }
          { const bf16x8 bfrag = pack_acc(Ct[3], 1); ML_LWAIT(3, q3); o0 = MFMA32(__builtin_bit_cast(bf16x8, q3), bfrag, o0); ML_DSR2X64(q3, qa, 44, 46); }
          { const bf16x8 bfrag = pack_acc(Ct[4], 0); ML_LWAIT(3, q0); o0 = MFMA32(__builtin_bit_cast(bf16x8, q0), bfrag, o0); ML_DSR2X64(q0, qa, 48, 50); }
          { const bf16x8 bfrag = pack_acc(Ct[4], 1); ML_LWAIT(3, q1); o0 = MFMA32(__builtin_bit_cast(bf16x8, q1), bfrag, o0); ML_DSR2X64(q1, qa, 52, 54); }
          { const bf16x8 bfrag = pack_acc(Ct[5], 0); ML_LWAIT(3, q2); o0 = MFMA32(__builtin_bit_cast(bf16x8, q2), bfrag, o0); ML_DSR2X64(q2, qa, 56, 58); }
          { const bf16x8 bfrag = pack_acc(Ct[5], 1); ML_LWAIT(3, q3); o0 = MFMA32(__builtin_bit_cast(bf16x8, q3), bfrag, o0); ML_DSR2X64(q3, qa, 60, 62); }
          { const bf16x8 bfrag = pack_acc(Ct[6], 0); ML_LWAIT(3, q0); o0 = MFMA32(__builtin_bit_cast(bf16x8, q0), bfrag, o0); }
          { const bf16x8 bfrag = pack_acc(Ct[6], 1); ML_LWAIT(2, q1); o0 = MFMA32(__builtin_bit_cast(bf16x8, q1), bfrag, o0); }
          { const bf16x8 bfrag = pack_acc(Ct[7], 0); ML_LWAIT(1, q2); o0 = MFMA32(__builtin_bit_cast(bf16x8, q2), bfrag, o0); }
          { const bf16x8 bfrag = pack_acc(Ct[7], 1); ML_LWAIT(0, q3); o0 = MFMA32(__builtin_bit_cast(bf16x8, q3), bfrag, o0); }
        }
#pragma unroll
        for (int g = 0; g < 4; ++g) { const f32x4 p0 = *(const LAS f32x4*)(sc + SC_RAT + 32 * ih + 8 * g + 4 * h);
#pragma unroll
            for (int q = 0; q < 4; ++q) o0[4 * g + q] *= p0[q]; }
        sg *= cs;
        if (sg < 1e-12f) {
#pragma unroll
            for (int dt = 0; dt < 8; ++dt)
#pragma unroll
                for (int i = 0; i < 16; ++i) Ct[dt][i] *= sg;
            sg = 1.f; }
        const float vsc = s2 * __builtin_amdgcn_rcpf(sg);
        { const LAS unsigned char* vp = lds + ML_V + (8 * h) * ML_PQ + (32 * w + r) * 2;
          const unsigned ka = (unsigned)(__UINTPTR_TYPE__)(lds + ML_KWT + r * ML_PT + 16 * h);
          const LAS unsigned char* pp = lds + ML_S + (32 * ih + r) * ML_PT + 16 * h;
          v4u k0, k1, k2, k3;
          ML_DSR128(k0, ka, 0);
          ML_DSR128(k1, ka, 4608);
          ML_DSR128(k2, ka, 9216);
          ML_DSR128(k3, ka, 13824);
          { float vv[8];
#pragma unroll
            for (int jj = 0; jj < 8; ++jj) vv[jj] = bf2f(lds_u16(vp + (0 + jj) * ML_PQ));
            const v4u xu = {pkbf(vv[0], vv[1]), pkbf(vv[2], vv[3]), pkbf(vv[4], vv[5]), pkbf(vv[6], vv[7])};
            const v4u xs = {pkbf(vv[0] * vsc, vv[1] * vsc), pkbf(vv[2] * vsc, vv[3] * vsc), pkbf(vv[4] * vsc, vv[5] * vsc), pkbf(vv[6] * vsc, vv[7] * vsc)};
            const bf16x8 vf = __builtin_bit_cast(bf16x8, xu), vfs = __builtin_bit_cast(bf16x8, xs);
            o0 = MFMA32(frag16(pp + 0), vf, o0);
            ML_LWAIT(3, k0); Ct[0] = MFMA32(__builtin_bit_cast(bf16x8, k0), vfs, Ct[0]); ML_DSR128(k0, ka, 18432);
            ML_LWAIT(3, k1); Ct[1] = MFMA32(__builtin_bit_cast(bf16x8, k1), vfs, Ct[1]); ML_DSR128(k1, ka, 23040);
            ML_LWAIT(3, k2); Ct[2] = MFMA32(__builtin_bit_cast(bf16x8, k2), vfs, Ct[2]); ML_DSR128(k2, ka, 27648);
            ML_LWAIT(3, k3); Ct[3] = MFMA32(__builtin_bit_cast(bf16x8, k3), vfs, Ct[3]); ML_DSR128(k3, ka, 32256);
            ML_LWAIT(3, k0); Ct[4] = MFMA32(__builtin_bit_cast(bf16x8, k0), vfs, Ct[4]); ML_DSR128(k0, ka, 32);
            ML_LWAIT(3, k1); Ct[5] = MFMA32(__builtin_bit_cast(bf16x8, k1), vfs, Ct[5]); ML_DSR128(k1, ka, 4640);
            ML_LWAIT(3, k2); Ct[6] = MFMA32(__builtin_bit_cast(bf16x8, k2), vfs, Ct[6]); ML_DSR128(k2, ka, 9248);
            ML_LWAIT(3, k3); Ct[7] = MFMA32(__builtin_bit_cast(bf16x8, k3), vfs, Ct[7]); ML_DSR128(k3, ka, 13856);
          }
          { float vv[8];
#pragma unroll
            for (int jj = 0; jj < 8; ++jj) vv[jj] = bf2f(lds_u16(vp + (16 + jj) * ML_PQ));
            const v4u xu = {pkbf(vv[0], vv[1]), pkbf(vv[2], vv[3]), pkbf(vv[4], vv[5]), pkbf(vv[6], vv[7])};
            const v4u xs = {pkbf(vv[0] * vsc, vv[1] * vsc), pkbf(vv[2] * vsc, vv[3] * vsc), pkbf(vv[4] * vsc, vv[5] * vsc), pkbf(vv[6] * vsc, vv[7] * vsc)};
            const bf16x8 vf = __builtin_bit_cast(bf16x8, xu), vfs = __builtin_bit_cast(bf16x8, xs);
            o0 = MFMA32(frag16(pp + 32), vf, o0);
            ML_LWAIT(3, k0); Ct[0] = MFMA32(__builtin_bit_cast(bf16x8, k0), vfs, Ct[0]); ML_DSR128(k0, ka, 18464);
            ML_LWAIT(3, k1); Ct[1] = MFMA32(__builtin_bit_cast(bf16x8, k1), vfs, Ct[1]); ML_DSR128(k1, ka, 23072);
            ML_LWAIT(3, k2); Ct[2] = MFMA32(__builtin_bit_cast(bf16x8, k2), vfs, Ct[2]); ML_DSR128(k2, ka, 27680);
            ML_LWAIT(3, k3); Ct[3] = MFMA32(__builtin_bit_cast(bf16x8, k3), vfs, Ct[3]); ML_DSR128(k3, ka, 32288);
            ML_LWAIT(3, k0); Ct[4] = MFMA32(__builtin_bit_cast(bf16x8, k0), vfs, Ct[4]); ML_DSR128(k0, ka, 64);
            ML_LWAIT(3, k1); Ct[5] = MFMA32(__builtin_bit_cast(bf16x8, k1), vfs, Ct[5]); ML_DSR128(k1, ka, 4672);
            ML_LWAIT(3, k2); Ct[6] = MFMA32(__builtin_bit_cast(bf16x8, k2), vfs, Ct[6]); ML_DSR128(k2, ka, 9280);
            ML_LWAIT(3, k3); Ct[7] = MFMA32(__builtin_bit_cast(bf16x8, k3), vfs, Ct[7]); ML_DSR128(k3, ka, 13888);
          }
          { float vv[8];
#pragma unroll
            for (int jj = 0; jj < 8; ++jj) vv[jj] = bf2f(lds_u16(vp + (32 + jj) * ML_PQ));
            const v4u xu = {pkbf(vv[0], vv[1]), pkbf(vv[2], vv[3]), pkbf(vv[4], vv[5]), pkbf(vv[6], vv[7])};
            const v4u xs = {pkbf(vv[0] * vsc, vv[1] * vsc), pkbf(vv[2] * vsc, vv[3] * vsc), pkbf(vv[4] * vsc, vv[5] * vsc), pkbf(vv[6] * vsc, vv[7] * vsc)};
            const bf16x8 vf = __builtin_bit_cast(bf16x8, xu), vfs = __builtin_bit_cast(bf16x8, xs);
            if (ih == 1) o0 = MFMA32(frag16(pp + 64), vf, o0);
            ML_LWAIT(3, k0); Ct[0] = MFMA32(__builtin_bit_cast(bf16x8, k0), vfs, Ct[0]); ML_DSR128(k0, ka, 18496);
            ML_LWAIT(3, k1); Ct[1] = MFMA32(__builtin_bit_cast(bf16x8, k1), vfs, Ct[1]); ML_DSR128(k1, ka, 23104);
            ML_LWAIT(3, k2); Ct[2] = MFMA32(__builtin_bit_cast(bf16x8, k2), vfs, Ct[2]); ML_DSR128(k2, ka, 27712);
            ML_LWAIT(3, k3); Ct[3] = MFMA32(__builtin_bit_cast(bf16x8, k3), vfs, Ct[3]); ML_DSR128(k3, ka, 32320);
            ML_LWAIT(3, k0); Ct[4] = MFMA32(__builtin_bit_cast(bf16x8, k0), vfs, Ct[4]); ML_DSR128(k0, ka, 96);
            ML_LWAIT(3, k1); Ct[5] = MFMA32(__builtin_bit_cast(bf16x8, k1), vfs, Ct[5]); ML_DSR128(k1, ka, 4704);
            ML_LWAIT(3, k2); Ct[6] = MFMA32(__builtin_bit_cast(bf16x8, k2), vfs, Ct[6]); ML_DSR128(k2, ka, 9312);
            ML_LWAIT(3, k3); Ct[7] = MFMA32(__builtin_bit_cast(bf16x8, k3), vfs, Ct[7]); ML_DSR128(k3, ka, 13920);
          }
          { float vv[8];
#pragma unroll
            for (int jj = 0; jj < 8; ++jj) vv[jj] = bf2f(lds_u16(vp + (48 + jj) * ML_PQ));
            const v4u xu = {pkbf(vv[0], vv[1]), pkbf(vv[2], vv[3]), pkbf(vv[4], vv[5]), pkbf(vv[6], vv[7])};
            const v4u xs = {pkbf(vv[0] * vsc, vv[1] * vsc), pkbf(vv[2] * vsc, vv[3] * vsc), pkbf(vv[4] * vsc, vv[5] * vsc), pkbf(vv[6] * vsc, vv[7] * vsc)};
            const bf16x8 vf = __builtin_bit_cast(bf16x8, xu), vfs = __builtin_bit_cast(bf16x8, xs);
            if (ih == 1) o0 = MFMA32(frag16(pp + 96), vf, o0);
            ML_LWAIT(3, k0); Ct[0] = MFMA32(__builtin_bit_cast(bf16x8, k0), vfs, Ct[0]); ML_DSR128(k0, ka, 18528);
            ML_LWAIT(3, k1); Ct[1] = MFMA32(__builtin_bit_cast(bf16x8, k1), vfs, Ct[1]); ML_DSR128(k1, ka, 23136);
            ML_LWAIT(3, k2); Ct[2] = MFMA32(__builtin_bit_cast(bf16x8, k2), vfs, Ct[2]); ML_DSR128(k2, ka, 27744);
            ML_LWAIT(3, k3); Ct[3] = MFMA32(__builtin_bit_cast(bf16x8, k3), vfs, Ct[3]); ML_DSR128(k3, ka, 32352);
            ML_LWAIT(3, k0); Ct[4] = MFMA32(__builtin_bit_cast(bf16x8, k0), vfs, Ct[4]);
            ML_LWAIT(2, k1); Ct[5] = MFMA32(__builtin_bit_cast(bf16x8, k1), vfs, Ct[5]);
            ML_LWAIT(1, k2); Ct[6] = MFMA32(__builtin_bit_cast(bf16x8, k2), vfs, Ct[6]);
            ML_LWAIT(0, k3); Ct[7] = MFMA32(__builtin_bit_cast(bf16x8, k3), vfs, Ct[7]);
          }
          asm volatile("" ::: "memory"); }
        }
        m = FL + fmaxf(m, cmax);
        ML_RAW_BARRIER();
        { int tz_ = tid; asm volatile("" : "+v"(tz_)); const int lane = tz_ & 63, r = lane & 31, h = lane >> 5;
#pragma unroll
        for (int g = 0; g < 4; ++g) { const f32x4 d0 = *(const LAS f32x4*)(sc + SC_RDEN + 32 * ih + 8 * g + 4 * h);
#pragma unroll
            for (int q = 0; q < 4; ++q) { const int i = 8 * g + 4 * h + q;
                *(LAS unsigned short*)(lds + ML_HB + i * ML_PHB + (32 * w + r) * 2) = (unsigned short)(pkbf(o0[4 * g + q] * d0[q], 0.f) & 0xffffu); } }
        }
        float og[4][4];
#pragma unroll
        for (int q = 0; q < 4; ++q) { const v2u ow = mo[q];
            og[q][0] = sigm(__uint_as_float(ow.x << 16)) * gn4.x; og[q][1] = sigm(__uint_as_float(ow.x & 0xffff0000u)) * gn4.y;
            og[q][2] = sigm(__uint_as_float(ow.y << 16)) * gn4.z; og[q][3] = sigm(__uint_as_float(ow.y & 0xffff0000u)) * gn4.w; }
#pragma unroll
        for (int q = 0; q < 4; ++q) asm volatile("" : "+v"(og[q][0]), "+v"(og[q][1]), "+v"(og[q][2]), "+v"(og[q][3]));
        if (c + 1 < TP / 64 && !(abl & 1)) ml_img_dma(img0 + (size_t)(c + 1) * MIMG_BYTES, lds, ih, w, tid & 63);
        ML_RAW_BARRIER();
        { int tz_ = tid; asm volatile("" : "+v"(tz_)); const int lane = tz_ & 63;
#pragma unroll
        for (int q = 0; q < 4; ++q) { const int i = 4 * w + q; const size_t row = (size_t)(r0 + 32 * ih + i);
            const v2u hw = *(const LAS v2u*)(lds + ML_HB + i * ML_PHB + lane * 8);
            const float h0 = bflo_(hw.x), h1 = bfhi_(hw.x), h2 = bflo_(hw.y), h3 = bfhi_(hw.y);
            float ss = (h0 * h0 + h1 * h1) + (h2 * h2 + h3 * h3); ss = wave_sum(ss);
            const float rs = __builtin_amdgcn_rsqf(ss * (1.f / 256.f) + EPS);
                        *(unsigned*)(ycat8 + row * KBR + 2048 + hh * 256 + 4 * lane) = pg8::pk4_fp8(og[q][0] * (h0 * rs), og[q][1] * (h1 * rs), og[q][2] * (h2 * rs), og[q][3] * (h3 * rs)); }
        }
        ML_RAW_BARRIER();
    }
    { int tz_ = tid; asm volatile("" : "+v"(tz_)); const int lane = tz_ & 63, r = lane & 31, h = lane >> 5;
      const size_t bh = ((size_t)l * NP + s) * 4 + hh; float* cp = A->out + O_P_C + bh * 256 * 256 + 32 * w + r;
      if (ih == 0) {
#pragma unroll
      for (int dt = 0; dt < 8; ++dt)
#pragma unroll
          for (int reg = 0; reg < 16; ++reg) cp[(size_t)(32 * dt + (reg & 3) + 8 * (reg >> 2) + 4 * h) * 256] = Ct[dt][reg] * sg;
      if (tz_ < 256) A->out[O_P_N + bh * 256 + tz_] = sc[SC_N + tz_];
      if (tz_ == 0) A->out[O_P_M + bh] = m; } }
    __syncthreads();
}

constexpr int LR_WA = 0, LR_WX = 34816, LR_U = 69632, LR_UF = 87040, LR_AF = 119808, LR_SEG = 152576, LR_HC = 156672, LR_P = 272;
static_assert(LR_HC + 1024 <= LDSCTL_OFF, "LRU LDS map");
DI void lru_chunk_unit(int l, int s, int n, int dh, LAS unsigned char* lds, int tid) {
    CArgs* A = kargs();
    const bf16* proj = (const bf16*)(A->ws + WS_PROJ); unsigned char* ycat8 = A->ws + WS_YCAT;
    const float* cw = A->in[16] + (size_t)l * 4 * 1024 + n * 128; const float* cb = A->in[17] + (size_t)l * 1024 + n * 128;
    const float* wa = A->in[18] + ((size_t)l * 8 + n) * 128 * 128; const float* ba = A->in[19] + (size_t)l * 1024 + n * 128;
    const float* wx = A->in[20] + ((size_t)l * 8 + n) * 128 * 128; const float* bx = A->in[21] + (size_t)l * 1024 + n * 128;
    const float* lam = A->in[22] + (size_t)l * 1024 + n * 128;
    const int w = __builtin_amdgcn_readfirstlane(tid >> 6), seg = __builtin_amdgcn_readfirstlane(tid >> 7);
    for (int idx = tid; idx < 64 * 128; idx += NTHREADS) { const int c = idx >> 6, d = idx & 63;
        *(LAS unsigned short*)(lds + LR_WA + d * LR_P + c * 2) = (unsigned short)(pkbf(wa[c * 128 + 64 * dh + d], 0.f) & 0xffffu);
        *(LAS unsigned short*)(lds + LR_WX + d * LR_P + c * 2) = (unsigned short)(pkbf(wx[c * 128 + 64 * dh + d], 0.f) & 0xffffu); }
    if (tid < 256) *(LAS float*)(lds + LR_HC + tid * 4) = 0.f;
    const float w0 = cw[tid & 127], w1 = cw[1024 + (tid & 127)], w2 = cw[2048 + (tid & 127)], w3 = cw[3072 + (tid & 127)], bb = cb[tid & 127];
    const int dcol = 64 * dh + 32 * (w & 1) + (tid & 31);
    const float bav = ba[dcol], bxv = bx[dcol], ls = logsig(lam[dcol]);
    v4u pf[3];
#define LRU_PREFETCH(tn) do { int tp_ = tid; asm volatile("" : "+v"(tp_)); const bf16* pb_ = proj + ((ptrdiff_t)(s * TP + 64 * (tn)) - 3) * (ptrdiff_t)PPITCH + C_LRUX + n * 128; \
        _Pragma("unroll") for (int i_ = 0; i_ < 3; ++i_) { const int idx_ = tp_ + 512 * i_, row_ = idx_ >> 4; pf[i_] = (v4u){0u, 0u, 0u, 0u}; \
            if (idx_ < 1072 && 64 * (tn) - 3 + row_ >= 0) pf[i_] = *(const v4u*)(pb_ + (unsigned)(row_ * PPITCH + 8 * (idx_ & 15))); } } while (0)
    LRU_PREFETCH(0);
    __syncthreads();
    for (int tile = 0; tile < TP / 64; ++tile) {
        const int r0 = s * TP + 64 * tile;
        { int tz_ = tid; asm volatile("" : "+v"(tz_));
#pragma unroll
          for (int i = 0; i < 3; ++i) { const int idx = tz_ + 512 * i; if (idx < 1072) *(LAS v4u*)(lds + LR_AF + idx * 16) = pf[i]; } }
        WG_RAW_BARRIER();
        { int tz_ = tid; asm volatile("" : "+v"(tz_)); const int c = tz_ & 127;
          const LAS unsigned char* xp = lds + LR_AF + (16 * seg) * 256 + c * 2;
          float x0 = bf2f(lds_u16(xp)), x1 = bf2f(lds_u16(xp + 256)), x2 = bf2f(lds_u16(xp + 512));
#pragma unroll 8
          for (int t = 0; t < 16; ++t) { const float x3 = bf2f(lds_u16(xp + (3 + t) * 256)); const int j = 16 * seg + t;
              const float u = bb + w0 * x0 + w1 * x1 + w2 * x2 + w3 * x3;
              *(LAS unsigned short*)(lds + LR_U + j * LR_P + c * 2) = (unsigned short)(pkbf(u, 0.f) & 0xffffu);
              *(LAS float*)(lds + LR_UF + (j * 128 + c) * 4) = u;
              if (tile == TP / 64 - 1 && seg == 3 && t >= 13 && (c >> 6) == dh) A->out[O_P_LRUC + (((size_t)l * NP + s) * 3 + (t - 13)) * 1024 + n * 128 + c] = x3;
              x0 = x1; x1 = x2; x2 = x3; } }
        if (tile + 1 < TP / 64) LRU_PREFETCH(tile + 1);
        WG_RAW_BARRIER();
        if (w < 4) { int tz_ = tid; asm volatile("" : "+v"(tz_)); const int lane = tz_ & 63, r = lane & 31, h = lane >> 5;
          const int it = w >> 1, dtile = w & 1, dl = 32 * dtile + r, d = 64 * dh + dl;
          f32x16 ga, gx;
#pragma unroll
          for (int i = 0; i < 16; ++i) { ga[i] = 0.f; gx[i] = 0.f; }
#pragma unroll
          for (int s8 = 0; s8 < 8; ++s8) { const bf16x8 af = frag16(lds + LR_U + (32 * it + r) * LR_P + (16 * s8 + 8 * h) * 2);
              ga = MFMA32(af, frag16(lds + LR_WA + dl * LR_P + (16 * s8 + 8 * h) * 2), ga);
              gx = MFMA32(af, frag16(lds + LR_WX + dl * LR_P + (16 * s8 + 8 * h) * 2), gx); }
          float uu[16];
#pragma unroll
          for (int reg = 0; reg < 16; ++reg) { const int i = 32 * it + (reg & 3) + 8 * (reg >> 2) + 4 * h; uu[reg] = *(const LAS float*)(lds + LR_UF + (i * 128 + d) * 4); }
          asm volatile("" ::: "memory");
#pragma unroll
          for (int reg = 0; reg < 16; ++reg) { const int i = 32 * it + (reg & 3) + 8 * (reg >> 2) + 4 * h;
              const float rr = sigm(ga[reg] + bav), ii = sigm(gx[reg] + bxv), la = 8.f * rr * ls;
              LAS float* up = (LAS float*)(lds + LR_UF + (i * 128 + d) * 4);
              const float u = uu[reg];
              *(LAS float*)(lds + LR_AF + (i * 128 + d) * 4) = __expf(la);
              *up = lru_in_scale(la) * (ii * u); } }
        WG_RAW_BARRIER();
        float la_[8], lv_[8];
        { int tz_ = tid; asm volatile("" : "+v"(tz_)); const int dl = tz_ & 63, d = 64 * dh + dl;
          float Ap = 1.f, H = 0.f;
#pragma unroll
          for (int t = 0; t < 8; ++t) { const int i = 8 * w + t; la_[t] = *(const LAS float*)(lds + LR_AF + (i * 128 + d) * 4); lv_[t] = *(const LAS float*)(lds + LR_UF + (i * 128 + d) * 4); }
          asm volatile("" ::: "memory");
#pragma unroll
          for (int t = 0; t < 8; ++t) { H = la_[t] * H + lv_[t]; Ap *= la_[t]; }
          *(LAS float*)(lds + LR_SEG + (w * 64 + dl) * 4) = Ap; *(LAS float*)(lds + LR_SEG + 2048 + (w * 64 + dl) * 4) = H; }
        WG_RAW_BARRIER();
        { int tz_ = tid; asm volatile("" : "+v"(tz_)); const int dl = tz_ & 63;
          float hcur = *(const LAS float*)(lds + LR_HC + ((tile & 1) * 128 + dl) * 4);
          float pa_[7], ph_[7];
#pragma unroll
          for (int s2 = 0; s2 < 7; ++s2) { pa_[s2] = *(const LAS float*)(lds + LR_SEG + (s2 * 64 + dl) * 4); ph_[s2] = *(const LAS float*)(lds + LR_SEG + 2048 + (s2 * 64 + dl) * 4); }
          asm volatile("" ::: "memory");
#pragma unroll
          for (int s2 = 0; s2 < 7; ++s2) if (s2 < w) hcur = pa_[s2] * hcur + ph_[s2];
          unsigned char* yp = ycat8 + (size_t)(r0 + 8 * w) * KBR + n * 128 + 64 * dh + dl;
#pragma unroll
          for (int t = 0; t < 8; ++t) { hcur = la_[t] * hcur + lv_[t]; yp[(size_t)t * KBR] = (unsigned char)(pg8::pk4_fp8(hcur, 0.f, 0.f, 0.f) & 0xffu); }
          if (w == 7) { *(LAS float*)(lds + LR_HC + (((tile + 1) & 1) * 128 + dl) * 4) = hcur;
              if (tile == TP / 64 - 1) A->out[O_P_LRUH + ((size_t)l * NP + s) * 1024 + n * 128 + 64 * dh + dl] = hcur; } }
        WG_RAW_BARRIER();
    }
}

DI void lru_samp_unit(int l, int g, int n, LAS unsigned char* lds, int tid) {
    CArgs* A = kargs();
    const bf16* proj = (const bf16*)(A->ws + WS_PROJ); unsigned char* ycat8 = A->ws + WS_YCAT;
    const float* cw = A->in[16] + (size_t)l * 4 * 1024 + n * 128; const float* cb = A->in[17] + (size_t)l * 1024 + n * 128;
    const float* wa = A->in[18] + ((size_t)l * 8 + n) * 128 * 128; const float* ba = A->in[19] + (size_t)l * 1024 + n * 128;
    const float* wx = A->in[20] + ((size_t)l * 8 + n) * 128 * 128; const float* bx = A->in[21] + (size_t)l * 1024 + n * 128;
    const float* lam = A->in[22] + (size_t)l * 1024 + n * 128;
    const int w = __builtin_amdgcn_readfirstlane(tid >> 6), seg = __builtin_amdgcn_readfirstlane(tid >> 7);
    const int c = tid & 127, ch = n * 128 + c;
    float xs[4][7];
#pragma unroll
    for (int q = 0; q < 4; ++q) { const int b = 16 * g + 4 * seg + q;
#pragma unroll
        for (int j = 0; j < 3; ++j) xs[q][j] = A->in[5][(((size_t)l * NS + b) * 3 + j) * 1024 + ch];
#pragma unroll
        for (int t = 0; t < 4; ++t) xs[q][3 + t] = bf2f(proj[(size_t)(MP + b * TS + t) * PPITCH + C_LRUX + ch]); }
    const float w0 = cw[c], w1 = cw[1024 + c], w2 = cw[2048 + c], w3 = cw[3072 + c], bb = cb[c];
    const int dcol = 32 * (w & 3) + (tid & 31);
    const float bav = ba[dcol], bxv = bx[dcol], ls = logsig(lam[dcol]);
    float h0[4];
#pragma unroll
    for (int q = 0; q < 4; ++q) h0[q] = A->in[4][((size_t)l * NS + 16 * g + 4 * seg + q) * 1024 + ch];
    for (int idx = tid; idx < 128 * 128; idx += NTHREADS) { const int c2 = idx >> 7, d = idx & 127;
        *(LAS unsigned short*)(lds + LR_WA + d * LR_P + c2 * 2) = (unsigned short)(pkbf(wa[idx], 0.f) & 0xffffu);
        *(LAS unsigned short*)(lds + LR_WX + d * LR_P + c2 * 2) = (unsigned short)(pkbf(wx[idx], 0.f) & 0xffffu); }
#pragma unroll
    for (int q = 0; q < 4; ++q) { const int b = 16 * g + 4 * seg + q;
#pragma unroll
        for (int t = 0; t < 4; ++t) { const int j = 16 * seg + 4 * q + t; const float u = bb + w0 * xs[q][t] + w1 * xs[q][t + 1] + w2 * xs[q][t + 2] + w3 * xs[q][t + 3];
            *(LAS unsigned short*)(lds + LR_U + j * LR_P + c * 2) = (unsigned short)(pkbf(u, 0.f) & 0xffffu);
            *(LAS float*)(lds + LR_UF + (j * 128 + c) * 4) = u; }
#pragma unroll
        for (int j = 0; j < 3; ++j) A->out[O_S_LRUC + (((size_t)l * NS + b) * 3 + j) * 1024 + ch] = xs[q][4 + j]; }
    __syncthreads();
    { const int lane = tid & 63, r = lane & 31, h = lane >> 5, it = w >> 2, dtile = w & 3, d = 32 * dtile + r;
      f32x16 ga, gx;
#pragma unroll
      for (int i = 0; i < 16; ++i) { ga[i] = 0.f; gx[i] = 0.f; }
#pragma unroll
      for (int s8 = 0; s8 < 8; ++s8) { const bf16x8 af = frag16(lds + LR_U + (32 * it + r) * LR_P + (16 * s8 + 8 * h) * 2);
          ga = MFMA32(af, frag16(lds + LR_WA + d * LR_P + (16 * s8 + 8 * h) * 2), ga);
          gx = MFMA32(af, frag16(lds + LR_WX + d * LR_P + (16 * s8 + 8 * h) * 2), gx); }
#pragma unroll
      for (int reg = 0; reg < 16; ++reg) { const int i = 32 * it + (reg & 3) + 8 * (reg >> 2) + 4 * h;
          const float rr = sigm(ga[reg] + bav), ii = sigm(gx[reg] + bxv), la = 8.f * rr * ls;
          LAS float* up = (LAS float*)(lds + LR_UF + (i * 128 + d) * 4);
          const float u = *up;
          *(LAS float*)(lds + LR_AF + (i * 128 + d) * 4) = __expf(la);
          *up = lru_in_scale(la) * (ii * u); } }
    __syncthreads();
#pragma unroll
    for (int q = 0; q < 4; ++q) { const int b = 16 * g + 4 * seg + q; float hc = h0[q];
#pragma unroll
        for (int t = 0; t < 4; ++t) { const int j = 16 * seg + 4 * q + t;
            hc = *(const LAS float*)(lds + LR_AF + (j * 128 + c) * 4) * hc + *(const LAS float*)(lds + LR_UF + (j * 128 + c) * 4);
            ycat8[(size_t)(MP + b * TS + t) * KBR + ch] = (unsigned char)(pg8::pk4_fp8(hc, 0.f, 0.f, 0.f) & 0xffu); }
        A->out[O_S_LRUH + ((size_t)l * NS + b) * 1024 + ch] = hc; }
    __syncthreads();
}

#ifndef EN_PRO
#define EN_PRO 1
#endif
#ifndef EN_MOD
#define EN_MOD 1
#endif
#ifndef EN_NORM
#define EN_NORM 1
#endif
#ifndef EN_PROJ
#define EN_PROJ 1
#endif
#ifndef EN_MIX
#define EN_MIX 1
#endif
#ifndef EN_MERGE
#define EN_MERGE 1
#endif
#ifndef EN_OUT
#define EN_OUT 1
#endif
#ifndef EN_FF1
#define EN_FF1 1
#endif
#ifndef EN_FF2
#define EN_FF2 1
#endif
#ifndef EN_ML
#define EN_ML 1
#endif
#ifndef EN_GLA
#define EN_GLA 1
#endif
#ifndef EN_LRU
#define EN_LRU 1
#endif
#ifndef REP_MIXP
#define REP_MIXP 1
#endif
#ifndef REP_ML
#define REP_ML 1
#endif
#ifndef REP_GLA
#define REP_GLA 1
#endif
#ifndef REP_LRU
#define REP_LRU 1
#endif
#ifndef REP_MIXS
#define REP_MIXS 1
#endif
#ifndef REP_GEMM
#define REP_GEMM 1
#endif
#ifndef REP_PROJ
#define REP_PROJ REP_GEMM
#endif
#ifndef REP_MERGE
#define REP_MERGE REP_GEMM
#endif
#ifndef REP_OUT
#define REP_OUT REP_GEMM
#endif
#ifndef REP_FF1
#define REP_FF1 REP_GEMM
#endif
#ifndef REP_FF2
#define REP_FF2 REP_GEMM
#endif
#ifndef REP_PRO
#define REP_PRO 1
#endif
#ifndef REP_MIX
#define REP_MIX 1
#endif
#ifndef REP_NORM
#define REP_NORM 1
#endif
#define WSP(T, off) ((T*)(ws + (off)))

DI void conv_win(CArgs* A, unsigned char* ws, int l, LAS float* scr, int gw, int ngw, int lane, int gtid, int gthreads) {
    const float* w_in = A->in[15] + (size_t)l * D * DIN; bf16* wt_in = WSP(bf16, WS_WIN) + (size_t)l * NPROJ_PAD * D;
    transpose_job(w_in, DIN, D, 3072, wt_in, D, scr, gw, ngw, lane);
    unsigned char* wt8 = ws + (WS_WIN8_0 + (size_t)l * (WS_WIN8_1 - WS_WIN8_0));
    transpose_job_f8(w_in + 3088, DIN, D, 1024, wt8 + (size_t)3072 * D, D, 64.f, scr, gw, ngw, lane);
    transpose_job(w_in + 3088 + 1024, DIN, D, 1024, wt_in + (size_t)4096 * D, D, scr, gw, ngw, lane);
    transpose_job_f8(w_in + 3088 + 2048, DIN, D, 1024, wt8 + (size_t)5120 * D, D, 64.f, scr, gw, ngw, lane);
    transpose_job_f8(w_in + 6168, DIN, D, 6144, wt8 + (size_t)6144 * D, D, 64.f, scr, gw, ngw, lane);
    for (int i = gtid; i < 256 * D; i += gthreads) { const int j = i >> 11, k = i & 2047;
        const float v = j < 24 ? w_in[(size_t)k * DIN + (j < 16 ? 3072 + j : 6160 + (j - 16))] : 0.f;
        wt_in[(size_t)(NPROJ + j) * D + k] = (bf16)f2bf(v); }
}
DI void conv_rest(CArgs* A, unsigned char* ws, int l, LAS float* scr, int gw, int ngw, int lane, bool with_ff2, bool with_br = true) {
    if (with_br) {
    unsigned char* wt_br = ws + WS_WBR + (size_t)l * D * KBR;
    transpose_job_f8(A->in[33] + (size_t)l * 1024 * D, D, 1024, D, wt_br, KBR, 64.f, scr, gw, ngw, lane);
    transpose_job_f8(A->in[34] + (size_t)l * 1024 * D, D, 1024, D, wt_br + 1024, KBR, 64.f, scr, gw, ngw, lane);
    transpose_job_f8(A->in[35] + (size_t)l * 1024 * D, D, 1024, D, wt_br + 2048, KBR, 64.f, scr, gw, ngw, lane);
    transpose_job_f8(A->in[36] + (size_t)l * D * D, D, D, D, ws + WS_WOUT + (size_t)l * D * D, D, 64.f, scr, gw, ngw, lane); }
    if (with_ff2) { const float* src = A->in[37] + (size_t)l * D * DFF; unsigned char* dst = ws + WS_WFF1 + (size_t)l * DFF * D;
      for (int it = gw; it < (D / 64) * (DFF / 32); it += ngw) transpose_item_f8(src, DFF, DFF, dst, D, 64.f, scr, it, lane); }
    if (with_ff2) { const float* src = A->in[38] + (size_t)l * DFF * D; unsigned char* dst = ws + WS_WFF2 + (size_t)l * D * DFF;
      for (int it = gw; it < (DFF / 64) * (D / 32); it += ngw) transpose_item_f8(src, D, D, dst, DFF, 64.f, scr, it, lane); }
}
__global__ void __launch_bounds__(NTHREADS, 2) mk_fwd(Args a_unused) {
    extern __shared__ __attribute__((aligned(16))) unsigned char lds_raw[];
    LAS unsigned char* lds = (LAS unsigned char*)lds_raw;
    const int bid = blockIdx.x;
    constexpr int G = GRID, ngw = GRID * NWAVES;
#define TIDS() int tid_ = threadIdx.x; asm volatile("" : "+v"(tid_)); const int tid = tid_, lane = tid & 63, wave = __builtin_amdgcn_readfirstlane(tid >> 6), gw = bid * NWAVES + wave; (void)lane; (void)gw
    for (int u = threadIdx.x; u < (LDS_BYTES - LDSCTL_OFF) / 4; u += NTHREADS) ((LAS unsigned*)(lds + LDSCTL_OFF))[u] = 0u;
    __syncthreads();
    int lo, hi;
    { CArgs* A = kargs(); lo = A->ph_lo; hi = A->ph_hi;
      (void)xcd_barrier_post((unsigned*)(A->ws + WS_CTL) + CW_BAR + A->li * XCD_BAR_WORDS, (volatile LAS unsigned*)(lds + MISC_OFF) + 8); }
#define IN(k) (lo <= (k) && (k) < hi)
#define SEAM(k) do { if (IN(k) && IN((k) + 1)) { CArgs* Ab = kargs(); XcdBarrier bar; bar.bar = (unsigned*)(Ab->ws + WS_CTL) + CW_BAR + Ab->li * XCD_BAR_WORDS; bar.x = xb_xcc_id(); \
        bar.st = (volatile LAS unsigned*)(lds + MISC_OFF) + 8; xcd_barrier(bar); } } while (0)

    if (EN_PRO && IN(0)) for (int rep_ = 0; rep_ < REP_PRO; ++rep_) {
        if (rep_) __syncthreads();
        TIDS(); CArgs* A = kargs(); unsigned char* const ws = A->ws;
        LAS float* scr = (LAS float*)(lds + RING_OFF + wave * 16384);
        for (int l = 0; l < DEPTH; ++l) transpose_job(A->in[11] + (size_t)l * D * NADA, NADA, D, NADA, WSP(bf16, WS_WADA) + (size_t)l * NADA * D, D, scr, gw, ngw, lane);
        for (int l = 0; l < DEPTH; ++l) { conv_win(A, ws, l, scr, gw, ngw, lane, bid * NTHREADS + tid, G * NTHREADS); conv_rest(A, ws, l, scr, gw, ngw, lane, l == 0, l == 0); }
        bf16* csilu = WSP(bf16, WS_CSILU);
        for (int i = bid * NTHREADS + tid; i < 256 * D; i += G * NTHREADS) { const int r = i >> 11, c = i & 2047;
            float v = 0.f;
            if (r < NP) v = A->in[2][r * D + c]; else if (r < NB) v = A->in[3][(r - NP) * D + c];
            csilu[i] = (bf16)f2bf(r < NB ? v * sigm(v) : 0.f); }
    }
    SEAM(0);

    if (EN_MOD && IN(1)) {
        CArgs* A = kargs(); unsigned char* const ws = A->ws;
        pg8::Gemm g{WSP(bf16, WS_CSILU), WSP(bf16, WS_WADA), 256, 2 * NADA, D, D, D}; pg8::StaticOrder S; S.init(256, 2 * NADA, G, bid);
        pg8::EpiF32 E{WSP(float, WS_MOD), 2 * NADA, A->in[12]};
        pg8::gemm_phase<pg8::EpiF32, pg8::StaticOrder>(lds + RING_OFF, g, S, E, nullptr);
    }
    SEAM(1);

    for (int l = 0; l < DEPTH; ++l) {
        const int pb = 2 + 9 * l;
        if (EN_NORM && IN(pb + 0)) { TIDS(); CArgs* A = kargs(); unsigned char* const ws = A->ws;
            if (l == 0) norm_rows(A->in[0], A->in[1], true, A->in[13] + (size_t)l * D, WSP(float, WS_MOD) + (size_t)l * NADA, WSP(bf16, WS_XN), nullptr, nullptr, gw, ngw, lane, WSP(bf16, WS_XB), 0, nullptr, nullptr, nullptr, nullptr, ws + WS_XN8);
            else norm_rows(WSP(bf16, WS_XB), WSP(bf16, WS_XA) + (size_t)MP * D, false, A->in[13] + (size_t)l * D, WSP(float, WS_MOD) + (size_t)l * NADA, WSP(bf16, WS_XN), nullptr, nullptr, gw, ngw, lane, nullptr,
                           16, WSP(bf16, WS_GIMG), WSP(float, WS_MOD) + (size_t)(l - 1) * NADA + 10240, WSP(bf16, WS_XB) + (size_t)MP * D, nullptr, ws + WS_XN8); }
        SEAM(pb + 0);
        if (EN_PROJ && IN(pb + 1)) for (int rg_ = 0; rg_ < REP_PROJ; ++rg_) { CArgs* A = kargs(); unsigned char* const ws = A->ws;
            { pg8::Gemm g{WSP(bf16, WS_XN), WSP(bf16, WS_WIN) + (size_t)l * NPROJ_PAD * D, MTOT, NPROJ_PAD, D, D, D};
              pg8::TileMapOrder S; S.so.init(MTOT, 17 * 256, G, bid); S.t1 = 12; S.t2 = 16; S.s0 = 0; S.s1 = 4; S.s2 = 32;
              pg8::EpiProj E{WSP(bf16, WS_PROJ), WSP(float, WS_SMALL), 1.f, ws + WS_MG8};
              pg8::gemm_phase<pg8::EpiProj, pg8::TileMapOrder>(lds + RING_OFF, g, S, E, nullptr); }
            { pg8::Gemm g{(const bf16*)(ws + WS_XN8), (const bf16*)(ws + (WS_WIN8_0 + (size_t)l * (WS_WIN8_1 - WS_WIN8_0))), MTOT, NPROJ_PAD, D / 2, D / 2, D / 2};
              pg8::TileMapOrder S; S.so.init(MTOT, 32 * 256, G, bid); S.t1 = 4; S.t2 = 8; S.s0 = 12; S.s1 = 16; S.s2 = 16; S.nh = 72; S.sk = 2;
              pg8::EpiProj E{WSP(bf16, WS_PROJ), WSP(float, WS_SMALL), 1.f / 64.f, ws + WS_MG8};
              pg8::gemm_phase<pg8::EpiProj, pg8::TileMapOrder, true>(lds + RING_OFF, g, S, E, nullptr); } }
        SEAM(pb + 1);
        if (EN_MIX && IN(pb + 2)) {
            TIDS();
            for (int u = bid; u < 1024; u += G) { if (u < 512) ml_prep_unit(l, u >> 7, (u >> 5) & 3, u & 31, lds + RING_OFF, tid); else gla_prep_unit(l, (u - 512) >> 7, (u >> 5) & 3, u & 31, lds + RING_OFF, tid); }
        }
        SEAM(pb + 2);
        if (EN_MIX && IN(pb + 3)) for (int rep_ = 0; rep_ < REP_MIX; ++rep_) {
            if (rep_) __syncthreads();
            TIDS();
            LAS float* fl = (LAS float*)(lds + RING_OFF);
#ifdef PROBE_S
            if (kargs()->li == 1 && bid < 112) {} else
#endif
            if (bid < 112) { if (rep_ == 0 || REP_MIXP) {
            if (bid < 32) { if (EN_ML && (rep_ == 0 || REP_ML)) ml_seq_unit(l, bid >> 3, (bid >> 1) & 3, bid & 1, lds + RING_OFF, tid); }
            else if (bid < 48) { if (EN_GLA && (rep_ == 0 || REP_GLA)) gla_seq_unit(l, (bid - 32) >> 2, bid & 3, lds + RING_OFF, tid); }
            else if (bid < 112) { if (EN_LRU && (rep_ == 0 || REP_LRU)) lru_chunk_unit(l, (bid - 48) >> 4, ((bid - 48) >> 1) & 7, bid & 1, lds + RING_OFF, tid); }
            } }
            else if (rep_ == 0 || REP_MIXS) for (int v = bid - 112; v < 1280; v += G - 112) {
                if (v < 512) { if (EN_ML) ml_unit(l, NP + (v >> 2), v & 3, fl, tid, lane, wave); }
                else if (v < 1024) { if (EN_GLA) gla_unit(l, NP + ((v - 512) >> 2), v & 3, fl, tid, lane, wave); }
                else { if (EN_LRU && v < 1024 + 64) lru_samp_unit(l, (v - 1024) >> 3, v & 7, lds + RING_OFF, tid); }
            }
            if (bid >= 112 && rep_ == 0) {
                __syncthreads();
                CArgs* A = kargs(); LAS float* scr = (LAS float*)(lds + RING_OFF + wave * 16384);
                const float* src = (l == 0 ? A->in[38] : A->in[37]) + (size_t)DFF * D; unsigned char* dst = A->ws + (l == 0 ? WS_WFF2 : WS_WFF1) + (size_t)D * DFF;
                const int sld = l == 0 ? D : DFF, dld = l == 0 ? DFF : D;
                for (int it = (bid - 112) * NWAVES + wave; it < (DFF / 64) * (D / 32); it += (G - 112) * NWAVES) transpose_item_f8(src, sld, sld, dst, dld, 64.f, scr, it, lane);
                __syncthreads(); }
        }
        SEAM(pb + 3);
        if (EN_MERGE && IN(pb + 4)) for (int rg_ = 0; rg_ < REP_MERGE; ++rg_) { CArgs* A = kargs(); unsigned char* const ws = A->ws;
            { pg8::Gemm g{WSP(bf16, WS_YCAT), (const bf16*)(ws + WS_WBR + (size_t)l * D * KBR), MP, D, KBR / 2, KBR / 2, KBR / 2}; pg8::StaticOrder S; S.init(MP, D, G, bid);
              pg8::EpiMergeF8 E{ws + WS_MG8, ws + WS_MERGED, 8.f / 64.f};
              pg8::gemm_phase<pg8::EpiMergeF8, pg8::StaticOrder, true>(lds + RING_OFF, g, S, E, nullptr); }
            { pg8::Gemm g{WSP(bf16, WS_YCAT), (const bf16*)(ws + WS_WBR + (size_t)l * D * KBR), MTOT, D, 512, KBR / 2, KBR / 2}; pg8::SplitOrder S{MP / 256, MS / 256, D / 256, 3, 512, G, bid};
              pg8::EpiGateSlab E{ws + WS_MG8, (bf16*)(ws + WS_GIMG + 64 * MiB), 9, 1.f / 64.f};
              pg8::gemm_phase<pg8::EpiGateSlab, pg8::SplitOrder, true>(lds + RING_OFF, g, S, E, nullptr); } }
        SEAM(pb + 4);
        if (EN_OUT && IN(pb + 5)) for (int rg_ = 0; rg_ < REP_OUT; ++rg_) { CArgs* A = kargs(); unsigned char* const ws = A->ws;
            { TIDS();
              const bf16* sl = (const bf16*)(ws + WS_GIMG + 64 * MiB); unsigned char* mg = ws + WS_MERGED + (size_t)MP * D;
              for (int row = gw; row < MS; row += ngw) { const v2u* s4 = (const v2u*)(sl + (size_t)row * D) + lane;
#pragma unroll
                  for (int j = 0; j < 8; ++j) { const v2u w0 = s4[64 * j], w1 = s4[(size_t)(MS * D / 4) + 64 * j], w2 = s4[(size_t)2 * (MS * D / 4) + 64 * j];
                      const f32x4 v = (f32x4){bflo_(w0.x), bfhi_(w0.x), bflo_(w0.y), bfhi_(w0.y)} + (f32x4){bflo_(w1.x), bfhi_(w1.x), bflo_(w1.y), bfhi_(w1.y)} + (f32x4){bflo_(w2.x), bfhi_(w2.x), bflo_(w2.y), bfhi_(w2.y)};
                      *((unsigned*)(mg + (size_t)row * D) + lane + 64 * j) = pg8::pk4_fp8(8.f * v.x, 8.f * v.y, 8.f * v.z, 8.f * v.w); } } }
            { pg8::Gemm g{WSP(bf16, WS_MERGED), (const bf16*)(ws + WS_WOUT + (size_t)l * D * D), MP, D, D / 2, D / 2, D / 2}; pg8::StaticOrder S; S.init(MP, D, G, bid);
              pg8::EpiResid E{WSP(bf16, WS_XB), WSP(bf16, WS_XA), WSP(float, WS_MOD) + (size_t)l * NADA + 4096, 1.f / 512.f};
              pg8::gemm_phase<pg8::EpiResid, pg8::StaticOrder, true>(lds + RING_OFF, g, S, E, nullptr); }
            { CArgs* Ab = kargs(); XcdBarrier bar; bar.bar = (unsigned*)(Ab->ws + WS_CTL) + CW_BAR + Ab->li * XCD_BAR_WORDS; bar.x = xb_xcc_id(); bar.st = (volatile LAS unsigned*)(lds + MISC_OFF) + 8; xcd_barrier(bar); }
            { pg8::Gemm g{WSP(bf16, WS_MERGED), (const bf16*)(ws + WS_WOUT + (size_t)l * D * D), MTOT, D, D / 8, D / 2, D / 2}; pg8::SplitOrder S{MP / 256, MS / 256, D / 256, 4, D / 8, G, bid};
              pg8::EpiSlab E{WSP(bf16, WS_GIMG), D / 8, 1.f / 512.f};
              pg8::gemm_phase<pg8::EpiSlab, pg8::SplitOrder, true>(lds + RING_OFF, g, S, E, nullptr); } }
        SEAM(pb + 5);
        if (EN_NORM && IN(pb + 6)) { TIDS(); CArgs* A = kargs(); unsigned char* const ws = A->ws;
            norm_rows(WSP(bf16, WS_XA), WSP(bf16, WS_XB) + (size_t)MP * D, false, A->in[14] + (size_t)l * D, WSP(float, WS_MOD) + (size_t)l * NADA + 6144, WSP(bf16, WS_XN), nullptr, nullptr, gw, ngw, lane, nullptr,
                      4, WSP(bf16, WS_GIMG), WSP(float, WS_MOD) + (size_t)l * NADA + 4096, WSP(bf16, WS_XA) + (size_t)MP * D, ws + WS_XN); }
        SEAM(pb + 6);
        if (EN_FF1 && IN(pb + 7)) for (int rg_ = 0; rg_ < REP_FF1; ++rg_) { CArgs* A = kargs(); unsigned char* const ws = A->ws;
            pg8::Gemm g{WSP(bf16, WS_XN), (const bf16*)(ws + WS_WFF1 + (size_t)l * DFF * D), MTOT, DFF, D / 2, D / 2, D / 2}; pg8::StaticOrder S; S.init(MTOT, DFF, G, bid);
            pg8::EpiRelu2F8 E{ws + WS_HFF, DFF, 1.f / 64.f};
            pg8::gemm_phase<pg8::EpiRelu2F8, pg8::StaticOrder, true>(lds + RING_OFF, g, S, E, nullptr);
            if (l == 0 && (int)blockIdx.x >= 64 && rg_ == 0) {
                __syncthreads();
                CArgs* A2 = kargs(); int t_ = (int)threadIdx.x; asm volatile("" : "+v"(t_));
                const int wv_ = __builtin_amdgcn_readfirstlane(t_ >> 6);
                conv_rest(A2, A2->ws, 1, (LAS float*)(lds + RING_OFF + wv_ * 16384), ((int)blockIdx.x - 64) * NWAVES + wv_, (G - 64) * NWAVES, t_ & 63, false, true);
                __syncthreads(); } }
        SEAM(pb + 7);
        if (EN_FF2 && IN(pb + 8)) for (int rg_ = 0; rg_ < REP_FF2; ++rg_) { CArgs* A = kargs(); unsigned char* const ws = A->ws;
            { pg8::Gemm g{WSP(bf16, WS_HFF), (const bf16*)(ws + WS_WFF2 + (size_t)l * D * DFF), MP, D, DFF / 2, DFF / 2, DFF / 2}; pg8::StaticOrder S; S.init(MP, D, G, bid);
              pg8::EpiResid E{WSP(bf16, WS_XA), WSP(bf16, WS_XB), WSP(float, WS_MOD) + (size_t)l * NADA + 10240, 1.f / 64.f};
              pg8::gemm_phase<pg8::EpiResid, pg8::StaticOrder, true>(lds + RING_OFF, g, S, E, nullptr); }
            { pg8::Gemm g{WSP(bf16, WS_HFF), (const bf16*)(ws + WS_WFF2 + (size_t)l * D * DFF), MTOT, D, DFF / 32, DFF / 2, DFF / 2}; pg8::SplitOrder S{MP / 256, MS / 256, D / 256, 16, DFF / 32, G, bid};
              pg8::EpiSlab E{WSP(bf16, WS_GIMG), DFF / 32, 1.f / 64.f};
              pg8::gemm_phase<pg8::EpiSlab, pg8::SplitOrder, true>(lds + RING_OFF, g, S, E, nullptr); } }
        SEAM(pb + 8);
    }
    if (EN_NORM && IN(20)) { TIDS(); CArgs* A = kargs(); unsigned char* const ws = A->ws;
        norm_rows(WSP(bf16, WS_XB), WSP(bf16, WS_XA) + (size_t)MP * D, false, A->in[39], nullptr, nullptr, A->out + O_YP, A->out + O_YS, gw, ngw, lane, nullptr,
                  16, WSP(bf16, WS_GIMG), WSP(float, WS_MOD) + (size_t)(DEPTH - 1) * NADA + 10240, WSP(bf16, WS_XB) + (size_t)MP * D); }
#undef IN
#undef SEAM
}

extern "C" void kernel_launch(void* const* d_in, const int* in_sizes, int n_in, void* d_out, int out_size, void* d_ws, size_t ws_size, hipStream_t stream) {
    static int grid = 0;
    if (grid == 0) {
        if (n_in != 40 || (size_t)out_size != O_END || ws_size < WS_END) { fprintf(stderr, "kernel_launch: unexpected shapes (n_in %d, out %d, ws %zu); nothing launched\n", n_in, out_size, ws_size); grid = -1; return; }
        if (hipFuncSetAttribute((const void*)mk_fwd, hipFuncAttributeMaxDynamicSharedMemorySize, LDS_BYTES) != hipSuccess) { fprintf(stderr, "kernel_launch: hipFuncSetAttribute failed\n"); grid = -1; return; }
        int per_cu = 0;
        if (hipOccupancyMaxActiveBlocksPerMultiprocessor(&per_cu, (const void*)mk_fwd, NTHREADS, LDS_BYTES) != hipSuccess || per_cu < 1)
            fprintf(stderr, "kernel_launch: note: occupancy query reports %d workgroups per CU\n", per_cu);
        (void)hipGetLastError();
        grid = GRID;
    }
    if (grid < 0) return;
    if (hipMemsetAsync((char*)d_ws + WS_CTL, 0, CTL_ZERO_BYTES, stream) != hipSuccess) { fprintf(stderr, "kernel_launch: hipMemsetAsync failed\n"); return; }
    Args a{};
    for (int i = 0; i < 40; ++i) a.in[i] = (const float*)d_in[i];
    a.out = (float*)d_out; a.ws = (unsigned char*)d_ws; a.pad = 0;
#ifndef PROBE_P
#define PROBE_P -1
#endif
#ifndef PROBE_G
#define PROBE_G 256
#endif
    int n_l = 0, lo_[4], hi_[4], fl_[4];
    if (N_LAUNCHES != 1) { for (int li = 0; li < PH_TOTAL; ++li) { a.ph_lo = li; a.ph_hi = li + 1; a.li = 0; a.pad = 0; hipLaunchKernelGGL(mk_fwd, dim3(grid), dim3(NTHREADS), LDS_BYTES, stream, a); } return; }
    if (PROBE_P < 0) { lo_[0] = 0; hi_[0] = PH_TOTAL; fl_[0] = grid; n_l = 1; }
#ifndef PROBE_Q
#define PROBE_Q PROBE_P
#endif
#ifdef PROBE_ABL
    else { lo_[0] = 0; hi_[0] = PROBE_P; fl_[0] = grid; lo_[1] = PROBE_P; hi_[1] = PROBE_Q + 1; fl_[1] = PROBE_G; lo_[2] = PROBE_P; hi_[2] = PH_TOTAL; fl_[2] = grid; n_l = 3; }
#else
    else { lo_[0] = 0; hi_[0] = PROBE_Q + 1; fl_[0] = grid; lo_[1] = PROBE_P; hi_[1] = PROBE_Q + 1; fl_[1] = PROBE_G; lo_[2] = PROBE_Q + 1; hi_[2] = PH_TOTAL; fl_[2] = grid; n_l = 3; }
#endif
    for (int li = 0; li < n_l; ++li) {
        a.ph_lo = lo_[li]; a.ph_hi = hi_[li]; a.li = li; a.pad = 0;
        hipLaunchKernelGGL(mk_fwd, dim3(fl_[li]), dim3(NTHREADS), LDS_BYTES, stream, a);
        const hipError_t le = hipPeekAtLastError();
        if (le != hipSuccess) { fprintf(stderr, "kernel_launch: launch %d failed: %s\n", li, hipGetErrorName(le)); break; }
    }
}
```

```cpp
#include <hip/hip_runtime.h>
#include <cstdio>
#include <cstdint>

constexpr int D = 2048, DEPTH = 2;
constexpr int NP = 4, TP = 2048, NS = 128, TS = 4;
constexpr int MP = NP * TP, MS = NS * TS, MTOT = MP + MS;
constexpr int NB = NP + NS;
constexpr int DIN = 12312, NPROJ = 12288, NPROJ_PAD = 12544, NSMALL = 24;
constexpr int PPITCH = 6144;
constexpr int C_LRUX = 0, C_GQ = 1024, C_GK = 1536, C_GV = 2048, C_GGATE = 3072, C_MX = 4096, C_MO = 5120, C_MG = 6144;
constexpr int DFF = 8192, NADA = 12288, KBR = 3072;
constexpr float EPS = 1e-6f;
#define MK_N_LAUNCHES 1
namespace pg8 {
#define PG8_LAS __attribute__((address_space(3)))
typedef unsigned short bf16_t;
typedef short bf16x8 __attribute__((ext_vector_type(8)));
typedef float f32x4 __attribute__((ext_vector_type(4)));
typedef unsigned u32x4 __attribute__((ext_vector_type(4)));
constexpr int BM = 256, BK = 64, HALF = 128, HTB = HALF * BK * 2  , STAGE_BYTES = 8 * HTB, NXCD = 8, WGM = 8;

__host__ __device__ __forceinline__ int lds_byte(int r, int c) { const int st = (r >> 4) * 2 + (c >> 5), rr = r & 15, cc = c & 31, ob = rr * 64 + cc * 2; return st * 1024 + (ob ^ (((ob >> 9) & 1) << 5)); }
__host__ __device__ __forceinline__ void stage_rc(int b, int& R, int& C) { const int st = b / 1024, sb = b % 1024, swz = sb ^ (((sb >> 9) & 1) << 5); R = (st >> 1) * 16 + swz / 64; C = (st & 1) * 32 + (swz % 64) / 2; }
__host__ __device__ __forceinline__ int perm32(int rho) { const int n = rho >> 4, i = rho & 15; return 8 * (i >> 2) + 4 * n + (i & 3); }

struct Unit { int pm, pn, koff; };
struct Gemm { const bf16_t* A; const bf16_t* Bt; int M, N, K, lda, ldb; };

struct StaticOrder {
    int nM, nN, nwg, G, c;
    __host__ __device__ void init(int M, int N, int G_, int c_) { nM = M / BM; nN = N / BM; nwg = nM * nN; G = G_; c = c_; }
    __host__ __device__ bool next(int i, Unit& u) const { return at((long)i * G + c, u); }
    __host__ __device__ bool at(long L, Unit& u) const {
        if (L >= nwg) return false;
        int wgid = (int)L; { const int q = nwg / NXCD, r = nwg % NXCD, xcd = wgid % NXCD, off = wgid / NXCD; wgid = (xcd < r ? xcd * (q + 1) : r * (q + 1) + (xcd - r) * q) + off; }
        const int nig = WGM * nN, gid = wgid / nig, fm = gid * WGM, gsz = (nM - fm) < WGM ? (nM - fm) : WGM;
        u.pm = fm + ((wgid % nig) % gsz); u.pn = (wgid % nig) / gsz; u.koff = 0; return true;
    }
    __device__ __forceinline__ void a_ready(const Unit&) const {}
    __device__ __forceinline__ void done(const Unit&) const {}
};
struct SplitOrder {
    int pm0, npm, nN, split, ksub, G, c;
    __device__ __forceinline__ bool next(int i, Unit& u) const {
        const int L = i * G + c, nt = npm * nN; if (L >= nt * split) return false;
        const int tile = L % nt, ks = L / nt; u.pm = pm0 + tile / nN; u.pn = tile % nN; u.koff = ks * ksub; return true;
    }
    __device__ __forceinline__ void a_ready(const Unit&) const {}
    __device__ __forceinline__ void done(const Unit&) const {}
};
struct TileMapOrder {
    StaticOrder so; int t1, t2, s0, s1, s2; int nh = 0, sk = 0;
    __device__ __forceinline__ bool next(int i, Unit& u) const {
        const int gl = so.G - nh, lt = (int)(so.c >= nh), early = lt * (int)(i < sk);
        const long L = early ? (long)i * gl + (so.c - nh) : (long)sk * gl + (long)(i - lt * sk) * so.G + so.c;
        if (!so.at(L, u)) return false; u.pn += s0 + (int)(u.pn >= t1) * (s1 - s0) + (int)(u.pn >= t2) * (s2 - s1); return true; }
    __device__ __forceinline__ void a_ready(const Unit&) const {}
    __device__ __forceinline__ void done(const Unit&) const {}
};


__device__ __forceinline__ unsigned cvt_pk_bf16(float lo, float hi) { unsigned r; asm volatile("v_cvt_pk_bf16_f32 %0, %1, %2" : "=v"(r) : "v"(lo), "v"(hi)); return r; }
typedef float f32x2 __attribute__((ext_vector_type(2)));
typedef int i32x4 __attribute__((ext_vector_type(4)));
typedef int i32x8 __attribute__((ext_vector_type(8)));
__device__ __forceinline__ unsigned pk4_fp8(float a, float b, float c, float d) { int w = __builtin_amdgcn_cvt_pk_fp8_f32(a, b, 0, false); w = __builtin_amdgcn_cvt_pk_fp8_f32(c, d, w, true); return (unsigned)w; }
__device__ __forceinline__ float bflo(unsigned w) { return __uint_as_float(w << 16); }
__device__ __forceinline__ float bfhi(unsigned w) { return __uint_as_float(w & 0xffff0000u); }

#define PG8_COORDS() int tz_ = threadIdx.x; asm volatile("" : "+v"(tz_)); const int wid_ = __builtin_amdgcn_readfirstlane(tz_ >> 6); \
    const int wr = wid_ >> 2, wc = wid_ & 3, fr = tz_ & 15, fq = (tz_ & 63) >> 4

struct EpiF32 {
    static constexpr bool PERM = false, AFTER_DRAIN = false; static constexpr int NMID = 0, MID1 = -1, MID2 = -1;
    float* C; int ldc; const float* bias;
    __device__ __forceinline__ void operator()(const f32x4 (&acc)[2][2][4][2], const Unit& u, int, int, int, int) const {
        PG8_COORDS();
        const int row0 = u.pm * BM + wr * 64 + fr, col0 = u.pn * BM + wc * 32 + 4 * fq;
        f32x4 bv[2][2];
#pragma unroll
        for (int bj = 0; bj < 2; ++bj)
#pragma unroll
            for (int n = 0; n < 2; ++n) bv[bj][n] = bias ? *(const f32x4*)(bias + col0 + bj * HALF + n * 16) : (f32x4){0.f, 0.f, 0.f, 0.f};
#pragma unroll
        for (int ai = 0; ai < 2; ++ai)
#pragma unroll
            for (int m = 0; m < 4; ++m) { float* rowp = C + (size_t)(row0 + ai * HALF + m * 16) * ldc + col0;
#pragma unroll
                for (int bj = 0; bj < 2; ++bj)
#pragma unroll
                    for (int n = 0; n < 2; ++n) *(f32x4*)(rowp + bj * HALF + n * 16) = acc[ai][bj][m][n] + bv[bj][n]; }
    }
    __device__ __forceinline__ void mid(f32x4 (&)[2][2][4][2], const Unit&, int, int, int, int, int) const {}
};

struct EpiProj {
    static constexpr bool PERM = true, AFTER_DRAIN = false; static constexpr int NMID = 0, MID1 = -1, MID2 = -1;
    bf16_t* O; float* sm; float ascale; unsigned char* mg8;
    __device__ __forceinline__ void operator()(const f32x4 (&acc)[2][2][4][2], const Unit& u, int, int, int, int) const {
        PG8_COORDS();
        const int row0 = u.pm * BM + wr * 64 + fr;
        if (u.pn < 24) {
            const int col0 = u.pn * BM + wc * 32 + 8 * fq;
#pragma unroll
            for (int ai = 0; ai < 2; ++ai)
#pragma unroll
                for (int m = 0; m < 4; ++m) { bf16_t* rowp = O + (size_t)(row0 + ai * HALF + m * 16) * 6144 + col0;
#pragma unroll
                    for (int bj = 0; bj < 2; ++bj) { const f32x4 v0 = acc[ai][bj][m][0] * ascale, v1 = acc[ai][bj][m][1] * ascale;
                        u32x4 w; w.x = cvt_pk_bf16(v0[0], v0[1]); w.y = cvt_pk_bf16(v0[2], v0[3]); w.z = cvt_pk_bf16(v1[0], v1[1]); w.w = cvt_pk_bf16(v1[2], v1[3]);
                        *(u32x4*)(rowp + bj * HALF) = w; } }
        } else if (u.pn < 48) {
            const int col0 = (u.pn - 24) * BM + wc * 32 + 8 * fq;
#pragma unroll
            for (int ai = 0; ai < 2; ++ai)
#pragma unroll
                for (int m = 0; m < 4; ++m) { unsigned char* rowp = mg8 + (size_t)(row0 + ai * HALF + m * 16) * 6144 + col0;
#pragma unroll
                    for (int bj = 0; bj < 2; ++bj) { const f32x4 v0 = acc[ai][bj][m][0] * ascale, v1 = acc[ai][bj][m][1] * ascale;
                        *(unsigned long long*)(rowp + bj * HALF) = (unsigned long long)pk4_fp8(v0[0], v0[1], v0[2], v0[3]) | ((unsigned long long)pk4_fp8(v1[0], v1[1], v1[2], v1[3]) << 32); } }
        } else {
#pragma unroll
            for (int ai = 0; ai < 2; ++ai)
#pragma unroll
                for (int m = 0; m < 4; ++m) { float* rowp = sm + (size_t)(row0 + ai * HALF + m * 16) * 24;
#pragma unroll
                    for (int n = 0; n < 2; ++n) { const int c = wc * 32 + 8 * fq + 4 * n;
                        if (c < 24) *(f32x4*)(rowp + c) = acc[ai][0][m][n]; } }
        }
    }
    __device__ __forceinline__ void mid(f32x4 (&)[2][2][4][2], const Unit&, int, int, int, int, int) const {}
};

template <int M1, int M2> struct EpiMergeT {
    static constexpr bool PERM = true, AFTER_DRAIN = false; static constexpr int NMID = 2, MID1 = M1, MID2 = M2;
    const unsigned char* proj; unsigned char* O; float ascale;
    static __device__ __forceinline__ void ld8(const unsigned char* p, float (&z)[8]) { const unsigned long long w = *(const unsigned long long*)p; const int lo = (int)(unsigned)w, hi = (int)(unsigned)(w >> 32);
        const f32x2 a = __builtin_amdgcn_cvt_pk_f32_fp8(lo, false), b = __builtin_amdgcn_cvt_pk_f32_fp8(lo, true), c = __builtin_amdgcn_cvt_pk_f32_fp8(hi, false), d = __builtin_amdgcn_cvt_pk_f32_fp8(hi, true);
        z[0] = a[0]; z[1] = a[1]; z[2] = b[0]; z[3] = b[1]; z[4] = c[0]; z[5] = c[1]; z[6] = d[0]; z[7] = d[1]; }
    static __device__ __forceinline__ float en(float z) { z = fminf(fmaxf(z, -30.f), 30.f); return __expf(-z); }
    __device__ __forceinline__ void mid(f32x4 (&acc)[2][2][4][2], const Unit& u, int t, int, int, int, int) const {
        PG8_COORDS();
        const int b = (t == MID1) ? 0 : 1;
        int row0 = u.pm * BM + wr * 64 + fr, col0 = u.pn * BM + wc * 32 + 8 * fq;
        asm volatile("" : "+v"(row0), "+v"(col0));
#pragma unroll
        for (int ai = 0; ai < 2; ++ai)
#pragma unroll
            for (int m = 0; m < 4; ++m) { const unsigned char* rowp = proj + (size_t)(row0 + ai * HALF + m * 16) * 6144 + 2048 * b + col0;
#pragma unroll
                for (int bj = 0; bj < 2; ++bj) { float za[8], zb[8]; ld8(rowp + bj * HALF, za); ld8(rowp + 2048 + bj * HALF, zb);
#pragma unroll
                    for (int j = 0; j < 8; ++j) { const float r = (1.f + en(zb[j])) / (1.f + en(za[j]));
                        acc[ai][bj][m][j >> 2][j & 3] *= r; } }
                asm volatile("" ::: "memory"); }
    }
    __device__ __forceinline__ void operator()(const f32x4 (&acc)[2][2][4][2], const Unit& u, int, int, int, int) const {
        PG8_COORDS();
        const int row0 = u.pm * BM + wr * 64 + fr, col0 = u.pn * BM + wc * 32 + 8 * fq;
#pragma unroll
        for (int ai = 0; ai < 2; ++ai)
#pragma unroll
            for (int m = 0; m < 4; ++m) { const size_t r = (size_t)(row0 + ai * HALF + m * 16); const unsigned char* gp = proj + r * 6144 + 4096 + col0; unsigned char* op = O + r * 2048 + col0;
#pragma unroll
                for (int bj = 0; bj < 2; ++bj) { float z[8], v[8]; ld8(gp + bj * HALF, z);
#pragma unroll
                    for (int j = 0; j < 8; ++j) v[j] = acc[ai][bj][m][j >> 2][j & 3] * ascale / (1.f + en(z[j]));
                    *(unsigned long long*)(op + bj * HALF) = (unsigned long long)pk4_fp8(v[0], v[1], v[2], v[3]) | ((unsigned long long)pk4_fp8(v[4], v[5], v[6], v[7]) << 32); }
                asm volatile("" ::: "memory"); }
    }
};

typedef EpiMergeT<16, 32> EpiMerge;
typedef EpiMergeT<8, 16> EpiMergeF8;

struct EpiResid {
    static constexpr bool PERM = false, AFTER_DRAIN = false; static constexpr int NMID = 0, MID1 = -1, MID2 = -1;
    const bf16_t* base; bf16_t* out; const float* gate; float ascale;
    __device__ __forceinline__ void operator()(const f32x4 (&acc)[2][2][4][2], const Unit& u, int, int, int, int) const {
        PG8_COORDS();
        const int row0 = u.pm * BM + wr * 64 + fr, col0 = u.pn * BM + wc * 32 + 4 * fq;
#pragma unroll
        for (int ai = 0; ai < 2; ++ai)
#pragma unroll
            for (int m = 0; m < 4; ++m) { const int row = row0 + ai * HALF + m * 16;
                const int cond = row < 8192 ? (row >> 11) : 4 + ((row - 8192) >> 2);
                const bf16_t* bp = base + (size_t)row * 2048 + col0; const float* gp = gate + (size_t)cond * 24576 + col0; bf16_t* op = out + (size_t)row * 2048 + col0;
#pragma unroll
                for (int bj = 0; bj < 2; ++bj)
#pragma unroll
                    for (int n = 0; n < 2; ++n) { const unsigned long long bw = *(const unsigned long long*)(bp + bj * HALF + n * 16); const unsigned b0 = (unsigned)bw, b1 = (unsigned)(bw >> 32);
                        const f32x4 bs = {bflo(b0), bfhi(b0), bflo(b1), bfhi(b1)}, gt = *(const f32x4*)(gp + bj * HALF + n * 16);
                        const f32x4 v = bs + gt * (acc[ai][bj][m][n] * ascale);
                        *(unsigned long long*)(op + bj * HALF + n * 16) = (unsigned long long)cvt_pk_bf16(v[0], v[1]) | ((unsigned long long)cvt_pk_bf16(v[2], v[3]) << 32); }
                asm volatile("" ::: "memory"); }
    }
    __device__ __forceinline__ void mid(f32x4 (&)[2][2][4][2], const Unit&, int, int, int, int, int) const {}
};

struct EpiSlab {
    static constexpr bool PERM = false, AFTER_DRAIN = false; static constexpr int NMID = 0, MID1 = -1, MID2 = -1;
    bf16_t* slab; int ksub; float ascale;
    __device__ __forceinline__ void operator()(const f32x4 (&acc)[2][2][4][2], const Unit& u, int, int, int, int) const {
        PG8_COORDS();
        const int row0 = u.pm * BM + wr * 64 + fr - 8192, col0 = u.pn * BM + wc * 32 + 4 * fq; bf16_t* sl = slab + (size_t)(u.koff / ksub) * 512 * 2048;
#pragma unroll
        for (int ai = 0; ai < 2; ++ai)
#pragma unroll
            for (int m = 0; m < 4; ++m) { bf16_t* op = sl + (size_t)(row0 + ai * HALF + m * 16) * 2048 + col0;
#pragma unroll
                for (int bj = 0; bj < 2; ++bj)
#pragma unroll
                    for (int n = 0; n < 2; ++n) { const f32x4 v = acc[ai][bj][m][n] * ascale; *(unsigned long long*)(op + bj * HALF + n * 16) = (unsigned long long)cvt_pk_bf16(v[0], v[1]) | ((unsigned long long)cvt_pk_bf16(v[2], v[3]) << 32); } }
    }
    __device__ __forceinline__ void mid(f32x4 (&)[2][2][4][2], const Unit&, int, int, int, int, int) const {}
};

struct EpiGateSlab {
    static constexpr bool PERM = false, AFTER_DRAIN = false; static constexpr int NMID = 0, MID1 = -1, MID2 = -1;
    const unsigned char* proj; bf16_t* slab; int kshift; float ascale;
    __device__ __forceinline__ void operator()(const f32x4 (&acc)[2][2][4][2], const Unit& u, int, int, int, int) const {
        PG8_COORDS();
        const int b = u.koff >> kshift, row0 = u.pm * BM + wr * 64 + fr, col0 = u.pn * BM + wc * 32 + 4 * fq; bf16_t* sl = slab + (size_t)b * 512 * 2048;
#pragma unroll
        for (int ai = 0; ai < 2; ++ai)
#pragma unroll
            for (int m = 0; m < 4; ++m) { const int row = row0 + ai * HALF + m * 16; const unsigned char* gp = proj + (size_t)row * 6144 + 2048 * b + col0; bf16_t* op = sl + (size_t)(row - 8192) * 2048 + col0;
#pragma unroll
                for (int bj = 0; bj < 2; ++bj)
#pragma unroll
                    for (int n = 0; n < 2; ++n) { const int gw = (int)*(const unsigned*)(gp + bj * HALF + n * 16); const f32x2 ga = __builtin_amdgcn_cvt_pk_f32_fp8(gw, false), gb = __builtin_amdgcn_cvt_pk_f32_fp8(gw, true);
                        f32x4 v = acc[ai][bj][m][n] * ascale;
                        v[0] /= 1.f + EpiMerge::en(ga[0]); v[1] /= 1.f + EpiMerge::en(ga[1]); v[2] /= 1.f + EpiMerge::en(gb[0]); v[3] /= 1.f + EpiMerge::en(gb[1]);
                        *(unsigned long long*)(op + bj * HALF + n * 16) = (unsigned long long)cvt_pk_bf16(v[0], v[1]) | ((unsigned long long)cvt_pk_bf16(v[2], v[3]) << 32); }
                asm volatile("" ::: "memory"); }
    }
    __device__ __forceinline__ void mid(f32x4 (&)[2][2][4][2], const Unit&, int, int, int, int, int) const {}
};

struct EpiRelu2 {
    static constexpr bool PERM = true, AFTER_DRAIN = false; static constexpr int NMID = 0, MID1 = -1, MID2 = -1;
    bf16_t* O; int ldc;
    __device__ __forceinline__ void operator()(const f32x4 (&acc)[2][2][4][2], const Unit& u, int, int, int, int) const {
        PG8_COORDS();
        const int row0 = u.pm * BM + wr * 64 + fr, col0 = u.pn * BM + wc * 32 + 8 * fq;
#pragma unroll
        for (int ai = 0; ai < 2; ++ai)
#pragma unroll
            for (int m = 0; m < 4; ++m) { bf16_t* rowp = O + (size_t)(row0 + ai * HALF + m * 16) * ldc + col0;
#pragma unroll
                for (int bj = 0; bj < 2; ++bj) { f32x4 v0 = acc[ai][bj][m][0], v1 = acc[ai][bj][m][1];
#pragma unroll
                    for (int j = 0; j < 4; ++j) { const float a = fmaxf(v0[j], 0.f), b = fmaxf(v1[j], 0.f); v0[j] = a * a; v1[j] = b * b; }
                    u32x4 w; w.x = cvt_pk_bf16(v0[0], v0[1]); w.y = cvt_pk_bf16(v0[2], v0[3]); w.z = cvt_pk_bf16(v1[0], v1[1]); w.w = cvt_pk_bf16(v1[2], v1[3]);
                    *(u32x4*)(rowp + bj * HALF) = w; } }
    }
    __device__ __forceinline__ void mid(f32x4 (&)[2][2][4][2], const Unit&, int, int, int, int, int) const {}
};


struct EpiRelu2F8 {
    static constexpr bool PERM = true, AFTER_DRAIN = false; static constexpr int NMID = 0, MID1 = -1, MID2 = -1;
    unsigned char* O; int ldc; float ascale;
    __device__ __forceinline__ void operator()(const f32x4 (&acc)[2][2][4][2], const Unit& u, int, int, int, int) const {
        PG8_COORDS();
        const int row0 = u.pm * BM + wr * 64 + fr, col0 = u.pn * BM + wc * 32 + 8 * fq;
#pragma unroll
        for (int ai = 0; ai < 2; ++ai)
#pragma unroll
            for (int m = 0; m < 4; ++m) { unsigned char* rowp = O + (size_t)(row0 + ai * HALF + m * 16) * ldc + col0;
#pragma unroll
                for (int bj = 0; bj < 2; ++bj) { f32x4 v0 = acc[ai][bj][m][0], v1 = acc[ai][bj][m][1];
#pragma unroll
                    for (int j = 0; j < 4; ++j) { const float a = fmaxf(v0[j] * ascale, 0.f), b = fmaxf(v1[j] * ascale, 0.f); v0[j] = a * a; v1[j] = b * b; }
                    unsigned long long w = (unsigned long long)pk4_fp8(v0[0], v0[1], v0[2], v0[3]) | ((unsigned long long)pk4_fp8(v1[0], v1[1], v1[2], v1[3]) << 32);
                    *(unsigned long long*)(rowp + bj * HALF) = w; } }
    }
    __device__ __forceinline__ void mid(f32x4 (&)[2][2][4][2], const Unit&, int, int, int, int, int) const {}
};
template <class Epi, class Sched, bool FP8 = false, bool STAMP = false>
__device__ __forceinline__ void gemm_phase(PG8_LAS unsigned char* lds, const Gemm g, const Sched& S, const Epi& E, unsigned long long* stamps) {
    int tid_ = threadIdx.x; asm volatile("" : "+v"(tid_));
    const int tid = tid_, wid = __builtin_amdgcn_readfirstlane(tid >> 6), lane = tid & 63, wr = wid >> 2, wc = wid & 3, fr = lane & 15, fq = lane >> 4;
    const int K = g.K, nt = K / BK;
    int ts_lo = 0, ts_hi = 0, nts = 0; const unsigned long long rt_entry = STAMP ? (unsigned long long)wall_clock64() : 0ull;
#define PG8_STAMP() do { if (STAMP && wid == 0 && nts < 64) { const unsigned long long _c = (unsigned long long)clock64(); \
        ts_lo = (lane == nts) ? (int)(unsigned)_c : ts_lo; ts_hi = (lane == nts) ? (int)(unsigned)(_c >> 32) : ts_hi; ++nts; } } while (0)
    PG8_STAMP();
    unsigned voffA[2], voffB[2];
#pragma unroll
    for (int i = 0; i < 2; ++i) { int R, C; stage_rc(tid * 16 + i * 8192, R, C); const int Rb = Epi::PERM ? ((R & ~31) + perm32(R & 31)) : R;
        voffA[i] = (unsigned)(R * g.lda + C) * 2u; voffB[i] = (unsigned)(Rb * g.ldb + C) * 2u; }
    const size_t kstep = (size_t)(BK * 2);
    const size_t hstepA = (size_t)HALF * g.lda * 2, hstepB = (size_t)HALF * g.ldb * 2;
    const size_t tstepA = 2 * hstepA, tstepB = 2 * hstepB;
    const unsigned ldsw = (unsigned)wid * 1024u;
    const int aoff = lds_byte(wr * 64 + fr, fq * 8), boff = lds_byte(wc * 32 + fr, fq * 8);
#define PG8_SA(b, h) (((b) * 2 + (h)) * HTB)
#define PG8_SB(b, h) ((4 + (b) * 2 + (h)) * HTB)
#define PG8_STAGE(bufoff, gbase, voff) do { _Pragma("unroll") for (int _i = 0; _i < 2; ++_i) \
        __builtin_amdgcn_global_load_lds((const unsigned*)((const char*)(gbase) + (voff)[_i]), (PG8_LAS unsigned*)(lds + (bufoff) + ldsw + _i * 8192), 16, 0, 0); } while (0)
#define PG8_LDA(dst, b, h) do { _Pragma("unroll") for (int m = 0; m < 4; ++m) { \
        if constexpr (FP8) { const i32x4 lo_ = *(const PG8_LAS i32x4*)(lds + PG8_SA(b, h) + aoff + m * 2048), hi_ = *(const PG8_LAS i32x4*)(lds + PG8_SA(b, h) + aoff + m * 2048 + 1024); dst##8[m] = __builtin_shufflevector(lo_, hi_, 0, 1, 2, 3, 4, 5, 6, 7); } \
        else { _Pragma("unroll") for (int k = 0; k < 2; ++k) dst[m][k] = *(const PG8_LAS bf16x8*)(lds + PG8_SA(b, h) + aoff + m * 2048 + k * 1024); } } } while (0)
#define PG8_LDB(dst, b, h) do { _Pragma("unroll") for (int n = 0; n < 2; ++n) { \
        if constexpr (FP8) { const i32x4 lo_ = *(const PG8_LAS i32x4*)(lds + PG8_SB(b, h) + boff + n * 2048), hi_ = *(const PG8_LAS i32x4*)(lds + PG8_SB(b, h) + boff + n * 2048 + 1024); dst##8[n] = __builtin_shufflevector(lo_, hi_, 0, 1, 2, 3, 4, 5, 6, 7); } \
        else { _Pragma("unroll") for (int k = 0; k < 2; ++k) dst[n][k] = *(const PG8_LAS bf16x8*)(lds + PG8_SB(b, h) + boff + n * 2048 + k * 1024); } } } while (0)
#define PG8_MMA(ai, bj, At, Bt) do { __builtin_amdgcn_s_setprio(1); _Pragma("unroll") for (int m = 0; m < 4; ++m) _Pragma("unroll") for (int n = 0; n < 2; ++n) { \
        if constexpr (FP8) asm volatile("v_mfma_scale_f32_16x16x128_f8f6f4 %0, %1, %2, %0, %3, %3 op_sel_hi:[0,0,0]" : "+v"(acc[ai][bj][m][n]) : "v"(Bt##8[n]), "v"(At##8[m]), "v"(one_scale)); \
        else { _Pragma("unroll") for (int k = 0; k < 2; ++k) acc[ai][bj][m][n] = __builtin_amdgcn_mfma_f32_16x16x32_bf16(Bt[n][k], At[m][k], acc[ai][bj][m][n], 0, 0, 0); } } \
        __builtin_amdgcn_s_setprio(0); } while (0)
#define PG8_WAIT_V(n) asm volatile("s_waitcnt vmcnt(" #n ")" ::: "memory")
#define PG8_WAIT_L(n) asm volatile("s_waitcnt lgkmcnt(" #n ")" ::: "memory")
#define PG8_BAR __builtin_amdgcn_s_barrier()
#define PG8_SCHED __builtin_amdgcn_sched_barrier(0)
    Unit cur, nxt; int ui = 0;
    if (!S.next(0, cur)) return;
    f32x4 acc[2][2][4][2];
#pragma unroll
    for (int a = 0; a < 2; ++a)
#pragma unroll
        for (int b = 0; b < 2; ++b)
#pragma unroll
            for (int m = 0; m < 4; ++m)
#pragma unroll
                for (int n = 0; n < 2; ++n) acc[a][b][m][n] = (f32x4){0.f, 0.f, 0.f, 0.f};
    bf16x8 At[4][2], B0[2][2], B1[2][2]; i32x8 At8[4], B08[2], B18[2]; const int one_scale = 0x7f7f7f7f;
    const char* cA = (const char*)g.A + (size_t)cur.pm * tstepA + (size_t)cur.koff * 2; const char* cB = (const char*)g.Bt + (size_t)cur.pn * tstepB + (size_t)cur.koff * 2;
    S.a_ready(cur);
    PG8_STAGE(PG8_SB(0, 0), cB, voffB); PG8_STAGE(PG8_SA(0, 0), cA, voffA); PG8_STAGE(PG8_SB(0, 1), cB + hstepB, voffB); PG8_STAGE(PG8_SA(0, 1), cA + hstepA, voffA);
    if (wr == 1) PG8_BAR;
    PG8_WAIT_V(4); PG8_BAR;
    PG8_STAGE(PG8_SB(1, 0), cB + kstep, voffB); PG8_STAGE(PG8_SA(1, 0), cA + kstep, voffA); PG8_STAGE(PG8_SB(1, 1), cB + hstepB + kstep, voffB);
    PG8_WAIT_V(6); PG8_BAR;
    PG8_STAMP();
    for (;;) {
        const bool has_next = S.next(ui + 1, nxt);
        const char* nA = has_next ? (const char*)g.A + (size_t)nxt.pm * tstepA + (size_t)nxt.koff * 2 : cA; const char* nB = has_next ? (const char*)g.Bt + (size_t)nxt.pn * tstepB + (size_t)nxt.koff * 2 : cB;
        for (int t = 0; t < nt; t += 2) {
            const bool last = (t == nt - 2);
            const char* a1 = cA + (size_t)(t + 1) * kstep;
            const char* a2 = last ? nA : cA + (size_t)(t + 2) * kstep; const char* b2 = last ? nB : cB + (size_t)(t + 2) * kstep;
            const char* a3 = a2 + kstep; const char* b3 = b2 + kstep;
            if (last && has_next) S.a_ready(nxt);
            if constexpr (Epi::NMID > 0) { if (t == Epi::MID1 || t == Epi::MID2) E.mid(acc, cur, t, wr, wc, fr, fq); }
            PG8_LDB(B0, 0, 0); PG8_SCHED; PG8_LDA(At, 0, 0); PG8_STAGE(PG8_SA(1, 1), a1 + hstepA, voffA);
            PG8_WAIT_L(8); PG8_BAR; PG8_WAIT_L(0); PG8_MMA(0, 0, At, B0); PG8_BAR; PG8_SCHED;
            PG8_LDB(B1, 0, 1); PG8_STAGE(PG8_SB(0, 0), b2, voffB);
            PG8_BAR; PG8_WAIT_L(0); PG8_MMA(0, 1, At, B1); PG8_BAR;
            PG8_LDA(At, 0, 1); PG8_STAGE(PG8_SA(0, 0), a2, voffA);
            PG8_BAR; PG8_WAIT_L(0); PG8_MMA(1, 0, At, B0); PG8_BAR; PG8_SCHED;
            PG8_STAGE(PG8_SB(0, 1), b2 + hstepB, voffB);
            PG8_WAIT_V(6); PG8_BAR; PG8_MMA(1, 1, At, B1); PG8_BAR;
            PG8_LDB(B0, 1, 0); PG8_SCHED; PG8_LDA(At, 1, 0); PG8_STAGE(PG8_SA(0, 1), a2 + hstepA, voffA);
            PG8_WAIT_L(8); PG8_BAR; PG8_WAIT_L(0); PG8_MMA(0, 0, At, B0); PG8_BAR; PG8_SCHED;
            PG8_LDB(B1, 1, 1); PG8_STAGE(PG8_SB(1, 0), b3, voffB);
            PG8_BAR; PG8_WAIT_L(0); PG8_MMA(0, 1, At, B1); PG8_BAR;
            PG8_LDA(At, 1, 1); PG8_STAGE(PG8_SA(1, 0), a3, voffA);
            PG8_BAR; PG8_WAIT_L(0); PG8_MMA(1, 0, At, B0); PG8_BAR; PG8_SCHED;
            PG8_STAGE(PG8_SB(1, 1), b3 + hstepB, voffB);
            PG8_WAIT_V(6); PG8_BAR; PG8_MMA(1, 1, At, B1); PG8_BAR;
        }
        PG8_STAMP();
        if constexpr (FP8) asm volatile("s_nop 15\n\ts_nop 15" ::: "memory");
        if constexpr (!Epi::AFTER_DRAIN) { E(acc, cur, wr, wc, fr, fq); S.done(cur); }
        PG8_STAMP();
        if (!has_next) break;
#pragma unroll
        for (int a = 0; a < 2; ++a)
#pragma unroll
            for (int b = 0; b < 2; ++b)
#pragma unroll
                for (int m = 0; m < 4; ++m)
#pragma unroll
                    for (int n = 0; n < 2; ++n) acc[a][b][m][n] = (f32x4){0.f, 0.f, 0.f, 0.f};
        cur = nxt; cA = nA; cB = nB; ++ui;
    }
    PG8_WAIT_V(0);
    if (wr == 0) PG8_BAR;
    PG8_BAR;
    if constexpr (Epi::AFTER_DRAIN) { E.fused(acc, cur, wr, wc, fr, fq, lds, wid, lane); S.done(cur); }
    PG8_STAMP();
    if (STAMP && wid == 0) { stamps[lane] = lane < nts ? (((unsigned long long)(unsigned)ts_hi << 32) | (unsigned)ts_lo) : 0ull;
        if (lane == 62) stamps[62] = rt_entry; if (lane == 63) stamps[63] = (unsigned long long)wall_clock64(); }
#undef PG8_STAMP
#undef PG8_SA
#undef PG8_SB
#undef PG8_STAGE
#undef PG8_LDA
#undef PG8_LDB
#undef PG8_MMA
#undef PG8_WAIT_V
#undef PG8_WAIT_L
#undef PG8_BAR
#undef PG8_SCHED
}
}

#define GAS __attribute__((address_space(1)))
#define LAS __attribute__((address_space(3)))
#define DI __device__ __forceinline__
typedef unsigned short bf16;
typedef unsigned v4u __attribute__((ext_vector_type(4)));
typedef unsigned v2u __attribute__((ext_vector_type(2)));
typedef float f32x4 __attribute__((ext_vector_type(4)));
#define RLX_AGENT __ATOMIC_RELAXED, __HIP_MEMORY_SCOPE_AGENT
#define LDS_WAIT() asm volatile("s_waitcnt lgkmcnt(0)" ::: "memory")

constexpr int NWAVES = 8, NTHREADS = 512, GRID = 256;
#ifndef MK_N_LAUNCHES
#define MK_N_LAUNCHES 1
#endif
constexpr int PH_TOTAL = 21;
constexpr int N_LAUNCHES = MK_N_LAUNCHES;

constexpr size_t O_YP = 0, O_YS = O_YP + (size_t)MP * D, O_P_LRUH = O_YS + (size_t)MS * D, O_P_LRUC = O_P_LRUH + (size_t)DEPTH * NP * 1024,
    O_P_GLA = O_P_LRUC + (size_t)DEPTH * NP * 3 * 1024, O_P_C = O_P_GLA + (size_t)DEPTH * NP * 4 * 128 * 256, O_P_N = O_P_C + (size_t)DEPTH * NP * 4 * 256 * 256,
    O_P_M = O_P_N + (size_t)DEPTH * NP * 4 * 256, O_P_MLC = O_P_M + (size_t)DEPTH * NP * 4, O_S_LRUH = O_P_MLC + (size_t)DEPTH * NP * 3 * 1024,
    O_S_LRUC = O_S_LRUH + (size_t)DEPTH * NS * 1024, O_S_GLA = O_S_LRUC + (size_t)DEPTH * NS * 3 * 1024, O_S_C = O_S_GLA + (size_t)DEPTH * NS * 4 * 128 * 256,
    O_S_N = O_S_C + (size_t)DEPTH * NS * 4 * 256 * 256, O_S_M = O_S_N + (size_t)DEPTH * NS * 4 * 256, O_S_MLC = O_S_M + (size_t)DEPTH * NS * 4,
    O_END = O_S_MLC + (size_t)DEPTH * NS * 3 * 1024;
static_assert(O_END == 123798560, "output size");

constexpr size_t MiB = 1u << 20;
constexpr size_t WS_CTL = 0, CTL_ZERO_BYTES = 1 * MiB;
constexpr size_t WS_WADA = 2 * MiB, WS_WIN = 98 * MiB, WS_WBR = 196 * MiB, WS_WOUT = 220 * MiB, WS_WFF1 = 236 * MiB, WS_WFF2 = 300 * MiB;
constexpr size_t WS_CSILU = 364 * MiB, WS_MOD = 365 * MiB, WS_XA = 389 * MiB, WS_XB = 457 * MiB, WS_XN = 525 * MiB, WS_MERGED = 559 * MiB, WS_YCAT = 593 * MiB,
    WS_SMALL = 644 * MiB, WS_PROJ = 645 * MiB, WS_HFF = 849 * MiB, WS_GIMG = 985 * MiB, WS_MIMG = 1008 * MiB, WS_END = 1100 * MiB;
static_assert(WS_WADA + (size_t)2 * NADA * D * 2 <= WS_WIN && WS_WIN + (size_t)2 * NPROJ_PAD * D * 2 <= WS_WBR && WS_WBR + (size_t)2 * D * KBR * 2 <= WS_WOUT &&
              WS_WOUT + (size_t)2 * D * D * 2 <= WS_WFF1 && WS_WFF1 + (size_t)2 * DFF * D * 2 <= WS_WFF2 && WS_WFF2 + (size_t)2 * DFF * D * 2 <= WS_CSILU &&
              WS_CSILU + (size_t)256 * D * 2 <= WS_MOD && WS_MOD + (size_t)256 * 2 * NADA * 4 <= WS_XA && WS_XA + (size_t)MTOT * D * 4 <= WS_XB && WS_XB + (size_t)MTOT * D * 4 <= WS_XN &&
              WS_XN + (size_t)MTOT * D * 2 <= WS_MERGED && WS_MERGED + (size_t)MTOT * D * 2 <= WS_YCAT && WS_YCAT + (size_t)MTOT * KBR * 2 <= WS_SMALL &&
              WS_SMALL + (size_t)MTOT * NSMALL * 4 <= WS_PROJ && WS_PROJ + (size_t)MTOT * NPROJ * 2 <= WS_HFF && WS_HFF + (size_t)MTOT * DFF * 2 <= WS_GIMG && WS_GIMG + (size_t)512 * 46080 <= WS_MIMG && WS_MIMG + (size_t)512 * 115712 <= WS_END, "d_ws map");
constexpr size_t WS_WIN8_0 = WS_WFF1 + 32 * MiB, WS_WIN8_1 = WS_WFF2 + 32 * MiB, WS_XN8 = WS_HFF + 72 * MiB;
static_assert((size_t)2 * DFF * D <= 32 * MiB && (size_t)NPROJ_PAD * D <= 32 * MiB && (size_t)MTOT * DFF <= 72 * MiB && WS_XN8 + (size_t)MTOT * D <= WS_GIMG, "fp8 copies fit in the free halves");
constexpr size_t WS_MG8 = WS_PROJ + 104 * MiB;
static_assert((size_t)MTOT * PPITCH * 2 <= 104 * MiB && WS_MG8 + (size_t)MTOT * 6144 <= WS_HFF, "proj / gate buffers");
constexpr int CW_BAR = 4096;

constexpr int RING_OFF = 0, RING_BYTES = 131072;
constexpr int LDS_BYTES = 163840;
constexpr int LDSCTL_OFF = LDS_BYTES - 1024, MISC_OFF = LDSCTL_OFF + 320;

DI float bf2f(bf16 b) { return __uint_as_float(((unsigned)b) << 16); }
DI unsigned f2bf(float f) { unsigned u = __float_as_uint(f); return (u + 0x7fffu + ((u >> 16) & 1u)) >> 16; }
typedef float f32x2v __attribute__((ext_vector_type(2)));
typedef __bf16 bf16x2v __attribute__((ext_vector_type(2)));
DI unsigned pkbf(float a, float b) { const f32x2v v = {a, b}; const bf16x2v r = __builtin_convertvector(v, bf16x2v); return __builtin_bit_cast(unsigned, r); }
DI unsigned pk2(float lo, float hi) { return f2bf(lo) | (f2bf(hi) << 16); }
DI float bflo_(unsigned w) { return __uint_as_float(w << 16); }
DI float bfhi_(unsigned w) { return __uint_as_float(w & 0xffff0000u); }
DI float sigm(float x) { return __builtin_amdgcn_rcpf(1.f + __expf(-x)); }
DI float lru_in_scale(float la) { const float t = 2.f * la;
    const float em = (t > -0.125f) ? -t * (1.f + t * (0.5f + t * (0.16666667f + t * (0.041666668f + t * 0.0083333338f)))) : 1.f - __expf(t);
    return __builtin_amdgcn_sqrtf(em); }
DI float logsig(float x) { return fminf(x, 0.f) - __logf(1.f + __expf(-fabsf(x))); }
template <int CTRL, int ROWMASK> DI float dpp_f(float v) { return __int_as_float(__builtin_amdgcn_update_dpp(0, __float_as_int(v), CTRL, ROWMASK, 0xf, false)); }
DI float wave_sum(float v) {
    v += dpp_f<0xB1, 0xf>(v);
    v += dpp_f<0x4E, 0xf>(v);
    v += dpp_f<0x141, 0xf>(v);
    v += dpp_f<0x140, 0xf>(v);
    v += dpp_f<0x142, 0xa>(v);
    v += dpp_f<0x143, 0xc>(v);
    return __int_as_float(__builtin_amdgcn_readlane(__float_as_int(v), 63));
}

#define XB_TMO      128
#define XB_XCNT(j)  (256  + 64 * (j))
#define XB_XSUB(j)  (1280 + 64 * (j))
#define XB_XGEN(j)  (2304 + 64 * (j))
#define XB_TOP      3328
#define XB_TOPGEN   3392
#define XCD_BAR_WORDS 3456
#define XB_SPIN_CAP (1u << 18)

__device__ __forceinline__ unsigned xb_ld(unsigned* p)              { return __hip_atomic_load(p, __ATOMIC_RELAXED, __HIP_MEMORY_SCOPE_AGENT); }
__device__ __forceinline__ unsigned xb_add(unsigned* p, unsigned v) { return __hip_atomic_fetch_add(p, v, __ATOMIC_RELAXED, __HIP_MEMORY_SCOPE_AGENT); }
__device__ __forceinline__ unsigned xb_xcc_id() { return (unsigned)__builtin_amdgcn_s_getreg((3 << 11) | 20) & 0xFu; }
#define XB_SPIN(cond, bar) do { unsigned _sp = 0; while (cond) { __builtin_amdgcn_s_sleep(1); \
    if ((++_sp & 255u) == 0u) { if (xb_ld(&(bar)[XB_TMO])) break; if (_sp > XB_SPIN_CAP) { atomicAdd(&(bar)[XB_TMO], 1u); break; } } } } while (0)

struct XcdBarrier {
    unsigned* bar; unsigned x;
    volatile LAS unsigned* st;
};
__device__ __forceinline__ XcdBarrier xcd_barrier_post(unsigned* bar, volatile LAS unsigned* st) {
    XcdBarrier b; b.bar = bar; b.x = xb_xcc_id(); b.st = st;
    if (threadIdx.x == 0) (void)xb_add(&bar[XB_XCNT(b.x)], 1u);
    return b;
}
__device__ __forceinline__ void xcd_barrier_complete(unsigned* bar, unsigned x, unsigned& nloc, unsigned& nx) {
    const unsigned G = gridDim.x * gridDim.y * gridDim.z;
    unsigned sum, cnt, mine, sp = 0u;
    for (;;) {
        sum = 0u; cnt = 0u; mine = 0u;
#pragma unroll
        for (unsigned j = 0; j < 16; ++j) { const unsigned c = xb_ld(&bar[XB_XCNT(j)]); sum += c; cnt += (c > 0u) ? 1u : 0u; mine = (j == x) ? c : mine; }
        if (sum == G) break;
        __builtin_amdgcn_s_sleep(1);
        if ((++sp & 255u) == 0u) { if (xb_ld(&bar[XB_TMO])) break; if (sp > XB_SPIN_CAP) { atomicAdd(&bar[XB_TMO], 1u); break; } }
    }
    nloc = mine > 0u ? mine : 1u; nx = cnt > 0u ? cnt : 1u;
}
__device__ __forceinline__ void xcd_barrier(const XcdBarrier& b) {
    asm volatile("s_waitcnt vmcnt(0)" ::: "memory");
    __syncthreads();
    if (threadIdx.x == 0) {
        unsigned* bar = b.bar;
        __builtin_amdgcn_s_waitcnt(0);
        unsigned nloc = b.st[0], nx = b.st[1];
        if (nloc == 0u) { xcd_barrier_complete(bar, b.x, nloc, nx); b.st[0] = nloc; b.st[1] = nx; }
        const unsigned old = xb_add(&bar[XB_XSUB(b.x)], 1u);
        const unsigned gen = old / nloc;
        if (old + 1u == (gen + 1u) * nloc) {
            __builtin_amdgcn_fence(__ATOMIC_RELEASE, "agent");
            asm volatile("s_waitcnt vmcnt(0)" ::: "memory");
            const unsigned og = xb_add(&bar[XB_TOP], 1u);
            const unsigned tg = og / nx;
            if (og + 1u == (tg + 1u) * nx) xb_add(&bar[XB_TOPGEN], 1u);
            else XB_SPIN(xb_ld(&bar[XB_TOPGEN]) == tg, bar);
            __builtin_amdgcn_fence(__ATOMIC_ACQUIRE, "agent");
            xb_add(&bar[XB_XGEN(b.x)], 1u);
            asm volatile("s_waitcnt vmcnt(0)" ::: "memory");
        } else {
            XB_SPIN(xb_ld(&bar[XB_XGEN(b.x)]) == gen, bar);
            __builtin_amdgcn_fence(__ATOMIC_ACQUIRE, "agent");
            asm volatile("s_waitcnt vmcnt(0)" ::: "memory");
        }
    }
    __syncthreads();
}

struct Args { const float* in[40]; float* out; unsigned char* ws; int ph_lo, ph_hi, li, pad; };
typedef __attribute__((address_space(4))) const Args CArgs;
__device__ __forceinline__ CArgs* kargs() { CArgs* p = (CArgs*)__builtin_amdgcn_kernarg_segment_ptr(); asm volatile("" : "+s"(p)); return p; }

DI void transpose_item(const float* src, int src_ld, int ncols, bf16* dst, int dst_ld, LAS float* scr, int item, int lane) {
    const int nblk = ncols / 32, kb = item / nblk, nb = item % nblk, k0 = 64 * kb, n0 = 32 * nb;
#pragma unroll 8
    for (int i = 0; i < 32; ++i) { const int kk = 2 * i + (lane >> 5); scr[kk * 33 + (lane & 31)] = __builtin_nontemporal_load(src + (size_t)(k0 + kk) * src_ld + n0 + (lane & 31)); }
    LDS_WAIT(); asm volatile("" ::: "memory");
    const int c = lane & 7;
#pragma unroll
    for (int j = 0; j < 4; ++j) { const int n = (lane >> 3) + 8 * j; const LAS float* s = scr + (8 * c) * 33 + n;
        v4u o; o.x = pk2(s[0 * 33], s[1 * 33]); o.y = pk2(s[2 * 33], s[3 * 33]); o.z = pk2(s[4 * 33], s[5 * 33]); o.w = pk2(s[6 * 33], s[7 * 33]);
        *(v4u*)(dst + (size_t)(n0 + n) * dst_ld + k0 + 8 * c) = o; }
    LDS_WAIT(); asm volatile("" ::: "memory");
}
DI void transpose_item_f8(const float* src, int src_ld, int ncols, unsigned char* dst, int dst_ld, float scale, LAS float* scr, int item, int lane) {
    const int nblk = ncols / 32, kb = item / nblk, nb = item % nblk, k0 = 64 * kb, n0 = 32 * nb;
#pragma unroll 8
    for (int i = 0; i < 32; ++i) { const int kk = 2 * i + (lane >> 5); scr[kk * 33 + (lane & 31)] = __builtin_nontemporal_load(src + (size_t)(k0 + kk) * src_ld + n0 + (lane & 31)); }
    LDS_WAIT(); asm volatile("" ::: "memory");
    const int c = lane & 7;
#pragma unroll
    for (int j = 0; j < 4; ++j) { const int n = (lane >> 3) + 8 * j; const LAS float* s = scr + (8 * c) * 33 + n;
        v2u o; o.x = pg8::pk4_fp8(s[0 * 33] * scale, s[1 * 33] * scale, s[2 * 33] * scale, s[3 * 33] * scale); o.y = pg8::pk4_fp8(s[4 * 33] * scale, s[5 * 33] * scale, s[6 * 33] * scale, s[7 * 33] * scale);
        *(v2u*)(dst + (size_t)(n0 + n) * dst_ld + k0 + 8 * c) = o; }
    LDS_WAIT(); asm volatile("" ::: "memory");
}
DI void transpose_job_f8(const float* src, int src_ld, int K, int ncols, unsigned char* dst, int dst_ld, float scale, LAS float* scr, int gw, int ngw, int lane) {
    const int nitems = (K / 64) * (ncols / 32);
    for (int it = gw; it < nitems; it += ngw) transpose_item_f8(src, src_ld, ncols, dst, dst_ld, scale, scr, it, lane);
}
DI void transpose_job(const float* src, int src_ld, int K, int ncols, bf16* dst, int dst_ld, LAS float* scr, int gw, int ngw, int lane) {
    const int nitems = (K / 64) * (ncols / 32);
    for (int it = gw; it < nitems; it += ngw) transpose_item(src, src_ld, ncols, dst, dst_ld, scr, it, lane);
}

DI void norm_rows(const void* xp, const void* xs, bool in_f32, const float* g, const float* modp  ,
                  bf16* out_bf, float* outp, float* outs, int gw, int ngw, int lane, bf16* copy_out = nullptr,
                  int nslab = 0, const bf16* slab = nullptr, const float* sgate = nullptr, bf16* xs_out = nullptr, unsigned char* out_f8 = nullptr, unsigned char* out_f8_also = nullptr) {
    for (int row = gw; row < MTOT; row += ngw) {
        f32x4 v[8]; float ss = 0.f;
        if (in_f32) { const float* xr = row < MP ? (const float*)xp + (size_t)row * D : (const float*)xs + (size_t)(row - MP) * D; const f32x4* x4 = (const f32x4*)xr + lane;
#pragma unroll
            for (int j = 0; j < 8; ++j) v[j] = x4[64 * j];
            if (copy_out) {
#pragma unroll
                for (int j = 0; j < 8; ++j) { v2u w; w.x = pkbf(v[j].x, v[j].y); w.y = pkbf(v[j].z, v[j].w); *((v2u*)(copy_out + (size_t)row * D) + lane + 64 * j) = w; } }
        } else { const bf16* xr = row < MP ? (const bf16*)xp + (size_t)row * D : (const bf16*)xs + (size_t)(row - MP) * D; const v2u* x2 = (const v2u*)xr + lane;
#pragma unroll
            for (int j = 0; j < 8; ++j) { const v2u w = x2[64 * j]; v[j] = (f32x4){bflo_(w.x), bfhi_(w.x), bflo_(w.y), bfhi_(w.y)}; } }
        const int cond = row < MP ? (row >> 11) : NP + ((row - MP) >> 2);
        if (nslab > 0 && row >= MP) {
            const v2u* s4 = (const v2u*)(slab + (size_t)(row - MP) * D) + lane; const f32x4* gt4 = (const f32x4*)(sgate + (size_t)cond * 24576) + lane;
            v2u* xo = (v2u*)(xs_out + (size_t)(row - MP) * D) + lane;
#pragma unroll
            for (int j = 0; j < 8; ++j) { f32x4 a = {0.f, 0.f, 0.f, 0.f};
                for (int k = 0; k < nslab; ++k) { const v2u w = s4[(size_t)k * (MS * D / 4) + 64 * j]; a += (f32x4){bflo_(w.x), bfhi_(w.x), bflo_(w.y), bfhi_(w.y)}; }
                v[j] = v[j] + gt4[64 * j] * a; v2u w; w.x = pkbf(v[j].x, v[j].y); w.y = pkbf(v[j].z, v[j].w); xo[64 * j] = w; }
        }
#pragma unroll
        for (int j = 0; j < 8; ++j) ss += (v[j].x * v[j].x + v[j].y * v[j].y) + (v[j].z * v[j].z + v[j].w * v[j].w);
        ss = wave_sum(ss);
        const float r = __builtin_amdgcn_rsqf(ss * (1.f / D) + EPS);
        const f32x4* g4 = (const f32x4*)g + lane;
#pragma unroll
        for (int j = 0; j < 8; ++j) {
            f32x4 y = v[j] * r * g4[64 * j];
            if (modp) { const f32x4* m4 = (const f32x4*)(modp + (size_t)cond * 24576) + lane; const f32x4 sh = m4[64 * j], sc = m4[512 + 64 * j]; y = y * (1.f + sc) + sh; }
            if (out_f8_also) *((unsigned*)(out_f8_also + (size_t)row * D) + lane + 64 * j) = pg8::pk4_fp8(y.x, y.y, y.z, y.w);
            if (out_f8) *((unsigned*)(out_f8 + (size_t)row * D) + lane + 64 * j) = pg8::pk4_fp8(y.x, y.y, y.z, y.w);
            else if (out_bf) { v2u w; w.x = pk2(y.x, y.y); w.y = pk2(y.z, y.w); *((v2u*)(out_bf + (size_t)row * D) + lane + 64 * j) = w; }
            else { float* o = row < MP ? outp + (size_t)row * D : outs + (size_t)(row - MP) * D; *((f32x4*)o + lane + 64 * j) = y; }
        }
    }
}

DI float* out_state(float* out, int s, int l, size_t off_p, size_t off_s, size_t per) {
    return s < NP ? out + off_p + ((size_t)l * NP + s) * per : out + off_s + ((size_t)l * NS + (s - NP)) * per;
}

DI void lru_unit(int l, bool prompt, int grp, int n, LAS float* lds, int tid) {
    CArgs* A = kargs();
    LAS float* u_s = lds; LAS float* a_s = lds + 2048; LAS float* v_s = lds + 4096;
    const bf16* proj = (const bf16*)(A->ws + WS_PROJ); bf16* ycat = (bf16*)(A->ws + WS_YCAT); unsigned char* ycat8 = A->ws + WS_YCAT; (void)ycat; (void)ycat8;
    const float* cw = A->in[16] + (size_t)l * 4 * 1024; const float* cb = A->in[17] + (size_t)l * 1024;
    const float* wa = A->in[18] + ((size_t)l * 8 + n) * 128 * 128; const float* ba = A->in[19] + (size_t)l * 1024 + n * 128;
    const float* wx = A->in[20] + ((size_t)l * 8 + n) * 128 * 128; const float* bx = A->in[21] + (size_t)l * 1024 + n * 128;
    const float* lam = A->in[22] + (size_t)l * 1024 + n * 128;
    const float* st_h = A->in[4]; const float* st_c = A->in[5];
    const int ntiles = prompt ? TP / 16 : 1;
    const int c = tid & 127, rg = tid >> 7, ch = n * 128 + c;
    float h = 0.f;
    for (int tile = 0; tile < ntiles; ++tile) {
        {
            const float w0 = cw[ch], w1 = cw[1024 + ch], w2 = cw[2048 + ch], w3 = cw[3072 + ch], bb = cb[ch];
#pragma unroll
            for (int q = 0; q < 4; ++q) {
                const int r = 4 * rg + q;
                int s, t, T, row0;
                if (prompt) { s = grp; t = tile * 16 + r; T = TP; row0 = grp * TP; } else { s = NP + 4 * grp + (r >> 2); t = r & 3; T = TS; row0 = MP + (4 * grp + (r >> 2)) * TS; }
                float x[4];
#pragma unroll
                for (int jj = 0; jj < 4; ++jj) { const int tp = t - 3 + jj;
                    if (tp >= 0) x[jj] = bf2f(proj[(size_t)(row0 + tp) * PPITCH + C_LRUX + ch]);
                    else x[jj] = prompt ? 0.f : st_c[(((size_t)l * NS + (s - NP)) * 3 + (3 + tp)) * 1024 + ch]; }
                u_s[r * 128 + c] = bb + w0 * x[0] + w1 * x[1] + w2 * x[2] + w3 * x[3];
                if (t >= T - 3) out_state(A->out, s, l, O_P_LRUC, O_S_LRUC, 3 * 1024)[(size_t)(t - (T - 3)) * 1024 + ch] = x[3];
            }
        }
        __syncthreads();
        {
            float aa[4], ax[4];
#pragma unroll
            for (int q = 0; q < 4; ++q) { aa[q] = ba[c]; ax[q] = bx[c]; }
#pragma unroll 16
            for (int cc = 0; cc < 128; ++cc) { const float wa_ = wa[cc * 128 + c], wx_ = wx[cc * 128 + c];
#pragma unroll
                for (int q = 0; q < 4; ++q) { const float uq = u_s[(4 * rg + q) * 128 + cc]; aa[q] += uq * wa_; ax[q] += uq * wx_; } }
            const float ls = logsig(lam[c]);
#pragma unroll
            for (int q = 0; q < 4; ++q) { const int r = 4 * rg + q; const float rr = sigm(aa[q]), ii = sigm(ax[q]), la = 8.f * rr * ls;
                a_s[r * 128 + c] = __expf(la); v_s[r * 128 + c] = lru_in_scale(la) * (ii * u_s[r * 128 + c]); }
        }
        __syncthreads();
        if (prompt) {
            if (tid < 128) {
#pragma unroll 4
                for (int r = 0; r < 16; ++r) { h = a_s[r * 128 + c] * h + v_s[r * 128 + c];
                    ycat[(size_t)(grp * TP + tile * 16 + r) * KBR + ch] = (bf16)f2bf(h); }
            }
        } else {
            const int b = 4 * grp + rg; float hh = st_h[((size_t)l * NS + b) * 1024 + ch];
#pragma unroll
            for (int t = 0; t < 4; ++t) { const int r = rg * 4 + t; hh = a_s[r * 128 + c] * hh + v_s[r * 128 + c];
                ycat[(size_t)(MP + b * TS + t) * KBR + ch] = (bf16)f2bf(hh); }
            A->out[O_S_LRUH + ((size_t)l * NS + b) * 1024 + ch] = hh;
        }
    }
    if (prompt && tid < 128) A->out[O_P_LRUH + ((size_t)l * NP + grp) * 1024 + ch] = h;
    __syncthreads();
}

DI void gla_unit(int l, int s, int hh, LAS float* lds, int tid, int lane, int wave) {
    CArgs* A = kargs();
    const int b = s - NP, row0 = MP + b * TS;
    const bf16* proj = (const bf16*)(A->ws + WS_PROJ); bf16* ycat = (bf16*)(A->ws + WS_YCAT); unsigned char* ycat8 = A->ws + WS_YCAT; (void)ycat; (void)ycat8;     const float* sm = (const float*)(A->ws + WS_SMALL);
    const float* wg2 = A->in[23] + (size_t)l * 16 * 512; const float* bg = A->in[24] + (size_t)l * 512; const float* gn = A->in[25] + (size_t)l * 256;
    LAS float* eg_s = lds; LAS float* q_s = lds + 512; LAS float* k_s = lds + 1024; LAS float* v_s = lds + 1536; LAS float* part = lds + 2560;
    f32x4 S[16];
    { const f32x4* sp = (const f32x4*)(A->in[6] + ((((size_t)l * NS + b) * 4 + hh) * 128 + 16 * wave) * 256) + lane;
#pragma unroll
      for (int dd = 0; dd < 16; ++dd) S[dd] = __builtin_nontemporal_load(sp + dd * 64); }
    for (int i = tid; i < 4 * 128; i += NTHREADS) { const int tb = i >> 7, d = i & 127, col = hh * 128 + d; const size_t row = (size_t)(row0 + tb);
        float z = bg[col];
#pragma unroll
        for (int r = 0; r < 16; ++r) z += sm[row * NSMALL + r] * wg2[r * 512 + col];
        eg_s[i] = __expf(logsig(z) * (1.f / 16.f));
        q_s[i] = bf2f(proj[row * PPITCH + C_GQ + col]) * 0.08838834764831845f;
        k_s[i] = bf2f(proj[row * PPITCH + C_GK + col]); }
    for (int i = tid; i < 4 * 256; i += NTHREADS) { const int tb = i >> 8, ee = i & 255; v_s[i] = bf2f(proj[(size_t)(row0 + tb) * PPITCH + C_GV + hh * 256 + ee]); }
    __syncthreads();
#pragma unroll
    for (int tb = 0; tb < 4; ++tb) {
        const f32x4 v4 = *(const LAS f32x4*)(v_s + tb * 256 + 4 * lane); f32x4 po = {0.f, 0.f, 0.f, 0.f};
        const LAS float* egp = eg_s + tb * 128 + 16 * wave; const LAS float* kp = k_s + tb * 128 + 16 * wave; const LAS float* qp = q_s + tb * 128 + 16 * wave;
#pragma unroll
        for (int d4 = 0; d4 < 4; ++d4) { const f32x4 eg4 = *(const LAS f32x4*)(egp + 4 * d4), k4 = *(const LAS f32x4*)(kp + 4 * d4), q4 = *(const LAS f32x4*)(qp + 4 * d4);
            S[4 * d4 + 0] = S[4 * d4 + 0] * eg4.x + v4 * k4.x; po += S[4 * d4 + 0] * q4.x;
            S[4 * d4 + 1] = S[4 * d4 + 1] * eg4.y + v4 * k4.y; po += S[4 * d4 + 1] * q4.y;
            S[4 * d4 + 2] = S[4 * d4 + 2] * eg4.z + v4 * k4.z; po += S[4 * d4 + 2] * q4.z;
            S[4 * d4 + 3] = S[4 * d4 + 3] * eg4.w + v4 * k4.w; po += S[4 * d4 + 3] * q4.w; }
        *(LAS f32x4*)(part + (tb * 8 + wave) * 256 + 4 * lane) = po;
    }
    { f32x4* op = (f32x4*)(A->out + O_S_GLA + ((((size_t)l * NS + b) * 4 + hh) * 128 + 16 * wave) * 256) + lane;
#pragma unroll
      for (int dd = 0; dd < 16; ++dd) __builtin_nontemporal_store(S[dd], op + dd * 64); }
    __syncthreads();
    if (wave < 4) { const int tb = wave; const size_t row = (size_t)(row0 + tb);
        f32x4 ov = {0.f, 0.f, 0.f, 0.f};
#pragma unroll
        for (int w8 = 0; w8 < 8; ++w8) ov += *(const LAS f32x4*)(part + (tb * 8 + w8) * 256 + 4 * lane);
        float ss = (ov.x * ov.x + ov.y * ov.y) + (ov.z * ov.z + ov.w * ov.w); ss = wave_sum(ss);
        const float rs = __builtin_amdgcn_rsqf(ss * (1.f / 256.f) + EPS);
        const f32x4 g4 = *(const f32x4*)(gn + 4 * lane);
        const v2u gw = *(const v2u*)(proj + row * PPITCH + C_GGATE + hh * 256 + 4 * lane);
        const float z0 = __uint_as_float(gw.x << 16), z1 = __uint_as_float(gw.x & 0xffff0000u), z2 = __uint_as_float(gw.y << 16), z3 = __uint_as_float(gw.y & 0xffff0000u);
                *(unsigned*)(ycat8 + row * KBR + 1024 + hh * 256 + 4 * lane) = pg8::pk4_fp8(ov.x * rs * g4.x * (z0 * sigm(z0)), ov.y * rs * g4.y * (z1 * sigm(z1)), ov.z * rs * g4.z * (z2 * sigm(z2)), ov.w * rs * g4.w * (z3 * sigm(z3))); }
    __syncthreads();
}

DI void ml_unit(int l, int s, int hh, LAS float* lds, int tid, int lane, int wave) {
    CArgs* A = kargs();
    const int b = s - NP, row0 = MP + b * TS;
    const bf16* proj = (const bf16*)(A->ws + WS_PROJ); bf16* ycat = (bf16*)(A->ws + WS_YCAT); unsigned char* ycat8 = A->ws + WS_YCAT; (void)ycat; (void)ycat8;     const float* sm = (const float*)(A->ws + WS_SMALL);
    const float* mcw = A->in[26] + (size_t)l * 4 * 1024; const float* mcb = A->in[27] + (size_t)l * 1024;
    const float* wq = A->in[28] + (size_t)l * 256 * 16; const float* wk = A->in[29] + (size_t)l * 256 * 16; const float* wv = A->in[30] + (size_t)l * 256 * 16;
    const float* bif = A->in[31] + (size_t)l * 8; const float* gn = A->in[32] + (size_t)l * 256;
    LAS float* mx_s = lds; LAS float* mc_s = lds + 1792; LAS float* q_s = lds + 2816; LAS float* k_s = lds + 3840; LAS float* v_s = lds + 4864;
    LAS float* ig_s = lds + 5888; LAS float* lf_s = lds + 5896; LAS float* part = lds + 5904;
    const size_t bh = ((size_t)l * NS + b) * 4 + hh;
    f32x4 C[32];
    { const f32x4* cp = (const f32x4*)(A->in[7] + (bh * 256 + 32 * wave) * 256) + lane;
#pragma unroll
      for (int dd = 0; dd < 32; ++dd) C[dd] = __builtin_nontemporal_load(cp + dd * 64); }
    float nn[4]; { const f32x4 n4 = *(const f32x4*)(A->in[8] + bh * 256 + 4 * lane); nn[0] = n4.x; nn[1] = n4.y; nn[2] = n4.z; nn[3] = n4.w; }
    float m = A->in[9][bh];
    const int c0 = tid & 255, ch0 = hh * 256 + c0, wb0 = (64 * hh + (c0 >> 2)) * 16 + (c0 & 3);
    const float cw0 = mcw[ch0], cw1 = mcw[1024 + ch0], cw2 = mcw[2048 + ch0], cw3 = mcw[3072 + ch0], cbv = mcb[ch0];
    float wq4[4], wk4[4], wv4[4];
#pragma unroll
    for (int cc = 0; cc < 4; ++cc) { wq4[cc] = wq[wb0 + 4 * cc]; wk4[cc] = wk[wb0 + 4 * cc] * 0.0625f; wv4[cc] = wv[wb0 + 4 * cc]; }
    float gi = 0.f, gf = 0.f; if (tid < 4) { gi = sm[(size_t)(row0 + tid) * NSMALL + 16 + hh] + bif[hh]; gf = sm[(size_t)(row0 + tid) * NSMALL + 20 + hh] + bif[4 + hh]; }
    for (int i = tid; i < 7 * 256; i += NTHREADS) { const int tr = i >> 8, c = i & 255, tp = tr - 3, ch = hh * 256 + c;
        const float x = tp >= 0 ? bf2f(proj[(size_t)(row0 + tp) * PPITCH + C_MX + ch]) : A->in[10][(((size_t)l * NS + b) * 3 + (3 + tp)) * 1024 + ch];
        mx_s[i] = x;
        if (tp >= 1) A->out[O_S_MLC + (((size_t)l * NS + b) * 3 + (tp - 1)) * 1024 + ch] = x; }
    __syncthreads();
    for (int i = tid; i < 4 * 256; i += NTHREADS) { const int tb = i >> 8, c = i & 255;
        const float acc = cbv + cw0 * mx_s[tb * 256 + c] + cw1 * mx_s[(tb + 1) * 256 + c] + cw2 * mx_s[(tb + 2) * 256 + c] + cw3 * mx_s[(tb + 3) * 256 + c];
        mc_s[i] = acc * sigm(acc); }
    __syncthreads();
    for (int i = tid; i < 4 * 256; i += NTHREADS) { const int tb = i >> 8, c = i & 255, nq = c >> 2;
        float q = 0.f, k = 0.f, v = 0.f;
#pragma unroll
        for (int cc = 0; cc < 4; ++cc) { const float mcv = mc_s[tb * 256 + 4 * nq + cc], mxv = mx_s[(tb + 3) * 256 + 4 * nq + cc];
            q += mcv * wq4[cc]; k += mcv * wk4[cc]; v += mxv * wv4[cc]; }
        q_s[i] = q; k_s[i] = k; v_s[i] = v; }
    if (tid < 4) { ig_s[tid] = gi; lf_s[tid] = logsig(gf); }
    __syncthreads();
    for (int tb = 0; tb < 4; ++tb) {
        const float lf = lf_s[tb], ig = ig_s[tb];
        const float mnew = fmaxf(lf + m, ig), fdec = __expf(lf + m - mnew), iw = __expf(ig - mnew); m = mnew;
        const f32x4 k4n = *(const LAS f32x4*)(k_s + tb * 256 + 4 * lane), q4n = *(const LAS f32x4*)(q_s + tb * 256 + 4 * lane);
        nn[0] = fdec * nn[0] + iw * k4n.x; nn[1] = fdec * nn[1] + iw * k4n.y; nn[2] = fdec * nn[2] + iw * k4n.z; nn[3] = fdec * nn[3] + iw * k4n.w;
        const float den = wave_sum((q4n.x * nn[0] + q4n.y * nn[1]) + (q4n.z * nn[2] + q4n.w * nn[3]));
        if (tid == 0) ig_s[4 + tb] = 1.f / fmaxf(fabsf(den), __expf(-m));
        const f32x4 v4 = *(const LAS f32x4*)(v_s + tb * 256 + 4 * lane) * iw; f32x4 pn = {0.f, 0.f, 0.f, 0.f};
        const LAS float* kp = k_s + tb * 256 + 32 * wave; const LAS float* qp = q_s + tb * 256 + 32 * wave;
#pragma unroll
        for (int d4 = 0; d4 < 8; ++d4) { const f32x4 k4 = *(const LAS f32x4*)(kp + 4 * d4), q4 = *(const LAS f32x4*)(qp + 4 * d4);
            C[4 * d4 + 0] = C[4 * d4 + 0] * fdec + v4 * k4.x; pn += C[4 * d4 + 0] * q4.x;
            C[4 * d4 + 1] = C[4 * d4 + 1] * fdec + v4 * k4.y; pn += C[4 * d4 + 1] * q4.y;
            C[4 * d4 + 2] = C[4 * d4 + 2] * fdec + v4 * k4.z; pn += C[4 * d4 + 2] * q4.z;
            C[4 * d4 + 3] = C[4 * d4 + 3] * fdec + v4 * k4.w; pn += C[4 * d4 + 3] * q4.w; }
        *(LAS f32x4*)(part + (tb * 8 + wave) * 256 + 4 * lane) = pn;
    }
    { f32x4* cp = (f32x4*)(A->out + O_S_C + (bh * 256 + 32 * wave) * 256) + lane;
#pragma unroll
      for (int dd = 0; dd < 32; ++dd) __builtin_nontemporal_store(C[dd], cp + dd * 64);
      if (wave == 0) { f32x4 n4; n4.x = nn[0]; n4.y = nn[1]; n4.z = nn[2]; n4.w = nn[3]; *(f32x4*)(A->out + O_S_N + bh * 256 + 4 * lane) = n4; }
      if (tid == 0) A->out[O_S_M + bh] = m; }
    __syncthreads();
    if (wave < 4) { const int tb = wave; const size_t row = (size_t)(row0 + tb);
        f32x4 hv = {0.f, 0.f, 0.f, 0.f};
#pragma unroll
        for (int w8 = 0; w8 < 8; ++w8) hv += *(const LAS f32x4*)(part + (tb * 8 + w8) * 256 + 4 * lane);
        const float rd = ig_s[4 + tb];
        hv = hv * rd;
        float ss = (hv.x * hv.x + hv.y * hv.y) + (hv.z * hv.z + hv.w * hv.w); ss = wave_sum(ss);
        const float rs = __builtin_amdgcn_rsqf(ss * (1.f / 256.f) + EPS);
        const f32x4 g4 = *(const f32x4*)(gn + 4 * lane);
        const v2u ow = *(const v2u*)(proj + row * PPITCH + C_MO + hh * 256 + 4 * lane);
        const float z0 = __uint_as_float(ow.x << 16), z1 = __uint_as_float(ow.x & 0xffff0000u), z2 = __uint_as_float(ow.y << 16), z3 = __uint_as_float(ow.y & 0xffff0000u);
                *(unsigned*)(ycat8 + row * KBR + 2048 + hh * 256 + 4 * lane) = pg8::pk4_fp8(sigm(z0) * (hv.x * rs * g4.x), sigm(z1) * (hv.y * rs * g4.y), sigm(z2) * (hv.z * rs * g4.z), sigm(z3) * (hv.w * rs * g4.w)); }
    __syncthreads();
}

typedef short bf16x8 __attribute__((ext_vector_type(8)));
typedef float f32x16 __attribute__((ext_vector_type(16)));
#define GL_DSR128(dst, addr, off) asm volatile("ds_read_b128 %0, %1 offset:" #off : "=v"(dst) : "v"(addr))
#define GL_DSR2X64(dst, addr, o0, o1) asm volatile("ds_read2_b64 %0, %1 offset0:" #o0 " offset1:" #o1 : "=v"(dst) : "v"(addr))
#define GL_LWAIT(n, x) asm volatile("s_waitcnt lgkmcnt(" #n ")" : "+v"(x))
#define WG_RAW_BARRIER() asm volatile("s_waitcnt lgkmcnt(0)\n\ts_barrier" ::: "memory")
#define MFMA32(a, b, c) __builtin_amdgcn_mfma_f32_32x32x16_bf16((a), (b), (c), 0, 0, 0)
DI bf16x8 frag16(const LAS unsigned char* p) { return *(const LAS bf16x8*)p; }
DI bf16x8 frag8x2(const LAS unsigned char* p) { const v2u lo = *(const LAS v2u*)p, hi = *(const LAS v2u*)(p + 16);
    const v4u w = {lo.x, lo.y, hi.x, hi.y}; return __builtin_bit_cast(bf16x8, w); }
DI bf16x8 pack_acc(const f32x16& x, int s) {
    const v4u w = {pkbf(x[8 * s + 0], x[8 * s + 1]), pkbf(x[8 * s + 2], x[8 * s + 3]), pkbf(x[8 * s + 4], x[8 * s + 5]), pkbf(x[8 * s + 6], x[8 * s + 7])};
    return __builtin_bit_cast(bf16x8, w); }
DI unsigned short lds_u16(const LAS unsigned char* p) { return *(const LAS unsigned short*)p; }

constexpr int GL_QE = 0, GL_KE = 17408, GL_KDT = 34816, GL_V = 53248, GL_A = 87040, GL_SM = 96256, GL_SEG = 100352, GL_DEC = 102400, GL_OS = 0;
constexpr int GL_PQ = 272, GL_PT = 144, GL_PV = 528, GL_PO = 1040;
constexpr int GIMG_BYTES = 46080, GI_Q = 0, GI_K = 17408, GI_A = 35840, GI_D = 45056, GI_PIECES = 2848;
DI int gimg_lds_off(int idx) {
    return idx < 1088 ? GL_QE + idx * 16 : idx < 2240 ? GL_KDT + (idx - 1088) * 16 : idx < 2816 ? GL_A + (idx - 2240) * 16 : GL_DEC + (idx - 2816) * 16;
}
DI void gla_prep_unit(int l, int s, int hh, int c, LAS unsigned char* lds, int tid) {
    CArgs* A = kargs();
    const bf16* proj = (const bf16*)(A->ws + WS_PROJ); const float* sm = (const float*)(A->ws + WS_SMALL);
    const float* wg2 = A->in[23] + (size_t)l * 16 * 512; const float* bg = A->in[24] + (size_t)l * 512;
    const int lane = tid & 63, w = __builtin_amdgcn_readfirstlane(tid >> 6), r = lane & 31, h = lane >> 5;
    const int d_ = tid & 127, seg = __builtin_amdgcn_readfirstlane(tid >> 7);
    float wg[16];
#pragma unroll
    for (int q = 0; q < 16; ++q) wg[q] = wg2[q * 512 + hh * 128 + d_];
    const float bgv = bg[hh * 128 + d_];
    const int r0 = s * TP + 64 * c;
#pragma unroll
    for (int i = 0; i < 2; ++i) { const int idx = tid + 512 * i, row = idx >> 4, ch = idx & 15; const bf16* rp = proj + (size_t)(r0 + row) * PPITCH + hh * 128 + 8 * ch;
        *(LAS v4u*)(lds + GL_QE + row * GL_PQ + ch * 16) = *(const v4u*)(rp + C_GQ); *(LAS v4u*)(lds + GL_KE + row * GL_PQ + ch * 16) = *(const v4u*)(rp + C_GK); }
    if (tid < 256) { const int row = tid >> 2, qd = tid & 3; *(LAS f32x4*)(lds + GL_SM + row * 64 + qd * 16) = *(const f32x4*)(sm + (size_t)(r0 + row) * NSMALL + 4 * qd); }
    __syncthreads();
    float b[16]; float run = 0.f;
#pragma unroll
    for (int t = 0; t < 16; ++t) { const LAS f32x4* sp = (const LAS f32x4*)(lds + GL_SM + (16 * seg + t) * 64);
        const f32x4 s0 = sp[0], s1 = sp[1], s2 = sp[2], s3 = sp[3];
        float z = bgv;
        z += s0.x * wg[0] + s0.y * wg[1] + s0.z * wg[2] + s0.w * wg[3]; z += s1.x * wg[4] + s1.y * wg[5] + s1.z * wg[6] + s1.w * wg[7];
        z += s2.x * wg[8] + s2.y * wg[9] + s2.z * wg[10] + s2.w * wg[11]; z += s3.x * wg[12] + s3.y * wg[13] + s3.z * wg[14] + s3.w * wg[15];
        run += logsig(z) * (1.f / 16.f); b[t] = run; }
    *(LAS float*)(lds + GL_SEG + (seg * 128 + d_) * 4) = run;
    __syncthreads();
    { float pre = 0.f, tot = 0.f;
#pragma unroll
      for (int s2 = 0; s2 < 4; ++s2) { const float x = *(const LAS float*)(lds + GL_SEG + (s2 * 128 + d_) * 4); tot += x; pre += (s2 < seg) ? x : 0.f; }
      float kd[16];
#pragma unroll
      for (int t = 0; t < 16; ++t) { const int j = 16 * seg + t; const float bb = b[t] + pre;
          const float qraw = bf2f(*(const LAS unsigned short*)(lds + GL_QE + j * GL_PQ + d_ * 2)), kraw = bf2f(*(const LAS unsigned short*)(lds + GL_KE + j * GL_PQ + d_ * 2));
          const float qe = qraw * 0.08838834764831845f * __expf(bb), ke = kraw * __expf(-bb); kd[t] = kraw * __expf(tot - bb);
          *(LAS unsigned short*)(lds + GL_QE + j * GL_PQ + d_ * 2) = (unsigned short)(pkbf(qe, 0.f) & 0xffffu);
          *(LAS unsigned short*)(lds + GL_KE + j * GL_PQ + d_ * 2) = (unsigned short)(pkbf(ke, 0.f) & 0xffffu); }
      v4u k0, k1; k0.x = pkbf(kd[0], kd[1]); k0.y = pkbf(kd[2], kd[3]); k0.z = pkbf(kd[4], kd[5]); k0.w = pkbf(kd[6], kd[7]);
      k1.x = pkbf(kd[8], kd[9]); k1.y = pkbf(kd[10], kd[11]); k1.z = pkbf(kd[12], kd[13]); k1.w = pkbf(kd[14], kd[15]);
      *(LAS v4u*)(lds + GL_KDT + d_ * GL_PT + seg * 32) = k0; *(LAS v4u*)(lds + GL_KDT + d_ * GL_PT + seg * 32 + 16) = k1;
      if (seg == 0) *(LAS float*)(lds + GL_DEC + d_ * 4) = __expf(tot); }
    __syncthreads();
    if (w < 3) { const int it = (w >= 1) ? 1 : 0, jt = (w == 2) ? 1 : 0; f32x16 a;
#pragma unroll
        for (int i = 0; i < 16; ++i) a[i] = 0.f;
#pragma unroll
        for (int s8 = 0; s8 < 8; ++s8) a = MFMA32(frag16(lds + GL_QE + (32 * it + r) * GL_PQ + (16 * s8 + 8 * h) * 2), frag16(lds + GL_KE + (32 * jt + r) * GL_PQ + (16 * s8 + 8 * h) * 2), a);
#pragma unroll
        for (int reg = 0; reg < 16; ++reg) { const int i = 32 * it + (reg & 3) + 8 * (reg >> 2) + 4 * h, j = 32 * jt + r;
            *(LAS unsigned short*)(lds + GL_A + i * GL_PT + j * 2) = (unsigned short)(pkbf(j <= i ? a[reg] : 0.f, 0.f) & 0xffffu); } }
    __syncthreads();
    { unsigned char* img = A->ws + WS_GIMG + (size_t)((s * 4 + hh) * (TP / 64) + c) * GIMG_BYTES;
      for (int idx = tid; idx < GI_PIECES; idx += NTHREADS) *(v4u*)(img + idx * 16) = *(const LAS v4u*)(lds + gimg_lds_off(idx)); }
    __syncthreads();
}

DI void gla_seq_unit(int l, int s, int hh, LAS unsigned char* lds, int tid) {
    CArgs* A = kargs();
    const bf16* proj = (const bf16*)(A->ws + WS_PROJ); bf16* ycat = (bf16*)(A->ws + WS_YCAT); unsigned char* ycat8 = A->ws + WS_YCAT; (void)ycat; (void)ycat8;
    const float* gn = A->in[25] + (size_t)l * 256;
    const unsigned char* img0 = A->ws + WS_GIMG + (size_t)((s * 4 + hh) * (TP / 64)) * GIMG_BYTES;
    const int w = __builtin_amdgcn_readfirstlane(tid >> 6);
    f32x16 St[4];
#pragma unroll
    for (int dt = 0; dt < 4; ++dt)
#pragma unroll
        for (int i = 0; i < 16; ++i) St[dt][i] = 0.f;
    v4u pi[6], pv[4];
#define GLA_PREFETCH(cn) do { int tp_ = tid; asm volatile("" : "+v"(tp_)); const unsigned char* ib_ = img0 + (size_t)(cn) * GIMG_BYTES; \
        _Pragma("unroll") for (int i_ = 0; i_ < 6; ++i_) { const int idx_ = tp_ + 512 * i_; pi[i_] = (v4u){0u, 0u, 0u, 0u}; if (idx_ < GI_PIECES) pi[i_] = *(const v4u*)(ib_ + (unsigned)idx_ * 16u); } \
        const bf16* vb_ = proj + (size_t)(s * TP + 64 * (cn)) * PPITCH + C_GV + hh * 256; \
        _Pragma("unroll") for (int i_ = 0; i_ < 4; ++i_) { const int idx_ = tp_ + 512 * i_; pv[i_] = *(const v4u*)(vb_ + (unsigned)((idx_ >> 5) * PPITCH + 8 * (idx_ & 31))); } } while (0)
    GLA_PREFETCH(0);
    for (int c = 0; c < TP / 64; ++c) {
        const int r0 = s * TP + 64 * c;
        { int tz_ = tid; asm volatile("" : "+v"(tz_));
#pragma unroll
          for (int i = 0; i < 6; ++i) { const int idx = tz_ + 512 * i; if (idx < GI_PIECES) *(LAS v4u*)(lds + gimg_lds_off(idx)) = pi[i]; }
#pragma unroll
          for (int i = 0; i < 4; ++i) { const int idx = tz_ + 512 * i; *(LAS v4u*)(lds + GL_V + (idx >> 5) * GL_PV + (idx & 31) * 16) = pv[i]; } }
        WG_RAW_BARRIER();
        if (c + 1 < TP / 64) GLA_PREFETCH(c + 1);
        v2u gwv[8];
#pragma unroll
        for (int q = 0; q < 8; ++q) gwv[q] = *(const v2u*)(proj + (size_t)(r0 + 8 * w + q) * PPITCH + C_GGATE + hh * 256 + 4 * (tid & 63));
        f32x16 o0, o1;
        { int tz_ = tid; asm volatile("" : "+v"(tz_)); const int lane = tz_ & 63, r = lane & 31, h = lane >> 5;
#pragma unroll
        for (int i = 0; i < 16; ++i) { o0[i] = 0.f; o1[i] = 0.f; }
        { const unsigned qa = (unsigned)(__UINTPTR_TYPE__)(lds + GL_QE + r * GL_PQ + 8 * h), qb = qa + 32 * GL_PQ;
          v4u f0, f1, f2, f3;
          GL_DSR2X64(f0, qa, 0, 2);
          GL_DSR2X64(f1, qb, 0, 2);
          GL_DSR2X64(f2, qa, 4, 6);
          GL_DSR2X64(f3, qb, 4, 6);
          { const bf16x8 bfrag = pack_acc(St[0], 0);
            GL_LWAIT(3, f0); o0 = MFMA32(__builtin_bit_cast(bf16x8, f0), bfrag, o0); GL_DSR2X64(f0, qa, 8, 10);
            GL_LWAIT(3, f1); o1 = MFMA32(__builtin_bit_cast(bf16x8, f1), bfrag, o1); GL_DSR2X64(f1, qb, 8, 10);
          }
          { const bf16x8 bfrag = pack_acc(St[0], 1);
            GL_LWAIT(3, f2); o0 = MFMA32(__builtin_bit_cast(bf16x8, f2), bfrag, o0); GL_DSR2X64(f2, qa, 12, 14);
            GL_LWAIT(3, f3); o1 = MFMA32(__builtin_bit_cast(bf16x8, f3), bfrag, o1); GL_DSR2X64(f3, qb, 12, 14);
          }
          { const bf16x8 bfrag = pack_acc(St[1], 0);
            GL_LWAIT(3, f0); o0 = MFMA32(__builtin_bit_cast(bf16x8, f0), bfrag, o0); GL_DSR2X64(f0, qa, 16, 18);
            GL_LWAIT(3, f1); o1 = MFMA32(__builtin_bit_cast(bf16x8, f1), bfrag, o1); GL_DSR2X64(f1, qb, 16, 18);
          }
          { const bf16x8 bfrag = pack_acc(St[1], 1);
            GL_LWAIT(3, f2); o0 = MFMA32(__builtin_bit_cast(bf16x8, f2), bfrag, o0); GL_DSR2X64(f2, qa, 20, 22);
            GL_LWAIT(3, f3); o1 = MFMA32(__builtin_bit_cast(bf16x8, f3), bfrag, o1); GL_DSR2X64(f3, qb, 20, 22);
          }
          { const bf16x8 bfrag = pack_acc(St[2], 0);
            GL_LWAIT(3, f0); o0 = MFMA32(__builtin_bit_cast(bf16x8, f0), bfrag, o0); GL_DSR2X64(f0, qa, 24, 26);
            GL_LWAIT(3, f1); o1 = MFMA32(__builtin_bit_cast(bf16x8, f1), bfrag, o1); GL_DSR2X64(f1, qb, 24, 26);
          }
          { const bf16x8 bfrag = pack_acc(St[2], 1);
            GL_LWAIT(3, f2); o0 = MFMA32(__builtin_bit_cast(bf16x8, f2), bfrag, o0); GL_DSR2X64(f2, qa, 28, 30);
            GL_LWAIT(3, f3); o1 = MFMA32(__builtin_bit_cast(bf16x8, f3), bfrag, o1); GL_DSR2X64(f3, qb, 28, 30);
          }
          { const bf16x8 bfrag = pack_acc(St[3], 0);
            GL_LWAIT(3, f0); o0 = MFMA32(__builtin_bit_cast(bf16x8, f0), bfrag, o0);
            GL_LWAIT(2, f1); o1 = MFMA32(__builtin_bit_cast(bf16x8, f1), bfrag, o1);
          }
          { const bf16x8 bfrag = pack_acc(St[3], 1);
            GL_LWAIT(1, f2); o0 = MFMA32(__builtin_bit_cast(bf16x8, f2), bfrag, o0);
            GL_LWAIT(0, f3); o1 = MFMA32(__builtin_bit_cast(bf16x8, f3), bfrag, o1);
          }
        }
        { const unsigned aa = (unsigned)(__UINTPTR_TYPE__)(lds + GL_A + r * GL_PT + 16 * h), ka = (unsigned)(__UINTPTR_TYPE__)(lds + GL_KDT + r * GL_PT + 16 * h);
          v4u f0, f1, f2, f3;
          GL_DSR128(f0, aa, 0);
          GL_DSR128(f1, aa, 4608);
          GL_DSR128(f2, ka, 0);
          GL_DSR128(f3, ka, 4608);
#pragma unroll
          for (int dt = 0; dt < 4; ++dt)
#pragma unroll
              for (int g = 0; g < 4; ++g) { const f32x4 dc = *(const LAS f32x4*)(lds + GL_DEC + (32 * dt + 8 * g + 4 * h) * 4);
                  St[dt][4 * g + 0] *= dc.x; St[dt][4 * g + 1] *= dc.y; St[dt][4 * g + 2] *= dc.z; St[dt][4 * g + 3] *= dc.w; }
          { v4u x; const LAS unsigned char* vp = lds + GL_V + (0 + 8 * h) * GL_PV + (32 * w + r) * 2;
            x.x = (unsigned)lds_u16(vp) | ((unsigned)lds_u16(vp + GL_PV) << 16); x.y = (unsigned)lds_u16(vp + 2 * GL_PV) | ((unsigned)lds_u16(vp + 3 * GL_PV) << 16);
            x.z = (unsigned)lds_u16(vp + 4 * GL_PV) | ((unsigned)lds_u16(vp + 5 * GL_PV) << 16); x.w = (unsigned)lds_u16(vp + 6 * GL_PV) | ((unsigned)lds_u16(vp + 7 * GL_PV) << 16);
            const bf16x8 vf = __builtin_bit_cast(bf16x8, x);
            GL_LWAIT(3, f0); o0 = MFMA32(__builtin_bit_cast(bf16x8, f0), vf, o0); GL_DSR128(f0, ka, 9216);
            GL_LWAIT(3, f1); o1 = MFMA32(__builtin_bit_cast(bf16x8, f1), vf, o1); GL_DSR128(f1, ka, 13824);
            GL_LWAIT(3, f2); St[0] = MFMA32(__builtin_bit_cast(bf16x8, f2), vf, St[0]); GL_DSR128(f2, aa, 32);
            GL_LWAIT(3, f3); St[1] = MFMA32(__builtin_bit_cast(bf16x8, f3), vf, St[1]); GL_DSR128(f3, aa, 4640);
            GL_LWAIT(3, f0); St[2] = MFMA32(__builtin_bit_cast(bf16x8, f0), vf, St[2]); GL_DSR128(f0, ka, 32);
            GL_LWAIT(3, f1); St[3] = MFMA32(__builtin_bit_cast(bf16x8, f1), vf, St[3]); GL_DSR128(f1, ka, 4640);
          }
          { v4u x; const LAS unsigned char* vp = lds + GL_V + (16 + 8 * h) * GL_PV + (32 * w + r) * 2;
            x.x = (unsigned)lds_u16(vp) | ((unsigned)lds_u16(vp + GL_PV) << 16); x.y = (unsigned)lds_u16(vp + 2 * GL_PV) | ((unsigned)lds_u16(vp + 3 * GL_PV) << 16);
            x.z = (unsigned)lds_u16(vp + 4 * GL_PV) | ((unsigned)lds_u16(vp + 5 * GL_PV) << 16); x.w = (unsigned)lds_u16(vp + 6 * GL_PV) | ((unsigned)lds_u16(vp + 7 * GL_PV) << 16);
            const bf16x8 vf = __builtin_bit_cast(bf16x8, x);
            GL_LWAIT(3, f2); o0 = MFMA32(__builtin_bit_cast(bf16x8, f2), vf, o0); GL_DSR128(f2, ka, 9248);
            GL_LWAIT(3, f3); o1 = MFMA32(__builtin_bit_cast(bf16x8, f3), vf, o1); GL_DSR128(f3, ka, 13856);
            GL_LWAIT(3, f0); St[0] = MFMA32(__builtin_bit_cast(bf16x8, f0), vf, St[0]); GL_DSR128(f0, aa, 4672);
            GL_LWAIT(3, f1); St[1] = MFMA32(__builtin_bit_cast(bf16x8, f1), vf, St[1]); GL_DSR128(f1, ka, 64);
            GL_LWAIT(3, f2); St[2] = MFMA32(__builtin_bit_cast(bf16x8, f2), vf, St[2]); GL_DSR128(f2, ka, 4672);
            GL_LWAIT(3, f3); St[3] = MFMA32(__builtin_bit_cast(bf16x8, f3), vf, St[3]); GL_DSR128(f3, ka, 9280);
          }
          { v4u x; const LAS unsigned char* vp = lds + GL_V + (32 + 8 * h) * GL_PV + (32 * w + r) * 2;
            x.x = (unsigned)lds_u16(vp) | ((unsigned)lds_u16(vp + GL_PV) << 16); x.y = (unsigned)lds_u16(vp + 2 * GL_PV) | ((unsigned)lds_u16(vp + 3 * GL_PV) << 16);
            x.z = (unsigned)lds_u16(vp + 4 * GL_PV) | ((unsigned)lds_u16(vp + 5 * GL_PV) << 16); x.w = (unsigned)lds_u16(vp + 6 * GL_PV) | ((unsigned)lds_u16(vp + 7 * GL_PV) << 16);
            const bf16x8 vf = __builtin_bit_cast(bf16x8, x);
            GL_LWAIT(3, f0); o1 = MFMA32(__builtin_bit_cast(bf16x8, f0), vf, o1); GL_DSR128(f0, ka, 13888);
            GL_LWAIT(3, f1); St[0] = MFMA32(__builtin_bit_cast(bf16x8, f1), vf, St[0]); GL_DSR128(f1, aa, 4704);
            GL_LWAIT(3, f2); St[1] = MFMA32(__builtin_bit_cast(bf16x8, f2), vf, St[1]); GL_DSR128(f2, ka, 96);
            GL_LWAIT(3, f3); St[2] = MFMA32(__builtin_bit_cast(bf16x8, f3), vf, St[2]); GL_DSR128(f3, ka, 4704);
            GL_LWAIT(3, f0); St[3] = MFMA32(__builtin_bit_cast(bf16x8, f0), vf, St[3]); GL_DSR128(f0, ka, 9312);
          }
          { v4u x; const LAS unsigned char* vp = lds + GL_V + (48 + 8 * h) * GL_PV + (32 * w + r) * 2;
            x.x = (unsigned)lds_u16(vp) | ((unsigned)lds_u16(vp + GL_PV) << 16); x.y = (unsigned)lds_u16(vp + 2 * GL_PV) | ((unsigned)lds_u16(vp + 3 * GL_PV) << 16);
            x.z = (unsigned)lds_u16(vp + 4 * GL_PV) | ((unsigned)lds_u16(vp + 5 * GL_PV) << 16); x.w = (unsigned)lds_u16(vp + 6 * GL_PV) | ((unsigned)lds_u16(vp + 7 * GL_PV) << 16);
            const bf16x8 vf = __builtin_bit_cast(bf16x8, x);
            GL_LWAIT(3, f1); o1 = MFMA32(__builtin_bit_cast(bf16x8, f1), vf, o1); GL_DSR128(f1, ka, 13920);
            GL_LWAIT(3, f2); St[0] = MFMA32(__builtin_bit_cast(bf16x8, f2), vf, St[0]);
            GL_LWAIT(2, f3); St[1] = MFMA32(__builtin_bit_cast(bf16x8, f3), vf, St[1]);
            GL_LWAIT(1, f0); St[2] = MFMA32(__builtin_bit_cast(bf16x8, f0), vf, St[2]);
            GL_LWAIT(0, f1); St[3] = MFMA32(__builtin_bit_cast(bf16x8, f1), vf, St[3]);
          }
          asm volatile("" ::: "memory"); }
        }
        WG_RAW_BARRIER();
        { int tz_ = tid; asm volatile("" : "+v"(tz_)); const int lane = tz_ & 63, r = lane & 31, h = lane >> 5;
#pragma unroll
        for (int reg = 0; reg < 16; ++reg) { const int i = (reg & 3) + 8 * (reg >> 2) + 4 * h;
            *(LAS float*)(lds + GL_OS + i * GL_PO + (32 * w + r) * 4) = o0[reg]; *(LAS float*)(lds + GL_OS + (32 + i) * GL_PO + (32 * w + r) * 4) = o1[reg]; } }
        WG_RAW_BARRIER();
        { int tz_ = tid; asm volatile("" : "+v"(tz_)); const int lane = tz_ & 63;
        const f32x4 gn4 = *(const f32x4*)(gn + 4 * lane);
#pragma unroll
        for (int q = 0; q < 8; ++q) { const int i = 8 * w + q; const size_t row = (size_t)(r0 + i);
            const f32x4 ov = *(const LAS f32x4*)(lds + GL_OS + i * GL_PO + lane * 16);
            float ss = (ov.x * ov.x + ov.y * ov.y) + (ov.z * ov.z + ov.w * ov.w); ss = wave_sum(ss);
            const float rs = __builtin_amdgcn_rsqf(ss * (1.f / 256.f) + EPS);
            const v2u gw = gwv[q];
            const float z0 = __uint_as_float(gw.x << 16), z1 = __uint_as_float(gw.x & 0xffff0000u), z2 = __uint_as_float(gw.y << 16), z3 = __uint_as_float(gw.y & 0xffff0000u);
                        *(unsigned*)(ycat8 + row * KBR + 1024 + hh * 256 + 4 * lane) = pg8::pk4_fp8(ov.x * rs * gn4.x * (z0 * sigm(z0)), ov.y * rs * gn4.y * (z1 * sigm(z1)), ov.z * rs * gn4.z * (z2 * sigm(z2)), ov.w * rs * gn4.w * (z3 * sigm(z3))); } }
        WG_RAW_BARRIER();
    }
    { int tz_ = tid; asm volatile("" : "+v"(tz_)); const int lane = tz_ & 63, r = lane & 31, h = lane >> 5;
      float* op = A->out + O_P_GLA + (((size_t)l * NP + s) * 4 + hh) * 128 * 256 + 32 * w + r;
#pragma unroll
      for (int dt = 0; dt < 4; ++dt)
#pragma unroll
          for (int reg = 0; reg < 16; ++reg) op[(size_t)(32 * dt + (reg & 3) + 8 * (reg >> 2) + 4 * h) * 256] = St[dt][reg]; }
    __syncthreads();
}

constexpr int ML_Q = 0, ML_K = 33792, ML_KWT = 67584, ML_V = 104448, ML_S = 138240, ML_SC = 147456, ML_HS = 0;
constexpr int ML_PQ = 528, ML_PT = 144, ML_PH = 1040;
constexpr int IS_F = 0, IS_PM = 64, IS_RSP = 128, IS_NP = 192, IS_FL = 448, IS_CMAX = 449;
constexpr int SC_COLF = 512, SC_RDEN = 512, SC_QN = 576, SC_N = 1088, SC_CW = 576, SC_RAT = 1344;
static_assert(ML_SC + (576 + 1280) * 4 <= LDSCTL_OFF && 67 * 512 <= ML_V - ML_KWT, "mLSTM LDS map");
constexpr int MIMG_BYTES = 115712, MI_PIECES = 7232;
DI int mimg_lds_off(int idx) { return idx < 2112 ? ML_Q + idx * 16 : idx < 4416 ? ML_KWT + (idx - 2112) * 16 : idx < 6528 ? ML_V + (idx - 4416) * 16 : idx < 7104 ? ML_S + (idx - 6528) * 16 : ML_SC + (idx - 7104) * 16; }
DI float quad_bcast(float v, int cc) {
    const int x = __float_as_int(v); int y;
    switch (cc) { case 0: y = __builtin_amdgcn_mov_dpp(x, 0x00, 0xf, 0xf, true); break; case 1: y = __builtin_amdgcn_mov_dpp(x, 0x55, 0xf, 0xf, true); break;
                  case 2: y = __builtin_amdgcn_mov_dpp(x, 0xaa, 0xf, 0xf, true); break; default: y = __builtin_amdgcn_mov_dpp(x, 0xff, 0xf, 0xf, true); break; }
    return __int_as_float(y);
}
DI void ml_prep_unit(int l, int s, int hh, int c, LAS unsigned char* lds, int tid) {
    CArgs* A = kargs();
    const bf16* proj = (const bf16*)(A->ws + WS_PROJ); const float* sm = (const float*)(A->ws + WS_SMALL);
    const float* mcw = A->in[26] + (size_t)l * 4 * 1024; const float* mcb = A->in[27] + (size_t)l * 1024; const float* bif = A->in[31] + (size_t)l * 8;
    const int lane = tid & 63, w = __builtin_amdgcn_readfirstlane(tid >> 6), r = lane & 31, h = lane >> 5;
    const int c_ = tid & 255, seg = __builtin_amdgcn_readfirstlane(tid >> 8);
    LAS float* sc = (LAS float*)(lds + ML_SC);
    const int r0 = s * TP + 64 * c;
    { const bf16* pb = proj + ((ptrdiff_t)r0 - 3) * (ptrdiff_t)PPITCH + C_MX + hh * 256;
#pragma unroll
      for (int i = 0; i < 5; ++i) { const int idx = tid + 512 * i, row = idx >> 5; v4u x = {0u, 0u, 0u, 0u};
          if (idx < 2144) { if (64 * c - 3 + row >= 0) x = *(const v4u*)(pb + (unsigned)(row * PPITCH + 8 * (idx & 31))); *(LAS v4u*)(lds + ML_KWT + row * 512 + (idx & 31) * 16) = x; } }
      if (tid < 256) { const int ch0 = hh * 256 + tid;
          sc[SC_CW + tid] = mcw[ch0]; sc[SC_CW + 256 + tid] = mcw[1024 + ch0]; sc[SC_CW + 512 + tid] = mcw[2048 + ch0]; sc[SC_CW + 768 + tid] = mcw[3072 + ch0]; sc[SC_CW + 1024 + tid] = mcb[ch0]; }
      if (w == 0) {
          const float ig = sm[(size_t)(r0 + lane) * NSMALL + 16 + hh] + bif[hh];
          const float lf = logsig(sm[(size_t)(r0 + lane) * NSMALL + 20 + hh] + bif[4 + hh]);
          float F = lf;
#pragma unroll
          for (int o = 1; o < 64; o <<= 1) { const float t = __shfl_up(F, o); F += (lane >= o) ? t : 0.f; }
          const float colf = ig - F; float pm = colf;
#pragma unroll
          for (int o = 1; o < 64; o <<= 1) { const float t = __shfl_up(pm, o); pm = (lane >= o) ? fmaxf(pm, t) : pm; }
          sc[IS_F + lane] = F; sc[IS_PM + lane] = pm; sc[SC_COLF + lane] = colf;
          if (lane == 63) { sc[IS_FL] = F; sc[IS_CMAX] = pm; } } }
    float wq4[4], wk4[4], wv4[4];
    { const int wb = (64 * hh + (c_ >> 2)) * 16 + (c_ & 3);
#pragma unroll
      for (int cc = 0; cc < 4; ++cc) { wq4[cc] = A->in[28][(size_t)l * 4096 + wb + 4 * cc]; wk4[cc] = A->in[29][(size_t)l * 4096 + wb + 4 * cc] * 0.0625f; wv4[cc] = A->in[30][(size_t)l * 4096 + wb + 4 * cc]; } }
    __syncthreads();
    { const float cw0 = sc[SC_CW + c_], cw1 = sc[SC_CW + 256 + c_], cw2 = sc[SC_CW + 512 + c_], cw3 = sc[SC_CW + 768 + c_], cbv = sc[SC_CW + 1024 + c_];
      const LAS unsigned char* xp = lds + ML_KWT + (32 * seg) * 512 + c_ * 2;
      float x0 = bf2f(lds_u16(xp)), x1 = bf2f(lds_u16(xp + 512)), x2 = bf2f(lds_u16(xp + 1024));
#pragma unroll 8
      for (int t = 0; t < 32; ++t) {
          const float x3 = bf2f(lds_u16(xp + (3 + t) * 512));
          const float pre = cbv + cw0 * x0 + cw1 * x1 + cw2 * x2 + cw3 * x3, mc = pre * sigm(pre);
          float q = 0.f, k = 0.f, v = 0.f;
#pragma unroll
          for (int cc = 0; cc < 4; ++cc) { const float mcv = quad_bcast(mc, cc), xv = quad_bcast(x3, cc); q += mcv * wq4[cc]; k += mcv * wk4[cc]; v += xv * wv4[cc]; }
          const int j = 32 * seg + t;
          *(LAS unsigned short*)(lds + ML_Q + j * ML_PQ + c_ * 2) = (unsigned short)(pkbf(q, 0.f) & 0xffffu);
          *(LAS unsigned short*)(lds + ML_K + j * ML_PQ + c_ * 2) = (unsigned short)(pkbf(k, 0.f) & 0xffffu);
          *(LAS unsigned short*)(lds + ML_V + j * ML_PQ + c_ * 2) = (unsigned short)(pkbf(v, 0.f) & 0xffffu);
          if (c == TP / 64 - 1 && seg == 1 && t >= 29) A->out[O_P_MLC + (((size_t)l * NP + s) * 3 + (t - 29)) * 1024 + hh * 256 + c_] = x3;
          x0 = x1; x1 = x2; x2 = x3;
      } }
    __syncthreads();
    { const float cmax = sc[IS_CMAX]; float np = 0.f; v4u kk[4];
#pragma unroll
      for (int t8 = 0; t8 < 4; ++t8) { float kw[8];
#pragma unroll
          for (int t = 0; t < 8; ++t) { const int j = 32 * seg + 8 * t8 + t; kw[t] = bf2f(lds_u16(lds + ML_K + j * ML_PQ + c_ * 2)) * __expf(sc[SC_COLF + j] - cmax); np += kw[t]; }
          kk[t8].x = pkbf(kw[0], kw[1]); kk[t8].y = pkbf(kw[2], kw[3]); kk[t8].z = pkbf(kw[4], kw[5]); kk[t8].w = pkbf(kw[6], kw[7]); }
#pragma unroll
      for (int t8 = 0; t8 < 4; ++t8) *(LAS v4u*)(lds + ML_KWT + c_ * ML_PT + seg * 64 + t8 * 16) = kk[t8];
      sc[SC_QN + seg * 256 + c_] = np; }
    if (w < 3) { const int it = (w >= 1) ? 1 : 0, jt = (w == 2) ? 1 : 0; f32x16 a;
#pragma unroll
        for (int i = 0; i < 16; ++i) a[i] = 0.f;
#pragma unroll
        for (int s16 = 0; s16 < 16; ++s16) { a = MFMA32(frag16(lds + ML_Q + (32 * it + r) * ML_PQ + (16 * s16 + 8 * h) * 2), frag16(lds + ML_K + (32 * jt + r) * ML_PQ + (16 * s16 + 8 * h) * 2), a);
            if ((s16 & 3) == 3) asm volatile("" ::: "memory"); }
        const int j = 32 * jt + r; const float cf = sc[SC_COLF + j];
#pragma unroll
        for (int g = 0; g < 4; ++g) { const f32x4 pmv = *(const LAS f32x4*)(sc + IS_PM + 32 * it + 8 * g + 4 * h);
#pragma unroll
            for (int q = 0; q < 4; ++q) { const int i = 32 * it + 8 * g + 4 * h + q; const float val = (j <= i) ? a[4 * g + q] * __expf(cf - pmv[q]) : 0.f;
                *(LAS unsigned short*)(lds + ML_S + i * ML_PT + j * 2) = (unsigned short)(pkbf(val, 0.f) & 0xffffu); } } }
    __syncthreads();
    if (w == 0) { const int i = lane; float rs_ = 0.f;
#pragma unroll
        for (int k8 = 0; k8 < 8; ++k8) { const v4u sw = *(const LAS v4u*)(lds + ML_S + i * ML_PT + k8 * 16);
            const float t8 = (bflo_(sw.x) + bfhi_(sw.x)) + (bflo_(sw.y) + bfhi_(sw.y)) + (bflo_(sw.z) + bfhi_(sw.z)) + (bflo_(sw.w) + bfhi_(sw.w));
            rs_ += (k8 < 4 || i >= 32) ? t8 : 0.f; }
        sc[IS_RSP + i] = rs_; }
    if (tid < 256) sc[IS_NP + tid] = sc[SC_QN + tid] + sc[SC_QN + 256 + tid];
    __syncthreads();
    { unsigned char* img = A->ws + WS_MIMG + (size_t)((s * 4 + hh) * (TP / 64) + c) * MIMG_BYTES;
      for (int idx = tid; idx < MI_PIECES; idx += NTHREADS) *(v4u*)(img + (size_t)idx * 16) = *(const LAS v4u*)(lds + mimg_lds_off(idx)); }
    __syncthreads();
}

DI void ml_img_dma(const unsigned char* img, LAS unsigned char* lds, int ih, int w, int lane) {
    for (int k = w; k < MI_PIECES / 64; k += NWAVES) {
        const bool skip = ih ? (k < 16 || (k >= 102 && k < 106)) : ((k > 16 && k < 33) || (k > 106 && k < 111));
        if (!skip) __builtin_amdgcn_global_load_lds((const unsigned*)(img + (size_t)(64 * k + lane) * 16), (LAS unsigned*)(lds + mimg_lds_off(64 * k)), 16, 0, 0); }
}
#define ML_RAW_BARRIER() asm volatile("s_waitcnt lgkmcnt(0)\n\ts_barrier" ::: "memory")
#define ML_DSR128(dst, addr, off) asm volatile("ds_read_b128 %0, %1 offset:" #off : "=v"(dst) : "v"(addr))
#define ML_DSR2X64(dst, addr, o0, o1) asm volatile("ds_read2_b64 %0, %1 offset0:" #o0 " offset1:" #o1 : "=v"(dst) : "v"(addr))
#define ML_LWAIT(n, x) asm volatile("s_waitcnt lgkmcnt(" #n ")" : "+v"(x))
constexpr int ML_HB = 33792, ML_PHB = 528;
DI void ml_seq_unit(int l, int s, int hh, int ih, LAS unsigned char* lds, int tid) {
    CArgs* A = kargs();
    const bf16* proj = (const bf16*)(A->ws + WS_PROJ); bf16* ycat = (bf16*)(A->ws + WS_YCAT); unsigned char* ycat8 = A->ws + WS_YCAT; (void)ycat; (void)ycat8;
    const float* gn = A->in[32] + (size_t)l * 256;
    const unsigned char* img0 = A->ws + WS_MIMG + (size_t)((s * 4 + hh) * (TP / 64)) * MIMG_BYTES;
    const int w = __builtin_amdgcn_readfirstlane(tid >> 6);
    LAS float* sc = (LAS float*)(lds + ML_SC);
    f32x16 Ct[8];
#pragma unroll
    for (int dt = 0; dt < 8; ++dt)
#pragma unroll
        for (int i = 0; i < 16; ++i) Ct[dt][i] = 0.f;
    if (tid < 256) sc[SC_N + tid] = 0.f;
    float m = 0.f, sg = 1.f;
#ifdef PROBE_ABL
    const int abl = (kargs()->li == 1) ? PROBE_ABL : 0;
#else
    constexpr int abl = 0;
#endif
    __syncthreads();
    ml_img_dma(img0, lds, ih, w, tid & 63);
    for (int c = 0; c < TP / 64; ++c) {
        const int r0 = s * TP + 64 * c;
        if (c == 0) asm volatile("s_waitcnt vmcnt(0)" ::: "memory"); else asm volatile("s_waitcnt vmcnt(4)" ::: "memory");
        ML_RAW_BARRIER();
        { int tz_ = tid; asm volatile("" : "+v"(tz_)); const int i = tz_ & 63; float acc = 0.f;
#pragma unroll
          for (int k8 = 0; k8 < 4; ++k8) { const v4u qw = *(const LAS v4u*)(lds + ML_Q + i * ML_PQ + (32 * w + 8 * k8) * 2);
              const f32x4 n0 = *(const LAS f32x4*)(sc + SC_N + 32 * w + 8 * k8), n1 = *(const LAS f32x4*)(sc + SC_N + 32 * w + 8 * k8 + 4);
              acc += bflo_(qw.x) * n0.x + bfhi_(qw.x) * n0.y + bflo_(qw.y) * n0.z + bfhi_(qw.y) * n0.w + bflo_(qw.z) * n1.x + bfhi_(qw.z) * n1.y + bflo_(qw.w) * n1.z + bfhi_(qw.w) * n1.w; }
          sc[SC_QN + w * 64 + i] = acc;
          if (w == 1) sc[SC_RAT + i] = __expf(fminf(m - sc[IS_PM + i], 60.f)) * sg; }
        const float FL = sc[IS_FL], cmax = sc[IS_CMAX];
        const float cs = __expf(fminf(0.f, m - cmax)), s2 = __expf(fminf(0.f, cmax - m));
        v2u mo[4]; f32x4 gn4;
        { int tm_ = tid; asm volatile("" : "+v"(tm_)); const unsigned lo_ = 4u * (unsigned)(tm_ & 63);
          const bf16* mb_ = proj + (size_t)(r0 + 32 * ih + 4 * w) * PPITCH + C_MO + hh * 256;
#pragma unroll
          for (int q = 0; q < 4; ++q) mo[q] = *(const v2u*)(mb_ + (unsigned)(q * PPITCH) + lo_);
          gn4 = *(const f32x4*)(gn + lo_); }
        ML_RAW_BARRIER();
        f32x16 o0;
        { int tz_ = tid; asm volatile("" : "+v"(tz_)); const int lane = tz_ & 63, r = lane & 31, h = lane >> 5;
        if (w == 0) { const int i = lane; const float pmi = sc[IS_PM + i];
            float qn = 0.f;
#pragma unroll
            for (int p = 0; p < 8; ++p) qn += sc[SC_QN + p * 64 + i];
            const float den = __expf(fminf(0.f, m - pmi)) * qn + __expf(fminf(0.f, pmi - m)) * sc[IS_RSP + i];
            sc[SC_RDEN + i] = __expf(-fminf(fmaxf(m - pmi, 0.f), 60.f)) / fmaxf(fabsf(den), __expf(-(sc[IS_F + i] + fmaxf(m, pmi)))); }
        if (tz_ < 256) sc[SC_N + tz_] = cs * sc[SC_N + tz_] + s2 * sc[IS_NP + tz_];
#pragma unroll
        for (int i = 0; i < 16; ++i) o0[i] = 0.f;
        { const unsigned qa = (unsigned)(__UINTPTR_TYPE__)(lds + ML_Q + (32 * ih + r) * ML_PQ + 8 * h);
          v4u q0, q1, q2, q3;
          ML_DSR2X64(q0, qa, 0, 2);
          ML_DSR2X64(q1, qa, 4, 6);
          ML_DSR2X64(q2, qa, 8, 10);
          ML_DSR2X64(q3, qa, 12, 14);
          { const bf16x8 bfrag = pack_acc(Ct[0], 0); ML_LWAIT(3, q0); o0 = MFMA32(__builtin_bit_cast(bf16x8, q0), bfrag, o0); ML_DSR2X64(q0, qa, 16, 18); }
          { const bf16x8 bfrag = pack_acc(Ct[0], 1); ML_LWAIT(3, q1); o0 = MFMA32(__builtin_bit_cast(bf16x8, q1), bfrag, o0); ML_DSR2X64(q1, qa, 20, 22); }
          { const bf16x8 bfrag = pack_acc(Ct[1], 0); ML_LWAIT(3, q2); o0 = MFMA32(__builtin_bit_cast(bf16x8, q2), bfrag, o0); ML_DSR2X64(q2, qa, 24, 26); }
          { const bf16x8 bfrag = pack_acc(Ct[1], 1); ML_LWAIT(3, q3); o0 = MFMA32(__builtin_bit_cast(bf16x8, q3), bfrag, o0); ML_DSR2X64(q3, qa, 28, 30); }
          { const bf16x8 bfrag = pack_acc(Ct[2], 0); ML_LWAIT(3, q0); o0 = MFMA32(__builtin_bit_cast(bf16x8, q0), bfrag, o0); ML_DSR2X64(q0, qa, 32, 34); }
          { const bf16x8 bfrag = pack_acc(Ct[2], 1); ML_LWAIT(3, q1); o0 = MFMA32(__builtin_bit_cast(bf16x8, q1), bfrag, o0); ML_DSR2X64(q1, qa, 36, 38); }
          { const bf16x8 bfrag = pack_acc(Ct[3], 0); ML_LWAIT(3, q2); o0 = MFMA32(__builtin_bit_cast(bf16x8, q2), bfrag, o0); ML_DSR2X64(q2, qa, 40, 42); }
          { const bf16x8 bfrag = pack_acc(Ct[3], 1); ML_LWAIT(3, q3); o0 = MFMA32(__builtin_bit_cast(bf16x8, q3), bfrag, o0); ML_DSR2X64(q3, qa, 44, 46); }
          { const bf16x8 bfrag = pack_acc(Ct[4], 0); ML_LWAIT(3, q0); o0 = MFMA32(__builtin_bit_cast(bf16x8, q0), bfrag, o0); ML_DSR2X64(q0, qa, 48, 50); }
          { const bf16x8 bfrag = pack_acc(Ct[4], 1); ML_LWAIT(3, q1); o0 = MFMA32(__builtin_bit_cast(bf16x8, q1), bfrag, o0); ML_DSR2X64(q1, qa, 52, 54); }
          { const bf16x8 bfrag = pack_acc(Ct[5], 0); ML_LWAIT(3, q2); o0 = MFMA32(__builtin_bit_cast(bf16x8, q2), bfrag, o0); ML_DSR2X64(q2, qa, 56, 58); }
          { const bf16x8 bfrag = pack_acc(Ct[5], 1); ML_LWAIT(3, q3); o0 = MFMA32(__builtin_bit_cast(bf16x8, q3), bfrag, o0); ML_DSR2X64(q3, qa, 60, 62); }
          { const bf16x8 bfrag = pack_acc(Ct[6], 0); ML_LWAIT(3, q0); o0 = MFMA32(__builtin_bit_cast(bf16x8, q0), bfrag, o0); }
          { const bf16x8 bfrag = pack_acc(Ct[6], 1); ML_LWAIT(2, q1); o0 = MFMA32(__builtin_bit_cast(bf16x8, q1), bfrag, o0); }
          { const bf16x8 bfrag = pack_acc(Ct[7], 0); ML_LWAIT(1, q2); o0 = MFMA32(__builtin_bit_cast(bf16x8, q2), bfrag, o0); }
          { const bf16x8 bfrag = pack_acc(Ct[7], 1); ML_LWAIT(0, q3); o0 = MFMA32(__builtin_bit_cast(bf16x8, q3), bfrag, o0); }
        }
#pragma unroll
        for (int g = 0; g < 4; ++g) { const f32x4 p0 = *(const LAS f32x4*)(sc + SC_RAT + 32 * ih + 8 * g + 4 * h);
#pragma unroll
            for (int q = 0; q < 4; ++q) o0[4 * g + q] *= p0[q]; }
        sg *= cs;
        if (sg < 1e-12f) {
#pragma unroll
            for (int dt = 0; dt < 8; ++dt)
#pragma unroll
                for (int i = 0; i < 16; ++i) Ct[dt][i] *= sg;
            sg = 1.f; }
        const float vsc = s2 * __builtin_amdgcn_rcpf(sg);
        { const LAS unsigned char* vp = lds + ML_V + (8 * h) * ML_PQ + (32 * w + r) * 2;
          const unsigned ka = (unsigned)(__UINTPTR_TYPE__)(lds + ML_KWT + r * ML_PT + 16 * h);
          const LAS unsigned char* pp = lds + ML_S + (32 * ih + r) * ML_PT + 16 * h;
          v4u k0, k1, k2, k3;
          ML_DSR128(k0, ka, 0);
          ML_DSR128(k1, ka, 4608);
          ML_DSR128(k2, ka, 9216);
          ML_DSR128(k3, ka, 13824);
          { float vv[8];
#pragma unroll
            for (int jj = 0; jj < 8; ++jj) vv[jj] = bf2f(lds_u16(vp + (0 + jj) * ML_PQ));
            const v4u xu = {pkbf(vv[0], vv[1]), pkbf(vv[2], vv[3]), pkbf(vv[4], vv[5]), pkbf(vv[6], vv[7])};
            const v4u xs = {pkbf(vv[0] * vsc, vv[1] * vsc), pkbf(vv[2] * vsc, vv[3] * vsc), pkbf(vv[4] * vsc, vv[5] * vsc), pkbf(vv[6] * vsc, vv[7] * vsc)};
            const bf16x8 vf = __builtin_bit_cast(bf16x8, xu), vfs = __builtin_bit_cast(bf16x8, xs);
            o0 = MFMA32(frag16(pp + 0), vf, o0);
            ML_LWAIT(3, k0); Ct[0] = MFMA32(__builtin_bit_cast(bf16x8, k0), vfs, Ct[0]); ML_DSR128(k0, ka, 18432);
            ML_LWAIT(3, k1); Ct[1] = MFMA32(__builtin_bit_cast(bf16x8, k1), vfs, Ct[1]); ML_DSR128(k1, ka, 23040);
            ML_LWAIT(3, k2); Ct[2] = MFMA32(__builtin_bit_cast(bf16x8, k2), vfs, Ct[2]); ML_DSR128(k2, ka, 27648);
            ML_LWAIT(3, k3); Ct[3] = MFMA32(__builtin_bit_cast(bf16x8, k3), vfs, Ct[3]); ML_DSR128(k3, ka, 32256);
            ML_LWAIT(3, k0); Ct[4] = MFMA32(__builtin_bit_cast(bf16x8, k0), vfs, Ct[4]); ML_DSR128(k0, ka, 32);
            ML_LWAIT(3, k1); Ct[5] = MFMA32(__builtin_bit_cast(bf16x8, k1), vfs, Ct[5]); ML_DSR128(k1, ka, 4640);
            ML_LWAIT(3, k2); Ct[6] = MFMA32(__builtin_bit_cast(bf16x8, k2), vfs, Ct[6]); ML_DSR128(k2, ka, 9248);
            ML_LWAIT(3, k3); Ct[7] = MFMA32(__builtin_bit_cast(bf16x8, k3), vfs, Ct[7]); ML_DSR128(k3, ka, 13856);
          }
          { float vv[8];
#pragma unroll
            for (int jj = 0; jj < 8; ++jj) vv[jj] = bf2f(lds_u16(vp + (16 + jj) * ML_PQ));
            const v4u xu = {pkbf(vv[0], vv[1]), pkbf(vv[2], vv[3]), pkbf(vv[4], vv[5]), pkbf(vv[6], vv[7])};
            const v4u xs = {pkbf(vv[0] * vsc, vv[1] * vsc), pkbf(vv[2] * vsc, vv[3] * vsc), pkbf(vv[4] * vsc, vv[5] * vsc), pkbf(vv[6] * vsc, vv[7] * vsc)};
            const bf16x8 vf = __builtin_bit_cast(bf16x8, xu), vfs = __builtin_bit_cast(bf16x8, xs);
            o0 = MFMA32(frag16(pp + 32), vf, o0);
            ML_LWAIT(3, k0); Ct[0] = MFMA32(__builtin_bit_cast(bf16x8, k0), vfs, Ct[0]); ML_DSR128(k0, ka, 18464);
            ML_LWAIT(3, k1); Ct[1] = MFMA32(__builtin_bit_cast(bf16x8, k1), vfs, Ct[1]); ML_DSR128(k1, ka, 23072);
            ML_LWAIT(3, k2); Ct[2] = MFMA32(__builtin_bit_cast(bf16x8, k2), vfs, Ct[2]); ML_DSR128(k2, ka, 27680);
            ML_LWAIT(3, k3); Ct[3] = MFMA32(__builtin_bit_cast(bf16x8, k3), vfs, Ct[3]); ML_DSR128(k3, ka, 32288);
            ML_LWAIT(3, k0); Ct[4] = MFMA32(__builtin_bit_cast(bf16x8, k0), vfs, Ct[4]); ML_DSR128(k0, ka, 64);
            ML_LWAIT(3, k1); Ct[5] = MFMA32(__builtin_bit_cast(bf16x8, k1), vfs, Ct[5]); ML_DSR128(k1, ka, 4672);
            ML_LWAIT(3, k2); Ct[6] = MFMA32(__builtin_bit_cast(bf16x8, k2), vfs, Ct[6]); ML_DSR128(k2, ka, 9280);
            ML_LWAIT(3, k3); Ct[7] = MFMA32(__builtin_bit_cast(bf16x8, k3), vfs, Ct[7]); ML_DSR128(k3, ka, 13888);
          }
          { float vv[8];
#pragma unroll
            for (int jj = 0; jj < 8; ++jj) vv[jj] = bf2f(lds_u16(vp + (32 + jj) * ML_PQ));
            const v4u xu = {pkbf(vv[0], vv[1]), pkbf(vv[2], vv[3]), pkbf(vv[4], vv[5]), pkbf(vv[6], vv[7])};
            const v4u xs = {pkbf(vv[0] * vsc, vv[1] * vsc), pkbf(vv[2] * vsc, vv[3] * vsc), pkbf(vv[4] * vsc, vv[5] * vsc), pkbf(vv[6] * vsc, vv[7] * vsc)};
            const bf16x8 vf = __builtin_bit_cast(bf16x8, xu), vfs = __builtin_bit_cast(bf16x8, xs);
            if (ih == 1) o0 = MFMA32(frag16(pp + 64), vf, o0);
            ML_LWAIT(3, k0); Ct[0] = MFMA32(__builtin_bit_cast(bf16x8, k0), vfs, Ct[0]); ML_DSR128(k0, ka, 18496);
            ML_LWAIT(3, k1); Ct[1] = MFMA32(__builtin_bit_cast(bf16x8, k1), vfs, Ct[1]); ML_DSR128(k1, ka, 23104);
            ML_LWAIT(3, k2); Ct[2] = MFMA32(__builtin_bit_cast(bf16x8, k2), vfs, Ct[2]); ML_DSR128(k2, ka, 27712);
            ML_LWAIT(3, k3); Ct[3] = MFMA32(__builtin_bit_cast(bf16x8, k3), vfs, Ct[3]); ML_DSR128(k3, ka, 32320);
            ML_LWAIT(3, k0); Ct[4] = MFMA32(__builtin_bit_cast(bf16x8, k0), vfs, Ct[4]); ML_DSR128(k0, ka, 96);
            ML_LWAIT(3, k1); Ct[5] = MFMA32(__builtin_bit_cast(bf16x8, k1), vfs, Ct[5]); ML_DSR128(k1, ka, 4704);
            ML_LWAIT(3, k2); Ct[6] = MFMA32(__builtin_bit_cast(bf16x8, k2), vfs, Ct[6]); ML_DSR128(k2, ka, 9312);
            ML_LWAIT(3, k3); Ct[7] = MFMA32(__builtin_bit_cast(bf16x8, k3), vfs, Ct[7]); ML_DSR128(k3, ka, 13920);
          }
          { float vv[8];
#pragma unroll
            for (int jj = 0; jj < 8; ++jj) vv[jj] = bf2f(lds_u16(vp + (48 + jj) * ML_PQ));
            const v4u xu = {pkbf(vv[0], vv[1]), pkbf(vv[2], vv[3]), pkbf(vv[4], vv[5]), pkbf(vv[6], vv[7])};
            const v4u xs = {pkbf(vv[0] * vsc, vv[1] * vsc), pkbf(vv[2] * vsc, vv[3] * vsc), pkbf(vv[4] * vsc, vv[5] * vsc), pkbf(vv[6] * vsc, vv[7] * vsc)};
            const bf16x8 vf = __builtin_bit_cast(bf16x8, xu), vfs = __builtin_bit_cast(bf16x8, xs);
            if (ih == 1) o0 = MFMA32(frag16(pp + 96), vf, o0);
            ML_LWAIT(3, k0); Ct[0] = MFMA32(__builtin_bit_cast(bf16x8, k0), vfs, Ct[0]); ML_DSR128(k0, ka, 18528);
            ML_LWAIT(3, k1); Ct[1] = MFMA32(__builtin_bit_cast(bf16x8, k1), vfs, Ct[1]); ML_DSR128(k1, ka, 23136);
            ML_LWAIT(3, k2); Ct[2] = MFMA32(__builtin_bit_cast(bf16x8, k2), vfs, Ct[2]); ML_DSR128(k2, ka, 27744);
            ML_LWAIT(3, k3); Ct[3] = MFMA32(__builtin_bit_cast(bf16x8, k3), vfs, Ct[3]); ML_DSR128(k3, ka, 32352);
            ML_LWAIT(3, k0); Ct[4] = MFMA32(__builtin_bit_cast(bf16x8, k0), vfs, Ct[4]);
            ML_LWAIT(2, k1); Ct[5] = MFMA32(__builtin_bit_cast(bf16x8, k1), vfs, Ct[5]);
            ML_LWAIT(1, k2); Ct[6] = MFMA32(__builtin_bit_cast(bf16x8, k2), vfs, Ct[6]);
            ML_LWAIT(0, k3); Ct[7] = MFMA32(__builtin_bit_cast(bf16x8, k3), vfs, Ct[7]);
          }
          asm volatile("" ::: "memory"); }
        }
        m = FL + fmaxf(m, cmax);
        ML_RAW_BARRIER();
        { int tz_ = tid; asm volatile("" : "+v"(tz_)); const int lane = tz_ & 63, r = lane & 31, h = lane >> 5;
#pragma unroll
        for (int g = 0; g < 4; ++g) { const f32x4 d0 = *(const LAS f32x4*)(sc + SC_RDEN + 32 * ih + 8 * g + 4 * h);
#pragma unroll
            for (int q = 0; q < 4; ++q) { const int i = 8 * g + 4 * h + q;
                *(LAS unsigned short*)(lds + ML_HB + i * ML_PHB + (32 * w + r) * 2) = (unsigned short)(pkbf(o0[4 * g + q] * d0[q], 0.f) & 0xffffu); } }
        }
        float og[4][4];
#pragma unroll
        for (int q = 0; q < 4; ++q) { const v2u ow = mo[q];
            og[q][0] = sigm(__uint_as_float(ow.x << 16)) * gn4.x; og[q][1] = sigm(__uint_as_float(ow.x & 0xffff0000u)) * gn4.y;
            og[q][2] = sigm(__uint_as_float(ow.y << 16)) * gn4.z; og[q][3] = sigm(__uint_as_float(ow.y & 0xffff0000u)) * gn4.w; }
#pragma unroll
        for (int q = 0; q < 4; ++q) asm volatile("" : "+v"(og[q][0]), "+v"(og[q][1]), "+v"(og[q][2]), "+v"(og[q][3]));
        if (c + 1 < TP / 64 && !(abl & 1)) ml_img_dma(img0 + (size_t)(c + 1) * MIMG_BYTES, lds, ih, w, tid & 63);
        ML_RAW_BARRIER();
        { int tz_ = tid; asm volatile("" : "+v"(tz_)); const int lane = tz_ & 63;
#pragma unroll
        for (int q = 0; q < 4; ++q) { const int i = 4 * w + q; const size_t row = (size_t)(r0 + 32 * ih + i);
            const v2u hw = *(const LAS v2u*)(lds + ML_HB + i * ML_PHB + lane * 8);
            const float h0 = bflo_(hw.x), h1 = bfhi_(hw.x), h2 = bflo_(hw.y), h3 = bfhi_(hw.y);
            float ss = (h0 * h0 + h1 * h1) + (h2 * h2 + h3 * h3); ss = wave_sum(ss);
            const float rs = __builtin_amdgcn_rsqf(ss * (1.f / 256.f) + EPS);
                        *(unsigned*)(ycat8 + row * KBR + 2048 + hh * 256 + 4 * lane) = pg8::pk4_fp8(og[q][0] * (h0 * rs), og[q][1] * (h1 * rs), og[q][2] * (h2 * rs), og[q][3] * (h3 * rs)); }
        }
        ML_RAW_BARRIER();
    }
    { int tz_ = tid; asm volatile("" : "+v"(tz_)); const int lane = tz_ & 63, r = lane & 31, h = lane >> 5;
      const size_t bh = ((size_t)l * NP + s) * 4 + hh; float* cp = A->out + O_P_C + bh * 256 * 256 + 32 * w + r;
      if (ih == 0) {
#pragma unroll
      for (int dt = 0; dt < 8; ++dt)
#pragma unroll
          for (int reg = 0; reg < 16; ++reg) cp[(size_t)(32 * dt + (reg & 3) + 8 * (reg >> 2) + 4 * h) * 256] = Ct[dt][reg] * sg;
      if (tz_ < 256) A->out[O_P_N + bh * 256 + tz_] = sc[SC_N + tz_];
      if (tz_ == 0) A->out[O_P_M + bh] = m; } }
    __syncthreads();
}

constexpr int LR_WA = 0, LR_WX = 34816, LR_U = 69632, LR_UF = 87040, LR_AF = 119808, LR_SEG = 152576, LR_HC = 156672, LR_P = 272;
static_assert(LR_HC + 1024 <= LDSCTL_OFF, "LRU LDS map");
DI void lru_chunk_unit(int l, int s, int n, int dh, LAS unsigned char* lds, int tid) {
    CArgs* A = kargs();
    const bf16* proj = (const bf16*)(A->ws + WS_PROJ); unsigned char* ycat8 = A->ws + WS_YCAT;
    const float* cw = A->in[16] + (size_t)l * 4 * 1024 + n * 128; const float* cb = A->in[17] + (size_t)l * 1024 + n * 128;
    const float* wa = A->in[18] + ((size_t)l * 8 + n) * 128 * 128; const float* ba = A->in[19] + (size_t)l * 1024 + n * 128;
    const float* wx = A->in[20] + ((size_t)l * 8 + n) * 128 * 128; const float* bx = A->in[21] + (size_t)l * 1024 + n * 128;
    const float* lam = A->in[22] + (size_t)l * 1024 + n * 128;
    const int w = __builtin_amdgcn_readfirstlane(tid >> 6), seg = __builtin_amdgcn_readfirstlane(tid >> 7);
    for (int idx = tid; idx < 64 * 128; idx += NTHREADS) { const int c = idx >> 6, d = idx & 63;
        *(LAS unsigned short*)(lds + LR_WA + d * LR_P + c * 2) = (unsigned short)(pkbf(wa[c * 128 + 64 * dh + d], 0.f) & 0xffffu);
        *(LAS unsigned short*)(lds + LR_WX + d * LR_P + c * 2) = (unsigned short)(pkbf(wx[c * 128 + 64 * dh + d], 0.f) & 0xffffu); }
    if (tid < 256) *(LAS float*)(lds + LR_HC + tid * 4) = 0.f;
    const float w0 = cw[tid & 127], w1 = cw[1024 + (tid & 127)], w2 = cw[2048 + (tid & 127)], w3 = cw[3072 + (tid & 127)], bb = cb[tid & 127];
    const int dcol = 64 * dh + 32 * (w & 1) + (tid & 31);
    const float bav = ba[dcol], bxv = bx[dcol], ls = logsig(lam[dcol]);
    v4u pf[3];
#define LRU_PREFETCH(tn) do { int tp_ = tid; asm volatile("" : "+v"(tp_)); const bf16* pb_ = proj + ((ptrdiff_t)(s * TP + 64 * (tn)) - 3) * (ptrdiff_t)PPITCH + C_LRUX + n * 128; \
        _Pragma("unroll") for (int i_ = 0; i_ < 3; ++i_) { const int idx_ = tp_ + 512 * i_, row_ = idx_ >> 4; pf[i_] = (v4u){0u, 0u, 0u, 0u}; \
            if (idx_ < 1072 && 64 * (tn) - 3 + row_ >= 0) pf[i_] = *(const v4u*)(pb_ + (unsigned)(row_ * PPITCH + 8 * (idx_ & 15))); } } while (0)
    LRU_PREFETCH(0);
    __syncthreads();
    for (int tile = 0; tile < TP / 64; ++tile) {
        const int r0 = s * TP + 64 * tile;
        { int tz_ = tid; asm volatile("" : "+v"(tz_));
#pragma unroll
          for (int i = 0; i < 3; ++i) { const int idx = tz_ + 512 * i; if (idx < 1072) *(LAS v4u*)(lds + LR_AF + idx * 16) = pf[i]; } }
        WG_RAW_BARRIER();
        { int tz_ = tid; asm volatile("" : "+v"(tz_)); const int c = tz_ & 127;
          const LAS unsigned char* xp = lds + LR_AF + (16 * seg) * 256 + c * 2;
          float x0 = bf2f(lds_u16(xp)), x1 = bf2f(lds_u16(xp + 256)), x2 = bf2f(lds_u16(xp + 512));
#pragma unroll 8
          for (int t = 0; t < 16; ++t) { const float x3 = bf2f(lds_u16(xp + (3 + t) * 256)); const int j = 16 * seg + t;
              const float u = bb + w0 * x0 + w1 * x1 + w2 * x2 + w3 * x3;
              *(LAS unsigned short*)(lds + LR_U + j * LR_P + c * 2) = (unsigned short)(pkbf(u, 0.f) & 0xffffu);
              *(LAS float*)(lds + LR_UF + (j * 128 + c) * 4) = u;
              if (tile == TP / 64 - 1 && seg == 3 && t >= 13 && (c >> 6) == dh) A->out[O_P_LRUC + (((size_t)l * NP + s) * 3 + (t - 13)) * 1024 + n * 128 + c] = x3;
              x0 = x1; x1 = x2; x2 = x3; } }
        if (tile + 1 < TP / 64) LRU_PREFETCH(tile + 1);
        WG_RAW_BARRIER();
        if (w < 4) { int tz_ = tid; asm volatile("" : "+v"(tz_)); const int lane = tz_ & 63, r = lane & 31, h = lane >> 5;
          const int it = w >> 1, dtile = w & 1, dl = 32 * dtile + r, d = 64 * dh + dl;
          f32x16 ga, gx;
#pragma unroll
          for (int i = 0; i < 16; ++i) { ga[i] = 0.f; gx[i] = 0.f; }
#pragma unroll
          for (int s8 = 0; s8 < 8; ++s8) { const bf16x8 af = frag16(lds + LR_U + (32 * it + r) * LR_P + (16 * s8 + 8 * h) * 2);
              ga = MFMA32(af, frag16(lds + LR_WA + dl * LR_P + (16 * s8 + 8 * h) * 2), ga);
              gx = MFMA32(af, frag16(lds + LR_WX + dl * LR_P + (16 * s8 + 8 * h) * 2), gx); }
          float uu[16];
#pragma unroll
          for (int reg = 0; reg < 16; ++reg) { const int i = 32 * it + (reg & 3) + 8 * (reg >> 2) + 4 * h; uu[reg] = *(const LAS float*)(lds + LR_UF + (i * 128 + d) * 4); }
          asm volatile("" ::: "memory");
#pragma unroll
          for (int reg = 0; reg < 16; ++reg) { const int i = 32 * it + (reg & 3) + 8 * (reg >> 2) + 4 * h;
              const float rr = sigm(ga[reg] + bav), ii = sigm(gx[reg] + bxv), la = 8.f * rr * ls;
              LAS float* up = (LAS float*)(lds + LR_UF + (i * 128 + d) * 4);
              const float u = uu[reg];
              *(LAS float*)(lds + LR_AF + (i * 128 + d) * 4) = __expf(la);
              *up = lru_in_scale(la) * (ii * u); } }
        WG_RAW_BARRIER();
        float la_[8], lv_[8];
        { int tz_ = tid; asm volatile("" : "+v"(tz_)); const int dl = tz_ & 63, d = 64 * dh + dl;
          float Ap = 1.f, H = 0.f;
#pragma unroll
          for (int t = 0; t < 8; ++t) { const int i = 8 * w + t; la_[t] = *(const LAS float*)(lds + LR_AF + (i * 128 + d) * 4); lv_[t] = *(const LAS float*)(lds + LR_UF + (i * 128 + d) * 4); }
          asm volatile("" ::: "memory");
#pragma unroll
          for (int t = 0; t < 8; ++t) { H = la_[t] * H + lv_[t]; Ap *= la_[t]; }
          *(LAS float*)(lds + LR_SEG + (w * 64 + dl) * 4) = Ap; *(LAS float*)(lds + LR_SEG + 2048 + (w * 64 + dl) * 4) = H; }
        WG_RAW_BARRIER();
        { int tz_ = tid; asm volatile("" : "+v"(tz_)); const int dl = tz_ & 63;
          float hcur = *(const LAS float*)(lds + LR_HC + ((tile & 1) * 128 + dl) * 4);
          float pa_[7], ph_[7];
#pragma unroll
          for (int s2 = 0; s2 < 7; ++s2) { pa_[s2] = *(const LAS float*)(lds + LR_SEG + (s2 * 64 + dl) * 4); ph_[s2] = *(const LAS float*)(lds + LR_SEG + 2048 + (s2 * 64 + dl) * 4); }
          asm volatile("" ::: "memory");
#pragma unroll
          for (int s2 = 0; s2 < 7; ++s2) if (s2 < w) hcur = pa_[s2] * hcur + ph_[s2];
          unsigned char* yp = ycat8 + (size_t)(r0 + 8 * w) * KBR + n * 128 + 64 * dh + dl;
#pragma unroll
          for (int t = 0; t < 8; ++t) { hcur = la_[t] * hcur + lv_[t]; yp[(size_t)t * KBR] = (unsigned char)(pg8::pk4_fp8(hcur, 0.f, 0.f, 0.f) & 0xffu); }
          if (w == 7) { *(LAS float*)(lds + LR_HC + (((tile + 1) & 1) * 128 + dl) * 4) = hcur;
              if (tile == TP / 64 - 1) A->out[O_P_LRUH + ((size_t)l * NP + s) * 1024 + n * 128 + 64 * dh + dl] = hcur; } }
        WG_RAW_BARRIER();
    }
}

DI void lru_samp_unit(int l, int g, int n, LAS unsigned char* lds, int tid) {
    CArgs* A = kargs();
    const bf16* proj = (const bf16*)(A->ws + WS_PROJ); unsigned char* ycat8 = A->ws + WS_YCAT;
    const float* cw = A->in[16] + (size_t)l * 4 * 1024 + n * 128; const float* cb = A->in[17] + (size_t)l * 1024 + n * 128;
    const float* wa = A->in[18] + ((size_t)l * 8 + n) * 128 * 128; const float* ba = A->in[19] + (size_t)l * 1024 + n * 128;
    const float* wx = A->in[20] + ((size_t)l * 8 + n) * 128 * 128; const float* bx = A->in[21] + (size_t)l * 1024 + n * 128;
    const float* lam = A->in[22] + (size_t)l * 1024 + n * 128;
    const int w = __builtin_amdgcn_readfirstlane(tid >> 6), seg = __builtin_amdgcn_readfirstlane(tid >> 7);
    const int c = tid & 127, ch = n * 128 + c;
    float xs[4][7];
#pragma unroll
    for (int q = 0; q < 4; ++q) { const int b = 16 * g + 4 * seg + q;
#pragma unroll
        for (int j = 0; j < 3; ++j) xs[q][j] = A->in[5][(((size_t)l * NS + b) * 3 + j) * 1024 + ch];
#pragma unroll
        for (int t = 0; t < 4; ++t) xs[q][3 + t] = bf2f(proj[(size_t)(MP + b * TS + t) * PPITCH + C_LRUX + ch]); }
    const float w0 = cw[c], w1 = cw[1024 + c], w2 = cw[2048 + c], w3 = cw[3072 + c], bb = cb[c];
    const int dcol = 32 * (w & 3) + (tid & 31);
    const float bav = ba[dcol], bxv = bx[dcol], ls = logsig(lam[dcol]);
    float h0[4];
#pragma unroll
    for (int q = 0; q < 4; ++q) h0[q] = A->in[4][((size_t)l * NS + 16 * g + 4 * seg + q) * 1024 + ch];
    for (int idx = tid; idx < 128 * 128; idx += NTHREADS) { const int c2 = idx >> 7, d = idx & 127;
        *(LAS unsigned short*)(lds + LR_WA + d * LR_P + c2 * 2) = (unsigned short)(pkbf(wa[idx], 0.f) & 0xffffu);
        *(LAS unsigned short*)(lds + LR_WX + d * LR_P + c2 * 2) = (unsigned short)(pkbf(wx[idx], 0.f) & 0xffffu); }
#pragma unroll
    for (int q = 0; q < 4; ++q) { const int b = 16 * g + 4 * seg + q;
#pragma unroll
        for (int t = 0; t < 4; ++t) { const int j = 16 * seg + 4 * q + t; const float u = bb + w0 * xs[q][t] + w1 * xs[q][t + 1] + w2 * xs[q][t + 2] + w3 * xs[q][t + 3];
            *(LAS unsigned short*)(lds + LR_U + j * LR_P + c * 2) = (unsigned short)(pkbf(u, 0.f) & 0xffffu);
            *(LAS float*)(lds + LR_UF + (j * 128 + c) * 4) = u; }
#pragma unroll
        for (int j = 0; j < 3; ++j) A->out[O_S_LRUC + (((size_t)l * NS + b) * 3 + j) * 1024 + ch] = xs[q][4 + j]; }
    __syncthreads();
    { const int lane = tid & 63, r = lane & 31, h = lane >> 5, it = w >> 2, dtile = w & 3, d = 32 * dtile + r;
      f32x16 ga, gx;
#pragma unroll
      for (int i = 0; i < 16; ++i) { ga[i] = 0.f; gx[i] = 0.f; }
#pragma unroll
      for (int s8 = 0; s8 < 8; ++s8) { const bf16x8 af = frag16(lds + LR_U + (32 * it + r) * LR_P + (16 * s8 + 8 * h) * 2);
          ga = MFMA32(af, frag16(lds + LR_WA + d * LR_P + (16 * s8 + 8 * h) * 2), ga);
          gx = MFMA32(af, frag16(lds + LR_WX + d * LR_P + (16 * s8 + 8 * h) * 2), gx); }
#pragma unroll
      for (int reg = 0; reg < 16; ++reg) { const int i = 32 * it + (reg & 3) + 8 * (reg >> 2) + 4 * h;
          const float rr = sigm(ga[reg] + bav), ii = sigm(gx[reg] + bxv), la = 8.f * rr * ls;
          LAS float* up = (LAS float*)(lds + LR_UF + (i * 128 + d) * 4);
          const float u = *up;
          *(LAS float*)(lds + LR_AF + (i * 128 + d) * 4) = __expf(la);
          *up = lru_in_scale(la) * (ii * u); } }
    __syncthreads();
#pragma unroll
    for (int q = 0; q < 4; ++q) { const int b = 16 * g + 4 * seg + q; float hc = h0[q];
#pragma unroll
        for (int t = 0; t < 4; ++t) { const int j = 16 * seg + 4 * q + t;
            hc = *(const LAS float*)(lds + LR_AF + (j * 128 + c) * 4) * hc + *(const LAS float*)(lds + LR_UF + (j * 128 + c) * 4);
            ycat8[(size_t)(MP + b * TS + t) * KBR + ch] = (unsigned char)(pg8::pk4_fp8(hc, 0.f, 0.f, 0.f) & 0xffu); }
        A->out[O_S_LRUH + ((size_t)l * NS + b) * 1024 + ch] = hc; }
    __syncthreads();
}

#ifndef EN_PRO
#define EN_PRO 1
#endif
#ifndef EN_MOD
#define EN_MOD 1
#endif
#ifndef EN_NORM
#define EN_NORM 1
#endif
#ifndef EN_PROJ
#define EN_PROJ 1
#endif
#ifndef EN_MIX
#define EN_MIX 1
#endif
#ifndef EN_MERGE
#define EN_MERGE 1
#endif
#ifndef EN_OUT
#define EN_OUT 1
#endif
#ifndef EN_FF1
#define EN_FF1 1
#endif
#ifndef EN_FF2
#define EN_FF2 1
#endif
#ifndef EN_ML
#define EN_ML 1
#endif
#ifndef EN_GLA
#define EN_GLA 1
#endif
#ifndef EN_LRU
#define EN_LRU 1
#endif
#ifndef REP_MIXP
#define REP_MIXP 1
#endif
#ifndef REP_ML
#define REP_ML 1
#endif
#ifndef REP_GLA
#define REP_GLA 1
#endif
#ifndef REP_LRU
#define REP_LRU 1
#endif
#ifndef REP_MIXS
#define REP_MIXS 1
#endif
#ifndef REP_GEMM
#define REP_GEMM 1
#endif
#ifndef REP_PROJ
#define REP_PROJ REP_GEMM
#endif
#ifndef REP_MERGE
#define REP_MERGE REP_GEMM
#endif
#ifndef REP_OUT
#define REP_OUT REP_GEMM
#endif
#ifndef REP_FF1
#define REP_FF1 REP_GEMM
#endif
#ifndef REP_FF2
#define REP_FF2 REP_GEMM
#endif
#ifndef REP_PRO
#define REP_PRO 1
#endif
#ifndef REP_MIX
#define REP_MIX 1
#endif
#ifndef REP_NORM
#define REP_NORM 1
#endif
#define WSP(T, off) ((T*)(ws + (off)))

DI void conv_win(CArgs* A, unsigned char* ws, int l, LAS float* scr, int gw, int ngw, int lane, int gtid, int gthreads, int what = 3) {
    const float* w_in = A->in[15] + (size_t)l * D * DIN; bf16* wt_in = WSP(bf16, WS_WIN) + (size_t)l * NPROJ_PAD * D;
    if (what & 1) transpose_job(w_in, DIN, D, 3072, wt_in, D, scr, gw, ngw, lane);
    if (!(what & 2)) return;
    unsigned char* wt8 = ws + (WS_WIN8_0 + (size_t)l * (WS_WIN8_1 - WS_WIN8_0));
    transpose_job_f8(w_in + 3088, DIN, D, 1024, wt8 + (size_t)3072 * D, D, 64.f, scr, gw, ngw, lane);
    transpose_job(w_in + 3088 + 1024, DIN, D, 1024, wt_in + (size_t)4096 * D, D, scr, gw, ngw, lane);
    transpose_job_f8(w_in + 3088 + 2048, DIN, D, 1024, wt8 + (size_t)5120 * D, D, 64.f, scr, gw, ngw, lane);
    transpose_job_f8(w_in + 6168, DIN, D, 6144, wt8 + (size_t)6144 * D, D, 64.f, scr, gw, ngw, lane);
    for (int i = gtid; i < 256 * D; i += gthreads) { const int j = i >> 11, k = i & 2047;
        const float v = j < 24 ? w_in[(size_t)k * DIN + (j < 16 ? 3072 + j : 6160 + (j - 16))] : 0.f;
        wt_in[(size_t)(NPROJ + j) * D + k] = (bf16)f2bf(v); }
}
DI void conv_rest(CArgs* A, unsigned char* ws, int l, LAS float* scr, int gw, int ngw, int lane, bool with_ff2, bool with_br = true) {
    if (with_br) {
    unsigned char* wt_br = ws + WS_WBR + (size_t)l * D * KBR;
    transpose_job_f8(A->in[33] + (size_t)l * 1024 * D, D, 1024, D, wt_br, KBR, 64.f, scr, gw, ngw, lane);
    transpose_job_f8(A->in[34] + (size_t)l * 1024 * D, D, 1024, D, wt_br + 1024, KBR, 64.f, scr, gw, ngw, lane);
    transpose_job_f8(A->in[35] + (size_t)l * 1024 * D, D, 1024, D, wt_br + 2048, KBR, 64.f, scr, gw, ngw, lane);
    transpose_job_f8(A->in[36] + (size_t)l * D * D, D, D, D, ws + WS_WOUT + (size_t)l * D * D, D, 64.f, scr, gw, ngw, lane); }
    if (with_ff2) { const float* src = A->in[37] + (size_t)l * D * DFF; unsigned char* dst = ws + WS_WFF1 + (size_t)l * DFF * D;
      for (int it = gw; it < (D / 64) * (DFF / 32); it += ngw) transpose_item_f8(src, DFF, DFF, dst, D, 64.f, scr, it, lane); }
    if (with_ff2) { const float* src = A->in[38] + (size_t)l * DFF * D; unsigned char* dst = ws + WS_WFF2 + (size_t)l * D * DFF;
      for (int it = gw; it < (DFF / 64) * (D / 32); it += ngw) transpose_item_f8(src, D, D, dst, DFF, 64.f, scr, it, lane); }
}
__global__ void __launch_bounds__(NTHREADS, 2) mk_fwd(Args a_unused) {
    extern __shared__ __attribute__((aligned(16))) unsigned char lds_raw[];
    LAS unsigned char* lds = (LAS unsigned char*)lds_raw;
    const int bid = blockIdx.x;
    constexpr int G = GRID, ngw = GRID * NWAVES;
#define TIDS() int tid_ = threadIdx.x; asm volatile("" : "+v"(tid_)); const int tid = tid_, lane = tid & 63, wave = __builtin_amdgcn_readfirstlane(tid >> 6), gw = bid * NWAVES + wave; (void)lane; (void)gw
    for (int u = threadIdx.x; u < (LDS_BYTES - LDSCTL_OFF) / 4; u += NTHREADS) ((LAS unsigned*)(lds + LDSCTL_OFF))[u] = 0u;
    __syncthreads();
    int lo, hi;
    { CArgs* A = kargs(); lo = A->ph_lo; hi = A->ph_hi;
      (void)xcd_barrier_post((unsigned*)(A->ws + WS_CTL) + CW_BAR + A->li * XCD_BAR_WORDS, (volatile LAS unsigned*)(lds + MISC_OFF) + 8); }
#define IN(k) (lo <= (k) && (k) < hi)
#define SEAM(k) do { if (IN(k) && IN((k) + 1)) { CArgs* Ab = kargs(); XcdBarrier bar; bar.bar = (unsigned*)(Ab->ws + WS_CTL) + CW_BAR + Ab->li * XCD_BAR_WORDS; bar.x = xb_xcc_id(); \
        bar.st = (volatile LAS unsigned*)(lds + MISC_OFF) + 8; xcd_barrier(bar); } } while (0)

    if (EN_PRO && IN(0)) for (int rep_ = 0; rep_ < REP_PRO; ++rep_) {
        if (rep_) __syncthreads();
        TIDS(); CArgs* A = kargs(); unsigned char* const ws = A->ws;
        LAS float* scr = (LAS float*)(lds + RING_OFF + wave * 16384);
        for (int l = 0; l < DEPTH; ++l) transpose_job(A->in[11] + (size_t)l * D * NADA, NADA, D, NADA, WSP(bf16, WS_WADA) + (size_t)l * NADA * D, D, scr, gw, ngw, lane);
        for (int l = 0; l < DEPTH; ++l) { conv_win(A, ws, l, scr, gw, ngw, lane, bid * NTHREADS + tid, G * NTHREADS, l == 0 ? 3 : 2); conv_rest(A, ws, l, scr, gw, ngw, lane, l == 0, l == 0); }
        bf16* csilu = WSP(bf16, WS_CSILU);
        for (int i = bid * NTHREADS + tid; i < 256 * D; i += G * NTHREADS) { const int r = i >> 11, c = i & 2047;
            float v = 0.f;
            if (r < NP) v = A->in[2][r * D + c]; else if (r < NB) v = A->in[3][(r - NP) * D + c];
            csilu[i] = (bf16)f2bf(r < NB ? v * sigm(v) : 0.f); }
    }
    SEAM(0);

    if (EN_MOD && IN(1)) {
        CArgs* A = kargs(); unsigned char* const ws = A->ws;
        pg8::Gemm g{WSP(bf16, WS_CSILU), WSP(bf16, WS_WADA), 256, 2 * NADA, D, D, D}; pg8::StaticOrder S; S.init(256, 2 * NADA, G, bid);
        pg8::EpiF32 E{WSP(float, WS_MOD), 2 * NADA, A->in[12]};
        pg8::gemm_phase<pg8::EpiF32, pg8::StaticOrder>(lds + RING_OFF, g, S, E, nullptr);
    }
    SEAM(1);

    for (int l = 0; l < DEPTH; ++l) {
        const int pb = 2 + 9 * l;
        if (EN_NORM && IN(pb + 0)) { TIDS(); CArgs* A = kargs(); unsigned char* const ws = A->ws;
            if (l == 0) norm_rows(A->in[0], A->in[1], true, A->in[13] + (size_t)l * D, WSP(float, WS_MOD) + (size_t)l * NADA, WSP(bf16, WS_XN), nullptr, nullptr, gw, ngw, lane, WSP(bf16, WS_XB), 0, nullptr, nullptr, nullptr, nullptr, ws + WS_XN8);
            else norm_rows(WSP(bf16, WS_XB), WSP(bf16, WS_XA) + (size_t)MP * D, false, A->in[13] + (size_t)l * D, WSP(float, WS_MOD) + (size_t)l * NADA, WSP(bf16, WS_XN), nullptr, nullptr, gw, ngw, lane, nullptr,
                           16, WSP(bf16, WS_GIMG), WSP(float, WS_MOD) + (size_t)(l - 1) * NADA + 10240, WSP(bf16, WS_XB) + (size_t)MP * D, nullptr, ws + WS_XN8); }
        SEAM(pb + 0);
        if (EN_PROJ && IN(pb + 1)) for (int rg_ = 0; rg_ < REP_PROJ; ++rg_) { CArgs* A = kargs(); unsigned char* const ws = A->ws;
            { pg8::Gemm g{WSP(bf16, WS_XN), WSP(bf16, WS_WIN) + (size_t)l * NPROJ_PAD * D, MTOT, NPROJ_PAD, D, D, D};
              pg8::TileMapOrder S; S.so.init(MTOT, 17 * 256, G, bid); S.t1 = 12; S.t2 = 16; S.s0 = 0; S.s1 = 4; S.s2 = 32;
              pg8::EpiProj E{WSP(bf16, WS_PROJ), WSP(float, WS_SMALL), 1.f, ws + WS_MG8};
              pg8::gemm_phase<pg8::EpiProj, pg8::TileMapOrder>(lds + RING_OFF, g, S, E, nullptr); }
            { pg8::Gemm g{(const bf16*)(ws + WS_XN8), (const bf16*)(ws + (WS_WIN8_0 + (size_t)l * (WS_WIN8_1 - WS_WIN8_0))), MTOT, NPROJ_PAD, D / 2, D / 2, D / 2};
              pg8::TileMapOrder S; S.so.init(MTOT, 32 * 256, G, bid); S.t1 = 4; S.t2 = 8; S.s0 = 12; S.s1 = 16; S.s2 = 16; S.nh = 72; S.sk = 2;
              pg8::EpiProj E{WSP(bf16, WS_PROJ), WSP(float, WS_SMALL), 1.f / 64.f, ws + WS_MG8};
              pg8::gemm_phase<pg8::EpiProj, pg8::TileMapOrder, true>(lds + RING_OFF, g, S, E, nullptr); } }
        SEAM(pb + 1);
        if (EN_MIX && IN(pb + 2)) {
            TIDS();
            for (int u = bid; u < 1024; u += G) { if (u < 512) ml_prep_unit(l, u >> 7, (u >> 5) & 3, u & 31, lds + RING_OFF, tid); else gla_prep_unit(l, (u - 512) >> 7, (u >> 5) & 3, u & 31, lds + RING_OFF, tid); }
        }
        SEAM(pb + 2);
        if (EN_MIX && IN(pb + 3)) for (int rep_ = 0; rep_ < REP_MIX; ++rep_) {
            if (rep_) __syncthreads();
            TIDS();
            LAS float* fl = (LAS float*)(lds + RING_OFF);
#ifdef PROBE_S
            if (kargs()->li == 1 && bid < 112) {} else
#endif
            if (bid < 112) { if (rep_ == 0 || REP_MIXP) {
            if (bid < 32) { if (EN_ML && (rep_ == 0 || REP_ML)) ml_seq_unit(l, bid >> 3, (bid >> 1) & 3, bid & 1, lds + RING_OFF, tid); }
            else if (bid < 48) { if (EN_GLA && (rep_ == 0 || REP_GLA)) gla_seq_unit(l, (bid - 32) >> 2, bid & 3, lds + RING_OFF, tid); }
            else if (bid < 112) { if (EN_LRU && (rep_ == 0 || REP_LRU)) lru_chunk_unit(l, (bid - 48) >> 4, ((bid - 48) >> 1) & 7, bid & 1, lds + RING_OFF, tid); }
            } }
            else if (rep_ == 0 || REP_MIXS) for (int v = bid - 112; v < 1280; v += G - 112) {
                if (v < 512) { if (EN_ML) ml_unit(l, NP + (v >> 2), v & 3, fl, tid, lane, wave); }
                else if (v < 1024) { if (EN_GLA) gla_unit(l, NP + ((v - 512) >> 2), v & 3, fl, tid, lane, wave); }
                else { if (EN_LRU && v < 1024 + 64) lru_samp_unit(l, (v - 1024) >> 3, v & 7, lds + RING_OFF, tid); }
            }
            if (bid >= 112 && rep_ == 0) {
                __syncthreads();
                CArgs* A = kargs(); LAS float* scr = (LAS float*)(lds + RING_OFF + wave * 16384);
                const float* src = (l == 0 ? A->in[38] : A->in[37]) + (size_t)DFF * D; unsigned char* dst = A->ws + (l == 0 ? WS_WFF2 : WS_WFF1) + (size_t)D * DFF;
                const int sld = l == 0 ? D : DFF, dld = l == 0 ? DFF : D;
                for (int it = (bid - 112) * NWAVES + wave; it < (DFF / 64) * (D / 32); it += (G - 112) * NWAVES) transpose_item_f8(src, sld, sld, dst, dld, 64.f, scr, it, lane);
                __syncthreads(); }
        }
        SEAM(pb + 3);
        if (EN_MERGE && IN(pb + 4)) for (int rg_ = 0; rg_ < REP_MERGE; ++rg_) { CArgs* A = kargs(); unsigned char* const ws = A->ws;
            { pg8::Gemm g{WSP(bf16, WS_YCAT), (const bf16*)(ws + WS_WBR + (size_t)l * D * KBR), MP, D, KBR / 2, KBR / 2, KBR / 2}; pg8::StaticOrder S; S.init(MP, D, G, bid);
              pg8::EpiMergeF8 E{ws + WS_MG8, ws + WS_MERGED, 8.f / 64.f};
              pg8::gemm_phase<pg8::EpiMergeF8, pg8::StaticOrder, true>(lds + RING_OFF, g, S, E, nullptr); }
            { pg8::Gemm g{WSP(bf16, WS_YCAT), (const bf16*)(ws + WS_WBR + (size_t)l * D * KBR), MTOT, D, 512, KBR / 2, KBR / 2}; pg8::SplitOrder S{MP / 256, MS / 256, D / 256, 3, 512, G, bid};
              pg8::EpiGateSlab E{ws + WS_MG8, (bf16*)(ws + WS_GIMG + 64 * MiB), 9, 1.f / 64.f};
              pg8::gemm_phase<pg8::EpiGateSlab, pg8::SplitOrder, true>(lds + RING_OFF, g, S, E, nullptr); }
            if (l == 0 && (int)blockIdx.x >= 48 && rg_ == 0) {
                __syncthreads();
                CArgs* A2 = kargs(); int t_ = (int)threadIdx.x; asm volatile("" : "+v"(t_));
                const int wv_ = __builtin_amdgcn_readfirstlane(t_ >> 6);
                conv_win(A2, A2->ws, 1, (LAS float*)(lds + RING_OFF + wv_ * 16384), ((int)blockIdx.x - 48) * NWAVES + wv_, (G - 48) * NWAVES, t_ & 63, 0, 1, 1);
                __syncthreads(); } }
        SEAM(pb + 4);
        if (EN_OUT && IN(pb + 5)) for (int rg_ = 0; rg_ < REP_OUT; ++rg_) { CArgs* A = kargs(); unsigned char* const ws = A->ws;
            { TIDS();
              const bf16* sl = (const bf16*)(ws + WS_GIMG + 64 * MiB); unsigned char* mg = ws + WS_MERGED + (size_t)MP * D;
              for (int row = gw; row < MS; row += ngw) { const v2u* s4 = (const v2u*)(sl + (size_t)row * D) + lane;
#pragma unroll
                  for (int j = 0; j < 8; ++j) { const v2u w0 = s4[64 * j], w1 = s4[(size_t)(MS * D / 4) + 64 * j], w2 = s4[(size_t)2 * (MS * D / 4) + 64 * j];
                      const f32x4 v = (f32x4){bflo_(w0.x), bfhi_(w0.x), bflo_(w0.y), bfhi_(w0.y)} + (f32x4){bflo_(w1.x), bfhi_(w1.x), bflo_(w1.y), bfhi_(w1.y)} + (f32x4){bflo_(w2.x), bfhi_(w2.x), bflo_(w2.y), bfhi_(w2.y)};
                      *((unsigned*)(mg + (size_t)row * D) + lane + 64 * j) = pg8::pk4_fp8(8.f * v.x, 8.f * v.y, 8.f * v.z, 8.f * v.w); } } }
            { pg8::Gemm g{WSP(bf16, WS_MERGED), (const bf16*)(ws + WS_WOUT + (size_t)l * D * D), MP, D, D / 2, D / 2, D / 2}; pg8::StaticOrder S; S.init(MP, D, G, bid);
              pg8::EpiResid E{WSP(bf16, WS_XB), WSP(bf16, WS_XA), WSP(float, WS_MOD) + (size_t)l * NADA + 4096, 1.f / 512.f};
              pg8::gemm_phase<pg8::EpiResid, pg8::StaticOrder, true>(lds + RING_OFF, g, S, E, nullptr); }
            { CArgs* Ab = kargs(); XcdBarrier bar; bar.bar = (unsigned*)(Ab->ws + WS_CTL) + CW_BAR + Ab->li * XCD_BAR_WORDS; bar.x = xb_xcc_id(); bar.st = (volatile LAS unsigned*)(lds + MISC_OFF) + 8; xcd_barrier(bar); }
            { pg8::Gemm g{WSP(bf16, WS_MERGED), (const bf16*)(ws + WS_WOUT + (size_t)l * D * D), MTOT, D, D / 8, D / 2, D / 2}; pg8::SplitOrder S{MP / 256, MS / 256, D / 256, 4, D / 8, G, bid};
              pg8::EpiSlab E{WSP(bf16, WS_GIMG), D / 8, 1.f / 512.f};
              pg8::gemm_phase<pg8::EpiSlab, pg8::SplitOrder, true>(lds + RING_OFF, g, S, E, nullptr); } }
        SEAM(pb + 5);
        if (EN_NORM && IN(pb + 6)) { TIDS(); CArgs* A = kargs(); unsigned char* const ws = A->ws;
            norm_rows(WSP(bf16, WS_XA), WSP(bf16, WS_XB) + (size_t)MP * D, false, A->in[14] + (size_t)l * D, WSP(float, WS_MOD) + (size_t)l * NADA + 6144, WSP(bf16, WS_XN), nullptr, nullptr, gw, ngw, lane, nullptr,
                      4, WSP(bf16, WS_GIMG), WSP(float, WS_MOD) + (size_t)l * NADA + 4096, WSP(bf16, WS_XA) + (size_t)MP * D, ws + WS_XN); }
        SEAM(pb + 6);
        if (EN_FF1 && IN(pb + 7)) for (int rg_ = 0; rg_ < REP_FF1; ++rg_) { CArgs* A = kargs(); unsigned char* const ws = A->ws;
            pg8::Gemm g{WSP(bf16, WS_XN), (const bf16*)(ws + WS_WFF1 + (size_t)l * DFF * D), MTOT, DFF, D / 2, D / 2, D / 2}; pg8::StaticOrder S; S.init(MTOT, DFF, G, bid);
            pg8::EpiRelu2F8 E{ws + WS_HFF, DFF, 1.f / 64.f};
            pg8::gemm_phase<pg8::EpiRelu2F8, pg8::StaticOrder, true>(lds + RING_OFF, g, S, E, nullptr);
            if (l == 0 && (int)blockIdx.x >= 64 && rg_ == 0) {
                __syncthreads();
                CArgs* A2 = kargs(); int t_ = (int)threadIdx.x; asm volatile("" : "+v"(t_));
                const int wv_ = __builtin_amdgcn_readfirstlane(t_ >> 6);
                conv_rest(A2, A2->ws, 1, (LAS float*)(lds + RING_OFF + wv_ * 16384), ((int)blockIdx.x - 64) * NWAVES + wv_, (G - 64) * NWAVES, t_ & 63, false, true);
                __syncthreads(); } }
        SEAM(pb + 7);
        if (EN_FF2 && IN(pb + 8)) for (int rg_ = 0; rg_ < REP_FF2; ++rg_) { CArgs* A = kargs(); unsigned char* const ws = A->ws;
            { pg8::Gemm g{WSP(bf16, WS_HFF), (const bf16*)(ws + WS_WFF2 + (size_t)l * D * DFF), MP, D, DFF / 2, DFF / 2, DFF / 2}; pg8::StaticOrder S; S.init(MP, D, G, bid);
              pg8::EpiResid E{WSP(bf16, WS_XA), WSP(bf16, WS_XB), WSP(float, WS_MOD) + (size_t)l * NADA + 10240, 1.f / 64.f};
              pg8::gemm_phase<pg8::EpiResid, pg8::StaticOrder, true>(lds + RING_OFF, g, S, E, nullptr); }
            { pg8::Gemm g{WSP(bf16, WS_HFF), (const bf16*)(ws + WS_WFF2 + (size_t)l * D * DFF), MTOT, D, DFF / 32, DFF / 2, DFF / 2}; pg8::SplitOrder S{MP / 256, MS / 256, D / 256, 16, DFF / 32, G, bid};
              pg8::EpiSlab E{WSP(bf16, WS_GIMG), DFF / 32, 1.f / 64.f};
              pg8::gemm_phase<pg8::EpiSlab, pg8::SplitOrder, true>(lds + RING_OFF, g, S, E, nullptr); } }
        SEAM(pb + 8);
    }
    if (EN_NORM && IN(20)) { TIDS(); CArgs* A = kargs(); unsigned char* const ws = A->ws;
        norm_rows(WSP(bf16, WS_XB), WSP(bf16, WS_XA) + (size_t)MP * D, false, A->in[39], nullptr, nullptr, A->out + O_YP, A->out + O_YS, gw, ngw, lane, nullptr,
                  16, WSP(bf16, WS_GIMG), WSP(float, WS_MOD) + (size_t)(DEPTH - 1) * NADA + 10240, WSP(bf16, WS_XB) + (size_t)MP * D); }
#undef IN
#undef SEAM
}

extern "C" void kernel_launch(void* const* d_in, const int* in_sizes, int n_in, void* d_out, int out_size, void* d_ws, size_t ws_size, hipStream_t stream) {
    static int grid = 0;
    if (grid == 0) {
        if (n_in != 40 || (size_t)out_size != O_END || ws_size < WS_END) { fprintf(stderr, "kernel_launch: unexpected shapes (n_in %d, out %d, ws %zu); nothing launched\n", n_in, out_size, ws_size); grid = -1; return; }
        if (hipFuncSetAttribute((const void*)mk_fwd, hipFuncAttributeMaxDynamicSharedMemorySize, LDS_BYTES) != hipSuccess) { fprintf(stderr, "kernel_launch: hipFuncSetAttribute failed\n"); grid = -1; return; }
        int per_cu = 0;
        if (hipOccupancyMaxActiveBlocksPerMultiprocessor(&per_cu, (const void*)mk_fwd, NTHREADS, LDS_BYTES) != hipSuccess || per_cu < 1)
            fprintf(stderr, "kernel_launch: note: occupancy query reports %d workgroups per CU\n", per_cu);
        (void)hipGetLastError();
        grid = GRID;
    }
    if (grid < 0) return;
    if (hipMemsetAsync((char*)d_ws + WS_CTL, 0, CTL_ZERO_BYTES, stream) != hipSuccess) { fprintf(stderr, "kernel_launch: hipMemsetAsync failed\n"); return; }
    Args a{};
    for (int i = 0; i < 40; ++i) a.in[i] = (const float*)d_in[i];
    a.out = (float*)d_out; a.ws = (unsigned char*)d_ws; a.pad = 0;
#ifndef PROBE_P
#define PROBE_P -1
#endif
#ifndef PROBE_G
#define PROBE_G 256
#endif
    int n_l = 0, lo_[4], hi_[4], fl_[4];
    if (N_LAUNCHES != 1) { for (int li = 0; li < PH_TOTAL; ++li) { a.ph_lo = li; a.ph_hi = li + 1; a.li = 0; a.pad = 0; hipLaunchKernelGGL(mk_fwd, dim3(grid), dim3(NTHREADS), LDS_BYTES, stream, a); } return; }
    if (PROBE_P < 0) { lo_[0] = 0; hi_[0] = PH_TOTAL; fl_[0] = grid; n_l = 1; }
#ifndef PROBE_Q
#define PROBE_Q PROBE_P
#endif
#ifdef PROBE_ABL
    else { lo_[0] = 0; hi_[0] = PROBE_P; fl_[0] = grid; lo_[1] = PROBE_P; hi_[1] = PROBE_Q + 1; fl_[1] = PROBE_G; lo_[2] = PROBE_P; hi_[2] = PH_TOTAL; fl_[2] = grid; n_l = 3; }
#else
    else { lo_[0] = 0; hi_[0] = PROBE_Q + 1; fl_[0] = grid; lo_[1] = PROBE_P; hi_[1] = PROBE_Q + 1; fl_[1] = PROBE_G; lo_[2] = PROBE_Q + 1; hi_[2] = PH_TOTAL; fl_[2] = grid; n_l = 3; }
#endif
    for (int li = 0; li < n_l; ++li) {
        a.ph_lo = lo_[li]; a.ph_hi = hi_[li]; a.li = li; a.pad = 0;
        hipLaunchKernelGGL(mk_fwd, dim3(fl_[li]), dim3(NTHREADS), LDS_BYTES, stream, a);
        const hipError_t le = hipPeekAtLastError();
        if (le != hipSuccess) { fprintf(stderr, "kernel_launch: launch %d failed: %s\n", li, hipGetErrorName(le)); break; }
    }
}
```

```cpp
#include <hip/hip_runtime.h>
#include <cstdio>
#include <cstdint>

constexpr int D = 2048, DEPTH = 2;
constexpr int NP = 4, TP = 2048, NS = 128, TS = 4;
constexpr int MP = NP * TP, MS = NS * TS, MTOT = MP + MS;
constexpr int NB = NP + NS;
constexpr int DIN = 12312, NPROJ = 12288, NPROJ_PAD = 12544, NSMALL = 24;
constexpr int PPITCH = 6144;
constexpr int C_LRUX = 0, C_GQ = 1024, C_GK = 1536, C_GV = 2048, C_GGATE = 3072, C_MX = 4096, C_MO = 5120, C_MG = 6144;
constexpr int DFF = 8192, NADA = 12288, KBR = 3072;
constexpr float EPS = 1e-6f;
#define MK_N_LAUNCHES 1
namespace pg8 {
#define PG8_LAS __attribute__((address_space(3)))
typedef unsigned short bf16_t;
typedef short bf16x8 __attribute__((ext_vector_type(8)));
typedef float f32x4 __attribute__((ext_vector_type(4)));
typedef unsigned u32x4 __attribute__((ext_vector_type(4)));
constexpr int BM = 256, BK = 64, HALF = 128, HTB = HALF * BK * 2  , STAGE_BYTES = 8 * HTB, NXCD = 8, WGM = 8;

__host__ __device__ __forceinline__ int lds_byte(int r, int c) { const int st = (r >> 4) * 2 + (c >> 5), rr = r & 15, cc = c & 31, ob = rr * 64 + cc * 2; return st * 1024 + (ob ^ (((ob >> 9) & 1) << 5)); }
__host__ __device__ __forceinline__ void stage_rc(int b, int& R, int& C) { const int st = b / 1024, sb = b % 1024, swz = sb ^ (((sb >> 9) & 1) << 5); R = (st >> 1) * 16 + swz / 64; C = (st & 1) * 32 + (swz % 64) / 2; }
__host__ __device__ __forceinline__ int perm32(int rho) { const int n = rho >> 4, i = rho & 15; return 8 * (i >> 2) + 4 * n + (i & 3); }

struct Unit { int pm, pn, koff; };
struct Gemm { const bf16_t* A; const bf16_t* Bt; int M, N, K, lda, ldb; };

struct StaticOrder {
    int nM, nN, nwg, G, c;
    __host__ __device__ void init(int M, int N, int G_, int c_) { nM = M / BM; nN = N / BM; nwg = nM * nN; G = G_; c = c_; }
    __host__ __device__ bool next(int i, Unit& u) const { return at((long)i * G + c, u); }
    __host__ __device__ bool at(long L, Unit& u) const {
        if (L >= nwg) return false;
        int wgid = (int)L; { const int q = nwg / NXCD, r = nwg % NXCD, xcd = wgid % NXCD, off = wgid / NXCD; wgid = (xcd < r ? xcd * (q + 1) : r * (q + 1) + (xcd - r) * q) + off; }
        const int nig = WGM * nN, gid = wgid / nig, fm = gid * WGM, gsz = (nM - fm) < WGM ? (nM - fm) : WGM;
        u.pm = fm + ((wgid % nig) % gsz); u.pn = (wgid % nig) / gsz; u.koff = 0; return true;
    }
    __device__ __forceinline__ void a_ready(const Unit&) const {}
    __device__ __forceinline__ void done(const Unit&) const {}
};
struct SplitOrder {
    int pm0, npm, nN, split, ksub, G, c;
    __device__ __forceinline__ bool next(int i, Unit& u) const {
        const int L = i * G + c, nt = npm * nN; if (L >= nt * split) return false;
        const int tile = L % nt, ks = L / nt; u.pm = pm0 + tile / nN; u.pn = tile % nN; u.koff = ks * ksub; return true;
    }
    __device__ __forceinline__ void a_ready(const Unit&) const {}
    __device__ __forceinline__ void done(const Unit&) const {}
};
struct TileMapOrder {
    StaticOrder so; int t1, t2, s0, s1, s2; int nh = 0, sk = 0;
    __device__ __forceinline__ bool next(int i, Unit& u) const {
        const int gl = so.G - nh, lt = (int)(so.c >= nh), early = lt * (int)(i < sk);
        const long L = early ? (long)i * gl + (so.c - nh) : (long)sk * gl + (long)(i - lt * sk) * so.G + so.c;
        if (!so.at(L, u)) return false; u.pn += s0 + (int)(u.pn >= t1) * (s1 - s0) + (int)(u.pn >= t2) * (s2 - s1); return true; }
    __device__ __forceinline__ void a_ready(const Unit&) const {}
    __device__ __forceinline__ void done(const Unit&) const {}
};


__device__ __forceinline__ unsigned cvt_pk_bf16(float lo, float hi) { unsigned r; asm volatile("v_cvt_pk_bf16_f32 %0, %1, %2" : "=v"(r) : "v"(lo), "v"(hi)); return r; }
typedef float f32x2 __attribute__((ext_vector_type(2)));
typedef int i32x4 __attribute__((ext_vector_type(4)));
typedef int i32x8 __attribute__((ext_vector_type(8)));
__device__ __forceinline__ unsigned pk4_fp8(float a, float b, float c, float d) { int w = __builtin_amdgcn_cvt_pk_fp8_f32(a, b, 0, false); w = __builtin_amdgcn_cvt_pk_fp8_f32(c, d, w, true); return (unsigned)w; }
__device__ __forceinline__ float bflo(unsigned w) { return __uint_as_float(w << 16); }
__device__ __forceinline__ float bfhi(unsigned w) { return __uint_as_float(w & 0xffff0000u); }

#define PG8_COORDS() int tz_ = threadIdx.x; asm volatile("" : "+v"(tz_)); const int wid_ = __builtin_amdgcn_readfirstlane(tz_ >> 6); \
    const int wr = wid_ >> 2, wc = wid_ & 3, fr = tz_ & 15, fq = (tz_ & 63) >> 4

struct EpiF32 {
    static constexpr bool PERM = false, AFTER_DRAIN = false; static constexpr int NMID = 0, MID1 = -1, MID2 = -1;
    float* C; int ldc; const float* bias;
    __device__ __forceinline__ void operator()(const f32x4 (&acc)[2][2][4][2], const Unit& u, int, int, int, int) const {
        PG8_COORDS();
        const int row0 = u.pm * BM + wr * 64 + fr, col0 = u.pn * BM + wc * 32 + 4 * fq;
        f32x4 bv[2][2];
#pragma unroll
        for (int bj = 0; bj < 2; ++bj)
#pragma unroll
            for (int n = 0; n < 2; ++n) bv[bj][n] = bias ? *(const f32x4*)(bias + col0 + bj * HALF + n * 16) : (f32x4){0.f, 0.f, 0.f, 0.f};
#pragma unroll
        for (int ai = 0; ai < 2; ++ai)
#pragma unroll
            for (int m = 0; m < 4; ++m) { float* rowp = C + (size_t)(row0 + ai * HALF + m * 16) * ldc + col0;
#pragma unroll
                for (int bj = 0; bj < 2; ++bj)
#pragma unroll
                    for (int n = 0; n < 2; ++n) *(f32x4*)(rowp + bj * HALF + n * 16) = acc[ai][bj][m][n] + bv[bj][n]; }
    }
    __device__ __forceinline__ void mid(f32x4 (&)[2][2][4][2], const Unit&, int, int, int, int, int) const {}
};

struct EpiProj {
    static constexpr bool PERM = true, AFTER_DRAIN = false; static constexpr int NMID = 0, MID1 = -1, MID2 = -1;
    bf16_t* O; float* sm; float ascale; unsigned char* mg8;
    __device__ __forceinline__ void operator()(const f32x4 (&acc)[2][2][4][2], const Unit& u, int, int, int, int) const {
        PG8_COORDS();
        const int row0 = u.pm * BM + wr * 64 + fr;
        if (u.pn < 24) {
            const int col0 = u.pn * BM + wc * 32 + 8 * fq;
#pragma unroll
            for (int ai = 0; ai < 2; ++ai)
#pragma unroll
                for (int m = 0; m < 4; ++m) { bf16_t* rowp = O + (size_t)(row0 + ai * HALF + m * 16) * 6144 + col0;
#pragma unroll
                    for (int bj = 0; bj < 2; ++bj) { const f32x4 v0 = acc[ai][bj][m][0] * ascale, v1 = acc[ai][bj][m][1] * ascale;
                        u32x4 w; w.x = cvt_pk_bf16(v0[0], v0[1]); w.y = cvt_pk_bf16(v0[2], v0[3]); w.z = cvt_pk_bf16(v1[0], v1[1]); w.w = cvt_pk_bf16(v1[2], v1[3]);
                        *(u32x4*)(rowp + bj * HALF) = w; } }
        } else if (u.pn < 48) {
            const int col0 = (u.pn - 24) * BM + wc * 32 + 8 * fq;
#pragma unroll
            for (int ai = 0; ai < 2; ++ai)
#pragma unroll
                for (int m = 0; m < 4; ++m) { unsigned char* rowp = mg8 + (size_t)(row0 + ai * HALF + m * 16) * 6144 + col0;
#pragma unroll
                    for (int bj = 0; bj < 2; ++bj) { const f32x4 v0 = acc[ai][bj][m][0] * ascale, v1 = acc[ai][bj][m][1] * ascale;
                        *(unsigned long long*)(rowp + bj * HALF) = (unsigned long long)pk4_fp8(v0[0], v0[1], v0[2], v0[3]) | ((unsigned long long)pk4_fp8(v1[0], v1[1], v1[2], v1[3]) << 32); } }
        } else {
#pragma unroll
            for (int ai = 0; ai < 2; ++ai)
#pragma unroll
                for (int m = 0; m < 4; ++m) { float* rowp = sm + (size_t)(row0 + ai * HALF + m * 16) * 24;
#pragma unroll
                    for (int n = 0; n < 2; ++n) { const int c = wc * 32 + 8 * fq + 4 * n;
                        if (c < 24) *(f32x4*)(rowp + c) = acc[ai][0][m][n]; } }
        }
    }
    __device__ __forceinline__ void mid(f32x4 (&)[2][2][4][2], const Unit&, int, int, int, int, int) const {}
};

template <int M1, int M2> struct EpiMergeT {
    static constexpr bool PERM = true, AFTER_DRAIN = false; static constexpr int NMID = 2, MID1 = M1, MID2 = M2;
    const unsigned char* proj; unsigned char* O; float ascale;
    static __device__ __forceinline__ void ld8(const unsigned char* p, float (&z)[8]) { const unsigned long long w = *(const unsigned long long*)p; const int lo = (int)(unsigned)w, hi = (int)(unsigned)(w >> 32);
        const f32x2 a = __builtin_amdgcn_cvt_pk_f32_fp8(lo, false), b = __builtin_amdgcn_cvt_pk_f32_fp8(lo, true), c = __builtin_amdgcn_cvt_pk_f32_fp8(hi, false), d = __builtin_amdgcn_cvt_pk_f32_fp8(hi, true);
        z[0] = a[0]; z[1] = a[1]; z[2] = b[0]; z[3] = b[1]; z[4] = c[0]; z[5] = c[1]; z[6] = d[0]; z[7] = d[1]; }
    static __device__ __forceinline__ float en(float z) { z = fminf(fmaxf(z, -30.f), 30.f); return __expf(-z); }
    __device__ __forceinline__ void mid(f32x4 (&acc)[2][2][4][2], const Unit& u, int t, int, int, int, int) const {
        PG8_COORDS();
        const int b = (t == MID1) ? 0 : 1;
        int row0 = u.pm * BM + wr * 64 + fr, col0 = u.pn * BM + wc * 32 + 8 * fq;
        asm volatile("" : "+v"(row0), "+v"(col0));
#pragma unroll
        for (int ai = 0; ai < 2; ++ai)
#pragma unroll
            for (int m = 0; m < 4; ++m) { const unsigned char* rowp = proj + (size_t)(row0 + ai * HALF + m * 16) * 6144 + 2048 * b + col0;
#pragma unroll
                for (int bj = 0; bj < 2; ++bj) { float za[8], zb[8]; ld8(rowp + bj * HALF, za); ld8(rowp + 2048 + bj * HALF, zb);
#pragma unroll
                    for (int j = 0; j < 8; ++j) { const float r = (1.f + en(zb[j])) / (1.f + en(za[j]));
                        acc[ai][bj][m][j >> 2][j & 3] *= r; } }
                asm volatile("" ::: "memory"); }
    }
    __device__ __forceinline__ void operator()(const f32x4 (&acc)[2][2][4][2], const Unit& u, int, int, int, int) const {
        PG8_COORDS();
        const int row0 = u.pm * BM + wr * 64 + fr, col0 = u.pn * BM + wc * 32 + 8 * fq;
#pragma unroll
        for (int ai = 0; ai < 2; ++ai)
#pragma unroll
            for (int m = 0; m < 4; ++m) { const size_t r = (size_t)(row0 + ai * HALF + m * 16); const unsigned char* gp = proj + r * 6144 + 4096 + col0; unsigned char* op = O + r * 2048 + col0;
#pragma unroll
                for (int bj = 0; bj < 2; ++bj) { float z[8], v[8]; ld8(gp + bj * HALF, z);
#pragma unroll
                    for (int j = 0; j < 8; ++j) v[j] = acc[ai][bj][m][j >> 2][j & 3] * ascale / (1.f + en(z[j]));
                    *(unsigned long long*)(op + bj * HALF) = (unsigned long long)pk4_fp8(v[0], v[1], v[2], v[3]) | ((unsigned long long)pk4_fp8(v[4], v[5], v[6], v[7]) << 32); }
                asm volatile("" ::: "memory"); }
    }
};

typedef EpiMergeT<16, 32> EpiMerge;
typedef EpiMergeT<8, 16> EpiMergeF8;

struct EpiResid {
    static constexpr bool PERM = false, AFTER_DRAIN = false; static constexpr int NMID = 0, MID1 = -1, MID2 = -1;
    const bf16_t* base; bf16_t* out; const float* gate; float ascale;
    __device__ __forceinline__ void operator()(const f32x4 (&acc)[2][2][4][2], const Unit& u, int, int, int, int) const {
        PG8_COORDS();
        const int row0 = u.pm * BM + wr * 64 + fr, col0 = u.pn * BM + wc * 32 + 4 * fq;
#pragma unroll
        for (int ai = 0; ai < 2; ++ai)
#pragma unroll
            for (int m = 0; m < 4; ++m) { const int row = row0 + ai * HALF + m * 16;
                const int cond = row < 8192 ? (row >> 11) : 4 + ((row - 8192) >> 2);
                const bf16_t* bp = base + (size_t)row * 2048 + col0; const float* gp = gate + (size_t)cond * 24576 + col0; bf16_t* op = out + (size_t)row * 2048 + col0;
#pragma unroll
                for (int bj = 0; bj < 2; ++bj)
#pragma unroll
                    for (int n = 0; n < 2; ++n) { const unsigned long long bw = *(const unsigned long long*)(bp + bj * HALF + n * 16); const unsigned b0 = (unsigned)bw, b1 = (unsigned)(bw >> 32);
                        const f32x4 bs = {bflo(b0), bfhi(b0), bflo(b1), bfhi(b1)}, gt = *(const f32x4*)(gp + bj * HALF + n * 16);
                        const f32x4 v = bs + gt * (acc[ai][bj][m][n] * ascale);
                        *(unsigned long long*)(op + bj * HALF + n * 16) = (unsigned long long)cvt_pk_bf16(v[0], v[1]) | ((unsigned long long)cvt_pk_bf16(v[2], v[3]) << 32); }
                asm volatile("" ::: "memory"); }
    }
    __device__ __forceinline__ void mid(f32x4 (&)[2][2][4][2], const Unit&, int, int, int, int, int) const {}
};

struct EpiSlab {
    static constexpr bool PERM = false, AFTER_DRAIN = false; static constexpr int NMID = 0, MID1 = -1, MID2 = -1;
    bf16_t* slab; int ksub; float ascale;
    __device__ __forceinline__ void operator()(const f32x4 (&acc)[2][2][4][2], const Unit& u, int, int, int, int) const {
        PG8_COORDS();
        const int row0 = u.pm * BM + wr * 64 + fr - 8192, col0 = u.pn * BM + wc * 32 + 4 * fq; bf16_t* sl = slab + (size_t)(u.koff / ksub) * 512 * 2048;
#pragma unroll
        for (int ai = 0; ai < 2; ++ai)
#pragma unroll
            for (int m = 0; m < 4; ++m) { bf16_t* op = sl + (size_t)(row0 + ai * HALF + m * 16) * 2048 + col0;
#pragma unroll
                for (int bj = 0; bj < 2; ++bj)
#pragma unroll
                    for (int n = 0; n < 2; ++n) { const f32x4 v = acc[ai][bj][m][n] * ascale; *(unsigned long long*)(op + bj * HALF + n * 16) = (unsigned long long)cvt_pk_bf16(v[0], v[1]) | ((unsigned long long)cvt_pk_bf16(v[2], v[3]) << 32); } }
    }
    __device__ __forceinline__ void mid(f32x4 (&)[2][2][4][2], const Unit&, int, int, int, int, int) const {}
};

struct EpiGateSlab {
    static constexpr bool PERM = false, AFTER_DRAIN = false; static constexpr int NMID = 0, MID1 = -1, MID2 = -1;
    const unsigned char* proj; bf16_t* slab; int kshift; float ascale;
    __device__ __forceinline__ void operator()(const f32x4 (&acc)[2][2][4][2], const Unit& u, int, int, int, int) const {
        PG8_COORDS();
        const int b = u.koff >> kshift, row0 = u.pm * BM + wr * 64 + fr, col0 = u.pn * BM + wc * 32 + 4 * fq; bf16_t* sl = slab + (size_t)b * 512 * 2048;
#pragma unroll
        for (int ai = 0; ai < 2; ++ai)
#pragma unroll
            for (int m = 0; m < 4; ++m) { const int row = row0 + ai * HALF + m * 16; const unsigned char* gp = proj + (size_t)row * 6144 + 2048 * b + col0; bf16_t* op = sl + (size_t)(row - 8192) * 2048 + col0;
#pragma unroll
                for (int bj = 0; bj < 2; ++bj)
#pragma unroll
                    for (int n = 0; n < 2; ++n) { const int gw = (int)*(const unsigned*)(gp + bj * HALF + n * 16); const f32x2 ga = __builtin_amdgcn_cvt_pk_f32_fp8(gw, false), gb = __builtin_amdgcn_cvt_pk_f32_fp8(gw, true);
                        f32x4 v = acc[ai][bj][m][n] * ascale;
                        v[0] /= 1.f + EpiMerge::en(ga[0]); v[1] /= 1.f + EpiMerge::en(ga[1]); v[2] /= 1.f + EpiMerge::en(gb[0]); v[3] /= 1.f + EpiMerge::en(gb[1]);
                        *(unsigned long long*)(op + bj * HALF + n * 16) = (unsigned long long)cvt_pk_bf16(v[0], v[1]) | ((unsigned long long)cvt_pk_bf16(v[2], v[3]) << 32); }
                asm volatile("" ::: "memory"); }
    }
    __device__ __forceinline__ void mid(f32x4 (&)[2][2][4][2], const Unit&, int, int, int, int, int) const {}
};

struct EpiRelu2 {
    static constexpr bool PERM = true, AFTER_DRAIN = false; static constexpr int NMID = 0, MID1 = -1, MID2 = -1;
    bf16_t* O; int ldc;
    __device__ __forceinline__ void operator()(const f32x4 (&acc)[2][2][4][2], const Unit& u, int, int, int, int) const {
        PG8_COORDS();
        const int row0 = u.pm * BM + wr * 64 + fr, col0 = u.pn * BM + wc * 32 + 8 * fq;
#pragma unroll
        for (int ai = 0; ai < 2; ++ai)
#pragma unroll
            for (int m = 0; m < 4; ++m) { bf16_t* rowp = O + (size_t)(row0 + ai * HALF + m * 16) * ldc + col0;
#pragma unroll
                for (int bj = 0; bj < 2; ++bj) { f32x4 v0 = acc[ai][bj][m][0], v1 = acc[ai][bj][m][1];
#pragma unroll
                    for (int j = 0; j < 4; ++j) { const float a = fmaxf(v0[j], 0.f), b = fmaxf(v1[j], 0.f); v0[j] = a * a; v1[j] = b * b; }
                    u32x4 w; w.x = cvt_pk_bf16(v0[0], v0[1]); w.y = cvt_pk_bf16(v0[2], v0[3]); w.z = cvt_pk_bf16(v1[0], v1[1]); w.w = cvt_pk_bf16(v1[2], v1[3]);
                    *(u32x4*)(rowp + bj * HALF) = w; } }
    }
    __device__ __forceinline__ void mid(f32x4 (&)[2][2][4][2], const Unit&, int, int, int, int, int) const {}
};


struct EpiRelu2F8 {
    static constexpr bool PERM = true, AFTER_DRAIN = false; static constexpr int NMID = 0, MID1 = -1, MID2 = -1;
    unsigned char* O; int ldc; float ascale;
    __device__ __forceinline__ void operator()(const f32x4 (&acc)[2][2][4][2], const Unit& u, int, int, int, int) const {
        PG8_COORDS();
        const int row0 = u.pm * BM + wr * 64 + fr, col0 = u.pn * BM + wc * 32 + 8 * fq;
#pragma unroll
        for (int ai = 0; ai < 2; ++ai)
#pragma unroll
            for (int m = 0; m < 4; ++m) { unsigned char* rowp = O + (size_t)(row0 + ai * HALF + m * 16) * ldc + col0;
#pragma unroll
                for (int bj = 0; bj < 2; ++bj) { f32x4 v0 = acc[ai][bj][m][0], v1 = acc[ai][bj][m][1];
#pragma unroll
                    for (int j = 0; j < 4; ++j) { const float a = fmaxf(v0[j] * ascale, 0.f), b = fmaxf(v1[j] * ascale, 0.f); v0[j] = a * a; v1[j] = b * b; }
                    unsigned long long w = (unsigned long long)pk4_fp8(v0[0], v0[1], v0[2], v0[3]) | ((unsigned long long)pk4_fp8(v1[0], v1[1], v1[2], v1[3]) << 32);
                    *(unsigned long long*)(rowp + bj * HALF) = w; } }
    }
    __device__ __forceinline__ void mid(f32x4 (&)[2][2][4][2], const Unit&, int, int, int, int, int) const {}
};
template <class Epi, class Sched, bool FP8 = false, bool STAMP = false>
__device__ __forceinline__ void gemm_phase(PG8_LAS unsigned char* lds, const Gemm g, const Sched& S, const Epi& E, unsigned long long* stamps) {
    int tid_ = threadIdx.x; asm volatile("" : "+v"(tid_));
    const int tid = tid_, wid = __builtin_amdgcn_readfirstlane(tid >> 6), lane = tid & 63, wr = wid >> 2, wc = wid & 3, fr = lane & 15, fq = lane >> 4;
    const int K = g.K, nt = K / BK;
    int ts_lo = 0, ts_hi = 0, nts = 0; const unsigned long long rt_entry = STAMP ? (unsigned long long)wall_clock64() : 0ull;
#define PG8_STAMP() do { if (STAMP && wid == 0 && nts < 64) { const unsigned long long _c = (unsigned long long)clock64(); \
        ts_lo = (lane == nts) ? (int)(unsigned)_c : ts_lo; ts_hi = (lane == nts) ? (int)(unsigned)(_c >> 32) : ts_hi; ++nts; } } while (0)
    PG8_STAMP();
    unsigned voffA[2], voffB[2];
#pragma unroll
    for (int i = 0; i < 2; ++i) { int R, C; stage_rc(tid * 16 + i * 8192, R, C); const int Rb = Epi::PERM ? ((R & ~31) + perm32(R & 31)) : R;
        voffA[i] = (unsigned)(R * g.lda + C) * 2u; voffB[i] = (unsigned)(Rb * g.ldb + C) * 2u; }
    const size_t kstep = (size_t)(BK * 2);
    const size_t hstepA = (size_t)HALF * g.lda * 2, hstepB = (size_t)HALF * g.ldb * 2;
    const size_t tstepA = 2 * hstepA, tstepB = 2 * hstepB;
    const unsigned ldsw = (unsigned)wid * 1024u;
    const int aoff = lds_byte(wr * 64 + fr, fq * 8), boff = lds_byte(wc * 32 + fr, fq * 8);
#define PG8_SA(b, h) (((b) * 2 + (h)) * HTB)
#define PG8_SB(b, h) ((4 + (b) * 2 + (h)) * HTB)
#define PG8_STAGE(bufoff, gbase, voff) do { _Pragma("unroll") for (int _i = 0; _i < 2; ++_i) \
        __builtin_amdgcn_global_load_lds((const unsigned*)((const char*)(gbase) + (voff)[_i]), (PG8_LAS unsigned*)(lds + (bufoff) + ldsw + _i * 8192), 16, 0, 0); } while (0)
#define PG8_LDA(dst, b, h) do { _Pragma("unroll") for (int m = 0; m < 4; ++m) { \
        if constexpr (FP8) { const i32x4 lo_ = *(const PG8_LAS i32x4*)(lds + PG8_SA(b, h) + aoff + m * 2048), hi_ = *(const PG8_LAS i32x4*)(lds + PG8_SA(b, h) + aoff + m * 2048 + 1024); dst##8[m] = __builtin_shufflevector(lo_, hi_, 0, 1, 2, 3, 4, 5, 6, 7); } \
        else { _Pragma("unroll") for (int k = 0; k < 2; ++k) dst[m][k] = *(const PG8_LAS bf16x8*)(lds + PG8_SA(b, h) + aoff + m * 2048 + k * 1024); } } } while (0)
#define PG8_LDB(dst, b, h) do { _Pragma("unroll") for (int n = 0; n < 2; ++n) { \
        if constexpr (FP8) { const i32x4 lo_ = *(const PG8_LAS i32x4*)(lds + PG8_SB(b, h) + boff + n * 2048), hi_ = *(const PG8_LAS i32x4*)(lds + PG8_SB(b, h) + boff + n * 2048 + 1024); dst##8[n] = __builtin_shufflevector(lo_, hi_, 0, 1, 2, 3, 4, 5, 6, 7); } \
        else { _Pragma("unroll") for (int k = 0; k < 2; ++k) dst[n][k] = *(const PG8_LAS bf16x8*)(lds + PG8_SB(b, h) + boff + n * 2048 + k * 1024); } } } while (0)
#define PG8_MMA(ai, bj, At, Bt) do { __builtin_amdgcn_s_setprio(1); _Pragma("unroll") for (int m = 0; m < 4; ++m) _Pragma("unroll") for (int n = 0; n < 2; ++n) { \
        if constexpr (FP8) asm volatile("v_mfma_scale_f32_16x16x128_f8f6f4 %0, %1, %2, %0, %3, %3 op_sel_hi:[0,0,0]" : "+v"(acc[ai][bj][m][n]) : "v"(Bt##8[n]), "v"(At##8[m]), "v"(one_scale)); \
        else { _Pragma("unroll") for (int k = 0; k < 2; ++k) acc[ai][bj][m][n] = __builtin_amdgcn_mfma_f32_16x16x32_bf16(Bt[n][k], At[m][k], acc[ai][bj][m][n], 0, 0, 0); } } \
        __builtin_amdgcn_s_setprio(0); } while (0)
#define PG8_WAIT_V(n) asm volatile("s_waitcnt vmcnt(" #n ")" ::: "memory")
#define PG8_WAIT_L(n) asm volatile("s_waitcnt lgkmcnt(" #n ")" ::: "memory")
#define PG8_BAR __builtin_amdgcn_s_barrier()
#define PG8_SCHED __builtin_amdgcn_sched_barrier(0)
    Unit cur, nxt; int ui = 0;
    if (!S.next(0, cur)) return;
    f32x4 acc[2][2][4][2];
#pragma unroll
    for (int a = 0; a < 2; ++a)
#pragma unroll
        for (int b = 0; b < 2; ++b)
#pragma unroll
            for (int m = 0; m < 4; ++m)
#pragma unroll
                for (int n = 0; n < 2; ++n) acc[a][b][m][n] = (f32x4){0.f, 0.f, 0.f, 0.f};
    bf16x8 At[4][2], B0[2][2], B1[2][2]; i32x8 At8[4], B08[2], B18[2]; const int one_scale = 0x7f7f7f7f;
    const char* cA = (const char*)g.A + (size_t)cur.pm * tstepA + (size_t)cur.koff * 2; const char* cB = (const char*)g.Bt + (size_t)cur.pn * tstepB + (size_t)cur.koff * 2;
    S.a_ready(cur);
    PG8_STAGE(PG8_SB(0, 0), cB, voffB); PG8_STAGE(PG8_SA(0, 0), cA, voffA); PG8_STAGE(PG8_SB(0, 1), cB + hstepB, voffB); PG8_STAGE(PG8_SA(0, 1), cA + hstepA, voffA);
    if (wr == 1) PG8_BAR;
    PG8_WAIT_V(4); PG8_BAR;
    PG8_STAGE(PG8_SB(1, 0), cB + kstep, voffB); PG8_STAGE(PG8_SA(1, 0), cA + kstep, voffA); PG8_STAGE(PG8_SB(1, 1), cB + hstepB + kstep, voffB);
    PG8_WAIT_V(6); PG8_BAR;
    PG8_STAMP();
    for (;;) {
        const bool has_next = S.next(ui + 1, nxt);
        const char* nA = has_next ? (const char*)g.A + (size_t)nxt.pm * tstepA + (size_t)nxt.koff * 2 : cA; const char* nB = has_next ? (const char*)g.Bt + (size_t)nxt.pn * tstepB + (size_t)nxt.koff * 2 : cB;
        for (int t = 0; t < nt; t += 2) {
            const bool last = (t == nt - 2);
            const char* a1 = cA + (size_t)(t + 1) * kstep;
            const char* a2 = last ? nA : cA + (size_t)(t + 2) * kstep; const char* b2 = last ? nB : cB + (size_t)(t + 2) * kstep;
            const char* a3 = a2 + kstep; const char* b3 = b2 + kstep;
            if (last && has_next) S.a_ready(nxt);
            if constexpr (Epi::NMID > 0) { if (t == Epi::MID1 || t == Epi::MID2) E.mid(acc, cur, t, wr, wc, fr, fq); }
            PG8_LDB(B0, 0, 0); PG8_SCHED; PG8_LDA(At, 0, 0); PG8_STAGE(PG8_SA(1, 1), a1 + hstepA, voffA);
            PG8_WAIT_L(8); PG8_BAR; PG8_WAIT_L(0); PG8_MMA(0, 0, At, B0); PG8_BAR; PG8_SCHED;
            PG8_LDB(B1, 0, 1); PG8_STAGE(PG8_SB(0, 0), b2, voffB);
            PG8_BAR; PG8_WAIT_L(0); PG8_MMA(0, 1, At, B1); PG8_BAR;
            PG8_LDA(At, 0, 1); PG8_STAGE(PG8_SA(0, 0), a2, voffA);
            PG8_BAR; PG8_WAIT_L(0); PG8_MMA(1, 0, At, B0); PG8_BAR; PG8_SCHED;
            PG8_STAGE(PG8_SB(0, 1), b2 + hstepB, voffB);
            PG8_WAIT_V(6); PG8_BAR; PG8_MMA(1, 1, At, B1); PG8_BAR;
            PG8_LDB(B0, 1, 0); PG8_SCHED; PG8_LDA(At, 1, 0); PG8_STAGE(PG8_SA(0, 1), a2 + hstepA, voffA);
            PG8_WAIT_L(8); PG8_BAR; PG8_WAIT_L(0); PG8_MMA(0, 0, At, B0); PG8_BAR; PG8_SCHED;
            PG8_LDB(B1, 1, 1); PG8_STAGE(PG8_SB(1, 0), b3, voffB);
            PG8_BAR; PG8_WAIT_L(0); PG8_MMA(0, 1, At, B1); PG8_BAR;
            PG8_LDA(At, 1, 1); PG8_STAGE(PG8_SA(1, 0), a3, voffA);
            PG8_BAR; PG8_WAIT_L(0); PG8_MMA(1, 0, At, B0); PG8_BAR; PG8_SCHED;
            PG8_STAGE(PG8_SB(1, 1), b3 + hstepB, voffB);
            PG8_WAIT_V(6); PG8_BAR; PG8_MMA(1, 1, At, B1); PG8_BAR;
        }
        PG8_STAMP();
        if constexpr (FP8) asm volatile("s_nop 15\n\ts_nop 15" ::: "memory");
        if constexpr (!Epi::AFTER_DRAIN) { E(acc, cur, wr, wc, fr, fq); S.done(cur); }
        PG8_STAMP();
        if (!has_next) break;
#pragma unroll
        for (int a = 0; a < 2; ++a)
#pragma unroll
            for (int b = 0; b < 2; ++b)
#pragma unroll
                for (int m = 0; m < 4; ++m)
#pragma unroll
                    for (int n = 0; n < 2; ++n) acc[a][b][m][n] = (f32x4){0.f, 0.f, 0.f, 0.f};
        cur = nxt; cA = nA; cB = nB; ++ui;
    }
    PG8_WAIT_V(0);
    if (wr == 0) PG8_BAR;
    PG8_BAR;
    if constexpr (Epi::AFTER_DRAIN) { E.fused(acc, cur, wr, wc, fr, fq, lds, wid, lane); S.done(cur); }
    PG8_STAMP();
    if (STAMP && wid == 0) { stamps[lane] = lane < nts ? (((unsigned long long)(unsigned)ts_hi << 32) | (unsigned)ts_lo) : 0ull;
        if (lane == 62) stamps[62] = rt_entry; if (lane == 63) stamps[63] = (unsigned long long)wall_clock64(); }
#undef PG8_STAMP
#undef PG8_SA
#undef PG8_SB
#undef PG8_STAGE
#undef PG8_LDA
#undef PG8_LDB
#undef PG8_MMA
#undef PG8_WAIT_V
#undef PG8_WAIT_L
#undef PG8_BAR
#undef PG8_SCHED
}
}

#define GAS __attribute__((address_space(1)))
#define LAS __attribute__((address_space(3)))
#define DI __device__ __forceinline__
typedef unsigned short bf16;
typedef unsigned v4u __attribute__((ext_vector_type(4)));
typedef unsigned v2u __attribute__((ext_vector_type(2)));
typedef float f32x4 __attribute__((ext_vector_type(4)));
#define RLX_AGENT __ATOMIC_RELAXED, __HIP_MEMORY_SCOPE_AGENT
#define LDS_WAIT() asm volatile("s_waitcnt lgkmcnt(0)" ::: "memory")

constexpr int NWAVES = 8, NTHREADS = 512, GRID = 256;
#ifndef MK_N_LAUNCHES
#define MK_N_LAUNCHES 1
#endif
constexpr int PH_TOTAL = 21;
constexpr int N_LAUNCHES = MK_N_LAUNCHES;

constexpr size_t O_YP = 0, O_YS = O_YP + (size_t)MP * D, O_P_LRUH = O_YS + (size_t)MS * D, O_P_LRUC = O_P_LRUH + (size_t)DEPTH * NP * 1024,
    O_P_GLA = O_P_LRUC + (size_t)DEPTH * NP * 3 * 1024, O_P_C = O_P_GLA + (size_t)DEPTH * NP * 4 * 128 * 256, O_P_N = O_P_C + (size_t)DEPTH * NP * 4 * 256 * 256,
    O_P_M = O_P_N + (size_t)DEPTH * NP * 4 * 256, O_P_MLC = O_P_M + (size_t)DEPTH * NP * 4, O_S_LRUH = O_P_MLC + (size_t)DEPTH * NP * 3 * 1024,
    O_S_LRUC = O_S_LRUH + (size_t)DEPTH * NS * 1024, O_S_GLA = O_S_LRUC + (size_t)DEPTH * NS * 3 * 1024, O_S_C = O_S_GLA + (size_t)DEPTH * NS * 4 * 128 * 256,
    O_S_N = O_S_C + (size_t)DEPTH * NS * 4 * 256 * 256, O_S_M = O_S_N + (size_t)DEPTH * NS * 4 * 256, O_S_MLC = O_S_M + (size_t)DEPTH * NS * 4,
    O_END = O_S_MLC + (size_t)DEPTH * NS * 3 * 1024;
static_assert(O_END == 123798560, "output size");

constexpr size_t MiB = 1u << 20;
constexpr size_t WS_CTL = 0, CTL_ZERO_BYTES = 1 * MiB;
constexpr size_t WS_WADA = 2 * MiB, WS_WIN = 98 * MiB, WS_WBR = 196 * MiB, WS_WOUT = 220 * MiB, WS_WFF1 = 236 * MiB, WS_WFF2 = 300 * MiB;
constexpr size_t WS_CSILU = 364 * MiB, WS_MOD = 365 * MiB, WS_XA = 389 * MiB, WS_XB = 457 * MiB, WS_XN = 525 * MiB, WS_MERGED = 559 * MiB, WS_YCAT = 593 * MiB,
    WS_SMALL = 644 * MiB, WS_PROJ = 645 * MiB, WS_HFF = 849 * MiB, WS_GIMG = 985 * MiB, WS_MIMG = 1008 * MiB, WS_END = 1100 * MiB;
static_assert(WS_WADA + (size_t)2 * NADA * D * 2 <= WS_WIN && WS_WIN + (size_t)2 * NPROJ_PAD * D * 2 <= WS_WBR && WS_WBR + (size_t)2 * D * KBR * 2 <= WS_WOUT &&
              WS_WOUT + (size_t)2 * D * D * 2 <= WS_WFF1 && WS_WFF1 + (size_t)2 * DFF * D * 2 <= WS_WFF2 && WS_WFF2 + (size_t)2 * DFF * D * 2 <= WS_CSILU &&
              WS_CSILU + (size_t)256 * D * 2 <= WS_MOD && WS_MOD + (size_t)256 * 2 * NADA * 4 <= WS_XA && WS_XA + (size_t)MTOT * D * 4 <= WS_XB && WS_XB + (size_t)MTOT * D * 4 <= WS_XN &&
              WS_XN + (size_t)MTOT * D * 2 <= WS_MERGED && WS_MERGED + (size_t)MTOT * D * 2 <= WS_YCAT && WS_YCAT + (size_t)MTOT * KBR * 2 <= WS_SMALL &&
              WS_SMALL + (size_t)MTOT * NSMALL * 4 <= WS_PROJ && WS_PROJ + (size_t)MTOT * NPROJ * 2 <= WS_HFF && WS_HFF + (size_t)MTOT * DFF * 2 <= WS_GIMG && WS_GIMG + (size_t)512 * 46080 <= WS_MIMG && WS_MIMG + (size_t)512 * 115712 <= WS_END, "d_ws map");
constexpr size_t WS_WIN8_0 = WS_WFF1 + 32 * MiB, WS_WIN8_1 = WS_WFF2 + 32 * MiB, WS_XN8 = WS_HFF + 72 * MiB;
static_assert((size_t)2 * DFF * D <= 32 * MiB && (size_t)NPROJ_PAD * D <= 32 * MiB && (size_t)MTOT * DFF <= 72 * MiB && WS_XN8 + (size_t)MTOT * D <= WS_GIMG, "fp8 copies fit in the free halves");
constexpr size_t WS_MG8 = WS_PROJ + 104 * MiB;
static_assert((size_t)MTOT * PPITCH * 2 <= 104 * MiB && WS_MG8 + (size_t)MTOT * 6144 <= WS_HFF, "proj / gate buffers");
constexpr int CW_BAR = 4096;

constexpr int RING_OFF = 0, RING_BYTES = 131072;
constexpr int LDS_BYTES = 163840;
constexpr int LDSCTL_OFF = LDS_BYTES - 1024, MISC_OFF = LDSCTL_OFF + 320;

DI float bf2f(bf16 b) { return __uint_as_float(((unsigned)b) << 16); }
DI unsigned f2bf(float f) { unsigned u = __float_as_uint(f); return (u + 0x7fffu + ((u >> 16) & 1u)) >> 16; }
typedef float f32x2v __attribute__((ext_vector_type(2)));
typedef __bf16 bf16x2v __attribute__((ext_vector_type(2)));
DI unsigned pkbf(float a, float b) { const f32x2v v = {a, b}; const bf16x2v r = __builtin_convertvector(v, bf16x2v); return __builtin_bit_cast(unsigned, r); }
DI unsigned pk2(float lo, float hi) { return f2bf(lo) | (f2bf(hi) << 16); }
DI float bflo_(unsigned w) { return __uint_as_float(w << 16); }
DI float bfhi_(unsigned w) { return __uint_as_float(w & 0xffff0000u); }
DI float sigm(float x) { return __builtin_amdgcn_rcpf(1.f + __expf(-x)); }
DI float lru_in_scale(float la) { const float t = 2.f * la;
    const float em = (t > -0.125f) ? -t * (1.f + t * (0.5f + t * (0.16666667f + t * (0.041666668f + t * 0.0083333338f)))) : 1.f - __expf(t);
    return __builtin_amdgcn_sqrtf(em); }
DI float logsig(float x) { return fminf(x, 0.f) - __logf(1.f + __expf(-fabsf(x))); }
template <int CTRL, int ROWMASK> DI float dpp_f(float v) { return __int_as_float(__builtin_amdgcn_update_dpp(0, __float_as_int(v), CTRL, ROWMASK, 0xf, false)); }
DI float wave_sum(float v) {
    v += dpp_f<0xB1, 0xf>(v);
    v += dpp_f<0x4E, 0xf>(v);
    v += dpp_f<0x141, 0xf>(v);
    v += dpp_f<0x140, 0xf>(v);
    v += dpp_f<0x142, 0xa>(v);
    v += dpp_f<0x143, 0xc>(v);
    return __int_as_float(__builtin_amdgcn_readlane(__float_as_int(v), 63));
}

#define XB_TMO      128
#define XB_XCNT(j)  (256  + 64 * (j))
#define XB_XSUB(j)  (1280 + 64 * (j))
#define XB_XGEN(j)  (2304 + 64 * (j))
#define XB_TOP      3328
#define XB_TOPGEN   3392
#define XCD_BAR_WORDS 3456
#define XB_SPIN_CAP (1u << 18)

__device__ __forceinline__ unsigned xb_ld(unsigned* p)              { return __hip_atomic_load(p, __ATOMIC_RELAXED, __HIP_MEMORY_SCOPE_AGENT); }
__device__ __forceinline__ unsigned xb_add(unsigned* p, unsigned v) { return __hip_atomic_fetch_add(p, v, __ATOMIC_RELAXED, __HIP_MEMORY_SCOPE_AGENT); }
__device__ __forceinline__ unsigned xb_xcc_id() { return (unsigned)__builtin_amdgcn_s_getreg((3 << 11) | 20) & 0xFu; }
#define XB_SPIN(cond, bar) do { unsigned _sp = 0; while (cond) { __builtin_amdgcn_s_sleep(1); \
    if ((++_sp & 255u) == 0u) { if (xb_ld(&(bar)[XB_TMO])) break; if (_sp > XB_SPIN_CAP) { atomicAdd(&(bar)[XB_TMO], 1u); break; } } } } while (0)

struct XcdBarrier {
    unsigned* bar; unsigned x;
    volatile LAS unsigned* st;
};
__device__ __forceinline__ XcdBarrier xcd_barrier_post(unsigned* bar, volatile LAS unsigned* st) {
    XcdBarrier b; b.bar = bar; b.x = xb_xcc_id(); b.st = st;
    if (threadIdx.x == 0) (void)xb_add(&bar[XB_XCNT(b.x)], 1u);
    return b;
}
__device__ __forceinline__ void xcd_barrier_complete(unsigned* bar, unsigned x, unsigned& nloc, unsigned& nx) {
    const unsigned G = gridDim.x * gridDim.y * gridDim.z;
    unsigned sum, cnt, mine, sp = 0u;
    for (;;) {
        sum = 0u; cnt = 0u; mine = 0u;
#pragma unroll
        for (unsigned j = 0; j < 16; ++j) { const unsigned c = xb_ld(&bar[XB_XCNT(j)]); sum += c; cnt += (c > 0u) ? 1u : 0u; mine = (j == x) ? c : mine; }
        if (sum == G) break;
        __builtin_amdgcn_s_sleep(1);
        if ((++sp & 255u) == 0u) { if (xb_ld(&bar[XB_TMO])) break; if (sp > XB_SPIN_CAP) { atomicAdd(&bar[XB_TMO], 1u); break; } }
    }
    nloc = mine > 0u ? mine : 1u; nx = cnt > 0u ? cnt : 1u;
}
__device__ __forceinline__ void xcd_barrier(const XcdBarrier& b) {
    asm volatile("s_waitcnt vmcnt(0)" ::: "memory");
    __syncthreads();
    if (threadIdx.x == 0) {
        unsigned* bar = b.bar;
        __builtin_amdgcn_s_waitcnt(0);
        unsigned nloc = b.st[0], nx = b.st[1];
        if (nloc == 0u) { xcd_barrier_complete(bar, b.x, nloc, nx); b.st[0] = nloc; b.st[1] = nx; }
        const unsigned old = xb_add(&bar[XB_XSUB(b.x)], 1u);
        const unsigned gen = old / nloc;
        if (old + 1u == (gen + 1u) * nloc) {
            __builtin_amdgcn_fence(__ATOMIC_RELEASE, "agent");
            asm volatile("s_waitcnt vmcnt(0)" ::: "memory");
            const unsigned og = xb_add(&bar[XB_TOP], 1u);
            const unsigned tg = og / nx;
            if (og + 1u == (tg + 1u) * nx) xb_add(&bar[XB_TOPGEN], 1u);
            else XB_SPIN(xb_ld(&bar[XB_TOPGEN]) == tg, bar);
            __builtin_amdgcn_fence(__ATOMIC_ACQUIRE, "agent");
            xb_add(&bar[XB_XGEN(b.x)], 1u);
            asm volatile("s_waitcnt vmcnt(0)" ::: "memory");
        } else {
            XB_SPIN(xb_ld(&bar[XB_XGEN(b.x)]) == gen, bar);
            __builtin_amdgcn_fence(__ATOMIC_ACQUIRE, "agent");
            asm volatile("s_waitcnt vmcnt(0)" ::: "memory");
        }
    }
    __syncthreads();
}

struct Args { const float* in[40]; float* out; unsigned char* ws; int ph_lo, ph_hi, li, pad; };
typedef __attribute__((address_space(4))) const Args CArgs;
__device__ __forceinline__ CArgs* kargs() { CArgs* p = (CArgs*)__builtin_amdgcn_kernarg_segment_ptr(); asm volatile("" : "+s"(p)); return p; }

DI void transpose_item(const float* src, int src_ld, int ncols, bf16* dst, int dst_ld, LAS float* scr, int item, int lane) {
    const int nblk = ncols / 32, kb = item / nblk, nb = item % nblk, k0 = 64 * kb, n0 = 32 * nb;
#pragma unroll 8
    for (int i = 0; i < 32; ++i) { const int kk = 2 * i + (lane >> 5); scr[kk * 33 + (lane & 31)] = __builtin_nontemporal_load(src + (size_t)(k0 + kk) * src_ld + n0 + (lane & 31)); }
    LDS_WAIT(); asm volatile("" ::: "memory");
    const int c = lane & 7;
#pragma unroll
    for (int j = 0; j < 4; ++j) { const int n = (lane >> 3) + 8 * j; const LAS float* s = scr + (8 * c) * 33 + n;
        v4u o; o.x = pk2(s[0 * 33], s[1 * 33]); o.y = pk2(s[2 * 33], s[3 * 33]); o.z = pk2(s[4 * 33], s[5 * 33]); o.w = pk2(s[6 * 33], s[7 * 33]);
        *(v4u*)(dst + (size_t)(n0 + n) * dst_ld + k0 + 8 * c) = o; }
    LDS_WAIT(); asm volatile("" ::: "memory");
}
DI void transpose_item_f8(const float* src, int src_ld, int ncols, unsigned char* dst, int dst_ld, float scale, LAS float* scr, int item, int lane) {
    const int nblk = ncols / 32, kb = item / nblk, nb = item % nblk, k0 = 64 * kb, n0 = 32 * nb;
#pragma unroll 8
    for (int i = 0; i < 32; ++i) { const int kk = 2 * i + (lane >> 5); scr[kk * 33 + (lane & 31)] = __builtin_nontemporal_load(src + (size_t)(k0 + kk) * src_ld + n0 + (lane & 31)); }
    LDS_WAIT(); asm volatile("" ::: "memory");
    const int c = lane & 7;
#pragma unroll
    for (int j = 0; j < 4; ++j) { const int n = (lane >> 3) + 8 * j; const LAS float* s = scr + (8 * c) * 33 + n;
        v2u o; o.x = pg8::pk4_fp8(s[0 * 33] * scale, s[1 * 33] * scale, s[2 * 33] * scale, s[3 * 33] * scale); o.y = pg8::pk4_fp8(s[4 * 33] * scale, s[5 * 33] * scale, s[6 * 33] * scale, s[7 * 33] * scale);
        *(v2u*)(dst + (size_t)(n0 + n) * dst_ld + k0 + 8 * c) = o; }
    LDS_WAIT(); asm volatile("" ::: "memory");
}
DI void transpose_job_f8(const float* src, int src_ld, int K, int ncols, unsigned char* dst, int dst_ld, float scale, LAS float* scr, int gw, int ngw, int lane) {
    const int nitems = (K / 64) * (ncols / 32);
    for (int it = gw; it < nitems; it += ngw) transpose_item_f8(src, src_ld, ncols, dst, dst_ld, scale, scr, it, lane);
}
DI void transpose_job(const float* src, int src_ld, int K, int ncols, bf16* dst, int dst_ld, LAS float* scr, int gw, int ngw, int lane) {
    const int nitems = (K / 64) * (ncols / 32);
    for (int it = gw; it < nitems; it += ngw) transpose_item(src, src_ld, ncols, dst, dst_ld, scr, it, lane);
}

DI void norm_rows(const void* xp, const void* xs, bool in_f32, const float* g, const float* modp  ,
                  bf16* out_bf, float* outp, float* outs, int gw, int ngw, int lane, bf16* copy_out = nullptr,
                  int nslab = 0, const bf16* slab = nullptr, const float* sgate = nullptr, bf16* xs_out = nullptr, unsigned char* out_f8 = nullptr, unsigned char* out_f8_also = nullptr) {
    for (int row = gw; row < MTOT; row += ngw) {
        f32x4 v[8]; float ss = 0.f;
        if (in_f32) { const float* xr = row < MP ? (const float*)xp + (size_t)row * D : (const float*)xs + (size_t)(row - MP) * D; const f32x4* x4 = (const f32x4*)xr + lane;
#pragma unroll
            for (int j = 0; j < 8; ++j) v[j] = x4[64 * j];
            if (copy_out) {
#pragma unroll
                for (int j = 0; j < 8; ++j) { v2u w; w.x = pkbf(v[j].x, v[j].y); w.y = pkbf(v[j].z, v[j].w); *((v2u*)(copy_out + (size_t)row * D) + lane + 64 * j) = w; } }
        } else { const bf16* xr = row < MP ? (const bf16*)xp + (size_t)row * D : (const bf16*)xs + (size_t)(row - MP) * D; const v2u* x2 = (const v2u*)xr + lane;
#pragma unroll
            for (int j = 0; j < 8; ++j) { const v2u w = x2[64 * j]; v[j] = (f32x4){bflo_(w.x), bfhi_(w.x), bflo_(w.y), bfhi_(w.y)}; } }
        const int cond = row < MP ? (row >> 11) : NP + ((row - MP) >> 2);
        if (nslab > 0 && row >= MP) {
            const v2u* s4 = (const v2u*)(slab + (size_t)(row - MP) * D) + lane; const f32x4* gt4 = (const f32x4*)(sgate + (size_t)cond * 24576) + lane;
            v2u* xo = (v2u*)(xs_out + (size_t)(row - MP) * D) + lane;
#pragma unroll
            for (int j = 0; j < 8; ++j) { f32x4 a = {0.f, 0.f, 0.f, 0.f};
                for (int k = 0; k < nslab; ++k) { const v2u w = s4[(size_t)k * (MS * D / 4) + 64 * j]; a += (f32x4){bflo_(w.x), bfhi_(w.x), bflo_(w.y), bfhi_(w.y)}; }
                v[j] = v[j] + gt4[64 * j] * a; v2u w; w.x = pkbf(v[j].x, v[j].y); w.y = pkbf(v[j].z, v[j].w); xo[64 * j] = w; }
        }
#pragma unroll
        for (int j = 0; j < 8; ++j) ss += (v[j].x * v[j].x + v[j].y * v[j].y) + (v[j].z * v[j].z + v[j].w * v[j].w);
        ss = wave_sum(ss);
        const float r = __builtin_amdgcn_rsqf(ss * (1.f / D) + EPS);
        const f32x4* g4 = (const f32x4*)g + lane;
#pragma unroll
        for (int j = 0; j < 8; ++j) {
            f32x4 y = v[j] * r * g4[64 * j];
            if (modp) { const f32x4* m4 = (const f32x4*)(modp + (size_t)cond * 24576) + lane; const f32x4 sh = m4[64 * j], sc = m4[512 + 64 * j]; y = y * (1.f + sc) + sh; }
            if (out_f8_also) *((unsigned*)(out_f8_also + (size_t)row * D) + lane + 64 * j) = pg8::pk4_fp8(y.x, y.y, y.z, y.w);
            if (out_f8) *((unsigned*)(out_f8 + (size_t)row * D) + lane + 64 * j) = pg8::pk4_fp8(y.x, y.y, y.z, y.w);
            else if (out_bf) { v2u w; w.x = pk2(y.x, y.y); w.y = pk2(y.z, y.w); *((v2u*)(out_bf + (size_t)row * D) + lane + 64 * j) = w; }
            else { float* o = row < MP ? outp + (size_t)row * D : outs + (size_t)(row - MP) * D; *((f32x4*)o + lane + 64 * j) = y; }
        }
    }
}

DI float* out_state(float* out, int s, int l, size_t off_p, size_t off_s, size_t per) {
    return s < NP ? out + off_p + ((size_t)l * NP + s) * per : out + off_s + ((size_t)l * NS + (s - NP)) * per;
}

DI void lru_unit(int l, bool prompt, int grp, int n, LAS float* lds, int tid) {
    CArgs* A = kargs();
    LAS float* u_s = lds; LAS float* a_s = lds + 2048; LAS float* v_s = lds + 4096;
    const bf16* proj = (const bf16*)(A->ws + WS_PROJ); bf16* ycat = (bf16*)(A->ws + WS_YCAT); unsigned char* ycat8 = A->ws + WS_YCAT; (void)ycat; (void)ycat8;
    const float* cw = A->in[16] + (size_t)l * 4 * 1024; const float* cb = A->in[17] + (size_t)l * 1024;
    const float* wa = A->in[18] + ((size_t)l * 8 + n) * 128 * 128; const float* ba = A->in[19] + (size_t)l * 1024 + n * 128;
    const float* wx = A->in[20] + ((size_t)l * 8 + n) * 128 * 128; const float* bx = A->in[21] + (size_t)l * 1024 + n * 128;
    const float* lam = A->in[22] + (size_t)l * 1024 + n * 128;
    const float* st_h = A->in[4]; const float* st_c = A->in[5];
    const int ntiles = prompt ? TP / 16 : 1;
    const int c = tid & 127, rg = tid >> 7, ch = n * 128 + c;
    float h = 0.f;
    for (int tile = 0; tile < ntiles; ++tile) {
        {
            const float w0 = cw[ch], w1 = cw[1024 + ch], w2 = cw[2048 + ch], w3 = cw[3072 + ch], bb = cb[ch];
#pragma unroll
            for (int q = 0; q < 4; ++q) {
                const int r = 4 * rg + q;
                int s, t, T, row0;
                if (prompt) { s = grp; t = tile * 16 + r; T = TP; row0 = grp * TP; } else { s = NP + 4 * grp + (r >> 2); t = r & 3; T = TS; row0 = MP + (4 * grp + (r >> 2)) * TS; }
                float x[4];
#pragma unroll
                for (int jj = 0; jj < 4; ++jj) { const int tp = t - 3 + jj;
                    if (tp >= 0) x[jj] = bf2f(proj[(size_t)(row0 + tp) * PPITCH + C_LRUX + ch]);
                    else x[jj] = prompt ? 0.f : st_c[(((size_t)l * NS + (s - NP)) * 3 + (3 + tp)) * 1024 + ch]; }
                u_s[r * 128 + c] = bb + w0 * x[0] + w1 * x[1] + w2 * x[2] + w3 * x[3];
                if (t >= T - 3) out_state(A->out, s, l, O_P_LRUC, O_S_LRUC, 3 * 1024)[(size_t)(t - (T - 3)) * 1024 + ch] = x[3];
            }
        }
        __syncthreads();
        {
            float aa[4], ax[4];
#pragma unroll
            for (int q = 0; q < 4; ++q) { aa[q] = ba[c]; ax[q] = bx[c]; }
#pragma unroll 16
            for (int cc = 0; cc < 128; ++cc) { const float wa_ = wa[cc * 128 + c], wx_ = wx[cc * 128 + c];
#pragma unroll
                for (int q = 0; q < 4; ++q) { const float uq = u_s[(4 * rg + q) * 128 + cc]; aa[q] += uq * wa_; ax[q] += uq * wx_; } }
            const float ls = logsig(lam[c]);
#pragma unroll
            for (int q = 0; q < 4; ++q) { const int r = 4 * rg + q; const float rr = sigm(aa[q]), ii = sigm(ax[q]), la = 8.f * rr * ls;
                a_s[r * 128 + c] = __expf(la); v_s[r * 128 + c] = lru_in_scale(la) * (ii * u_s[r * 128 + c]); }
        }
        __syncthreads();
        if (prompt) {
            if (tid < 128) {
#pragma unroll 4
                for (int r = 0; r < 16; ++r) { h = a_s[r * 128 + c] * h + v_s[r * 128 + c];
                    ycat[(size_t)(grp * TP + tile * 16 + r) * KBR + ch] = (bf16)f2bf(h); }
            }
        } else {
            const int b = 4 * grp + rg; float hh = st_h[((size_t)l * NS + b) * 1024 + ch];
#pragma unroll
            for (int t = 0; t < 4; ++t) { const int r = rg * 4 + t; hh = a_s[r * 128 + c] * hh + v_s[r * 128 + c];
                ycat[(size_t)(MP + b * TS + t) * KBR + ch] = (bf16)f2bf(hh); }
            A->out[O_S_LRUH + ((size_t)l * NS + b) * 1024 + ch] = hh;
        }
    }
    if (prompt && tid < 128) A->out[O_P_LRUH + ((size_t)l * NP + grp) * 1024 + ch] = h;
    __syncthreads();
}

DI void gla_unit(int l, int s, int hh, LAS float* lds, int tid, int lane, int wave) {
    CArgs* A = kargs();
    const int b = s - NP, row0 = MP + b * TS;
    const bf16* proj = (const bf16*)(A->ws + WS_PROJ); bf16* ycat = (bf16*)(A->ws + WS_YCAT); unsigned char* ycat8 = A->ws + WS_YCAT; (void)ycat; (void)ycat8;     const float* sm = (const float*)(A->ws + WS_SMALL);
    const float* wg2 = A->in[23] + (size_t)l * 16 * 512; const float* bg = A->in[24] + (size_t)l * 512; const float* gn = A->in[25] + (size_t)l * 256;
    LAS float* eg_s = lds; LAS float* q_s = lds + 512; LAS float* k_s = lds + 1024; LAS float* v_s = lds + 1536; LAS float* part = lds + 2560;
    f32x4 S[16];
    { const f32x4* sp = (const f32x4*)(A->in[6] + ((((size_t)l * NS + b) * 4 + hh) * 128 + 16 * wave) * 256) + lane;
#pragma unroll
      for (int dd = 0; dd < 16; ++dd) S[dd] = __builtin_nontemporal_load(sp + dd * 64); }
    for (int i = tid; i < 4 * 128; i += NTHREADS) { const int tb = i >> 7, d = i & 127, col = hh * 128 + d; const size_t row = (size_t)(row0 + tb);
        float z = bg[col];
#pragma unroll
        for (int r = 0; r < 16; ++r) z += sm[row * NSMALL + r] * wg2[r * 512 + col];
        eg_s[i] = __expf(logsig(z) * (1.f / 16.f));
        q_s[i] = bf2f(proj[row * PPITCH + C_GQ + col]) * 0.08838834764831845f;
        k_s[i] = bf2f(proj[row * PPITCH + C_GK + col]); }
    for (int i = tid; i < 4 * 256; i += NTHREADS) { const int tb = i >> 8, ee = i & 255; v_s[i] = bf2f(proj[(size_t)(row0 + tb) * PPITCH + C_GV + hh * 256 + ee]); }
    __syncthreads();
#pragma unroll
    for (int tb = 0; tb < 4; ++tb) {
        const f32x4 v4 = *(const LAS f32x4*)(v_s + tb * 256 + 4 * lane); f32x4 po = {0.f, 0.f, 0.f, 0.f};
        const LAS float* egp = eg_s + tb * 128 + 16 * wave; const LAS float* kp = k_s + tb * 128 + 16 * wave; const LAS float* qp = q_s + tb * 128 + 16 * wave;
#pragma unroll
        for (int d4 = 0; d4 < 4; ++d4) { const f32x4 eg4 = *(const LAS f32x4*)(egp + 4 * d4), k4 = *(const LAS f32x4*)(kp + 4 * d4), q4 = *(const LAS f32x4*)(qp + 4 * d4);
            S[4 * d4 + 0] = S[4 * d4 + 0] * eg4.x + v4 * k4.x; po += S[4 * d4 + 0] * q4.x;
            S[4 * d4 + 1] = S[4 * d4 + 1] * eg4.y + v4 * k4.y; po += S[4 * d4 + 1] * q4.y;
            S[4 * d4 + 2] = S[4 * d4 + 2] * eg4.z + v4 * k4.z; po += S[4 * d4 + 2] * q4.z;
            S[4 * d4 + 3] = S[4 * d4 + 3] * eg4.w + v4 * k4.w; po += S[4 * d4 + 3] * q4.w; }
        *(LAS f32x4*)(part + (tb * 8 + wave) * 256 + 4 * lane) = po;
    }
    { f32x4* op = (f32x4*)(A->out + O_S_GLA + ((((size_t)l * NS + b) * 4 + hh) * 128 + 16 * wave) * 256) + lane;
#pragma unroll
      for (int dd = 0; dd < 16; ++dd) __builtin_nontemporal_store(S[dd], op + dd * 64); }
    __syncthreads();
    if (wave < 4) { const int tb = wave; const size_t row = (size_t)(row0 + tb);
        f32x4 ov = {0.f, 0.f, 0.f, 0.f};
#pragma unroll
        for (int w8 = 0; w8 < 8; ++w8) ov += *(const LAS f32x4*)(part + (tb * 8 + w8) * 256 + 4 * lane);
        float ss = (ov.x * ov.x + ov.y * ov.y) + (ov.z * ov.z + ov.w * ov.w); ss = wave_sum(ss);
        const float rs = __builtin_amdgcn_rsqf(ss * (1.f / 256.f) + EPS);
        const f32x4 g4 = *(const f32x4*)(gn + 4 * lane);
        const v2u gw = *(const v2u*)(proj + row * PPITCH + C_GGATE + hh * 256 + 4 * lane);
        const float z0 = __uint_as_float(gw.x << 16), z1 = __uint_as_float(gw.x & 0xffff0000u), z2 = __uint_as_float(gw.y << 16), z3 = __uint_as_float(gw.y & 0xffff0000u);
                *(unsigned*)(ycat8 + row * KBR + 1024 + hh * 256 + 4 * lane) = pg8::pk4_fp8(ov.x * rs * g4.x * (z0 * sigm(z0)), ov.y * rs * g4.y * (z1 * sigm(z1)), ov.z * rs * g4.z * (z2 * sigm(z2)), ov.w * rs * g4.w * (z3 * sigm(z3))); }
    __syncthreads();
}

DI void ml_unit(int l, int s, int hh, LAS float* lds, int tid, int lane, int wave) {
    CArgs* A = kargs();
    const int b = s - NP, row0 = MP + b * TS;
    const bf16* proj = (const bf16*)(A->ws + WS_PROJ); bf16* ycat = (bf16*)(A->ws + WS_YCAT); unsigned char* ycat8 = A->ws + WS_YCAT; (void)ycat; (void)ycat8;     const float* sm = (const float*)(A->ws + WS_SMALL);
    const float* mcw = A->in[26] + (size_t)l * 4 * 1024; const float* mcb = A->in[27] + (size_t)l * 1024;
    const float* wq = A->in[28] + (size_t)l * 256 * 16; const float* wk = A->in[29] + (size_t)l * 256 * 16; const float* wv = A->in[30] + (size_t)l * 256 * 16;
    const float* bif = A->in[31] + (size_t)l * 8; const float* gn = A->in[32] + (size_t)l * 256;
    LAS float* mx_s = lds; LAS float* mc_s = lds + 1792; LAS float* q_s = lds + 2816; LAS float* k_s = lds + 3840; LAS float* v_s = lds + 4864;
    LAS float* ig_s = lds + 5888; LAS float* lf_s = lds + 5896; LAS float* part = lds + 5904;
    const size_t bh = ((size_t)l * NS + b) * 4 + hh;
    f32x4 C[32];
    { const f32x4* cp = (const f32x4*)(A->in[7] + (bh * 256 + 32 * wave) * 256) + lane;
#pragma unroll
      for (int dd = 0; dd < 32; ++dd) C[dd] = __builtin_nontemporal_load(cp + dd * 64); }
    float nn[4]; { const f32x4 n4 = *(const f32x4*)(A->in[8] + bh * 256 + 4 * lane); nn[0] = n4.x; nn[1] = n4.y; nn[2] = n4.z; nn[3] = n4.w; }
    float m = A->in[9][bh];
    const int c0 = tid & 255, ch0 = hh * 256 + c0, wb0 = (64 * hh + (c0 >> 2)) * 16 + (c0 & 3);
    const float cw0 = mcw[ch0], cw1 = mcw[1024 + ch0], cw2 = mcw[2048 + ch0], cw3 = mcw[3072 + ch0], cbv = mcb[ch0];
    float wq4[4], wk4[4], wv4[4];
#pragma unroll
    for (int cc = 0; cc < 4; ++cc) { wq4[cc] = wq[wb0 + 4 * cc]; wk4[cc] = wk[wb0 + 4 * cc] * 0.0625f; wv4[cc] = wv[wb0 + 4 * cc]; }
    float gi = 0.f, gf = 0.f; if (tid < 4) { gi = sm[(size_t)(row0 + tid) * NSMALL + 16 + hh] + bif[hh]; gf = sm[(size_t)(row0 + tid) * NSMALL + 20 + hh] + bif[4 + hh]; }
    for (int i = tid; i < 7 * 256; i += NTHREADS) { const int tr = i >> 8, c = i & 255, tp = tr - 3, ch = hh * 256 + c;
        const float x = tp >= 0 ? bf2f(proj[(size_t)(row0 + tp) * PPITCH + C_MX + ch]) : A->in[10][(((size_t)l * NS + b) * 3 + (3 + tp)) * 1024 + ch];
        mx_s[i] = x;
        if (tp >= 1) A->out[O_S_MLC + (((size_t)l * NS + b) * 3 + (tp - 1)) * 1024 + ch] = x; }
    __syncthreads();
    for (int i = tid; i < 4 * 256; i += NTHREADS) { const int tb = i >> 8, c = i & 255;
        const float acc = cbv + cw0 * mx_s[tb * 256 + c] + cw1 * mx_s[(tb + 1) * 256 + c] + cw2 * mx_s[(tb + 2) * 256 + c] + cw3 * mx_s[(tb + 3) * 256 + c];
        mc_s[i] = acc * sigm(acc); }
    __syncthreads();
    for (int i = tid; i < 4 * 256; i += NTHREADS) { const int tb = i >> 8, c = i & 255, nq = c >> 2;
        float q = 0.f, k = 0.f, v = 0.f;
#pragma unroll
        for (int cc = 0; cc < 4; ++cc) { const float mcv = mc_s[tb * 256 + 4 * nq + cc], mxv = mx_s[(tb + 3) * 256 + 4 * nq + cc];
            q += mcv * wq4[cc]; k += mcv * wk4[cc]; v += mxv * wv4[cc]; }
        q_s[i] = q; k_s[i] = k; v_s[i] = v; }
    if (tid < 4) { ig_s[tid] = gi; lf_s[tid] = logsig(gf); }
    __syncthreads();
    for (int tb = 0; tb < 4; ++tb) {
        const float lf = lf_s[tb], ig = ig_s[tb];
        const float mnew = fmaxf(lf + m, ig), fdec = __expf(lf + m - mnew), iw = __expf(ig - mnew); m = mnew;
        const f32x4 k4n = *(const LAS f32x4*)(k_s + tb * 256 + 4 * lane), q4n = *(const LAS f32x4*)(q_s + tb * 256 + 4 * lane);
        nn[0] = fdec * nn[0] + iw * k4n.x; nn[1] = fdec * nn[1] + iw * k4n.y; nn[2] = fdec * nn[2] + iw * k4n.z; nn[3] = fdec * nn[3] + iw * k4n.w;
        const float den = wave_sum((q4n.x * nn[0] + q4n.y * nn[1]) + (q4n.z * nn[2] + q4n.w * nn[3]));
        if (tid == 0) ig_s[4 + tb] = 1.f / fmaxf(fabsf(den), __expf(-m));
        const f32x4 v4 = *(const LAS f32x4*)(v_s + tb * 256 + 4 * lane) * iw; f32x4 pn = {0.f, 0.f, 0.f, 0.f};
        const LAS float* kp = k_s + tb * 256 + 32 * wave; const LAS float* qp = q_s + tb * 256 + 32 * wave;
#pragma unroll
        for (int d4 = 0; d4 < 8; ++d4) { const f32x4 k4 = *(const LAS f32x4*)(kp + 4 * d4), q4 = *(const LAS f32x4*)(qp + 4 * d4);
            C[4 * d4 + 0] = C[4 * d4 + 0] * fdec + v4 * k4.x; pn += C[4 * d4 + 0] * q4.x;
            C[4 * d4 + 1] = C[4 * d4 + 1] * fdec + v4 * k4.y; pn += C[4 * d4 + 1] * q4.y;
            C[4 * d4 + 2] = C[4 * d4 + 2] * fdec + v4 * k4.z; pn += C[4 * d4 + 2] * q4.z;
            C[4 * d4 + 3] = C[4 * d4 + 3] * fdec + v4 * k4.w; pn += C[4 * d4 + 3] * q4.w; }
        *(LAS f32x4*)(part + (tb * 8 + wave) * 256 + 4 * lane) = pn;
    }
    { f32x4* cp = (f32x4*)(A->out + O_S_C + (bh * 256 + 32 * wave) * 256) + lane;
#pragma unroll
      for (int dd = 0; dd < 32; ++dd) __builtin_nontemporal_store(C[dd], cp + dd * 64);
      if (wave == 0) { f32x4 n4; n4.x = nn[0]; n4.y = nn[1]; n4.z = nn[2]; n4.w = nn[3]; *(f32x4*)(A->out + O_S_N + bh * 256 + 4 * lane) = n4; }
      if (tid == 0) A->out[O_S_M + bh] = m; }
    __syncthreads();
    if (wave < 4) { const int tb = wave; const size_t row = (size_t)(row0 + tb);
        f32x4 hv = {0.f, 0.f, 0.f, 0.f};
#pragma unroll
        for (int w8 = 0; w8 < 8; ++w8) hv += *(const LAS f32x4*)(part + (tb * 8 + w8) * 256 + 4 * lane);
        const float rd = ig_s[4 + tb];
        hv = hv * rd;
        float ss = (hv.x * hv.x + hv.y * hv.y) + (hv.z * hv.z + hv.w * hv.w); ss = wave_sum(ss);
        const float rs = __builtin_amdgcn_rsqf(ss * (1.f / 256.f) + EPS);
        const f32x4 g4 = *(const f32x4*)(gn + 4 * lane);
        const v2u ow = *(const v2u*)(proj + row * PPITCH + C_MO + hh * 256 + 4 * lane);
        const float z0 = __uint_as_float(ow.x << 16), z1 = __uint_as_float(ow.x & 0xffff0000u), z2 = __uint_as_float(ow.y << 16), z3 = __uint_as_float(ow.y & 0xffff0000u);
                *(unsigned*)(ycat8 + row * KBR + 2048 + hh * 256 + 4 * lane) = pg8::pk4_fp8(sigm(z0) * (hv.x * rs * g4.x), sigm(z1) * (hv.y * rs * g4.y), sigm(z2) * (hv.z * rs * g4.z), sigm(z3) * (hv.w * rs * g4.w)); }
    __syncthreads();
}

typedef short bf16x8 __attribute__((ext_vector_type(8)));
typedef float f32x16 __attribute__((ext_vector_type(16)));
#define GL_DSR128(dst, addr, off) asm volatile("ds_read_b128 %0, %1 offset:" #off : "=v"(dst) : "v"(addr))
#define GL_DSR2X64(dst, addr, o0, o1) asm volatile("ds_read2_b64 %0, %1 offset0:" #o0 " offset1:" #o1 : "=v"(dst) : "v"(addr))
#define GL_LWAIT(n, x) asm volatile("s_waitcnt lgkmcnt(" #n ")" : "+v"(x))
#define WG_RAW_BARRIER() asm volatile("s_waitcnt lgkmcnt(0)\n\ts_barrier" ::: "memory")
#define MFMA32(a, b, c) __builtin_amdgcn_mfma_f32_32x32x16_bf16((a), (b), (c), 0, 0, 0)
DI bf16x8 frag16(const LAS unsigned char* p) { return *(const LAS bf16x8*)p; }
DI bf16x8 frag8x2(const LAS unsigned char* p) { const v2u lo = *(const LAS v2u*)p, hi = *(const LAS v2u*)(p + 16);
    const v4u w = {lo.x, lo.y, hi.x, hi.y}; return __builtin_bit_cast(bf16x8, w); }
DI bf16x8 pack_acc(const f32x16& x, int s) {
    const v4u w = {pkbf(x[8 * s + 0], x[8 * s + 1]), pkbf(x[8 * s + 2], x[8 * s + 3]), pkbf(x[8 * s + 4], x[8 * s + 5]), pkbf(x[8 * s + 6], x[8 * s + 7])};
    return __builtin_bit_cast(bf16x8, w); }
DI unsigned short lds_u16(const LAS unsigned char* p) { return *(const LAS unsigned short*)p; }

constexpr int GL_QE = 0, GL_KE = 17408, GL_KDT = 34816, GL_V = 53248, GL_A = 87040, GL_SM = 96256, GL_SEG = 100352, GL_DEC = 102400, GL_OS = 0;
constexpr int GL_PQ = 272, GL_PT = 144, GL_PV = 528, GL_PO = 1040;
constexpr int GIMG_BYTES = 46080, GI_Q = 0, GI_K = 17408, GI_A = 35840, GI_D = 45056, GI_PIECES = 2848;
DI int gimg_lds_off(int idx) {
    return idx < 1088 ? GL_QE + idx * 16 : idx < 2240 ? GL_KDT + (idx - 1088) * 16 : idx < 2816 ? GL_A + (idx - 2240) * 16 : GL_DEC + (idx - 2816) * 16;
}
DI void gla_prep_unit(int l, int s, int hh, int c, LAS unsigned char* lds, int tid) {
    CArgs* A = kargs();
    const bf16* proj = (const bf16*)(A->ws + WS_PROJ); const float* sm = (const float*)(A->ws + WS_SMALL);
    const float* wg2 = A->in[23] + (size_t)l * 16 * 512; const float* bg = A->in[24] + (size_t)l * 512;
    const int lane = tid & 63, w = __builtin_amdgcn_readfirstlane(tid >> 6), r = lane & 31, h = lane >> 5;
    const int d_ = tid & 127, seg = __builtin_amdgcn_readfirstlane(tid >> 7);
    float wg[16];
#pragma unroll
    for (int q = 0; q < 16; ++q) wg[q] = wg2[q * 512 + hh * 128 + d_];
    const float bgv = bg[hh * 128 + d_];
    const int r0 = s * TP + 64 * c;
#pragma unroll
    for (int i = 0; i < 2; ++i) { const int idx = tid + 512 * i, row = idx >> 4, ch = idx & 15; const bf16* rp = proj + (size_t)(r0 + row) * PPITCH + hh * 128 + 8 * ch;
        *(LAS v4u*)(lds + GL_QE + row * GL_PQ + ch * 16) = *(const v4u*)(rp + C_GQ); *(LAS v4u*)(lds + GL_KE + row * GL_PQ + ch * 16) = *(const v4u*)(rp + C_GK); }
    if (tid < 256) { const int row = tid >> 2, qd = tid & 3; *(LAS f32x4*)(lds + GL_SM + row * 64 + qd * 16) = *(const f32x4*)(sm + (size_t)(r0 + row) * NSMALL + 4 * qd); }
    __syncthreads();
    float b[16]; float run = 0.f;
#pragma unroll
    for (int t = 0; t < 16; ++t) { const LAS f32x4* sp = (const LAS f32x4*)(lds + GL_SM + (16 * seg + t) * 64);
        const f32x4 s0 = sp[0], s1 = sp[1], s2 = sp[2], s3 = sp[3];
        float z = bgv;
        z += s0.x * wg[0] + s0.y * wg[1] + s0.z * wg[2] + s0.w * wg[3]; z += s1.x * wg[4] + s1.y * wg[5] + s1.z * wg[6] + s1.w * wg[7];
        z += s2.x * wg[8] + s2.y * wg[9] + s2.z * wg[10] + s2.w * wg[11]; z += s3.x * wg[12] + s3.y * wg[13] + s3.z * wg[14] + s3.w * wg[15];
        run += logsig(z) * (1.f / 16.f); b[t] = run; }
    *(LAS float*)(lds + GL_SEG + (seg * 128 + d_) * 4) = run;
    __syncthreads();
    { float pre = 0.f, tot = 0.f;
#pragma unroll
      for (int s2 = 0; s2 < 4; ++s2) { const float x = *(const LAS float*)(lds + GL_SEG + (s2 * 128 + d_) * 4); tot += x; pre += (s2 < seg) ? x : 0.f; }
      float kd[16];
#pragma unroll
      for (int t = 0; t < 16; ++t) { const int j = 16 * seg + t; const float bb = b[t] + pre;
          const float qraw = bf2f(*(const LAS unsigned short*)(lds + GL_QE + j * GL_PQ + d_ * 2)), kraw = bf2f(*(const LAS unsigned short*)(lds + GL_KE + j * GL_PQ + d_ * 2));
          const float qe = qraw * 0.08838834764831845f * __expf(bb), ke = kraw * __expf(-bb); kd[t] = kraw * __expf(tot - bb);
          *(LAS unsigned short*)(lds + GL_QE + j * GL_PQ + d_ * 2) = (unsigned short)(pkbf(qe, 0.f) & 0xffffu);
          *(LAS unsigned short*)(lds + GL_KE + j * GL_PQ + d_ * 2) = (unsigned short)(pkbf(ke, 0.f) & 0xffffu); }
      v4u k0, k1; k0.x = pkbf(kd[0], kd[1]); k0.y = pkbf(kd[2], kd[3]); k0.z = pkbf(kd[4], kd[5]); k0.w = pkbf(kd[6], kd[7]);
      k1.x = pkbf(kd[8], kd[9]); k1.y = pkbf(kd[10], kd[11]); k1.z = pkbf(kd[12], kd[13]); k1.w = pkbf(kd[14], kd[15]);
      *(LAS v4u*)(lds + GL_KDT + d_ * GL_PT + seg * 32) = k0; *(LAS v4u*)(lds + GL_KDT + d_ * GL_PT + seg * 32 + 16) = k1;
      if (seg == 0) *(LAS float*)(lds + GL_DEC + d_ * 4) = __expf(tot); }
    __syncthreads();
    if (w < 3) { const int it = (w >= 1) ? 1 : 0, jt = (w == 2) ? 1 : 0; f32x16 a;
#pragma unroll
        for (int i = 0; i < 16; ++i) a[i] = 0.f;
#pragma unroll
        for (int s8 = 0; s8 < 8; ++s8) a = MFMA32(frag16(lds + GL_QE + (32 * it + r) * GL_PQ + (16 * s8 + 8 * h) * 2), frag16(lds + GL_KE + (32 * jt + r) * GL_PQ + (16 * s8 + 8 * h) * 2), a);
#pragma unroll
        for (int reg = 0; reg < 16; ++reg) { const int i = 32 * it + (reg & 3) + 8 * (reg >> 2) + 4 * h, j = 32 * jt + r;
            *(LAS unsigned short*)(lds + GL_A + i * GL_PT + j * 2) = (unsigned short)(pkbf(j <= i ? a[reg] : 0.f, 0.f) & 0xffffu); } }
    __syncthreads();
    { unsigned char* img = A->ws + WS_GIMG + (size_t)((s * 4 + hh) * (TP / 64) + c) * GIMG_BYTES;
      for (int idx = tid; idx < GI_PIECES; idx += NTHREADS) *(v4u*)(img + idx * 16) = *(const LAS v4u*)(lds + gimg_lds_off(idx)); }
    __syncthreads();
}

DI void gla_seq_unit(int l, int s, int hh, LAS unsigned char* lds, int tid) {
    CArgs* A = kargs();
    const bf16* proj = (const bf16*)(A->ws + WS_PROJ); bf16* ycat = (bf16*)(A->ws + WS_YCAT); unsigned char* ycat8 = A->ws + WS_YCAT; (void)ycat; (void)ycat8;
    const float* gn = A->in[25] + (size_t)l * 256;
    const unsigned char* img0 = A->ws + WS_GIMG + (size_t)((s * 4 + hh) * (TP / 64)) * GIMG_BYTES;
    const int w = __builtin_amdgcn_readfirstlane(tid >> 6);
    f32x16 St[4];
#pragma unroll
    for (int dt = 0; dt < 4; ++dt)
#pragma unroll
        for (int i = 0; i < 16; ++i) St[dt][i] = 0.f;
    v4u pi[6], pv[4];
#define GLA_PREFETCH(cn) do { int tp_ = tid; asm volatile("" : "+v"(tp_)); const unsigned char* ib_ = img0 + (size_t)(cn) * GIMG_BYTES; \
        _Pragma("unroll") for (int i_ = 0; i_ < 6; ++i_) { const int idx_ = tp_ + 512 * i_; pi[i_] = (v4u){0u, 0u, 0u, 0u}; if (idx_ < GI_PIECES) pi[i_] = *(const v4u*)(ib_ + (unsigned)idx_ * 16u); } \
        const bf16* vb_ = proj + (size_t)(s * TP + 64 * (cn)) * PPITCH + C_GV + hh * 256; \
        _Pragma("unroll") for (int i_ = 0; i_ < 4; ++i_) { const int idx_ = tp_ + 512 * i_; pv[i_] = *(const v4u*)(vb_ + (unsigned)((idx_ >> 5) * PPITCH + 8 * (idx_ & 31))); } } while (0)
    GLA_PREFETCH(0);
    for (int c = 0; c < TP / 64; ++c) {
        const int r0 = s * TP + 64 * c;
        { int tz_ = tid; asm volatile("" : "+v"(tz_));
#pragma unroll
          for (int i = 0; i < 6; ++i) { const int idx = tz_ + 512 * i; if (idx < GI_PIECES) *(LAS v4u*)(lds + gimg_lds_off(idx)) = pi[i]; }
#pragma unroll
          for (int i = 0; i < 4; ++i) { const int idx = tz_ + 512 * i; *(LAS v4u*)(lds + GL_V + (idx >> 5) * GL_PV + (idx & 31) * 16) = pv[i]; } }
        WG_RAW_BARRIER();
        if (c + 1 < TP / 64) GLA_PREFETCH(c + 1);
        v2u gwv[8];
#pragma unroll
        for (int q = 0; q < 8; ++q) gwv[q] = *(const v2u*)(proj + (size_t)(r0 + 8 * w + q) * PPITCH + C_GGATE + hh * 256 + 4 * (tid & 63));
        f32x16 o0, o1;
        { int tz_ = tid; asm volatile("" : "+v"(tz_)); const int lane = tz_ & 63, r = lane & 31, h = lane >> 5;
#pragma unroll
        for (int i = 0; i < 16; ++i) { o0[i] = 0.f; o1[i] = 0.f; }
        { const unsigned qa = (unsigned)(__UINTPTR_TYPE__)(lds + GL_QE + r * GL_PQ + 8 * h), qb = qa + 32 * GL_PQ;
          v4u f0, f1, f2, f3;
          GL_DSR2X64(f0, qa, 0, 2);
          GL_DSR2X64(f1, qb, 0, 2);
          GL_DSR2X64(f2, qa, 4, 6);
          GL_DSR2X64(f3, qb, 4, 6);
          { const bf16x8 bfrag = pack_acc(St[0], 0);
            GL_LWAIT(3, f0); o0 = MFMA32(__builtin_bit_cast(bf16x8, f0), bfrag, o0); GL_DSR2X64(f0, qa, 8, 10);
            GL_LWAIT(3, f1); o1 = MFMA32(__builtin_bit_cast(bf16x8, f1), bfrag, o1); GL_DSR2X64(f1, qb, 8, 10);
          }
          { const bf16x8 bfrag = pack_acc(St[0], 1);
            GL_LWAIT(3, f2); o0 = MFMA32(__builtin_bit_cast(bf16x8, f2), bfrag, o0); GL_DSR2X64(f2, qa, 12, 14);
            GL_LWAIT(3, f3); o1 = MFMA32(__builtin_bit_cast(bf16x8, f3), bfrag, o1); GL_DSR2X64(f3, qb, 12, 14);
          }
          { const bf16x8 bfrag = pack_acc(St[1], 0);
            GL_LWAIT(3, f0); o0 = MFMA32(__builtin_bit_cast(bf16x8, f0), bfrag, o0); GL_DSR2X64(f0, qa, 16, 18);
            GL_LWAIT(3, f1); o1 = MFMA32(__builtin_bit_cast(bf16x8, f1), bfrag, o1); GL_DSR2X64(f1, qb, 16, 18);
          }
          { const bf16x8 bfrag = pack_acc(St[1], 1);
            GL_LWAIT(3, f2); o0 = MFMA32(__builtin_bit_cast(bf16x8, f2), bfrag, o0); GL_DSR2X64(f2, qa, 20, 22);
            GL_LWAIT(3, f3); o1 = MFMA32(__builtin_bit_cast(bf16x8, f3), bfrag, o1); GL_DSR2X64(f3, qb, 20, 22);
          }
          { const bf16x8 bfrag = pack_acc(St[2], 0);
            GL_LWAIT(3, f0); o0 = MFMA32(__builtin_bit_cast(bf16x8, f0), bfrag, o0); GL_DSR2X64(f0, qa, 24, 26);
            GL_LWAIT(3, f1); o1 = MFMA32(__builtin_bit_cast(bf16x8, f1), bfrag, o1); GL_DSR2X64(f1, qb, 24, 26);
          }
          { const bf16x8 bfrag = pack_acc(St[2], 1);
            GL_LWAIT(3, f2); o0 = MFMA32(__builtin_bit_cast(bf16x8, f2), bfrag, o0); GL_DSR2X64(f2, qa, 28, 30);
            GL_LWAIT(3, f3); o1 = MFMA32(__builtin_bit_cast(bf16x8, f3), bfrag, o1); GL_DSR2X64(f3, qb, 28, 30);
          }
          { const bf16x8 bfrag = pack_acc(St[3], 0);
            GL_LWAIT(3, f0); o0 = MFMA32(__builtin_bit_cast(bf16x8, f0), bfrag, o0);
            GL_LWAIT(2, f1); o1 = MFMA32(__builtin_bit_cast(bf16x8, f1), bfrag, o1);
          }
          { const bf16x8 bfrag = pack_acc(St[3], 1);
            GL_LWAIT(1, f2); o0 = MFMA32(__builtin_bit_cast(bf16x8, f2), bfrag, o0);
            GL_LWAIT(0, f3); o1 = MFMA32(__builtin_bit_cast(bf16x8, f3), bfrag, o1);
          }
        }
        { const unsigned aa = (unsigned)(__UINTPTR_TYPE__)(lds + GL_A + r * GL_PT + 16 * h), ka = (unsigned)(__UINTPTR_TYPE__)(lds + GL_KDT + r * GL_PT + 16 * h);
          v4u f0, f1, f2, f3;
          GL_DSR128(f0, aa, 0);
          GL_DSR128(f1, aa, 4608);
          GL_DSR128(f2, ka, 0);
          GL_DSR128(f3, ka, 4608);
#pragma unroll
          for (int dt = 0; dt < 4; ++dt)
#pragma unroll
              for (int g = 0; g < 4; ++g) { const f32x4 dc = *(const LAS f32x4*)(lds + GL_DEC + (32 * dt + 8 * g + 4 * h) * 4);
                  St[dt][4 * g + 0] *= dc.x; St[dt][4 * g + 1] *= dc.y; St[dt][4 * g + 2] *= dc.z; St[dt][4 * g + 3] *= dc.w; }
          { v4u x; const LAS unsigned char* vp = lds + GL_V + (0 + 8 * h) * GL_PV + (32 * w + r) * 2;
            x.x = (unsigned)lds_u16(vp) | ((unsigned)lds_u16(vp + GL_PV) << 16); x.y = (unsigned)lds_u16(vp + 2 * GL_PV) | ((unsigned)lds_u16(vp + 3 * GL_PV) << 16);
            x.z = (unsigned)lds_u16(vp + 4 * GL_PV) | ((unsigned)lds_u16(vp + 5 * GL_PV) << 16); x.w = (unsigned)lds_u16(vp + 6 * GL_PV) | ((unsigned)lds_u16(vp + 7 * GL_PV) << 16);
            const bf16x8 vf = __builtin_bit_cast(bf16x8, x);
            GL_LWAIT(3, f0); o0 = MFMA32(__builtin_bit_cast(bf16x8, f0), vf, o0); GL_DSR128(f0, ka, 9216);
            GL_LWAIT(3, f1); o1 = MFMA32(__builtin_bit_cast(bf16x8, f1), vf, o1); GL_DSR128(f1, ka, 13824);
            GL_LWAIT(3, f2); St[0] = MFMA32(__builtin_bit_cast(bf16x8, f2), vf, St[0]); GL_DSR128(f2, aa, 32);
            GL_LWAIT(3, f3); St[1] = MFMA32(__builtin_bit_cast(bf16x8, f3), vf, St[1]); GL_DSR128(f3, aa, 4640);
            GL_LWAIT(3, f0); St[2] = MFMA32(__builtin_bit_cast(bf16x8, f0), vf, St[2]); GL_DSR128(f0, ka, 32);
            GL_LWAIT(3, f1); St[3] = MFMA32(__builtin_bit_cast(bf16x8, f1), vf, St[3]); GL_DSR128(f1, ka, 4640);
          }
          { v4u x; const LAS unsigned char* vp = lds + GL_V + (16 + 8 * h) * GL_PV + (32 * w + r) * 2;
            x.x = (unsigned)lds_u16(vp) | ((unsigned)lds_u16(vp + GL_PV) << 16); x.y = (unsigned)lds_u16(vp + 2 * GL_PV) | ((unsigned)lds_u16(vp + 3 * GL_PV) << 16);
            x.z = (unsigned)lds_u16(vp + 4 * GL_PV) | ((unsigned)lds_u16(vp + 5 * GL_PV) << 16); x.w = (unsigned)lds_u16(vp + 6 * GL_PV) | ((unsigned)lds_u16(vp + 7 * GL_PV) << 16);
            const bf16x8 vf = __builtin_bit_cast(bf16x8, x);
            GL_LWAIT(3, f2); o0 = MFMA32(__builtin_bit_cast(bf16x8, f2), vf, o0); GL_DSR128(f2, ka, 9248);
            GL_LWAIT(3, f3); o1 = MFMA32(__builtin_bit_cast(bf16x8, f3), vf, o1); GL_DSR128(f3, ka, 13856);
            GL_LWAIT(3, f0); St[0] = MFMA32(__builtin_bit_cast(bf16x8, f0), vf, St[0]); GL_DSR128(f0, aa, 4672);
            GL_LWAIT(3, f1); St[1] = MFMA32(__builtin_bit_cast(bf16x8, f1), vf, St[1]); GL_DSR128(f1, ka, 64);
            GL_LWAIT(3, f2); St[2] = MFMA32(__builtin_bit_cast(bf16x8, f2), vf, St[2]); GL_DSR128(f2, ka, 4672);
            GL_LWAIT(3, f3); St[3] = MFMA32(__builtin_bit_cast(bf16x8, f3), vf, St[3]); GL_DSR128(f3, ka, 9280);
          }
          { v4u x; const LAS unsigned char* vp = lds + GL_V + (32 + 8 * h) * GL_PV + (32 * w + r) * 2;
            x.x = (unsigned)lds_u16(vp) | ((unsigned)lds_u16(vp + GL_PV) << 16); x.y = (unsigned)lds_u16(vp + 2 * GL_PV) | ((unsigned)lds_u16(vp + 3 * GL_PV) << 16);
            x.z = (unsigned)lds_u16(vp + 4 * GL_PV) | ((unsigned)lds_u16(vp + 5 * GL_PV) << 16); x.w = (unsigned)lds_u16(vp + 6 * GL_PV) | ((unsigned)lds_u16(vp + 7 * GL_PV) << 16);
            const bf16x8 vf = __builtin_bit_cast(bf16x8, x);
            GL_LWAIT(3, f0); o1 = MFMA32(__builtin_bit_cast(bf16x8, f0), vf, o1); GL_DSR128(f0, ka, 13888);
            GL_LWAIT(3, f1); St[0] = MFMA32(__builtin_bit_cast(bf16x8, f1), vf, St[0]); GL_DSR128(f1, aa, 4704);
            GL_LWAIT(3, f2); St[1] = MFMA32(__builtin_bit_cast(bf16x8, f2), vf, St[1]); GL_DSR128(f2, ka, 96);
            GL_LWAIT(3, f3); St[2] = MFMA32(__builtin_bit_cast(bf16x8, f3), vf, St[2]); GL_DSR128(f3, ka, 4704);
            GL_LWAIT(3, f0); St[3] = MFMA32(__builtin_bit_cast(bf16x8, f0), vf, St[3]); GL_DSR128(f0, ka, 9312);
          }
          { v4u x; const LAS unsigned char* vp = lds + GL_V + (48 + 8 * h) * GL_PV + (32 * w + r) * 2;
            x.x = (unsigned)lds_u16(vp) | ((unsigned)lds_u16(vp + GL_PV) << 16); x.y = (unsigned)lds_u16(vp + 2 * GL_PV) | ((unsigned)lds_u16(vp + 3 * GL_PV) << 16);
            x.z = (unsigned)lds_u16(vp + 4 * GL_PV) | ((unsigned)lds_u16(vp + 5 * GL_PV) << 16); x.w = (unsigned)lds_u16(vp + 6 * GL_PV) | ((unsigned)lds_u16(vp + 7 * GL_PV) << 16);
            const bf16x8 vf = __builtin_bit_cast(bf16x8, x);
            GL_LWAIT(3, f1); o1 = MFMA32(__builtin_bit_cast(bf16x8, f1), vf, o1); GL_DSR128(f1, ka, 13920);
            GL_LWAIT(3, f2); St[0] = MFMA32(__builtin_bit_cast(bf16x8, f2), vf, St[0]);
            GL_LWAIT(2, f3); St[1] = MFMA32(__builtin_bit_cast(bf16x8, f3), vf, St[1]);
            GL_LWAIT(1, f0); St[2] = MFMA32(__builtin_bit_cast(bf16x8, f0), vf, St[2]);
            GL_LWAIT(0, f1); St[3] = MFMA32(__builtin_bit_cast(bf16x8, f1), vf, St[3]);
          }
          asm volatile("" ::: "memory"); }
        }
        WG_RAW_BARRIER();
        { int tz_ = tid; asm volatile("" : "+v"(tz_)); const int lane = tz_ & 63, r = lane & 31, h = lane >> 5;
#pragma unroll
        for (int reg = 0; reg < 16; ++reg) { const int i = (reg & 3) + 8 * (reg >> 2) + 4 * h;
            *(LAS float*)(lds + GL_OS + i * GL_PO + (32 * w + r) * 4) = o0[reg]; *(LAS float*)(lds + GL_OS + (32 + i) * GL_PO + (32 * w + r) * 4) = o1[reg]; } }
        WG_RAW_BARRIER();
        { int tz_ = tid; asm volatile("" : "+v"(tz_)); const int lane = tz_ & 63;
        const f32x4 gn4 = *(const f32x4*)(gn + 4 * lane);
#pragma unroll
        for (int q = 0; q < 8; ++q) { const int i = 8 * w + q; const size_t row = (size_t)(r0 + i);
            const f32x4 ov = *(const LAS f32x4*)(lds + GL_OS + i * GL_PO + lane * 16);
            float ss = (ov.x * ov.x + ov.y * ov.y) + (ov.z * ov.z + ov.w * ov.w); ss = wave_sum(ss);
            const float rs = __builtin_amdgcn_rsqf(ss * (1.f / 256.f) + EPS);
            const v2u gw = gwv[q];
            const float z0 = __uint_as_float(gw.x << 16), z1 = __uint_as_float(gw.x & 0xffff0000u), z2 = __uint_as_float(gw.y << 16), z3 = __uint_as_float(gw.y & 0xffff0000u);
                        *(unsigned*)(ycat8 + row * KBR + 1024 + hh * 256 + 4 * lane) = pg8::pk4_fp8(ov.x * rs * gn4.x * (z0 * sigm(z0)), ov.y * rs * gn4.y * (z1 * sigm(z1)), ov.z * rs * gn4.z * (z2 * sigm(z2)), ov.w * rs * gn4.w * (z3 * sigm(z3))); } }
        WG_RAW_BARRIER();
    }
    { int tz_ = tid; asm volatile("" : "+v"(tz_)); const int lane = tz_ & 63, r = lane & 31, h = lane >> 5;
      float* op = A->out + O_P_GLA + (((size_t)l * NP + s) * 4 + hh) * 128 * 256 + 32 * w + r;
#pragma unroll
      for (int dt = 0; dt < 4; ++dt)
#pragma unroll
          for (int reg = 0; reg < 16; ++reg) op[(size_t)(32 * dt + (reg & 3) + 8 * (reg >> 2) + 4 * h) * 256] = St[dt][reg]; }
    __syncthreads();
}

constexpr int ML_Q = 0, ML_K = 33792, ML_KWT = 67584, ML_V = 104448, ML_S = 138240, ML_SC = 147456, ML_HS = 0;
constexpr int ML_PQ = 528, ML_PT = 144, ML_PH = 1040;
constexpr int IS_F = 0, IS_PM = 64, IS_RSP = 128, IS_NP = 192, IS_FL = 448, IS_CMAX = 449;
constexpr int SC_COLF = 512, SC_RDEN = 512, SC_QN = 576, SC_N = 1088, SC_CW = 576, SC_RAT = 1344;
static_assert(ML_SC + (576 + 1280) * 4 <= LDSCTL_OFF && 67 * 512 <= ML_V - ML_KWT, "mLSTM LDS map");
constexpr int MIMG_BYTES = 115712, MI_PIECES = 7232;
DI int mimg_lds_off(int idx) { return idx < 2112 ? ML_Q + idx * 16 : idx < 4416 ? ML_KWT + (idx - 2112) * 16 : idx < 6528 ? ML_V + (idx - 4416) * 16 : idx < 7104 ? ML_S + (idx - 6528) * 16 : ML_SC + (idx - 7104) * 16; }
DI float quad_bcast(float v, int cc) {
    const int x = __float_as_int(v); int y;
    switch (cc) { case 0: y = __builtin_amdgcn_mov_dpp(x, 0x00, 0xf, 0xf, true); break; case 1: y = __builtin_amdgcn_mov_dpp(x, 0x55, 0xf, 0xf, true); break;
                  case 2: y = __builtin_amdgcn_mov_dpp(x, 0xaa, 0xf, 0xf, true); break; default: y = __builtin_amdgcn_mov_dpp(x, 0xff, 0xf, 0xf, true); break; }
    return __int_as_float(y);
}
DI void ml_prep_unit(int l, int s, int hh, int c, LAS unsigned char* lds, int tid) {
    CArgs* A = kargs();
    const bf16* proj = (const bf16*)(A->ws + WS_PROJ); const float* sm = (const float*)(A->ws + WS_SMALL);
    const float* mcw = A->in[26] + (size_t)l * 4 * 1024; const float* mcb = A->in[27] + (size_t)l * 1024; const float* bif = A->in[31] + (size_t)l * 8;
    const int lane = tid & 63, w = __builtin_amdgcn_readfirstlane(tid >> 6), r = lane & 31, h = lane >> 5;
    const int c_ = tid & 255, seg = __builtin_amdgcn_readfirstlane(tid >> 8);
    LAS float* sc = (LAS float*)(lds + ML_SC);
    const int r0 = s * TP + 64 * c;
    { const bf16* pb = proj + ((ptrdiff_t)r0 - 3) * (ptrdiff_t)PPITCH + C_MX + hh * 256;
#pragma unroll
      for (int i = 0; i < 5; ++i) { const int idx = tid + 512 * i, row = idx >> 5; v4u x = {0u, 0u, 0u, 0u};
          if (idx < 2144) { if (64 * c - 3 + row >= 0) x = *(const v4u*)(pb + (unsigned)(row * PPITCH + 8 * (idx & 31))); *(LAS v4u*)(lds + ML_KWT + row * 512 + (idx & 31) * 16) = x; } }
      if (tid < 256) { const int ch0 = hh * 256 + tid;
          sc[SC_CW + tid] = mcw[ch0]; sc[SC_CW + 256 + tid] = mcw[1024 + ch0]; sc[SC_CW + 512 + tid] = mcw[2048 + ch0]; sc[SC_CW + 768 + tid] = mcw[3072 + ch0]; sc[SC_CW + 1024 + tid] = mcb[ch0]; }
      if (w == 0) {
          const float ig = sm[(size_t)(r0 + lane) * NSMALL + 16 + hh] + bif[hh];
          const float lf = logsig(sm[(size_t)(r0 + lane) * NSMALL + 20 + hh] + bif[4 + hh]);
          float F = lf;
#pragma unroll
          for (int o = 1; o < 64; o <<= 1) { const float t = __shfl_up(F, o); F += (lane >= o) ? t : 0.f; }
          const float colf = ig - F; float pm = colf;
#pragma unroll
          for (int o = 1; o < 64; o <<= 1) { const float t = __shfl_up(pm, o); pm = (lane >= o) ? fmaxf(pm, t) : pm; }
          sc[IS_F + lane] = F; sc[IS_PM + lane] = pm; sc[SC_COLF + lane] = colf;
          if (lane == 63) { sc[IS_FL] = F; sc[IS_CMAX] = pm; } } }
    float wq4[4], wk4[4], wv4[4];
    { const int wb = (64 * hh + (c_ >> 2)) * 16 + (c_ & 3);
#pragma unroll
      for (int cc = 0; cc < 4; ++cc) { wq4[cc] = A->in[28][(size_t)l * 4096 + wb + 4 * cc]; wk4[cc] = A->in[29][(size_t)l * 4096 + wb + 4 * cc] * 0.0625f; wv4[cc] = A->in[30][(size_t)l * 4096 + wb + 4 * cc]; } }
    __syncthreads();
    { const float cw0 = sc[SC_CW + c_], cw1 = sc[SC_CW + 256 + c_], cw2 = sc[SC_CW + 512 + c_], cw3 = sc[SC_CW + 768 + c_], cbv = sc[SC_CW + 1024 + c_];
      const LAS unsigned char* xp = lds + ML_KWT + (32 * seg) * 512 + c_ * 2;
      float x0 = bf2f(lds_u16(xp)), x1 = bf2f(lds_u16(xp + 512)), x2 = bf2f(lds_u16(xp + 1024));
#pragma unroll 8
      for (int t = 0; t < 32; ++t) {
          const float x3 = bf2f(lds_u16(xp + (3 + t) * 512));
          const float pre = cbv + cw0 * x0 + cw1 * x1 + cw2 * x2 + cw3 * x3, mc = pre * sigm(pre);
          float q = 0.f, k = 0.f, v = 0.f;
#pragma unroll
          for (int cc = 0; cc < 4; ++cc) { const float mcv = quad_bcast(mc, cc), xv = quad_bcast(x3, cc); q += mcv * wq4[cc]; k += mcv * wk4[cc]; v += xv * wv4[cc]; }
          const int j = 32 * seg + t;
          *(LAS unsigned short*)(lds + ML_Q + j * ML_PQ + c_ * 2) = (unsigned short)(pkbf(q, 0.f) & 0xffffu);
          *(LAS unsigned short*)(lds + ML_K + j * ML_PQ + c_ * 2) = (unsigned short)(pkbf(k, 0.f) & 0xffffu);
          *(LAS unsigned short*)(lds + ML_V + j * ML_PQ + c_ * 2) = (unsigned short)(pkbf(v, 0.f) & 0xffffu);
          if (c == TP / 64 - 1 && seg == 1 && t >= 29) A->out[O_P_MLC + (((size_t)l * NP + s) * 3 + (t - 29)) * 1024 + hh * 256 + c_] = x3;
          x0 = x1; x1 = x2; x2 = x3;
      } }
    __syncthreads();
    { const float cmax = sc[IS_CMAX]; float np = 0.f; v4u kk[4];
#pragma unroll
      for (int t8 = 0; t8 < 4; ++t8) { float kw[8];
#pragma unroll
          for (int t = 0; t < 8; ++t) { const int j = 32 * seg + 8 * t8 + t; kw[t] = bf2f(lds_u16(lds + ML_K + j * ML_PQ + c_ * 2)) * __expf(sc[SC_COLF + j] - cmax); np += kw[t]; }
          kk[t8].x = pkbf(kw[0], kw[1]); kk[t8].y = pkbf(kw[2], kw[3]); kk[t8].z = pkbf(kw[4], kw[5]); kk[t8].w = pkbf(kw[6], kw[7]); }
#pragma unroll
      for (int t8 = 0; t8 < 4; ++t8) *(LAS v4u*)(lds + ML_KWT + c_ * ML_PT + seg * 64 + t8 * 16) = kk[t8];
      sc[SC_QN + seg * 256 + c_] = np; }
    if (w < 3) { const int it = (w >= 1) ? 1 : 0, jt = (w == 2) ? 1 : 0; f32x16 a;
#pragma unroll
        for (int i = 0; i < 16; ++i) a[i] = 0.f;
#pragma unroll
        for (int s16 = 0; s16 < 16; ++s16) { a = MFMA32(frag16(lds + ML_Q + (32 * it + r) * ML_PQ + (16 * s16 + 8 * h) * 2), frag16(lds + ML_K + (32 * jt + r) * ML_PQ + (16 * s16 + 8 * h) * 2), a);
            if ((s16 & 3) == 3) asm volatile("" ::: "memory"); }
        const int j = 32 * jt + r; const float cf = sc[SC_COLF + j];
#pragma unroll
        for (int g = 0; g < 4; ++g) { const f32x4 pmv = *(const LAS f32x4*)(sc + IS_PM + 32 * it + 8 * g + 4 * h);
#pragma unroll
            for (int q = 0; q < 4; ++q) { const int i = 32 * it + 8 * g + 4 * h + q; const float val = (j <= i) ? a[4 * g + q] * __expf(cf - pmv[q]) : 0.f;
                *(LAS unsigned short*)(lds + ML_S + i * ML_PT + j * 2) = (unsigned short)(pkbf(val, 0.f) & 0xffffu); } } }
    __syncthreads();
    if (w == 0) { const int i = lane; float rs_ = 0.f;
#pragma unroll
        for (int k8 = 0; k8 < 8; ++k8) { const v4u sw = *(const LAS v4u*)(lds + ML_S + i * ML_PT + k8 * 16);
            const float t8 = (bflo_(sw.x) + bfhi_(sw.x)) + (bflo_(sw.y) + bfhi_(sw.y)) + (bflo_(sw.z) + bfhi_(sw.z)) + (bflo_(sw.w) + bfhi_(sw.w));
            rs_ += (k8 < 4 || i >= 32) ? t8 : 0.f; }
        sc[IS_RSP + i] = rs_; }
    if (tid < 256) sc[IS_NP + tid] = sc[SC_QN + tid] + sc[SC_QN + 256 + tid];
    __syncthreads();
    { unsigned char* img = A->ws + WS_MIMG + (size_t)((s * 4 + hh) * (TP / 64) + c) * MIMG_BYTES;
      for (int idx = tid; idx < MI_PIECES; idx += NTHREADS) *(v4u*)(img + (size_t)idx * 16) = *(const LAS v4u*)(lds + mimg_lds_off(idx)); }
    __syncthreads();
}

DI void ml_img_dma(const unsigned char* img, LAS unsigned char* lds, int ih, int w, int lane) {
    for (int k = w; k < MI_PIECES / 64; k += NWAVES) {
        const bool skip = ih ? (k < 16 || (k >= 102 && k < 106)) : ((k > 16 && k < 33) || (k > 106 && k < 111));
        if (!skip) __builtin_amdgcn_global_load_lds((const unsigned*)(img + (size_t)(64 * k + lane) * 16), (LAS unsigned*)(lds + mimg_lds_off(64 * k)), 16, 0, 0); }
}
#define ML_RAW_BARRIER() asm volatile("s_waitcnt lgkmcnt(0)\n\ts_barrier" ::: "memory")
#define ML_DSR128(dst, addr, off) asm volatile("ds_read_b128 %0, %1 offset:" #off : "=v"(dst) : "v"(addr))
#define ML_DSR2X64(dst, addr, o0, o1) asm volatile("ds_read2_b64 %0, %1 offset0:" #o0 " offset1:" #o1 : "=v"(dst) : "v"(addr))
#define ML_LWAIT(n, x) asm volatile("s_waitcnt lgkmcnt(" #n ")" : "+v"(x))
constexpr int ML_HB = 33792, ML_PHB = 528;
DI void ml_seq_unit(int l, int s, int hh, int ih, LAS unsigned char* lds, int tid) {
    CArgs* A = kargs();
    const bf16* proj = (const bf16*)(A->ws + WS_PROJ); bf16* ycat = (bf16*)(A->ws + WS_YCAT); unsigned char* ycat8 = A->ws + WS_YCAT; (void)ycat; (void)ycat8;
    const float* gn = A->in[32] + (size_t)l * 256;
    const unsigned char* img0 = A->ws + WS_MIMG + (size_t)((s * 4 + hh) * (TP / 64)) * MIMG_BYTES;
    const int w = __builtin_amdgcn_readfirstlane(tid >> 6);
    LAS float* sc = (LAS float*)(lds + ML_SC);
    f32x16 Ct[8];
#pragma unroll
    for (int dt = 0; dt < 8; ++dt)
#pragma unroll
        for (int i = 0; i < 16; ++i) Ct[dt][i] = 0.f;
    if (tid < 256) sc[SC_N + tid] = 0.f;
    float m = 0.f, sg = 1.f;
#ifdef PROBE_ABL
    const int abl = (kargs()->li == 1) ? PROBE_ABL : 0;
#else
    constexpr int abl = 0;
#endif
    __syncthreads();
    ml_img_dma(img0, lds, ih, w, tid & 63);
    for (int c = 0; c < TP / 64; ++c) {
        const int r0 = s * TP + 64 * c;
        if (c == 0) asm volatile("s_waitcnt vmcnt(0)" ::: "memory"); else asm volatile("s_waitcnt vmcnt(4)" ::: "memory");
        ML_RAW_BARRIER();
        { int tz_ = tid; asm volatile("" : "+v"(tz_)); const int i = tz_ & 63; float acc = 0.f;
#pragma unroll
          for (int k8 = 0; k8 < 4; ++k8) { const v4u qw = *(const LAS v4u*)(lds + ML_Q + i * ML_PQ + (32 * w + 8 * k8) * 2);
              const f32x4 n0 = *(const LAS f32x4*)(sc + SC_N + 32 * w + 8 * k8), n1 = *(const LAS f32x4*)(sc + SC_N + 32 * w + 8 * k8 + 4);
              acc += bflo_(qw.x) * n0.x + bfhi_(qw.x) * n0.y + bflo_(qw.y) * n0.z + bfhi_(qw.y) * n0.w + bflo_(qw.z) * n1.x + bfhi_(qw.z) * n1.y + bflo_(qw.w) * n1.z + bfhi_(qw.w) * n1.w; }
          sc[SC_QN + w * 64 + i] = acc;
          if (w == 1) sc[SC_RAT + i] = __expf(fminf(m - sc[IS_PM + i], 60.f)) * sg; }
        const float FL = sc[IS_FL], cmax = sc[IS_CMAX];
        const float cs = __expf(fminf(0.f, m - cmax)), s2 = __expf(fminf(0.f, cmax - m));
        v2u mo[4]; f32x4 gn4;
        { int tm_ = tid; asm volatile("" : "+v"(tm_)); const unsigned lo_ = 4u * (unsigned)(tm_ & 63);
          const bf16* mb_ = proj + (size_t)(r0 + 32 * ih + 4 * w) * PPITCH + C_MO + hh * 256;
#pragma unroll
          for (int q = 0; q < 4; ++q) mo[q] = *(const v2u*)(mb_ + (unsigned)(q * PPITCH) + lo_);
          gn4 = *(const f32x4*)(gn + lo_); }
        ML_RAW_BARRIER();
        f32x16 o0;
        { int tz_ = tid; asm volatile("" : "+v"(tz_)); const int lane = tz_ & 63, r = lane & 31, h = lane >> 5;
        if (w == 0) { const int i = lane; const float pmi = sc[IS_PM + i];
            float qn = 0.f;
#pragma unroll
            for (int p = 0; p < 8; ++p) qn += sc[SC_QN + p * 64 + i];
            const float den = __expf(fminf(0.f, m - pmi)) * qn + __expf(fminf(0.f, pmi - m)) * sc[IS_RSP + i];
            sc[SC_RDEN + i] = __expf(-fminf(fmaxf(m - pmi, 0.f), 60.f)) / fmaxf(fabsf(den), __expf(-(sc[IS_F + i] + fmaxf(m, pmi)))); }
        if (tz_ < 256) sc[SC_N + tz_] = cs * sc[SC_N + tz_] + s2 * sc[IS_NP + tz_];
#pragma unroll
        for (int i = 0; i < 16; ++i) o0[i] = 0.f;
        { const unsigned qa = (unsigned)(__UINTPTR_TYPE__)(lds + ML_Q + (32 * ih + r) * ML_PQ + 8 * h);
          v4u q0, q1, q2, q3;
          ML_DSR2X64(q0, qa, 0, 2);
          ML_DSR2X64(q1, qa, 4, 6);
          ML_DSR2X64(q2, qa, 8, 10);
          ML_DSR2X64(q3, qa, 12, 14);
          { const bf16x8 bfrag = pack_acc(Ct[0], 0); ML_LWAIT(3, q0); o0 = MFMA32(__builtin_bit_cast(bf16x8, q0), bfrag, o0); ML_DSR2X64(q0, qa, 16, 18); }
          { const bf16x8 bfrag = pack_acc(Ct[0], 1); ML_LWAIT(3, q1); o0 = MFMA32(__builtin_bit_cast(bf16x8, q1), bfrag, o0); ML_DSR2X64(q1, qa, 20, 22); }
          { const bf16x8 bfrag = pack_acc(Ct[1], 0); ML_LWAIT(3, q2); o0 = MFMA32(__builtin_bit_cast(bf16x8, q2), bfrag, o0); ML_DSR2X64(q2, qa, 24, 26); }
          { const bf16x8 bfrag = pack_acc(Ct[1], 1); ML_LWAIT(3, q3); o0 = MFMA32(__builtin_bit_cast(bf16x8, q3), bfrag, o0); ML_DSR2X64(q3, qa, 28, 30); }
          { const bf16x8 bfrag = pack_acc(Ct[2], 0); ML_LWAIT(3, q0); o0 = MFMA32(__builtin_bit_cast(bf16x8, q0), bfrag, o0); ML_DSR2X64(q0, qa, 32, 34); }
          { const bf16x8 bfrag = pack_acc(Ct[2], 1); ML_LWAIT(3, q1); o0 = MFMA32(__builtin_bit_cast(bf16x8, q1), bfrag, o0); ML_DSR2X64(q1, qa, 36, 38); }
          { const bf16x8 bfrag = pack_acc(Ct[3], 0); ML_LWAIT(3, q2); o0 = MFMA32(__builtin_bit_cast(bf16x8, q2), bfrag, o0); ML_DSR2X64(q2, qa, 40, 42); }
          { const bf16x8 bfrag = pack_acc(Ct[3], 1); ML_LWAIT(3, q3); o0 = MFMA32(__builtin_bit_cast(bf16x8, q3), bfrag, o0); ML_DSR2X64(q3, qa, 44, 46); }
          { const bf16x8 bfrag = pack_acc(Ct[4], 0); ML_LWAIT(3, q0); o0 = MFMA32(__builtin_bit_cast(bf16x8, q0), bfrag, o0); ML_DSR2X64(q0, qa, 48, 50); }
          { const bf16x8 bfrag = pack_acc(Ct[4], 1); ML_LWAIT(3, q1); o0 = MFMA32(__builtin_bit_cast(bf16x8, q1), bfrag, o0); ML_DSR2X64(q1, qa, 52, 54); }
          { const bf16x8 bfrag = pack_acc(Ct[5], 0); ML_LWAIT(3, q2); o0 = MFMA32(__builtin_bit_cast(bf16x8, q2), bfrag, o0); ML_DSR2X64(q2, qa, 56, 58); }
          { const bf16x8 bfrag = pack_acc(Ct[5], 1); ML_LWAIT(3, q3); o0 = MFMA32(__builtin_bit_cast(bf16x8, q3), bfrag, o0); ML_DSR2X64(q3, qa, 60, 62); }
          { const bf16x8 bfrag = pack_acc(Ct[6], 0); ML_LWAIT(3, q0); o0 = MFMA32(__builtin_bit_cast(bf16x8, q0), bfrag, o0); }
          { const bf16x8 bfrag = pack_acc(Ct[6], 1); ML_LWAIT(2, q1); o0 = MFMA32(__builtin_bit_cast(bf16x8, q1), bfrag, o0); }
          { const bf16x8 bfrag = pack_acc(Ct[7], 0); ML_LWAIT(1, q2); o0 = MFMA32(__builtin_bit_cast(bf16x8, q2), bfrag, o0); }
          { const bf16x8 bfrag = pack_acc(Ct[7], 1); ML_LWAIT(0, q3); o0 = MFMA32(__builtin_bit_cast(bf16x8, q3), bfrag, o0); }
        }
#pragma unroll
        for (int g = 0; g < 4; ++g) { const f32x4 p0 = *(const LAS f32x4*)(sc + SC_RAT + 32 * ih + 8 * g + 4 * h);
#pragma unroll
            for (int q = 0; q < 4; ++q) o0[4 * g + q] *= p0[q]; }
        sg *= cs;
        if (sg < 1e-12f) {
#pragma unroll
            for (int dt = 0; dt < 8; ++dt)
#pragma unroll
                for (int i = 0; i < 16; ++i) Ct[dt][i] *= sg;
            sg = 1.f; }
        const float vsc = s2 * __builtin_amdgcn_rcpf(sg);
        { const LAS unsigned char* vp = lds + ML_V + (8 * h) * ML_PQ + (32 * w + r) * 2;
          const unsigned ka = (unsigned)(__UINTPTR_TYPE__)(lds + ML_KWT + r * ML_PT + 16 * h);
          const LAS unsigned char* pp = lds + ML_S + (32 * ih + r) * ML_PT + 16 * h;
          v4u k0, k1, k2, k3;
          ML_DSR128(k0, ka, 0);
          ML_DSR128(k1, ka, 4608);
          ML_DSR128(k2, ka, 9216);
          ML_DSR128(k3, ka, 13824);
          { float vv[8];
#pragma unroll
            for (int jj = 0; jj < 8; ++jj) vv[jj] = bf2f(lds_u16(vp + (0 + jj) * ML_PQ));
            const v4u xu = {pkbf(vv[0], vv[1]), pkbf(vv[2], vv[3]), pkbf(vv[4], vv[5]), pkbf(vv[6], vv[7])};
            const v4u xs = {pkbf(vv[0] * vsc, vv[1] * vsc), pkbf(vv[2] * vsc, vv[3] * vsc), pkbf(vv[4] * vsc, vv[5] * vsc), pkbf(vv[6] * vsc, vv[7] * vsc)};
            const bf16x8 vf = __builtin_bit_cast(bf16x8, xu), vfs = __builtin_bit_cast(bf16x8, xs);
            o0 = MFMA32(frag16(pp + 0), vf, o0);
            ML_LWAIT(3, k0); Ct[0] = MFMA32(__builtin_bit_cast(bf16x8, k0), vfs, Ct[0]); ML_DSR128(k0, ka, 18432);
            ML_LWAIT(3, k1); Ct[1] = MFMA32(__builtin_bit_cast(bf16x8, k1), vfs, Ct[1]); ML_DSR128(k1, ka, 23040);
            ML_LWAIT(3, k2); Ct[2] = MFMA32(__builtin_bit_cast(bf16x8, k2), vfs, Ct[2]); ML_DSR128(k2, ka, 27648);
            ML_LWAIT(3, k3); Ct[3] = MFMA32(__builtin_bit_cast(bf16x8, k3), vfs, Ct[3]); ML_DSR128(k3, ka, 32256);
            ML_LWAIT(3, k0); Ct[4] = MFMA32(__builtin_bit_cast(bf16x8, k0), vfs, Ct[4]); ML_DSR128(k0, ka, 32);
            ML_LWAIT(3, k1); Ct[5] = MFMA32(__builtin_bit_cast(bf16x8, k1), vfs, Ct[5]); ML_DSR128(k1, ka, 4640);
            ML_LWAIT(3, k2); Ct[6] = MFMA32(__builtin_bit_cast(bf16x8, k2), vfs, Ct[6]); ML_DSR128(k2, ka, 9248);
            ML_LWAIT(3, k3); Ct[7] = MFMA32(__builtin_bit_cast(bf16x8, k3), vfs, Ct[7]); ML_DSR128(k3, ka, 13856);
          }
          { float vv[8];
#pragma unroll
            for (int jj = 0; jj < 8; ++jj) vv[jj] = bf2f(lds_u16(vp + (16 + jj) * ML_PQ));
            const v4u xu = {pkbf(vv[0], vv[1]), pkbf(vv[2], vv[3]), pkbf(vv[4], vv[5]), pkbf(vv[6], vv[7])};
            const v4u xs = {pkbf(vv[0] * vsc, vv[1] * vsc), pkbf(vv[2] * vsc, vv[3] * vsc), pkbf(vv[4] * vsc, vv[5] * vsc), pkbf(vv[6] * vsc, vv[7] * vsc)};
            const bf16x8 vf = __builtin_bit_cast(bf16x8, xu), vfs = __builtin_bit_cast(bf16x8, xs);
            o0 = MFMA32(frag16(pp + 32), vf, o0);
            ML_LWAIT(3, k0); Ct[0] = MFMA32(__builtin_bit_cast(bf16x8, k0), vfs, Ct[0]); ML_DSR128(k0, ka, 18464);
            ML_LWAIT(3, k1); Ct[1] = MFMA32(__builtin_bit_cast(bf16x8, k1), vfs, Ct[1]); ML_DSR128(k1, ka, 23072);
            ML_LWAIT(3, k2); Ct[2] = MFMA32(__builtin_bit_cast(bf16x8, k2), vfs, Ct[2]); ML_DSR128(k2, ka, 27680);
            ML_LWAIT(3, k3); Ct[3] = MFMA32(__builtin_bit_cast(bf16x8, k3), vfs, Ct[3]); ML_DSR128(k3, ka, 32288);
            ML_LWAIT(3, k0); Ct[4] = MFMA32(__builtin_bit_cast(bf16x8, k0), vfs, Ct[4]); ML_DSR128(k0, ka, 64);
            ML_LWAIT(3, k1); Ct[5] = MFMA32(__builtin_bit_cast(bf16x8, k1), vfs, Ct[5]); ML_DSR128(k1, ka, 4672);
            ML_LWAIT(3, k2); Ct[6] = MFMA32(__builtin_bit_cast(bf16x8, k2), vfs, Ct[6]); ML_DSR128(k2, ka, 9280);
            ML_LWAIT(3, k3); Ct[7] = MFMA32(__builtin_bit_cast(bf16x8, k3), vfs, Ct[7]); ML_DSR128(k3, ka, 13888);
          }
          { float vv[8];
#pragma unroll
            for (int jj = 0; jj < 8; ++jj) vv[jj] = bf2f(lds_u16(vp + (32 + jj) * ML_PQ));
            const v4u xu = {pkbf(vv[0], vv[1]), pkbf(vv[2], vv[3]), pkbf(vv[4], vv[5]), pkbf(vv[6], vv[7])};
            const v4u xs = {pkbf(vv[0] * vsc, vv[1] * vsc), pkbf(vv[2] * vsc, vv[3] * vsc), pkbf(vv[4] * vsc, vv[5] * vsc), pkbf(vv[6] * vsc, vv[7] * vsc)};
            const bf16x8 vf = __builtin_bit_cast(bf16x8, xu), vfs = __builtin_bit_cast(bf16x8, xs);
            if (ih == 1) o0 = MFMA32(frag16(pp + 64), vf, o0);
            ML_LWAIT(3, k0); Ct[0] = MFMA32(__builtin_bit_cast(bf16x8, k0), vfs, Ct[0]); ML_DSR128(k0, ka, 18496);
            ML_LWAIT(3, k1); Ct[1] = MFMA32(__builtin_bit_cast(bf16x8, k1), vfs, Ct[1]); ML_DSR128(k1, ka, 23104);
            ML_LWAIT(3, k2); Ct[2] = MFMA32(__builtin_bit_cast(bf16x8, k2), vfs, Ct[2]); ML_DSR128(k2, ka, 27712);
            ML_LWAIT(3, k3); Ct[3] = MFMA32(__builtin_bit_cast(bf16x8, k3), vfs, Ct[3]); ML_DSR128(k3, ka, 32320);
            ML_LWAIT(3, k0); Ct[4] = MFMA32(__builtin_bit_cast(bf16x8, k0), vfs, Ct[4]); ML_DSR128(k0, ka, 96);
            ML_LWAIT(3, k1); Ct[5] = MFMA32(__builtin_bit_cast(bf16x8, k1), vfs, Ct[5]); ML_DSR128(k1, ka, 4704);
            ML_LWAIT(3, k2); Ct[6] = MFMA32(__builtin_bit_cast(bf16x8, k2), vfs, Ct[6]); ML_DSR128(k2, ka, 9312);
            ML_LWAIT(3, k3); Ct[7] = MFMA32(__builtin_bit_cast(bf16x8, k3), vfs, Ct[7]); ML_DSR128(k3, ka, 13920);
          }
          { float vv[8];
#pragma unroll
            for (int jj = 0; jj < 8; ++jj) vv[jj] = bf2f(lds_u16(vp + (48 + jj) * ML_PQ));
            const v4u xu = {pkbf(vv[0], vv[1]), pkbf(vv[2], vv[3]), pkbf(vv[4], vv[5]), pkbf(vv[6], vv[7])};
            const v4u xs = {pkbf(vv[0] * vsc, vv[1] * vsc), pkbf(vv[2] * vsc, vv[3] * vsc), pkbf(vv[4] * vsc, vv[5] * vsc), pkbf(vv[6] * vsc, vv[7] * vsc)};
            const bf16x8 vf = __builtin_bit_cast(bf16x8, xu), vfs = __builtin_bit_cast(bf16x8, xs);
            if (ih == 1) o0 = MFMA32(frag16(pp + 96), vf, o0);
            ML_LWAIT(3, k0); Ct[0] = MFMA32(__builtin_bit_cast(bf16x8, k0), vfs, Ct[0]); ML_DSR128(k0, ka, 18528);
            ML_LWAIT(3, k1); Ct[1] = MFMA32(__builtin_bit_cast(bf16x8, k1), vfs, Ct[1]); ML_DSR128(k1, ka, 23136);
            ML_LWAIT(3, k2); Ct[2] = MFMA32(__builtin_bit_cast(bf16x8, k2), vfs, Ct[2]); ML_DSR128(k2, ka, 27744);
            ML_LWAIT(3, k3); Ct[3] = MFMA32(__builtin_bit_cast(bf16x8, k3), vfs, Ct[3]); ML_DSR128(k3, ka, 32352);
            ML_LWAIT(3, k0); Ct[4] = MFMA32(__builtin_bit_cast(bf16x8, k0), vfs, Ct[4]);
            ML_LWAIT(2, k1); Ct[5] = MFMA32(__builtin_bit_cast(bf16x8, k1), vfs, Ct[5]);
            ML_LWAIT(1, k2); Ct[6] = MFMA32(__builtin_bit_cast(bf16x8, k2), vfs, Ct[6]);
            ML_LWAIT(0, k3); Ct[7] = MFMA32(__builtin_bit_cast(bf16x8, k3), vfs, Ct[7]);
          }
          asm volatile("" ::: "memory"); }
        }
        m = FL + fmaxf(m, cmax);
        ML_RAW_BARRIER();
        { int tz_ = tid; asm volatile("" : "+v"(tz_)); const int lane = tz_ & 63, r = lane & 31, h = lane >> 5;
#pragma unroll
        for (int g = 0; g < 4; ++g) { const f32x4 d0 = *(const LAS f32x4*)(sc + SC_RDEN + 32 * ih + 8 * g + 4 * h);
#pragma unroll
            for (int q = 0; q < 4; ++q) { const int i = 8 * g + 4 * h + q;
                *(LAS unsigned short*)(lds + ML_HB + i * ML_PHB + (32 * w + r) * 2) = (unsigned short)(pkbf(o0[4 * g + q] * d0[q], 0.f) & 0xffffu); } }
        }
        float og[4][4];
#pragma unroll
        for (int q = 0; q < 4; ++q) { const v2u ow = mo[q];
            og[q][0] = sigm(__uint_as_float(ow.x << 16)) * gn4.x; og[q][1] = sigm(__uint_as_float(ow.x & 0xffff0000u)) * gn4.y;
            og[q][2] = sigm(__uint_as_float(ow.y << 16)) * gn4.z; og[q][3] = sigm(__uint_as_float(ow.y & 0xffff0000u)) * gn4.w; }
#pragma unroll
        for (int q = 0; q < 4; ++q) asm volatile("" : "+v"(og[q][0]), "+v"(og[q][1]), "+v"(og[q][2]), "+v"(og[q][3]));
        if (c + 1 < TP / 64 && !(abl & 1)) ml_img_dma(img0 + (size_t)(c + 1) * MIMG_BYTES, lds, ih, w, tid & 63);
        ML_RAW_BARRIER();
        { int tz_ = tid; asm volatile("" : "+v"(tz_)); const int lane = tz_ & 63;
#pragma unroll
        for (int q = 0; q < 4; ++q) { const int i = 4 * w + q; const size_t row = (size_t)(r0 + 32 * ih + i);
            const v2u hw = *(const LAS v2u*)(lds + ML_HB + i * ML_PHB + lane * 8);
            const float h0 = bflo_(hw.x), h1 = bfhi_(hw.x), h2 = bflo_(hw.y), h3 = bfhi_(hw.y);
            float ss = (h0 * h0 + h1 * h1) + (h2 * h2 + h3 * h3); ss = wave_sum(ss);
            const float rs = __builtin_amdgcn_rsqf(ss * (1.f / 256.f) + EPS);
                        *(unsigned*)(ycat8 + row * KBR + 2048 + hh * 256 + 4 * lane) = pg8::pk4_fp8(og[q][0] * (h0 * rs), og[q][1] * (h1 * rs), og[q][2] * (h2 * rs), og[q][3] * (h3 * rs)); }
        }
        ML_RAW_BARRIER();
    }
    { int tz_ = tid; asm volatile("" : "+v"(tz_)); const int lane = tz_ & 63, r = lane & 31, h = lane >> 5;
      const size_t bh = ((size_t)l * NP + s) * 4 + hh; float* cp = A->out + O_P_C + bh * 256 * 256 + 32 * w + r;
      if (ih == 0) {
#pragma unroll
      for (int dt = 0; dt < 8; ++dt)
#pragma unroll
          for (int reg = 0; reg < 16; ++reg) cp[(size_t)(32 * dt + (reg & 3) + 8 * (reg >> 2) + 4 * h) * 256] = Ct[dt][reg] * sg;
      if (tz_ < 256) A->out[O_P_N + bh * 256 + tz_] = sc[SC_N + tz_];
      if (tz_ == 0) A->out[O_P_M + bh] = m; } }
    __syncthreads();
}

constexpr int LR_WA = 0, LR_WX = 34816, LR_U = 69632, LR_UF = 87040, LR_AF = 119808, LR_SEG = 152576, LR_HC = 156672, LR_P = 272;
static_assert(LR_HC + 1024 <= LDSCTL_OFF, "LRU LDS map");
DI void lru_chunk_unit(int l, int s, int n, int dh, LAS unsigned char* lds, int tid) {
    CArgs* A = kargs();
    const bf16* proj = (const bf16*)(A->ws + WS_PROJ); unsigned char* ycat8 = A->ws + WS_YCAT;
    const float* cw = A->in[16] + (size_t)l * 4 * 1024 + n * 128; const float* cb = A->in[17] + (size_t)l * 1024 + n * 128;
    const float* wa = A->in[18] + ((size_t)l * 8 + n) * 128 * 128; const float* ba = A->in[19] + (size_t)l * 1024 + n * 128;
    const float* wx = A->in[20] + ((size_t)l * 8 + n) * 128 * 128; const float* bx = A->in[21] + (size_t)l * 1024 + n * 128;
    const float* lam = A->in[22] + (size_t)l * 1024 + n * 128;
    const int w = __builtin_amdgcn_readfirstlane(tid >> 6), seg = __builtin_amdgcn_readfirstlane(tid >> 7);
    for (int idx = tid; idx < 64 * 128; idx += NTHREADS) { const int c = idx >> 6, d = idx & 63;
        *(LAS unsigned short*)(lds + LR_WA + d * LR_P + c * 2) = (unsigned short)(pkbf(wa[c * 128 + 64 * dh + d], 0.f) & 0xffffu);
        *(LAS unsigned short*)(lds + LR_WX + d * LR_P + c * 2) = (unsigned short)(pkbf(wx[c * 128 + 64 * dh + d], 0.f) & 0xffffu); }
    if (tid < 256) *(LAS float*)(lds + LR_HC + tid * 4) = 0.f;
    const float w0 = cw[tid & 127], w1 = cw[1024 + (tid & 127)], w2 = cw[2048 + (tid & 127)], w3 = cw[3072 + (tid & 127)], bb = cb[tid & 127];
    const int dcol = 64 * dh + 32 * (w & 1) + (tid & 31);
    const float bav = ba[dcol], bxv = bx[dcol], ls = logsig(lam[dcol]);
    v4u pf[3];
#define LRU_PREFETCH(tn) do { int tp_ = tid; asm volatile("" : "+v"(tp_)); const bf16* pb_ = proj + ((ptrdiff_t)(s * TP + 64 * (tn)) - 3) * (ptrdiff_t)PPITCH + C_LRUX + n * 128; \
        _Pragma("unroll") for (int i_ = 0; i_ < 3; ++i_) { const int idx_ = tp_ + 512 * i_, row_ = idx_ >> 4; pf[i_] = (v4u){0u, 0u, 0u, 0u}; \
            if (idx_ < 1072 && 64 * (tn) - 3 + row_ >= 0) pf[i_] = *(const v4u*)(pb_ + (unsigned)(row_ * PPITCH + 8 * (idx_ & 15))); } } while (0)
    LRU_PREFETCH(0);
    __syncthreads();
    for (int tile = 0; tile < TP / 64; ++tile) {
        const int r0 = s * TP + 64 * tile;
        { int tz_ = tid; asm volatile("" : "+v"(tz_));
#pragma unroll
          for (int i = 0; i < 3; ++i) { const int idx = tz_ + 512 * i; if (idx < 1072) *(LAS v4u*)(lds + LR_AF + idx * 16) = pf[i]; } }
        WG_RAW_BARRIER();
        { int tz_ = tid; asm volatile("" : "+v"(tz_)); const int c = tz_ & 127;
          const LAS unsigned char* xp = lds + LR_AF + (16 * seg) * 256 + c * 2;
          float x0 = bf2f(lds_u16(xp)), x1 = bf2f(lds_u16(xp + 256)), x2 = bf2f(lds_u16(xp + 512));
#pragma unroll 8
          for (int t = 0; t < 16; ++t) { const float x3 = bf2f(lds_u16(xp + (3 + t) * 256)); const int j = 16 * seg + t;
              const float u = bb + w0 * x0 + w1 * x1 + w2 * x2 + w3 * x3;
              *(LAS unsigned short*)(lds + LR_U + j * LR_P + c * 2) = (unsigned short)(pkbf(u, 0.f) & 0xffffu);
              *(LAS float*)(lds + LR_UF + (j * 128 + c) * 4) = u;
              if (tile == TP / 64 - 1 && seg == 3 && t >= 13 && (c >> 6) == dh) A->out[O_P_LRUC + (((size_t)l * NP + s) * 3 + (t - 13)) * 1024 + n * 128 + c] = x3;
              x0 = x1; x1 = x2; x2 = x3; } }
        if (tile + 1 < TP / 64) LRU_PREFETCH(tile + 1);
        WG_RAW_BARRIER();
        if (w < 4) { int tz_ = tid; asm volatile("" : "+v"(tz_)); const int lane = tz_ & 63, r = lane & 31, h = lane >> 5;
          const int it = w >> 1, dtile = w & 1, dl = 32 * dtile + r, d = 64 * dh + dl;
          f32x16 ga, gx;
#pragma unroll
          for (int i = 0; i < 16; ++i) { ga[i] = 0.f; gx[i] = 0.f; }
#pragma unroll
          for (int s8 = 0; s8 < 8; ++s8) { const bf16x8 af = frag16(lds + LR_U + (32 * it + r) * LR_P + (16 * s8 + 8 * h) * 2);
              ga = MFMA32(af, frag16(lds + LR_WA + dl * LR_P + (16 * s8 + 8 * h) * 2), ga);
              gx = MFMA32(af, frag16(lds + LR_WX + dl * LR_P + (16 * s8 + 8 * h) * 2), gx); }
          float uu[16];
#pragma unroll
          for (int reg = 0; reg < 16; ++reg) { const int i = 32 * it + (reg & 3) + 8 * (reg >> 2) + 4 * h; uu[reg] = *(const LAS float*)(lds + LR_UF + (i * 128 + d) * 4); }
          asm volatile("" ::: "memory");
#pragma unroll
          for (int reg = 0; reg < 16; ++reg) { const int i = 32 * it + (reg & 3) + 8 * (reg >> 2) + 4 * h;
              const float rr = sigm(ga[reg] + bav), ii = sigm(gx[reg] + bxv), la = 8.f * rr * ls;
              LAS float* up = (LAS float*)(lds + LR_UF + (i * 128 + d) * 4);
              const float u = uu[reg];
              *(LAS float*)(lds + LR_AF + (i * 128 + d) * 4) = __expf(la);
              *up = lru_in_scale(la) * (ii * u); } }
        WG_RAW_BARRIER();
        float la_[8], lv_[8];
        { int tz_ = tid; asm volatile("" : "+v"(tz_)); const int dl = tz_ & 63, d = 64 * dh + dl;
          float Ap = 1.f, H = 0.f;
#pragma unroll
          for (int t = 0; t < 8; ++t) { const int i = 8 * w + t; la_[t] = *(const LAS float*)(lds + LR_AF + (i * 128 + d) * 4); lv_[t] = *(const LAS float*)(lds + LR_UF + (i * 128 + d) * 4); }
          asm volatile("" ::: "memory");
#pragma unroll
          for (int t = 0; t < 8; ++t) { H = la_[t] * H + lv_[t]; Ap *= la_[t]; }
          *(LAS float*)(lds + LR_SEG + (w * 64 + dl) * 4) = Ap; *(LAS float*)(lds + LR_SEG + 2048 + (w * 64 + dl) * 4) = H; }
        WG_RAW_BARRIER();
        { int tz_ = tid; asm volatile("" : "+v"(tz_)); const int dl = tz_ & 63;
          float hcur = *(const LAS float*)(lds + LR_HC + ((tile & 1) * 128 + dl) * 4);
          float pa_[7], ph_[7];
#pragma unroll
          for (int s2 = 0; s2 < 7; ++s2) { pa_[s2] = *(const LAS float*)(lds + LR_SEG + (s2 * 64 + dl) * 4); ph_[s2] = *(const LAS float*)(lds + LR_SEG + 2048 + (s2 * 64 + dl) * 4); }
          asm volatile("" ::: "memory");
#pragma unroll
          for (int s2 = 0; s2 < 7; ++s2) if (s2 < w) hcur = pa_[s2] * hcur + ph_[s2];
          unsigned char* yp = ycat8 + (size_t)(r0 + 8 * w) * KBR + n * 128 + 64 * dh + dl;
#pragma unroll
          for (int t = 0; t < 8; ++t) { hcur = la_[t] * hcur + lv_[t]; yp[(size_t)t * KBR] = (unsigned char)(pg8::pk4_fp8(hcur, 0.f, 0.f, 0.f) & 0xffu); }
          if (w == 7) { *(LAS float*)(lds + LR_HC + (((tile + 1) & 1) * 128 + dl) * 4) = hcur;
              if (tile == TP / 64 - 1) A->out[O_P_LRUH + ((size_t)l * NP + s) * 1024 + n * 128 + 64 * dh + dl] = hcur; } }
        WG_RAW_BARRIER();
    }
}

DI void lru_samp_unit(int l, int g, int n, LAS unsigned char* lds, int tid) {
    CArgs* A = kargs();
    const bf16* proj = (const bf16*)(A->ws + WS_PROJ); unsigned char* ycat8 = A->ws + WS_YCAT;
    const float* cw = A->in[16] + (size_t)l * 4 * 1024 + n * 128; const float* cb = A->in[17] + (size_t)l * 1024 + n * 128;
    const float* wa = A->in[18] + ((size_t)l * 8 + n) * 128 * 128; const float* ba = A->in[19] + (size_t)l * 1024 + n * 128;
    const float* wx = A->in[20] + ((size_t)l * 8 + n) * 128 * 128; const float* bx = A->in[21] + (size_t)l * 1024 + n * 128;
    const float* lam = A->in[22] + (size_t)l * 1024 + n * 128;
    const int w = __builtin_amdgcn_readfirstlane(tid >> 6), seg = __builtin_amdgcn_readfirstlane(tid >> 7);
    const int c = tid & 127, ch = n * 128 + c;
    float xs[4][7];
#pragma unroll
    for (int q = 0; q < 4; ++q) { const int b = 16 * g + 4 * seg + q;
#pragma unroll
        for (int j = 0; j < 3; ++j) xs[q][j] = A->in[5][(((size_t)l * NS + b) * 3 + j) * 1024 + ch];
#pragma unroll
        for (int t = 0; t < 4; ++t) xs[q][3 + t] = bf2f(proj[(size_t)(MP + b * TS + t) * PPITCH + C_LRUX + ch]); }
    const float w0 = cw[c], w1 = cw[1024 + c], w2 = cw[2048 + c], w3 = cw[3072 + c], bb = cb[c];
    const int dcol = 32 * (w & 3) + (tid & 31);
    const float bav = ba[dcol], bxv = bx[dcol], ls = logsig(lam[dcol]);
    float h0[4];
#pragma unroll
    for (int q = 0; q < 4; ++q) h0[q] = A->in[4][((size_t)l * NS + 16 * g + 4 * seg + q) * 1024 + ch];
    for (int idx = tid; idx < 128 * 128; idx += NTHREADS) { const int c2 = idx >> 7, d = idx & 127;
        *(LAS unsigned short*)(lds + LR_WA + d * LR_P + c2 * 2) = (unsigned short)(pkbf(wa[idx], 0.f) & 0xffffu);
        *(LAS unsigned short*)(lds + LR_WX + d * LR_P + c2 * 2) = (unsigned short)(pkbf(wx[idx], 0.f) & 0xffffu); }
#pragma unroll
    for (int q = 0; q < 4; ++q) { const int b = 16 * g + 4 * seg + q;
#pragma unroll
        for (int t = 0; t < 4; ++t) { const int j = 16 * seg + 4 * q + t; const float u = bb + w0 * xs[q][t] + w1 * xs[q][t + 1] + w2 * xs[q][t + 2] + w3 * xs[q][t + 3];
            *(LAS unsigned short*)(lds + LR_U + j * LR_P + c * 2) = (unsigned short)(pkbf(u, 0.f) & 0xffffu);
            *(LAS float*)(lds + LR_UF + (j * 128 + c) * 4) = u; }
#pragma unroll
        for (int j = 0; j < 3; ++j) A->out[O_S_LRUC + (((size_t)l * NS + b) * 3 + j) * 1024 + ch] = xs[q][4 + j]; }
    __syncthreads();
    { const int lane = tid & 63, r = lane & 31, h = lane >> 5, it = w >> 2, dtile = w & 3, d = 32 * dtile + r;
      f32x16 ga, gx;
#pragma unroll
      for (int i = 0; i < 16; ++i) { ga[i] = 0.f; gx[i] = 0.f; }
#pragma unroll
      for (int s8 = 0; s8 < 8; ++s8) { const bf16x8 af = frag16(lds + LR_U + (32 * it + r) * LR_P + (16 * s8 + 8 * h) * 2);
          ga = MFMA32(af, frag16(lds + LR_WA + d * LR_P + (16 * s8 + 8 * h) * 2), ga);
          gx = MFMA32(af, frag16(lds + LR_WX + d * LR_P + (16 * s8 + 8 * h) * 2), gx); }
#pragma unroll
      for (int reg = 0; reg < 16; ++reg) { const int i = 32 * it + (reg & 3) + 8 * (reg >> 2) + 4 * h;
          const float rr = sigm(ga[reg] + bav), ii = sigm(gx[reg] + bxv), la = 8.f * rr * ls;
          LAS float* up = (LAS float*)(lds + LR_UF + (i * 128 + d) * 4);
          const float u = *up;
          *(LAS float*)(lds + LR_AF + (i * 128 + d) * 4) = __expf(la);
          *up = lru_in_scale(la) * (ii * u); } }
    __syncthreads();
#pragma unroll
    for (int q = 0; q < 4; ++q) { const int b = 16 * g + 4 * seg + q; float hc = h0[q];
#pragma unroll
        for (int t = 0; t < 4; ++t) { const int j = 16 * seg + 4 * q + t;
            hc = *(const LAS float*)(lds + LR_AF + (j * 128 + c) * 4) * hc + *(const LAS float*)(lds + LR_UF + (j * 128 + c) * 4);
            ycat8[(size_t)(MP + b * TS + t) * KBR + ch] = (unsigned char)(pg8::pk4_fp8(hc, 0.f, 0.f, 0.f) & 0xffu); }
        A->out[O_S_LRUH + ((size_t)l * NS + b) * 1024 + ch] = hc; }
    __syncthreads();
}

#ifndef EN_PRO
#define EN_PRO 1
#endif
#ifndef EN_MOD
#define EN_MOD 1
#endif
#ifndef EN_NORM
#define EN_NORM 1
#endif
#ifndef EN_PROJ
#define EN_PROJ 1
#endif
#ifndef EN_MIX
#define EN_MIX 1
#endif
#ifndef EN_MERGE
#define EN_MERGE 1
#endif
#ifndef EN_OUT
#define EN_OUT 1
#endif
#ifndef EN_FF1
#define EN_FF1 1
#endif
#ifndef EN_FF2
#define EN_FF2 1
#endif
#ifndef EN_ML
#define EN_ML 1
#endif
#ifndef EN_GLA
#define EN_GLA 1
#endif
#ifndef EN_LRU
#define EN_LRU 1
#endif
#ifndef REP_MIXP
#define REP_MIXP 1
#endif
#ifndef REP_ML
#define REP_ML 1
#endif
#ifndef REP_GLA
#define REP_GLA 1
#endif
#ifndef REP_LRU
#define REP_LRU 1
#endif
#ifndef REP_MIXS
#define REP_MIXS 1
#endif
#ifndef REP_GEMM
#define REP_GEMM 1
#endif
#ifndef REP_PROJ
#define REP_PROJ REP_GEMM
#endif
#ifndef REP_MERGE
#define REP_MERGE REP_GEMM
#endif
#ifndef REP_OUT
#define REP_OUT REP_GEMM
#endif
#ifndef REP_FF1
#define REP_FF1 REP_GEMM
#endif
#ifndef REP_FF2
#define REP_FF2 REP_GEMM
#endif
#ifndef REP_PRO
#define REP_PRO 1
#endif
#ifndef REP_MIX
#define REP_MIX 1
#endif
#ifndef REP_NORM
#define REP_NORM 1
#endif
#define WSP(T, off) ((T*)(ws + (off)))

DI void conv_win(CArgs* A, unsigned char* ws, int l, LAS float* scr, int gw, int ngw, int lane, int gtid, int gthreads, int what = 7) {
    const float* w_in = A->in[15] + (size_t)l * D * DIN; bf16* wt_in = WSP(bf16, WS_WIN) + (size_t)l * NPROJ_PAD * D;
    if (what & 1) transpose_job(w_in, DIN, D, 3072, wt_in, D, scr, gw, ngw, lane);
    unsigned char* wt8 = ws + (WS_WIN8_0 + (size_t)l * (WS_WIN8_1 - WS_WIN8_0));
    if (what & 4) {
    transpose_job_f8(w_in + 3088, DIN, D, 1024, wt8 + (size_t)3072 * D, D, 64.f, scr, gw, ngw, lane);
    transpose_job(w_in + 3088 + 1024, DIN, D, 1024, wt_in + (size_t)4096 * D, D, scr, gw, ngw, lane); }
    if (!(what & 2)) return;
    transpose_job_f8(w_in + 3088 + 2048, DIN, D, 1024, wt8 + (size_t)5120 * D, D, 64.f, scr, gw, ngw, lane);
    transpose_job_f8(w_in + 6168, DIN, D, 6144, wt8 + (size_t)6144 * D, D, 64.f, scr, gw, ngw, lane);
    for (int i = gtid; i < 256 * D; i += gthreads) { const int j = i >> 11, k = i & 2047;
        const float v = j < 24 ? w_in[(size_t)k * DIN + (j < 16 ? 3072 + j : 6160 + (j - 16))] : 0.f;
        wt_in[(size_t)(NPROJ + j) * D + k] = (bf16)f2bf(v); }
}
DI void conv_rest(CArgs* A, unsigned char* ws, int l, LAS float* scr, int gw, int ngw, int lane, bool with_ff2, bool with_br = true) {
    if (with_br) {
    unsigned char* wt_br = ws + WS_WBR + (size_t)l * D * KBR;
    transpose_job_f8(A->in[33] + (size_t)l * 1024 * D, D, 1024, D, wt_br, KBR, 64.f, scr, gw, ngw, lane);
    transpose_job_f8(A->in[34] + (size_t)l * 1024 * D, D, 1024, D, wt_br + 1024, KBR, 64.f, scr, gw, ngw, lane);
    transpose_job_f8(A->in[35] + (size_t)l * 1024 * D, D, 1024, D, wt_br + 2048, KBR, 64.f, scr, gw, ngw, lane);
    transpose_job_f8(A->in[36] + (size_t)l * D * D, D, D, D, ws + WS_WOUT + (size_t)l * D * D, D, 64.f, scr, gw, ngw, lane); }
    if (with_ff2) { const float* src = A->in[37] + (size_t)l * D * DFF; unsigned char* dst = ws + WS_WFF1 + (size_t)l * DFF * D;
      for (int it = gw; it < (D / 64) * (DFF / 32); it += ngw) transpose_item_f8(src, DFF, DFF, dst, D, 64.f, scr, it, lane); }
    if (with_ff2) { const float* src = A->in[38] + (size_t)l * DFF * D; unsigned char* dst = ws + WS_WFF2 + (size_t)l * D * DFF;
      for (int it = gw; it < (DFF / 64) * (D / 32); it += ngw) transpose_item_f8(src, D, D, dst, DFF, 64.f, scr, it, lane); }
}
__global__ void __launch_bounds__(NTHREADS, 2) mk_fwd(Args a_unused) {
    extern __shared__ __attribute__((aligned(16))) unsigned char lds_raw[];
    LAS unsigned char* lds = (LAS unsigned char*)lds_raw;
    const int bid = blockIdx.x;
    constexpr int G = GRID, ngw = GRID * NWAVES;
#define TIDS() int tid_ = threadIdx.x; asm volatile("" : "+v"(tid_)); const int tid = tid_, lane = tid & 63, wave = __builtin_amdgcn_readfirstlane(tid >> 6), gw = bid * NWAVES + wave; (void)lane; (void)gw
    for (int u = threadIdx.x; u < (LDS_BYTES - LDSCTL_OFF) / 4; u += NTHREADS) ((LAS unsigned*)(lds + LDSCTL_OFF))[u] = 0u;
    __syncthreads();
    int lo, hi;
    { CArgs* A = kargs(); lo = A->ph_lo; hi = A->ph_hi;
      (void)xcd_barrier_post((unsigned*)(A->ws + WS_CTL) + CW_BAR + A->li * XCD_BAR_WORDS, (volatile LAS unsigned*)(lds + MISC_OFF) + 8); }
#define IN(k) (lo <= (k) && (k) < hi)
#define SEAM(k) do { if (IN(k) && IN((k) + 1)) { CArgs* Ab = kargs(); XcdBarrier bar; bar.bar = (unsigned*)(Ab->ws + WS_CTL) + CW_BAR + Ab->li * XCD_BAR_WORDS; bar.x = xb_xcc_id(); \
        bar.st = (volatile LAS unsigned*)(lds + MISC_OFF) + 8; xcd_barrier(bar); } } while (0)

    if (EN_PRO && IN(0)) for (int rep_ = 0; rep_ < REP_PRO; ++rep_) {
        if (rep_) __syncthreads();
        TIDS(); CArgs* A = kargs(); unsigned char* const ws = A->ws;
        LAS float* scr = (LAS float*)(lds + RING_OFF + wave * 16384);
        for (int l = 0; l < DEPTH; ++l) transpose_job(A->in[11] + (size_t)l * D * NADA, NADA, D, NADA, WSP(bf16, WS_WADA) + (size_t)l * NADA * D, D, scr, gw, ngw, lane);
        for (int l = 0; l < DEPTH; ++l) { conv_win(A, ws, l, scr, gw, ngw, lane, bid * NTHREADS + tid, G * NTHREADS, l == 0 ? 7 : 2); conv_rest(A, ws, l, scr, gw, ngw, lane, l == 0, l == 0); }
        bf16* csilu = WSP(bf16, WS_CSILU);
        for (int i = bid * NTHREADS + tid; i < 256 * D; i += G * NTHREADS) { const int r = i >> 11, c = i & 2047;
            float v = 0.f;
            if (r < NP) v = A->in[2][r * D + c]; else if (r < NB) v = A->in[3][(r - NP) * D + c];
            csilu[i] = (bf16)f2bf(r < NB ? v * sigm(v) : 0.f); }
    }
    SEAM(0);

    if (EN_MOD && IN(1)) {
        CArgs* A = kargs(); unsigned char* const ws = A->ws;
        pg8::Gemm g{WSP(bf16, WS_CSILU), WSP(bf16, WS_WADA), 256, 2 * NADA, D, D, D}; pg8::StaticOrder S; S.init(256, 2 * NADA, G, bid);
        pg8::EpiF32 E{WSP(float, WS_MOD), 2 * NADA, A->in[12]};
        pg8::gemm_phase<pg8::EpiF32, pg8::StaticOrder>(lds + RING_OFF, g, S, E, nullptr);
    }
    SEAM(1);

    for (int l = 0; l < DEPTH; ++l) {
        const int pb = 2 + 9 * l;
        if (EN_NORM && IN(pb + 0)) { TIDS(); CArgs* A = kargs(); unsigned char* const ws = A->ws;
            if (l == 0) norm_rows(A->in[0], A->in[1], true, A->in[13] + (size_t)l * D, WSP(float, WS_MOD) + (size_t)l * NADA, WSP(bf16, WS_XN), nullptr, nullptr, gw, ngw, lane, WSP(bf16, WS_XB), 0, nullptr, nullptr, nullptr, nullptr, ws + WS_XN8);
            else norm_rows(WSP(bf16, WS_XB), WSP(bf16, WS_XA) + (size_t)MP * D, false, A->in[13] + (size_t)l * D, WSP(float, WS_MOD) + (size_t)l * NADA, WSP(bf16, WS_XN), nullptr, nullptr, gw, ngw, lane, nullptr,
                           16, WSP(bf16, WS_GIMG), WSP(float, WS_MOD) + (size_t)(l - 1) * NADA + 10240, WSP(bf16, WS_XB) + (size_t)MP * D, nullptr, ws + WS_XN8); }
        SEAM(pb + 0);
        if (EN_PROJ && IN(pb + 1)) for (int rg_ = 0; rg_ < REP_PROJ; ++rg_) { CArgs* A = kargs(); unsigned char* const ws = A->ws;
            { pg8::Gemm g{WSP(bf16, WS_XN), WSP(bf16, WS_WIN) + (size_t)l * NPROJ_PAD * D, MTOT, NPROJ_PAD, D, D, D};
              pg8::TileMapOrder S; S.so.init(MTOT, 17 * 256, G, bid); S.t1 = 12; S.t2 = 16; S.s0 = 0; S.s1 = 4; S.s2 = 32;
              pg8::EpiProj E{WSP(bf16, WS_PROJ), WSP(float, WS_SMALL), 1.f, ws + WS_MG8};
              pg8::gemm_phase<pg8::EpiProj, pg8::TileMapOrder>(lds + RING_OFF, g, S, E, nullptr); }
            { pg8::Gemm g{(const bf16*)(ws + WS_XN8), (const bf16*)(ws + (WS_WIN8_0 + (size_t)l * (WS_WIN8_1 - WS_WIN8_0))), MTOT, NPROJ_PAD, D / 2, D / 2, D / 2};
              pg8::TileMapOrder S; S.so.init(MTOT, 32 * 256, G, bid); S.t1 = 4; S.t2 = 8; S.s0 = 12; S.s1 = 16; S.s2 = 16; S.nh = 72; S.sk = 2;
              pg8::EpiProj E{WSP(bf16, WS_PROJ), WSP(float, WS_SMALL), 1.f / 64.f, ws + WS_MG8};
              pg8::gemm_phase<pg8::EpiProj, pg8::TileMapOrder, true>(lds + RING_OFF, g, S, E, nullptr); } }
        SEAM(pb + 1);
        if (EN_MIX && IN(pb + 2)) {
            TIDS();
            for (int u = bid; u < 1024; u += G) { if (u < 512) ml_prep_unit(l, u >> 7, (u >> 5) & 3, u & 31, lds + RING_OFF, tid); else gla_prep_unit(l, (u - 512) >> 7, (u >> 5) & 3, u & 31, lds + RING_OFF, tid); }
        }
        SEAM(pb + 2);
        if (EN_MIX && IN(pb + 3)) for (int rep_ = 0; rep_ < REP_MIX; ++rep_) {
            if (rep_) __syncthreads();
            TIDS();
            LAS float* fl = (LAS float*)(lds + RING_OFF);
#ifdef PROBE_S
            if (kargs()->li == 1 && bid < 112) {} else
#endif
            if (bid < 112) { if (rep_ == 0 || REP_MIXP) {
            if (bid < 32) { if (EN_ML && (rep_ == 0 || REP_ML)) ml_seq_unit(l, bid >> 3, (bid >> 1) & 3, bid & 1, lds + RING_OFF, tid); }
            else if (bid < 48) { if (EN_GLA && (rep_ == 0 || REP_GLA)) gla_seq_unit(l, (bid - 32) >> 2, bid & 3, lds + RING_OFF, tid); }
            else if (bid < 112) { if (EN_LRU && (rep_ == 0 || REP_LRU)) lru_chunk_unit(l, (bid - 48) >> 4, ((bid - 48) >> 1) & 7, bid & 1, lds + RING_OFF, tid); }
            } }
            else if (rep_ == 0 || REP_MIXS) for (int v = bid - 112; v < 1280; v += G - 112) {
                if (v < 512) { if (EN_ML) ml_unit(l, NP + (v >> 2), v & 3, fl, tid, lane, wave); }
                else if (v < 1024) { if (EN_GLA) gla_unit(l, NP + ((v - 512) >> 2), v & 3, fl, tid, lane, wave); }
                else { if (EN_LRU && v < 1024 + 64) lru_samp_unit(l, (v - 1024) >> 3, v & 7, lds + RING_OFF, tid); }
            }
            if (bid >= 112 && rep_ == 0) {
                __syncthreads();
                CArgs* A = kargs(); LAS float* scr = (LAS float*)(lds + RING_OFF + wave * 16384);
                const float* src = (l == 0 ? A->in[38] : A->in[37]) + (size_t)DFF * D; unsigned char* dst = A->ws + (l == 0 ? WS_WFF2 : WS_WFF1) + (size_t)D * DFF;
                const int sld = l == 0 ? D : DFF, dld = l == 0 ? DFF : D;
                for (int it = (bid - 112) * NWAVES + wave; it < (DFF / 64) * (D / 32); it += (G - 112) * NWAVES) transpose_item_f8(src, sld, sld, dst, dld, 64.f, scr, it, lane);
                __syncthreads(); }
        }
        SEAM(pb + 3);
        if (EN_MERGE && IN(pb + 4)) for (int rg_ = 0; rg_ < REP_MERGE; ++rg_) { CArgs* A = kargs(); unsigned char* const ws = A->ws;
            { pg8::Gemm g{WSP(bf16, WS_YCAT), (const bf16*)(ws + WS_WBR + (size_t)l * D * KBR), MP, D, KBR / 2, KBR / 2, KBR / 2}; pg8::StaticOrder S; S.init(MP, D, G, bid);
              pg8::EpiMergeF8 E{ws + WS_MG8, ws + WS_MERGED, 8.f / 64.f};
              pg8::gemm_phase<pg8::EpiMergeF8, pg8::StaticOrder, true>(lds + RING_OFF, g, S, E, nullptr); }
            { pg8::Gemm g{WSP(bf16, WS_YCAT), (const bf16*)(ws + WS_WBR + (size_t)l * D * KBR), MTOT, D, 512, KBR / 2, KBR / 2}; pg8::SplitOrder S{MP / 256, MS / 256, D / 256, 3, 512, G, bid};
              pg8::EpiGateSlab E{ws + WS_MG8, (bf16*)(ws + WS_GIMG + 64 * MiB), 9, 1.f / 64.f};
              pg8::gemm_phase<pg8::EpiGateSlab, pg8::SplitOrder, true>(lds + RING_OFF, g, S, E, nullptr); }
            if (l == 0 && (int)blockIdx.x >= 48 && rg_ == 0) {
                __syncthreads();
                CArgs* A2 = kargs(); int t_ = (int)threadIdx.x; asm volatile("" : "+v"(t_));
                const int wv_ = __builtin_amdgcn_readfirstlane(t_ >> 6);
                conv_win(A2, A2->ws, 1, (LAS float*)(lds + RING_OFF + wv_ * 16384), ((int)blockIdx.x - 48) * NWAVES + wv_, (G - 48) * NWAVES, t_ & 63, 0, 1, 1);
                __syncthreads(); } }
        SEAM(pb + 4);
        if (EN_OUT && IN(pb + 5)) for (int rg_ = 0; rg_ < REP_OUT; ++rg_) { CArgs* A = kargs(); unsigned char* const ws = A->ws;
            { TIDS();
              const bf16* sl = (const bf16*)(ws + WS_GIMG + 64 * MiB); unsigned char* mg = ws + WS_MERGED + (size_t)MP * D;
              for (int row = gw; row < MS; row += ngw) { const v2u* s4 = (const v2u*)(sl + (size_t)row * D) + lane;
#pragma unroll
                  for (int j = 0; j < 8; ++j) { const v2u w0 = s4[64 * j], w1 = s4[(size_t)(MS * D / 4) + 64 * j], w2 = s4[(size_t)2 * (MS * D / 4) + 64 * j];
                      const f32x4 v = (f32x4){bflo_(w0.x), bfhi_(w0.x), bflo_(w0.y), bfhi_(w0.y)} + (f32x4){bflo_(w1.x), bfhi_(w1.x), bflo_(w1.y), bfhi_(w1.y)} + (f32x4){bflo_(w2.x), bfhi_(w2.x), bflo_(w2.y), bfhi_(w2.y)};
                      *((unsigned*)(mg + (size_t)row * D) + lane + 64 * j) = pg8::pk4_fp8(8.f * v.x, 8.f * v.y, 8.f * v.z, 8.f * v.w); } } }
            { pg8::Gemm g{WSP(bf16, WS_MERGED), (const bf16*)(ws + WS_WOUT + (size_t)l * D * D), MP, D, D / 2, D / 2, D / 2}; pg8::StaticOrder S; S.init(MP, D, G, bid);
              pg8::EpiResid E{WSP(bf16, WS_XB), WSP(bf16, WS_XA), WSP(float, WS_MOD) + (size_t)l * NADA + 4096, 1.f / 512.f};
              pg8::gemm_phase<pg8::EpiResid, pg8::StaticOrder, true>(lds + RING_OFF, g, S, E, nullptr); }
            { CArgs* Ab = kargs(); XcdBarrier bar; bar.bar = (unsigned*)(Ab->ws + WS_CTL) + CW_BAR + Ab->li * XCD_BAR_WORDS; bar.x = xb_xcc_id(); bar.st = (volatile LAS unsigned*)(lds + MISC_OFF) + 8; xcd_barrier(bar); }
            { pg8::Gemm g{WSP(bf16, WS_MERGED), (const bf16*)(ws + WS_WOUT + (size_t)l * D * D), MTOT, D, D / 8, D / 2, D / 2}; pg8::SplitOrder S{MP / 256, MS / 256, D / 256, 4, D / 8, G, bid};
              pg8::EpiSlab E{WSP(bf16, WS_GIMG), D / 8, 1.f / 512.f};
              pg8::gemm_phase<pg8::EpiSlab, pg8::SplitOrder, true>(lds + RING_OFF, g, S, E, nullptr); }
            if (l == 0 && (int)blockIdx.x >= 64 && rg_ == 0) {
                __syncthreads();
                CArgs* A2 = kargs(); int t_ = (int)threadIdx.x; asm volatile("" : "+v"(t_));
                const int wv_ = __builtin_amdgcn_readfirstlane(t_ >> 6);
                conv_win(A2, A2->ws, 1, (LAS float*)(lds + RING_OFF + wv_ * 16384), ((int)blockIdx.x - 64) * NWAVES + wv_, (G - 64) * NWAVES, t_ & 63, 0, 1, 4);
                __syncthreads(); } }
        SEAM(pb + 5);
        if (EN_NORM && IN(pb + 6)) { TIDS(); CArgs* A = kargs(); unsigned char* const ws = A->ws;
            norm_rows(WSP(bf16, WS_XA), WSP(bf16, WS_XB) + (size_t)MP * D, false, A->in[14] + (size_t)l * D, WSP(float, WS_MOD) + (size_t)l * NADA + 6144, WSP(bf16, WS_XN), nullptr, nullptr, gw, ngw, lane, nullptr,
                      4, WSP(bf16, WS_GIMG), WSP(float, WS_MOD) + (size_t)l * NADA + 4096, WSP(bf16, WS_XA) + (size_t)MP * D, ws + WS_XN); }
        SEAM(pb + 6);
        if (EN_FF1 && IN(pb + 7)) for (int rg_ = 0; rg_ < REP_FF1; ++rg_) { CArgs* A = kargs(); unsigned char* const ws = A->ws;
            pg8::Gemm g{WSP(bf16, WS_XN), (const bf16*)(ws + WS_WFF1 + (size_t)l * DFF * D), MTOT, DFF, D / 2, D / 2, D / 2}; pg8::StaticOrder S; S.init(MTOT, DFF, G, bid);
            pg8::EpiRelu2F8 E{ws + WS_HFF, DFF, 1.f / 64.f};
            pg8::gemm_phase<pg8::EpiRelu2F8, pg8::StaticOrder, true>(lds + RING_OFF, g, S, E, nullptr);
            if (l == 0 && (int)blockIdx.x >= 64 && rg_ == 0) {
                __syncthreads();
                CArgs* A2 = kargs(); int t_ = (int)threadIdx.x; asm volatile("" : "+v"(t_));
                const int wv_ = __builtin_amdgcn_readfirstlane(t_ >> 6);
                conv_rest(A2, A2->ws, 1, (LAS float*)(lds + RING_OFF + wv_ * 16384), ((int)blockIdx.x - 64) * NWAVES + wv_, (G - 64) * NWAVES, t_ & 63, false, true);
                __syncthreads(); } }
        SEAM(pb + 7);
        if (EN_FF2 && IN(pb + 8)) for (int rg_ = 0; rg_ < REP_FF2; ++rg_) { CArgs* A = kargs(); unsigned char* const ws = A->ws;
            { pg8::Gemm g{WSP(bf16, WS_HFF), (const bf16*)(ws + WS_WFF2 + (size_t)l * D * DFF), MP, D, DFF / 2, DFF / 2, DFF / 2}; pg8::StaticOrder S; S.init(MP, D, G, bid);
              pg8::EpiResid E{WSP(bf16, WS_XA), WSP(bf16, WS_XB), WSP(float, WS_MOD) + (size_t)l * NADA + 10240, 1.f / 64.f};
              pg8::gemm_phase<pg8::EpiResid, pg8::StaticOrder, true>(lds + RING_OFF, g, S, E, nullptr); }
            { pg8::Gemm g{WSP(bf16, WS_HFF), (const bf16*)(ws + WS_WFF2 + (size_t)l * D * DFF), MTOT, D, DFF / 32, DFF / 2, DFF / 2}; pg8::SplitOrder S{MP / 256, MS / 256, D / 256, 16, DFF / 32, G, bid};
              pg8::EpiSlab E{WSP(bf16, WS_GIMG), DFF / 32, 1.f / 64.f};
              pg8::gemm_phase<pg8::EpiSlab, pg8::SplitOrder, true>(lds + RING_OFF, g, S, E, nullptr); } }
        SEAM(pb + 8);
    }
    if (EN_NORM && IN(20)) { TIDS(); CArgs* A = kargs(); unsigned char* const ws = A->ws;
        norm_rows(WSP(bf16, WS_XB), WSP(bf16, WS_XA) + (size_t)MP * D, false, A->in[39], nullptr, nullptr, A->out + O_YP, A->out + O_YS, gw, ngw, lane, nullptr,
                  16, WSP(bf16, WS_GIMG), WSP(float, WS_MOD) + (size_t)(DEPTH - 1) * NADA + 10240, WSP(bf16, WS_XB) + (size_t)MP * D); }
#undef IN
#undef SEAM
}

extern "C" void kernel_launch(void* const* d_in, const int* in_sizes, int n_in, void* d_out, int out_size, void* d_ws, size_t ws_size, hipStream_t stream) {
    static int grid = 0;
    if (grid == 0) {
        if (n_in != 40 || (size_t)out_size != O_END || ws_size < WS_END) { fprintf(stderr, "kernel_launch: unexpected shapes (n_in %d, out %d, ws %zu); nothing launched\n", n_in, out_size, ws_size); grid = -1; return; }
        if (hipFuncSetAttribute((const void*)mk_fwd, hipFuncAttributeMaxDynamicSharedMemorySize, LDS_BYTES) != hipSuccess) { fprintf(stderr, "kernel_launch: hipFuncSetAttribute failed\n"); grid = -1; return; }
        int per_cu = 0;
        if (hipOccupancyMaxActiveBlocksPerMultiprocessor(&per_cu, (const void*)mk_fwd, NTHREADS, LDS_BYTES) != hipSuccess || per_cu < 1)
            fprintf(stderr, "kernel_launch: note: occupancy query reports %d workgroups per CU\n", per_cu);
        (void)hipGetLastError();
        grid = GRID;
    }
    if (grid < 0) return;
    if (hipMemsetAsync((char*)d_ws + WS_CTL, 0, CTL_ZERO_BYTES, stream) != hipSuccess) { fprintf(stderr, "kernel_launch: hipMemsetAsync failed\n"); return; }
    Args a{};
    for (int i = 0; i < 40; ++i) a.in[i] = (const float*)d_in[i];
    a.out = (float*)d_out; a.ws = (unsigned char*)d_ws; a.pad = 0;
#ifndef PROBE_P
#define PROBE_P -1
#endif
#ifndef PROBE_G
#define PROBE_G 256
#endif
    int n_l = 0, lo_[4], hi_[4], fl_[4];
    if (N_LAUNCHES != 1) { for (int li = 0; li < PH_TOTAL; ++li) { a.ph_lo = li; a.ph_hi = li + 1; a.li = 0; a.pad = 0; hipLaunchKernelGGL(mk_fwd, dim3(grid), dim3(NTHREADS), LDS_BYTES, stream, a); } return; }
    if (PROBE_P < 0) { lo_[0] = 0; hi_[0] = PH_TOTAL; fl_[0] = grid; n_l = 1; }
#ifndef PROBE_Q
#define PROBE_Q PROBE_P
#endif
#ifdef PROBE_ABL
    else { lo_[0] = 0; hi_[0] = PROBE_P; fl_[0] = grid; lo_[1] = PROBE_P; hi_[1] = PROBE_Q + 1; fl_[1] = PROBE_G; lo_[2] = PROBE_P; hi_[2] = PH_TOTAL; fl_[2] = grid; n_l = 3; }
#else
    else { lo_[0] = 0; hi_[0] = PROBE_Q + 1; fl_[0] = grid; lo_[1] = PROBE_P; hi_[1] = PROBE_Q + 1; fl_[1] = PROBE_G; lo_[2] = PROBE_Q + 1; hi_[2] = PH_TOTAL; fl_[2] = grid; n_l = 3; }
#endif
    for (int li = 0; li < n_l; ++li) {
        a.ph_lo = lo_[li]; a.ph_hi = hi_[li]; a.li = li; a.pad = 0;
        hipLaunchKernelGGL(mk_fwd, dim3(fl_[li]), dim3(NTHREADS), LDS_BYTES, stream, a);
        const hipError_t le = hipPeekAtLastError();
        if (le != hipSuccess) { fprintf(stderr, "kernel_launch: launch %d failed: %s\n", li, hipGetErrorName(le)); break; }
    }
}
```
